# Optimizing an MI355X kernel written in HIP

```python
import math
import jax, jax.numpy as jnp
from jax import lax
import numpy as np


D_MODEL = 1024
BATCH = 8
SEQ = 4096
DEPTH = 2

CHUNK = 64
Q_BLOCK = 128
HEAD_DIM = 64
A_HEADS = 4
A_V_DIM = 2 * HEAD_DIM
B_HEADS = 8
B_KV_HEADS = 2
B_GROUP = B_HEADS // B_KV_HEADS
WINDOW = 128
W_CHUNKS = WINDOW // CHUNK
BAND = (W_CHUNKS + 1) * CHUNK
C_HEADS = 8
IDX_HEADS = 4
IDX_DIM = 32
TOPK_MAX = 256
NUM_BUCKETS = 32
MAX_DISTANCE = 1024
REL_HEADS = A_HEADS + B_HEADS + C_HEADS
N_BRANCH = 3
BRANCH_WIDTH = 512
N_GROUPS = 4
EXPERTS_PER_GROUP = 4
N_EXPERTS = N_GROUPS * EXPERTS_PER_GROUP
TOP_E = 2
EXPERT_FF = 256
EPS = 1e-6
NEG = -1e30

COL_SIZES = (A_HEADS * 2 * HEAD_DIM, A_HEADS * 2 * HEAD_DIM, A_HEADS * A_V_DIM,
             B_HEADS * HEAD_DIM, B_KV_HEADS * HEAD_DIM, B_KV_HEADS * HEAD_DIM,
             C_HEADS * HEAD_DIM, HEAD_DIM, HEAD_DIM,
             IDX_HEADS * IDX_DIM, IDX_DIM, IDX_HEADS)
IN_COLS = sum(COL_SIZES)

kernel_name = 'hybrid_chunk_causal_block'


def rms_norm(x, g):
    xf = x.astype(jnp.float32)
    y = xf * lax.rsqrt(jnp.mean(xf * xf, axis=-1, keepdims=True) + EPS)
    return (y * g.astype(jnp.float32)).astype(x.dtype)


def t5_bucket(rel):
    half = NUM_BUCKETS // 2
    max_exact = half // 2
    n = jnp.abs(rel)
    n_f = jnp.maximum(n, 1).astype(jnp.float32)
    large = max_exact + (jnp.log(n_f / max_exact) / math.log(MAX_DISTANCE / max_exact)
                         * (half - max_exact)).astype(jnp.int32)
    large = jnp.minimum(large, half - 1)
    return jnp.where(rel > 0, half, 0) + jnp.where(n < max_exact, n, large)


def band_chunks(t, n_chunks):
    tc = t.reshape(t.shape[0], n_chunks, CHUNK, *t.shape[2:])
    pad = [(0, 0), (W_CHUNKS, 0)] + [(0, 0)] * (tc.ndim - 2)
    tp = jnp.pad(tc, pad)
    return jnp.concatenate([tp[:, i:i + n_chunks] for i in range(W_CHUNKS + 1)], axis=2)


def diff_attention(q, k, v, bias_tab, q_g, k_g, lam_par, subln_g, lambda_init):
    bsz, seq = q.shape[0], q.shape[1]
    n_blocks = seq // Q_BLOCK
    q = rms_norm(q, q_g) * (HEAD_DIM ** -0.5)
    k = rms_norm(k, k_g)
    lp = lam_par.astype(jnp.float32)
    lam = jnp.exp(jnp.sum(lp[0] * lp[1])) - jnp.exp(jnp.sum(lp[2] * lp[3])) + lambda_init
    q_blocks = jnp.moveaxis(q.reshape(bsz, n_blocks, Q_BLOCK, A_HEADS, 2, HEAD_DIM), 1, 0)
    starts = jnp.arange(n_blocks, dtype=jnp.int32) * Q_BLOCK
    key_pos = jnp.arange(seq, dtype=jnp.int32)

    def one_block(args):
        qb, start = args
        q_pos = start + jnp.arange(Q_BLOCK, dtype=jnp.int32)
        bias = bias_tab[t5_bucket(key_pos[None, :] - q_pos[:, None])]
        allowed = (key_pos[None, :] // CHUNK) <= (q_pos[:, None] // CHUNK)
        s = jnp.einsum('bqhmd,bkhmd->bhmqk', qb, k).astype(jnp.float32)
        s = s + jnp.transpose(bias, (2, 0, 1)).astype(jnp.float32)[None, :, None]
        s = jnp.where(allowed, s, NEG)
        p = jax.nn.softmax(s, axis=-1)
        p = p[:, :, 0] - lam * p[:, :, 1]
        return jnp.einsum('bhqk,bkhe->bqhe', p.astype(v.dtype), v)

    out = lax.map(one_block, (q_blocks, starts))
    out = jnp.moveaxis(out, 0, 1).reshape(bsz, seq, A_HEADS, A_V_DIM)
    out = rms_norm(out, subln_g) * (1.0 - lambda_init)
    return out.reshape(bsz, seq, A_HEADS * A_V_DIM)


def sliding_sink_attention(q, k, v, bias_tab, q_g, k_g, sinks):
    bsz, seq = q.shape[0], q.shape[1]
    n_chunks = seq // CHUNK
    q = rms_norm(q, q_g) * (HEAD_DIM ** -0.5)
    k = rms_norm(k, k_g)
    q = q.reshape(bsz, n_chunks, CHUNK, B_KV_HEADS, B_GROUP, HEAD_DIM)
    k_band = band_chunks(k, n_chunks)
    v_band = band_chunks(v, n_chunks)
    k_off = jnp.arange(BAND, dtype=jnp.int32) - W_CHUNKS * CHUNK
    q_off = jnp.arange(CHUNK, dtype=jnp.int32)
    bias = bias_tab[t5_bucket(k_off[None, :] - q_off[:, None])]
    bias = jnp.transpose(bias.reshape(CHUNK, BAND, B_KV_HEADS, B_GROUP), (2, 3, 0, 1)).astype(jnp.float32)
    valid = (jnp.arange(n_chunks, dtype=jnp.int32)[:, None] * CHUNK + k_off[None, :]) >= 0
    s = jnp.einsum('bcqhgd,bckhd->bchgqk', q, k_band).astype(jnp.float32) + bias
    s = jnp.where(valid[None, :, None, None, None, :], s, NEG)
    sink = sinks.astype(jnp.float32).reshape(B_KV_HEADS, B_GROUP)[None, None, :, :, None, None]
    m = jnp.maximum(jnp.max(s, axis=-1, keepdims=True), sink)
    e = jnp.exp(s - m)
    p = e / (jnp.sum(e, axis=-1, keepdims=True) + jnp.exp(sink - m))
    out = jnp.einsum('bchgqk,bckhd->bcqhgd', p.astype(v.dtype), v_band)
    return out.reshape(bsz, seq, B_HEADS * HEAD_DIM)


def dsa_attention(q, k, v, q_idx, k_idx, w_idx, bias_tab, q_g, k_g):
    bsz, seq = q.shape[0], q.shape[1]
    n_blocks = seq // Q_BLOCK
    top_k = min(TOPK_MAX, seq // 4)
    q = rms_norm(q, q_g) * (HEAD_DIM ** -0.5)
    k = rms_norm(k, k_g)
    w_idx = w_idx.astype(jnp.float32) * (IDX_HEADS ** -0.5 * IDX_DIM ** -0.5)

    def blocks(t):
        return jnp.moveaxis(t.reshape(bsz, n_blocks, Q_BLOCK, *t.shape[2:]), 1, 0)

    starts = jnp.arange(n_blocks, dtype=jnp.int32) * Q_BLOCK
    key_chunk = jnp.arange(seq, dtype=jnp.int32) // CHUNK
    gather = jax.vmap(lambda table, idx: table[idx])

    def one_block(args):
        qb, qib, wib, start = args
        q_pos = start + jnp.arange(Q_BLOCK, dtype=jnp.int32)
        q_chunk = q_pos // CHUNK
        logits = jnp.einsum('bqhd,bkd->bqhk', qib, k_idx).astype(jnp.float32)
        score = jnp.einsum('bqhk,bqh->bqk', jax.nn.relu(logits), wib)
        score = jnp.where(key_chunk[None, None, :] <= q_chunk[None, :, None], score, NEG)
        _, sel = lax.top_k(score, top_k)
        k_sel = gather(k, sel)
        v_sel = gather(v, sel)
        bias = bias_tab[t5_bucket(sel - q_pos[None, :, None])]
        ok = (sel // CHUNK) <= q_chunk[None, :, None]
        s = jnp.einsum('bqhd,bqkd->bqhk', qb, k_sel).astype(jnp.float32)
        s = s + jnp.swapaxes(bias, -1, -2).astype(jnp.float32)
        s = jnp.where(ok[:, :, None, :], s, NEG)
        p = jax.nn.softmax(s, axis=-1)
        return jnp.einsum('bqhk,bqkd->bqhd', p.astype(v.dtype), v_sel)

    out = lax.map(one_block, (blocks(q), blocks(q_idx), blocks(w_idx), starts))
    return jnp.moveaxis(out, 0, 1).reshape(bsz, seq, C_HEADS * HEAD_DIM)


def hybrid_mixer(h, rel_bias, w_in, qk_g, lam_par, subln_g, sinks, w_branch, w_gate, b_gate, w_out, lambda_init):
    bsz, seq = h.shape[0], h.shape[1]
    proj = h @ w_in
    split_points = np.cumsum(COL_SIZES)[:-1].tolist()
    aq, ak, av, bq, bk, bv, cq, ck, cv, iq, ik, iw = jnp.split(proj, split_points, axis=-1)
    oa = diff_attention(aq.reshape(bsz, seq, A_HEADS, 2, HEAD_DIM),
                        ak.reshape(bsz, seq, A_HEADS, 2, HEAD_DIM),
                        av.reshape(bsz, seq, A_HEADS, A_V_DIM),
                        rel_bias[:, :A_HEADS], qk_g[0, 0], qk_g[0, 1], lam_par, subln_g, lambda_init)
    ob = sliding_sink_attention(bq.reshape(bsz, seq, B_HEADS, HEAD_DIM),
                                bk.reshape(bsz, seq, B_KV_HEADS, HEAD_DIM),
                                bv.reshape(bsz, seq, B_KV_HEADS, HEAD_DIM),
                                rel_bias[:, A_HEADS:A_HEADS + B_HEADS], qk_g[1, 0], qk_g[1, 1], sinks)
    oc = dsa_attention(cq.reshape(bsz, seq, C_HEADS, HEAD_DIM), ck, cv,
                       iq.reshape(bsz, seq, IDX_HEADS, IDX_DIM), ik, iw,
                       rel_bias[:, A_HEADS + B_HEADS:], qk_g[2, 0], qk_g[2, 1])
    branches = jnp.stack([oa, ob, oc], axis=2)
    y = jnp.einsum('bsnw,nwd->bsnd', branches, w_branch)
    gates = jax.nn.sigmoid(h @ w_gate + b_gate).reshape(bsz, seq, N_BRANCH, D_MODEL)
    return jnp.sum(gates * y, axis=2) @ w_out


def hier_moe(h, w_rg, b_rg, w_re, b_re, w_g, w_u, w_d):
    bsz, seq = h.shape[0], h.shape[1]
    g_logits = (h @ w_rg + b_rg).astype(jnp.float32)
    g_prob = jax.nn.softmax(g_logits, axis=-1)
    _, g_sel = lax.top_k(g_logits, 1)
    p_group = jnp.take_along_axis(g_prob, g_sel, axis=-1)
    e_logits = (h @ w_re + b_re).astype(jnp.float32).reshape(bsz, seq, N_GROUPS, EXPERTS_PER_GROUP)
    e_in_group = jnp.take_along_axis(e_logits, g_sel[..., None], axis=2)[:, :, 0]
    e_val, e_sel = lax.top_k(e_in_group, TOP_E)
    weights = jax.nn.softmax(e_val, axis=-1) * p_group
    expert_id = g_sel * EXPERTS_PER_GROUP + e_sel
    gate = jnp.sum(jax.nn.one_hot(expert_id, N_EXPERTS, dtype=jnp.float32) * weights[..., None], axis=2)
    hid = jax.nn.silu(jnp.einsum('bsd,edf->bsef', h, w_g)) * jnp.einsum('bsd,edf->bsef', h, w_u)
    hid = hid * gate[..., None].astype(hid.dtype)
    return jnp.einsum('bsef,efd->bsd', hid, w_d)


def setup_inputs(seed: int = 0) -> dict:
    key = jax.random.key(seed)
    ks = jax.random.split(key, 20)

    def nrm(k, shape, scale):
        return jax.random.normal(k, shape, jnp.float32) * scale

    return {
        'x': nrm(ks[0], (BATCH, SEQ, D_MODEL), 1.0),
        'rel_bias': nrm(ks[1], (NUM_BUCKETS, REL_HEADS), 0.5),
        'norm_mix_g': 1.0 + nrm(ks[2], (DEPTH, D_MODEL), 0.05),
        'w_in': nrm(ks[3], (DEPTH, D_MODEL, IN_COLS), D_MODEL ** -0.5),
        'qk_norm_g': 1.0 + nrm(ks[4], (DEPTH, N_BRANCH, 2, HEAD_DIM), 0.05),
        'diff_lambda': nrm(ks[5], (DEPTH, 4, HEAD_DIM), 0.1),
        'diff_subln_g': 1.0 + nrm(ks[6], (DEPTH, A_V_DIM), 0.05),
        'sinks': nrm(ks[7], (DEPTH, B_HEADS), 0.5),
        'w_branch': nrm(ks[8], (DEPTH, N_BRANCH, BRANCH_WIDTH, D_MODEL), BRANCH_WIDTH ** -0.5),
        'w_gate': nrm(ks[9], (DEPTH, D_MODEL, N_BRANCH * D_MODEL), D_MODEL ** -0.5),
        'b_gate': nrm(ks[10], (DEPTH, N_BRANCH * D_MODEL), 0.02),
        'w_out': nrm(ks[11], (DEPTH, D_MODEL, D_MODEL), D_MODEL ** -0.5),
        'norm_ffn_g': 1.0 + nrm(ks[12], (DEPTH, D_MODEL), 0.05),
        'w_router_group': nrm(ks[13], (DEPTH, D_MODEL, N_GROUPS), D_MODEL ** -0.5),
        'b_router_group': nrm(ks[14], (DEPTH, N_GROUPS), 0.01),
        'w_router_expert': nrm(ks[15], (DEPTH, D_MODEL, N_EXPERTS), D_MODEL ** -0.5),
        'b_router_expert': nrm(ks[16], (DEPTH, N_EXPERTS), 0.01),
        'w_ff_gate': nrm(ks[17], (DEPTH, N_EXPERTS, D_MODEL, EXPERT_FF), D_MODEL ** -0.5),
        'w_ff_up': nrm(ks[18], (DEPTH, N_EXPERTS, D_MODEL, EXPERT_FF), D_MODEL ** -0.5),
        'w_ff_down': nrm(ks[19], (DEPTH, N_EXPERTS, EXPERT_FF, D_MODEL), EXPERT_FF ** -0.5),
    }


def reference(x, rel_bias, norm_mix_g, w_in, qk_norm_g, diff_lambda, diff_subln_g, sinks,
              w_branch, w_gate, b_gate, w_out, norm_ffn_g, w_router_group, b_router_group,
              w_router_expert, b_router_expert, w_ff_gate, w_ff_up, w_ff_down):
    for l in range(DEPTH):
        lambda_init = 0.8 - 0.6 * math.exp(-0.3 * l)
        h = rms_norm(x, norm_mix_g[l])
        x = x + hybrid_mixer(h, rel_bias, w_in[l], qk_norm_g[l], diff_lambda[l], diff_subln_g[l],
                             sinks[l], w_branch[l], w_gate[l], b_gate[l], w_out[l], lambda_init)
        h = rms_norm(x, norm_ffn_g[l])
        x = x + hier_moe(h, w_router_group[l], b_router_group[l], w_router_expert[l], b_router_expert[l],
                         w_ff_gate[l], w_ff_up[l], w_ff_down[l])
    return x
```

```cpp
#include <hip/hip_runtime.h>
#include <stdint.h>
#include <stdio.h>

#ifndef FUSED
#define FUSED 1
#endif

#define LAS __attribute__((address_space(3)))
typedef unsigned short bf16_t;

constexpr int NB = 8, NS = 4096, ND = 1024, NTOK = NB * NS;
constexpr int IN_COLS = 3108;
constexpr float LOG2E = 1.4426950408889634f;
constexpr float QSCALE = 0.125f * LOG2E;
constexpr float EPS = 1e-6f;
constexpr float IWSCALE = 0.08838834764831845f;

constexpr size_t MB = (size_t)1 << 20;
constexpr size_t OFF_CTRL = 0;
constexpr size_t CTRL_BYTES = 65536;
constexpr size_t OFF_ROUTE = 1 * MB;
constexpr size_t OFF_WT = 5 * MB;
constexpr size_t OFF_H = 49 * MB;
constexpr size_t OFF_BR = 113 * MB;
constexpr size_t OFF_PROJ = 209 * MB;
constexpr size_t OFF_MERGED = OFF_PROJ + 192 * MB;
constexpr size_t PO_AQ = 0, PO_AK = 32 * MB, PO_AV = 64 * MB, PO_BQ = 96 * MB, PO_BK = 128 * MB, PO_BV = 136 * MB, PO_CQ = 144 * MB,
                 PO_CK = 176 * MB, PO_CV = 180 * MB, PO_IQ = 184 * MB, PO_IK = 192 * MB, PO_IW = 194 * MB;

struct Params {
    const float* in[20];
    float* out;
    char* ws;
};
enum { I_X = 0, I_RELB, I_NMG, I_WIN, I_QKG, I_LAM, I_SUBLN, I_SINK, I_WBR, I_WGATE, I_BGATE, I_WOUT, I_NFG, I_WRG, I_BRG, I_WRE, I_BRE, I_WFG, I_WFU, I_WFD };

struct Proj { bf16_t *aq, *ak, *av, *bq, *bk, *bv, *cq, *ck, *cv, *iq, *ik; float* iw; };
__device__ __forceinline__ Proj proj_ptrs(char* ws) {
    char* p = ws + OFF_PROJ; Proj r;
    r.aq = (bf16_t*)(p + PO_AQ); r.ak = (bf16_t*)(p + PO_AK); r.av = (bf16_t*)(p + PO_AV); r.bq = (bf16_t*)(p + PO_BQ); r.bk = (bf16_t*)(p + PO_BK); r.bv = (bf16_t*)(p + PO_BV);
    r.cq = (bf16_t*)(p + PO_CQ); r.ck = (bf16_t*)(p + PO_CK); r.cv = (bf16_t*)(p + PO_CV); r.iq = (bf16_t*)(p + PO_IQ); r.ik = (bf16_t*)(p + PO_IK); r.iw = (float*)(p + PO_IW);
    return r;
}

__device__ __forceinline__ int tid_opaque() { int t = threadIdx.x; asm volatile("" : "+v"(t)); return t; }
__device__ __forceinline__ float bf2f(bf16_t b) { return __uint_as_float(((unsigned)b) << 16); }
__device__ __forceinline__ bf16_t f2bf(float f) { unsigned u = __float_as_uint(f); u += 0x7FFFu + ((u >> 16) & 1u); return (bf16_t)(u >> 16); }
__device__ __forceinline__ float bflo(unsigned w) { return __uint_as_float(w << 16); }
__device__ __forceinline__ float bfhi(unsigned w) { return __uint_as_float(w & 0xffff0000u); }
__device__ __forceinline__ unsigned pack2(float lo, float hi) { return (unsigned)f2bf(lo) | ((unsigned)f2bf(hi) << 16); }
__device__ __forceinline__ float wsum(float v) { for (int o = 32; o; o >>= 1) v += __shfl_xor(v, o); return v; }
__device__ __forceinline__ float wmax(float v) { for (int o = 32; o; o >>= 1) v = fmaxf(v, __shfl_xor(v, o)); return v; }
__device__ __forceinline__ int t5_bucket(int rel) {
    const int n = rel < 0 ? -rel : rel;
    int b = n;
    if (n >= 8) b = 8 + (n >= 15) + (n >= 27) + (n >= 50) + (n >= 91) + (n >= 166) + (n >= 305) + (n >= 559);
    return (rel > 0 ? 16 : 0) + b;
}
__device__ __forceinline__ float lambda_init_of(int l) { return 0.8f - 0.6f * expf(-0.3f * (float)l); }
__device__ __forceinline__ float dot8(uint4 kv, const float* q) {
    return bflo(kv.x) * q[0] + bfhi(kv.x) * q[1] + bflo(kv.y) * q[2] + bfhi(kv.y) * q[3] + bflo(kv.z) * q[4] + bfhi(kv.z) * q[5] + bflo(kv.w) * q[6] + bfhi(kv.w) * q[7];
}


#define XB_TMO      128
#define XB_XCNT(j)  (256  + 64 * (j))
#define XB_XSUB(j)  (1280 + 64 * (j))
#define XB_XGEN(j)  (2304 + 64 * (j))
#define XB_TOP      3328
#define XB_TOPGEN   3392
#define XCD_BAR_WORDS 3456
#define XB_SPIN_CAP (1u << 18)
__device__ __forceinline__ unsigned xb_ld(unsigned* p)              { return __hip_atomic_load(p, __ATOMIC_RELAXED, __HIP_MEMORY_SCOPE_AGENT); }
__device__ __forceinline__ unsigned xb_add(unsigned* p, unsigned v) { return __hip_atomic_fetch_add(p, v, __ATOMIC_RELAXED, __HIP_MEMORY_SCOPE_AGENT); }
__device__ __forceinline__ unsigned xb_xcc_id() { return (unsigned)__builtin_amdgcn_s_getreg((3 << 11) | 20) & 0xFu; }
#define XB_SPIN(cond, bar) do { unsigned _sp = 0; while (cond) { __builtin_amdgcn_s_sleep(1); \
    if ((++_sp & 255u) == 0u) { if (xb_ld(&(bar)[XB_TMO])) break; if (_sp > XB_SPIN_CAP) { atomicAdd(&(bar)[XB_TMO], 1u); break; } } } } while (0)
struct XcdBarrier { unsigned* bar; unsigned x; volatile LAS unsigned* st; };
__device__ __forceinline__ XcdBarrier xcd_barrier_post(unsigned* bar, volatile LAS unsigned* st) {
    XcdBarrier b; b.bar = bar; b.x = xb_xcc_id(); b.st = st;
    if (threadIdx.x == 0) (void)xb_add(&bar[XB_XCNT(b.x)], 1u);
    return b;
}
__device__ __forceinline__ void xcd_barrier_complete(unsigned* bar, unsigned x, unsigned& nloc, unsigned& nx) {
    const unsigned G = gridDim.x * gridDim.y * gridDim.z;
    unsigned sum, cnt, mine, sp = 0u;
    for (;;) {
        sum = 0u; cnt = 0u; mine = 0u;
#pragma unroll
        for (unsigned j = 0; j < 16; ++j) { const unsigned c = xb_ld(&bar[XB_XCNT(j)]); sum += c; cnt += (c > 0u) ? 1u : 0u; mine = (j == x) ? c : mine; }
        if (sum == G) break;
        __builtin_amdgcn_s_sleep(1);
        if ((++sp & 255u) == 0u) { if (xb_ld(&bar[XB_TMO])) break; if (sp > XB_SPIN_CAP) { atomicAdd(&bar[XB_TMO], 1u); break; } }
    }
    nloc = mine > 0u ? mine : 1u; nx = cnt > 0u ? cnt : 1u;
}
__device__ __forceinline__ void xcd_barrier(const XcdBarrier& b) {
    asm volatile("s_waitcnt vmcnt(0)" ::: "memory");
    __syncthreads();
    if (threadIdx.x == 0) {
        unsigned* bar = b.bar;
        __builtin_amdgcn_s_waitcnt(0);
        unsigned nloc = b.st[0], nx = b.st[1];
        if (nloc == 0u) { xcd_barrier_complete(bar, b.x, nloc, nx); b.st[0] = nloc; b.st[1] = nx; }
        const unsigned old = xb_add(&bar[XB_XSUB(b.x)], 1u);
        const unsigned gen = old / nloc;
        if (old + 1u == (gen + 1u) * nloc) {
            __builtin_amdgcn_fence(__ATOMIC_RELEASE, "agent");
            asm volatile("s_waitcnt vmcnt(0)" ::: "memory");
            const unsigned og = xb_add(&bar[XB_TOP], 1u);
            const unsigned tg = og / nx;
            if (og + 1u == (tg + 1u) * nx) xb_add(&bar[XB_TOPGEN], 1u);
            else XB_SPIN(xb_ld(&bar[XB_TOPGEN]) == tg, bar);
            __builtin_amdgcn_fence(__ATOMIC_ACQUIRE, "agent");
            xb_add(&bar[XB_XGEN(b.x)], 1u);
            asm volatile("s_waitcnt vmcnt(0)" ::: "memory");
        } else {
            XB_SPIN(xb_ld(&bar[XB_XGEN(b.x)]) == gen, bar);
            __builtin_amdgcn_fence(__ATOMIC_ACQUIRE, "agent");
            asm volatile("s_waitcnt vmcnt(0)" ::: "memory");
        }
    }
    __syncthreads();
}

__device__ __forceinline__ void ngemm_tile(const bf16_t* A, int lda, const float* W, int ldw, int K, int ncols, int row0, int col0, float (&acc)[8][4], float* lds) {
    float* As = lds; float* Bs = lds + 16 * 132;
    const int tid = tid_opaque(), ty = tid >> 5, tx = tid & 31;
#pragma unroll
    for (int i = 0; i < 8; ++i)
#pragma unroll
        for (int j = 0; j < 4; ++j) acc[i][j] = 0.f;
    for (int k0 = 0; k0 < K; k0 += 16) {
        {
            const int r = tid >> 2, kq = (tid & 3) * 4;
            const uint2 v = *(const uint2*)(A + (size_t)(row0 + r) * lda + k0 + kq);
            As[(kq + 0) * 132 + r] = bflo(v.x); As[(kq + 1) * 132 + r] = bfhi(v.x); As[(kq + 2) * 132 + r] = bflo(v.y); As[(kq + 3) * 132 + r] = bfhi(v.y);
        }
        {
            const int k = tid >> 5, c = (tid & 31) * 4;
            const float* wp = W + (size_t)(k0 + k) * ldw + col0 + c;
            float4 v = make_float4(0.f, 0.f, 0.f, 0.f);
            if (col0 + c + 3 < ncols) v = *(const float4*)wp;
            else { if (col0 + c < ncols) v.x = wp[0]; if (col0 + c + 1 < ncols) v.y = wp[1]; if (col0 + c + 2 < ncols) v.z = wp[2]; }
            *(float4*)(Bs + k * 128 + c) = v;
        }
        __syncthreads();
#pragma unroll 2
        for (int kk = 0; kk < 16; ++kk) {
            const float4 a0 = *(const float4*)(As + kk * 132 + ty * 8), a1 = *(const float4*)(As + kk * 132 + ty * 8 + 4);
            const float4 b = *(const float4*)(Bs + kk * 128 + tx * 4);
            const float a[8] = {a0.x, a0.y, a0.z, a0.w, a1.x, a1.y, a1.z, a1.w}; const float bb[4] = {b.x, b.y, b.z, b.w};
#pragma unroll
            for (int i = 0; i < 8; ++i)
#pragma unroll
                for (int j = 0; j < 4; ++j) acc[i][j] += a[i] * bb[j];
        }
        __syncthreads();
    }
}

__device__ void ph_rmsnorm(const float* xsrc, const float* g, bf16_t* H) {
    const int tidq = tid_opaque(); const int lane = tidq & 63, wid = tidq >> 6;
    for (int row = blockIdx.x * 8 + wid; row < NTOK; row += gridDim.x * 8) {
        const float4* xp = (const float4*)(xsrc + (size_t)row * ND);
        float4 v[4]; float ss = 0.f;
#pragma unroll
        for (int j = 0; j < 4; ++j) { v[j] = xp[j * 64 + lane]; ss += v[j].x * v[j].x + v[j].y * v[j].y + v[j].z * v[j].z + v[j].w * v[j].w; }
        ss = wsum(ss);
        const float rstd = rsqrtf(ss * (1.0f / ND) + EPS);
#pragma unroll
        for (int j = 0; j < 4; ++j) {
            const float4 gv = ((const float4*)g)[j * 64 + lane];
            uint2 o; o.x = pack2(v[j].x * rstd * gv.x, v[j].y * rstd * gv.y); o.y = pack2(v[j].z * rstd * gv.z, v[j].w * rstd * gv.w);
            *(uint2*)(H + (size_t)row * ND + (j * 64 + lane) * 4) = o;
        }
    }
}

__device__ __forceinline__ void store_proj_raw(const Proj& pj, int tok, int c, float v) {
    if (c < 512) pj.aq[(size_t)tok * 512 + c] = f2bf(v);
    else if (c < 1024) pj.ak[(size_t)tok * 512 + c - 512] = f2bf(v);
    else if (c < 1536) pj.av[(size_t)tok * 512 + c - 1024] = f2bf(v);
    else if (c < 2048) pj.bq[(size_t)tok * 512 + c - 1536] = f2bf(v);
    else if (c < 2176) pj.bk[(size_t)tok * 128 + c - 2048] = f2bf(v);
    else if (c < 2304) pj.bv[(size_t)tok * 128 + c - 2176] = f2bf(v);
    else if (c < 2816) pj.cq[(size_t)tok * 512 + c - 2304] = f2bf(v);
    else if (c < 2880) pj.ck[(size_t)tok * 64 + c - 2816] = f2bf(v);
    else if (c < 2944) pj.cv[(size_t)tok * 64 + c - 2880] = f2bf(v);
    else if (c < 3072) pj.iq[(size_t)tok * 128 + c - 2944] = f2bf(v);
    else if (c < 3104) pj.ik[(size_t)tok * 32 + c - 3072] = f2bf(v);
    else if (c < 3108) pj.iw[(size_t)tok * 4 + c - 3104] = v * IWSCALE;
}
__device__ void ph_inproj_naive(const Params& P, int l, float* lds) {
    const Proj pj = proj_ptrs(P.ws);
    const bf16_t* H = (const bf16_t*)(P.ws + OFF_H);
    const float* W = P.in[I_WIN] + (size_t)l * ND * IN_COLS;
    const int tid = tid_opaque(), ty = tid >> 5, tx = tid & 31;
    for (int t = blockIdx.x; t < 256 * 25; t += gridDim.x) {
        const int tm = t / 25, tn = t % 25;
        float acc[8][4];
        ngemm_tile(H, ND, W, IN_COLS, ND, IN_COLS, tm * 128, tn * 128, acc, lds);
#pragma unroll
        for (int i = 0; i < 8; ++i)
#pragma unroll
            for (int j = 0; j < 4; ++j) { const int c = tn * 128 + tx * 4 + j; if (c < IN_COLS) store_proj_raw(pj, tm * 128 + ty * 8 + i, c, acc[i][j]); }
    }
}
__device__ void ph_headnorm_naive(const Params& P, int l) {
    const Proj pj = proj_ptrs(P.ws);
    const float* qkg = P.in[I_QKG] + (size_t)l * 3 * 2 * 64;
    const int tidq = tid_opaque(); const int lane = tidq & 63, wid = tidq >> 6;
    for (long t = (long)blockIdx.x * 8 + wid; t < (long)NTOK * 35; t += (long)gridDim.x * 8) {
        const int tok = (int)(t / 35), g = (int)(t % 35);
        bf16_t* p; const float* gv; float sc = 1.f;
        if (g < 8) { p = pj.aq + (size_t)tok * 512 + g * 64; gv = qkg + 0; sc = QSCALE; }
        else if (g < 16) { p = pj.ak + (size_t)tok * 512 + (g - 8) * 64; gv = qkg + 64; }
        else if (g < 24) { p = pj.bq + (size_t)tok * 512 + (g - 16) * 64; gv = qkg + 128; sc = QSCALE; }
        else if (g < 26) { p = pj.bk + (size_t)tok * 128 + (g - 24) * 64; gv = qkg + 192; }
        else if (g < 34) { p = pj.cq + (size_t)tok * 512 + (g - 26) * 64; gv = qkg + 256; sc = QSCALE; }
        else { p = pj.ck + (size_t)tok * 64; gv = qkg + 320; }
        const float v = bf2f(p[lane]);
        const float ss = wsum(v * v);
        p[lane] = f2bf(v * rsqrtf(ss * (1.0f / 64) + EPS) * gv[lane] * sc);
    }
}

__device__ void ph_attnA_naive(const Params& P, int l, float* lds) {
    const Proj pj = proj_ptrs(P.ws);
    bf16_t* BR = (bf16_t*)(P.ws + OFF_BR);
    const int tidq = tid_opaque(); const int lane = tidq & 63, wid = tidq >> 6;
    float* btab = lds;
    float* qs = lds + 128 + wid * 128;
    for (int i = tidq; i < 128; i += 512) btab[i] = P.in[I_RELB][(i >> 2) * 20 + (i & 3)] * LOG2E;
    __syncthreads();
    const float* lp = P.in[I_LAM] + (size_t)l * 256;
    const float linit = lambda_init_of(l);
    const float lam = expf(wsum(lp[lane] * lp[64 + lane])) - expf(wsum(lp[128 + lane] * lp[192 + lane])) + linit;
    const float* subg = P.in[I_SUBLN] + (size_t)l * 128;
    for (int t = blockIdx.x * 8 + wid; t < NB * 4 * NS; t += gridDim.x * 8) {
        const int q = t & (NS - 1), h = (t >> 12) & 3, b = t >> 14;
        const int tok = b * NS + q;
        qs[lane] = bf2f(pj.aq[(size_t)tok * 512 + (h * 2) * 64 + lane]);
        qs[64 + lane] = bf2f(pj.aq[(size_t)tok * 512 + (h * 2 + 1) * 64 + lane]);
        const int nkt = (q >> 6) + 1;
        float M0 = -INFINITY, Z0 = 0.f, M1 = -INFINITY, Z1 = 0.f;
        for (int kt = 0; kt < nkt; ++kt) {
            asm volatile("" ::: "memory");
            const int key = kt * 64 + lane;
            const uint4* kp = (const uint4*)(pj.ak + (size_t)(b * NS + key) * 512 + h * 128);
            float s0 = 0.f, s1 = 0.f;
#pragma unroll 1
            for (int d = 0; d < 8; ++d) { asm volatile("" ::: "memory"); s0 += dot8(kp[d], qs + d * 8); s1 += dot8(kp[8 + d], qs + 64 + d * 8); }
            const float bias = btab[t5_bucket(key - q) * 4 + h];
            s0 += bias; s1 += bias;
            float mn = fmaxf(M0, s0); Z0 = Z0 * exp2f(M0 - mn) + exp2f(s0 - mn); M0 = mn;
            mn = fmaxf(M1, s1); Z1 = Z1 * exp2f(M1 - mn) + exp2f(s1 - mn); M1 = mn;
        }
        { const float mw = wmax(M0); Z0 = wsum(Z0 * exp2f(M0 - mw)); M0 = mw; }
        { const float mw = wmax(M1); Z1 = wsum(Z1 * exp2f(M1 - mw)); M1 = mw; }
        const float iz0 = 1.f / Z0, iz1 = lam / Z1;
        float a0 = 0.f, a1 = 0.f;
        for (int kt = 0; kt < nkt; ++kt) {
            asm volatile("" ::: "memory");
            const int key = kt * 64 + lane;
            const uint4* kp = (const uint4*)(pj.ak + (size_t)(b * NS + key) * 512 + h * 128);
            float s0 = 0.f, s1 = 0.f;
#pragma unroll 1
            for (int d = 0; d < 8; ++d) { asm volatile("" ::: "memory"); s0 += dot8(kp[d], qs + d * 8); s1 += dot8(kp[8 + d], qs + 64 + d * 8); }
            const float bias = btab[t5_bucket(key - q) * 4 + h];
            const float p = exp2f(s0 + bias - M0) * iz0 - exp2f(s1 + bias - M1) * iz1;
            const unsigned* vp = (const unsigned*)(pj.av + (size_t)(b * NS + kt * 64) * 512 + h * 128) + lane;
#pragma unroll 4
            for (int j = 0; j < 64; ++j) { const float pjv = __shfl(p, j); const unsigned w = vp[(size_t)j * 256]; a0 += pjv * bflo(w); a1 += pjv * bfhi(w); }
        }
        const float ss = wsum(a0 * a0 + a1 * a1);
        const float rstd = rsqrtf(ss * (1.0f / 128) + EPS) * (1.0f - linit);
        *(unsigned*)(BR + (size_t)tok * 1536 + h * 128 + lane * 2) = pack2(a0 * rstd * subg[lane * 2], a1 * rstd * subg[lane * 2 + 1]);
    }
}

__device__ void ph_attnB_naive(const Params& P, int l, float* lds) {
    const Proj pj = proj_ptrs(P.ws);
    bf16_t* BR = (bf16_t*)(P.ws + OFF_BR);
    const int tidq = tid_opaque(); const int lane = tidq & 63, wid = tidq >> 6;
    float* btab = lds;
    float* qs = lds + 256 + wid * 64;
    __syncthreads();
    for (int i = tidq; i < 256; i += 512) btab[i] = P.in[I_RELB][(i >> 3) * 20 + 4 + (i & 7)] * LOG2E;
    __syncthreads();
    const float* sinks = P.in[I_SINK] + (size_t)l * 8;
    for (int t = blockIdx.x * 8 + wid; t < NTOK * 8; t += gridDim.x * 8) {
        const int hq = t & 7, tok = t >> 3, q = tok & (NS - 1), b = tok >> 12, kvh = hq >> 2, c = q >> 6;
        qs[lane] = bf2f(pj.bq[(size_t)tok * 512 + hq * 64 + lane]);
        float s[3];
#pragma unroll
        for (int g = 0; g < 3; ++g) {
            const int pos = c * 64 - 128 + g * 64 + lane;
            s[g] = -INFINITY;
            if (pos >= 0) {
                const uint4* kp = (const uint4*)(pj.bk + (size_t)(b * NS + pos) * 128 + kvh * 64);
                float a = 0.f;
#pragma unroll
                for (int d = 0; d < 8; ++d) a += dot8(kp[d], qs + d * 8);
                s[g] = a + btab[t5_bucket(pos - q) * 8 + hq];
            }
        }
        const float sink = sinks[hq] * LOG2E;
        const float m = fmaxf(wmax(fmaxf(fmaxf(s[0], s[1]), s[2])), sink);
        float e[3];
#pragma unroll
        for (int g = 0; g < 3; ++g) e[g] = exp2f(s[g] - m);
        const float Z = wsum(e[0] + e[1] + e[2]) + exp2f(sink - m);
        const float iz = 1.f / Z;
        float acc = 0.f;
#pragma unroll
        for (int g = 0; g < 3; ++g) {
            const int pos0 = c * 64 - 128 + g * 64;
            if (pos0 >= 0) {
                const bf16_t* vp = pj.bv + (size_t)(b * NS + pos0) * 128 + kvh * 64 + lane;
#pragma unroll 4
                for (int j = 0; j < 64; ++j) acc += __shfl(e[g], j) * bf2f(vp[(size_t)j * 128]);
            }
        }
        BR[(size_t)tok * 1536 + 512 + hq * 64 + lane] = f2bf(acc * iz);
    }
}

__device__ void ph_attnC_naive(const Params& P, int l, float* lds) {
    const Proj pj = proj_ptrs(P.ws);
    bf16_t* BR = (bf16_t*)(P.ws + OFF_BR);
    const int tidq = tid_opaque(); const int lane = tidq & 63, wid = tidq >> 6;
    float* btab = lds;
    unsigned* keys = (unsigned*)(lds + 256) + wid * 4480;
    int* sel = (int*)(keys + 4096);
    float* iqs = (float*)(keys + 4096 + 256);
    __syncthreads();
    for (int i = tidq; i < 256; i += 512) btab[i] = P.in[I_RELB][(i >> 3) * 20 + 12 + (i & 7)] * LOG2E;
    __syncthreads();
    for (int tok = blockIdx.x * 8 + wid; tok < NTOK; tok += gridDim.x * 8) {
        const int q = tok & (NS - 1), b = tok >> 12, c = q >> 6, N = (c + 1) * 64, ntile = c + 1;
        iqs[lane] = bf2f(pj.iq[(size_t)tok * 128 + lane]); iqs[64 + lane] = bf2f(pj.iq[(size_t)tok * 128 + 64 + lane]);
        const float4 wv = *(const float4*)(pj.iw + (size_t)tok * 4);
        int cnt;
        if (N <= 256) { for (int i = lane; i < N; i += 64) sel[i] = i; cnt = N; }
        else {
            for (int kt = 0; kt < ntile; ++kt) {
                asm volatile("" ::: "memory");
                const int key = kt * 64 + lane;
                const uint4* kp = (const uint4*)(pj.ik + (size_t)(b * NS + key) * 32);
                const uint4 k0 = kp[0], k1 = kp[1], k2 = kp[2], k3 = kp[3];
                float sc = 0.f;
#pragma unroll
                for (int hh = 0; hh < 4; ++hh) {
                    const float lg = dot8(k0, iqs + hh * 32) + dot8(k1, iqs + hh * 32 + 8) + dot8(k2, iqs + hh * 32 + 16) + dot8(k3, iqs + hh * 32 + 24);
                    const float w = hh == 0 ? wv.x : hh == 1 ? wv.y : hh == 2 ? wv.z : wv.w;
                    sc += fmaxf(lg, 0.f) * w;
                }
                sc += 0.0f;
                const unsigned u = __float_as_uint(sc);
                keys[key] = (u & 0x80000000u) ? ~u : (u | 0x80000000u);
            }
            unsigned T = 0;
            for (int bit = 31; bit >= 0; --bit) {
                const unsigned cand = T | (1u << bit);
                int n = 0;
                for (int kt = 0; kt < ntile; ++kt) n += __popcll(__ballot(keys[kt * 64 + lane] >= cand));
                if (n >= 256) T = cand;
            }
            int ngt = 0;
            for (int kt = 0; kt < ntile; ++kt) ngt += __popcll(__ballot(keys[kt * 64 + lane] > T));
            const int need = 256 - ngt;
            int nsel = 0, neq = 0;
            const unsigned long long ltmask = (1ull << lane) - 1ull;
            for (int kt = 0; kt < ntile; ++kt) {
                const unsigned kv = keys[kt * 64 + lane];
                const unsigned long long eqm = __ballot(kv == T);
                const bool take = (kv > T) || (kv == T && (neq + __popcll(eqm & ltmask)) < need);
                const unsigned long long tm = __ballot(take);
                if (take) sel[nsel + __popcll(tm & ltmask)] = kt * 64 + lane;
                nsel += __popcll(tm); neq += __popcll(eqm);
            }
            cnt = 256;
        }
        int idx[4];
#pragma unroll
        for (int j = 0; j < 4; ++j) idx[j] = (lane + 64 * j < cnt) ? sel[lane + 64 * j] : 0;
        for (int h = 0; h < 8; ++h) {
            iqs[lane] = bf2f(pj.cq[(size_t)tok * 512 + h * 64 + lane]);
            const float* qv = iqs;
            float s[4];
#pragma unroll
            for (int j = 0; j < 4; ++j) {
                asm volatile("" ::: "memory");
                s[j] = -INFINITY;
                if (lane + 64 * j < cnt) {
                    const uint4* kp = (const uint4*)(pj.ck + (size_t)(b * NS + idx[j]) * 64);
                    float a = 0.f;
#pragma unroll
                    for (int d = 0; d < 8; ++d) a += dot8(kp[d], qv + d * 8);
                    s[j] = a + btab[t5_bucket(idx[j] - q) * 8 + h];
                }
            }
            const float m = wmax(fmaxf(fmaxf(s[0], s[1]), fmaxf(s[2], s[3])));
            float e[4];
#pragma unroll
            for (int j = 0; j < 4; ++j) e[j] = exp2f(s[j] - m);
            const float iz = 1.f / wsum(e[0] + e[1] + e[2] + e[3]);
            float acc = 0.f;
#pragma unroll
            for (int j = 0; j < 4; ++j) {
                const int nj = cnt - 64 * j < 64 ? cnt - 64 * j : 64;
#pragma unroll 2
                for (int i = 0; i < nj; ++i) { const float pv = __shfl(e[j], i); const int id = __shfl(idx[j], i); acc += pv * bf2f(pj.cv[(size_t)(b * NS + id) * 64 + lane]); }
            }
            BR[(size_t)tok * 1536 + 1024 + h * 64 + lane] = f2bf(acc * iz);
        }
    }
}

__device__ void ph_gatebranch_naive(const Params& P, int l, float* lds) {
    const bf16_t* H = (const bf16_t*)(P.ws + OFF_H);
    const bf16_t* BR = (const bf16_t*)(P.ws + OFF_BR);
    bf16_t* MG = (bf16_t*)(P.ws + OFF_MERGED);
    const float* Wg = P.in[I_WGATE] + (size_t)l * ND * 3072;
    const float* bg = P.in[I_BGATE] + (size_t)l * 3072;
    const float* Wb = P.in[I_WBR] + (size_t)l * 3 * 512 * ND;
    const int tid = tid_opaque(), ty = tid >> 5, tx = tid & 31;
    for (int t = blockIdx.x; t < 256 * 8; t += gridDim.x) {
        const int tm = t >> 3, tn = t & 7;
        float m[8][4];
#pragma unroll
        for (int i = 0; i < 8; ++i)
#pragma unroll
            for (int j = 0; j < 4; ++j) m[i][j] = 0.f;
        for (int n = 0; n < 3; ++n) {
            float g[8][4], y[8][4];
            ngemm_tile(H, ND, Wg, 3072, ND, 3072, tm * 128, n * 1024 + tn * 128, g, lds);
            ngemm_tile(BR + n * 512, 1536, Wb + (size_t)n * 512 * ND, ND, 512, ND, tm * 128, tn * 128, y, lds);
#pragma unroll
            for (int i = 0; i < 8; ++i)
#pragma unroll
                for (int j = 0; j < 4; ++j) { const float z = g[i][j] + bg[n * 1024 + tn * 128 + tx * 4 + j]; m[i][j] += y[i][j] / (1.f + expf(-z)); }
        }
#pragma unroll
        for (int i = 0; i < 8; ++i) {
            uint2 o; o.x = pack2(m[i][0], m[i][1]); o.y = pack2(m[i][2], m[i][3]);
            *(uint2*)(MG + (size_t)(tm * 128 + ty * 8 + i) * ND + tn * 128 + tx * 4) = o;
        }
    }
}
__device__ void ph_out_naive(const Params& P, int l, float* lds) {
    const bf16_t* MG = (const bf16_t*)(P.ws + OFF_MERGED);
    const float* W = P.in[I_WOUT] + (size_t)l * ND * ND;
    const float* xsrc = l == 0 ? P.in[I_X] : P.out;
    const int tid = tid_opaque(), ty = tid >> 5, tx = tid & 31;
    for (int t = blockIdx.x; t < 256 * 8; t += gridDim.x) {
        const int tm = t >> 3, tn = t & 7;
        float acc[8][4];
        ngemm_tile(MG, ND, W, ND, ND, ND, tm * 128, tn * 128, acc, lds);
#pragma unroll
        for (int i = 0; i < 8; ++i) {
            const size_t o = (size_t)(tm * 128 + ty * 8 + i) * ND + tn * 128 + tx * 4;
            const float4 xv = *(const float4*)(xsrc + o);
            *(float4*)(P.out + o) = make_float4(xv.x + acc[i][0], xv.y + acc[i][1], xv.z + acc[i][2], xv.w + acc[i][3]);
        }
    }
}

__device__ void ph_norm2_route(const Params& P, int l) {
    bf16_t* H = (bf16_t*)(P.ws + OFF_H);
    int* eid = (int*)(P.ws + OFF_ROUTE); float* ew = (float*)(P.ws + OFF_ROUTE + 256 * 1024);
    const float* g = P.in[I_NFG] + (size_t)l * ND;
    const float* wrg = P.in[I_WRG] + (size_t)l * ND * 4; const float* brg = P.in[I_BRG] + (size_t)l * 4;
    const float* wre = P.in[I_WRE] + (size_t)l * ND * 16; const float* bre = P.in[I_BRE] + (size_t)l * 16;
    const int tidq = tid_opaque(); const int lane = tidq & 63, wid = tidq >> 6;
    for (int row = blockIdx.x * 8 + wid; row < NTOK; row += gridDim.x * 8) {
        const float4* xp = (const float4*)(P.out + (size_t)row * ND);
        float4 v[4]; float ss = 0.f;
#pragma unroll
        for (int j = 0; j < 4; ++j) { v[j] = xp[j * 64 + lane]; ss += v[j].x * v[j].x + v[j].y * v[j].y + v[j].z * v[j].z + v[j].w * v[j].w; }
        ss = wsum(ss);
        const float rstd = rsqrtf(ss * (1.0f / ND) + EPS);
        float hv[4][4];
#pragma unroll
        for (int j = 0; j < 4; ++j) {
            const int k0 = (j * 64 + lane) * 4;
            const float4 gv = ((const float4*)g)[j * 64 + lane];
            hv[j][0] = v[j].x * rstd * gv.x; hv[j][1] = v[j].y * rstd * gv.y; hv[j][2] = v[j].z * rstd * gv.z; hv[j][3] = v[j].w * rstd * gv.w;
            uint2 o; o.x = pack2(hv[j][0], hv[j][1]); o.y = pack2(hv[j][2], hv[j][3]);
            *(uint2*)(H + (size_t)row * ND + k0) = o;
        }
        float mylg = 0.f;
#pragma unroll 1
        for (int qd = 0; qd < 5; ++qd) {
            const float* wb = qd == 0 ? wrg : wre + (qd - 1) * 4; const int ld = qd == 0 ? 4 : 16;
            float4 a = make_float4(0.f, 0.f, 0.f, 0.f);
#pragma unroll
            for (int j = 0; j < 4; ++j)
#pragma unroll
                for (int e = 0; e < 4; ++e) { const float4 w = *(const float4*)(wb + (size_t)((j * 64 + lane) * 4 + e) * ld); a.x += hv[j][e] * w.x; a.y += hv[j][e] * w.y; a.z += hv[j][e] * w.z; a.w += hv[j][e] * w.w; }
            a.x = wsum(a.x); a.y = wsum(a.y); a.z = wsum(a.z); a.w = wsum(a.w);
            if (lane == qd * 4) mylg = a.x; if (lane == qd * 4 + 1) mylg = a.y; if (lane == qd * 4 + 2) mylg = a.z; if (lane == qd * 4 + 3) mylg = a.w;
        }
        float lg[20];
#pragma unroll
        for (int i = 0; i < 20; ++i) lg[i] = __shfl(mylg, i);
        if (lane == 0) {
            float gl[4];
#pragma unroll
            for (int i = 0; i < 4; ++i) gl[i] = lg[i] + brg[i];
            int gs = 0; float gm = gl[0];
#pragma unroll
            for (int i = 1; i < 4; ++i) if (gl[i] > gm) { gm = gl[i]; gs = i; }
            float zs = 0.f;
#pragma unroll
            for (int i = 0; i < 4; ++i) zs += expf(gl[i] - gm);
            const float pgroup = 1.f / zs;
            float el[4];
#pragma unroll
            for (int i = 0; i < 4; ++i) { el[i] = 0.f;
#pragma unroll
                for (int gq = 0; gq < 4; ++gq) if (gq == gs) el[i] = lg[4 + gq * 4 + i] + bre[gq * 4 + i]; }
            int e1 = 0; float v1 = el[0];
#pragma unroll
            for (int i = 1; i < 4; ++i) if (el[i] > v1) { v1 = el[i]; e1 = i; }
            int e2 = -1; float v2 = -INFINITY;
#pragma unroll
            for (int i = 0; i < 4; ++i) if (i != e1 && el[i] > v2) { v2 = el[i]; e2 = i; }
            const float x2 = expf(v2 - v1), w1 = 1.f / (1.f + x2), w2 = x2 / (1.f + x2);
            eid[row * 2] = gs * 4 + e1; eid[row * 2 + 1] = gs * 4 + e2;
            ew[row * 2] = w1 * pgroup; ew[row * 2 + 1] = w2 * pgroup;
        }
    }
}

__device__ void ph_moe_naive(const Params& P, int l, float* lds) {
    const bf16_t* H = (const bf16_t*)(P.ws + OFF_H);
    const int* eid = (const int*)(P.ws + OFF_ROUTE); const float* ew = (const float*)(P.ws + OFF_ROUTE + 256 * 1024);
    const int tidq = tid_opaque(); const int lane = tidq & 63, wid = tidq >> 6;
    float* hs = lds + wid * 1280;
    float* hid = hs + 1024;
    for (int tok = blockIdx.x * 8 + wid; tok < NTOK; tok += gridDim.x * 8) {
#pragma unroll
        for (int j = 0; j < 4; ++j) { const uint2 w = *(const uint2*)(H + (size_t)tok * ND + (j * 64 + lane) * 4); float* d = hs + (j * 64 + lane) * 4; d[0] = bflo(w.x); d[1] = bfhi(w.x); d[2] = bflo(w.y); d[3] = bfhi(w.y); }
        float o[16];
#pragma unroll
        for (int i = 0; i < 16; ++i) o[i] = 0.f;
        for (int s = 0; s < 2; ++s) {
            const int e = eid[tok * 2 + s]; const float w = ew[tok * 2 + s];
            const float* wg = P.in[I_WFG] + ((size_t)l * 16 + e) * ND * 256;
            const float* wu = P.in[I_WFU] + ((size_t)l * 16 + e) * ND * 256;
            const float* wd = P.in[I_WFD] + ((size_t)l * 16 + e) * 256 * ND;
            float4 ga = make_float4(0.f, 0.f, 0.f, 0.f), ua = ga;
            for (int k = 0; k < ND; ++k) {
                const float hv = hs[k];
                const float4 a = *(const float4*)(wg + (size_t)k * 256 + lane * 4), u = *(const float4*)(wu + (size_t)k * 256 + lane * 4);
                ga.x += hv * a.x; ga.y += hv * a.y; ga.z += hv * a.z; ga.w += hv * a.w; ua.x += hv * u.x; ua.y += hv * u.y; ua.z += hv * u.z; ua.w += hv * u.w;
            }
            float4 hv4;
            hv4.x = ga.x / (1.f + expf(-ga.x)) * ua.x * w; hv4.y = ga.y / (1.f + expf(-ga.y)) * ua.y * w; hv4.z = ga.z / (1.f + expf(-ga.z)) * ua.z * w; hv4.w = ga.w / (1.f + expf(-ga.w)) * ua.w * w;
            *(float4*)(hid + lane * 4) = hv4;
            for (int f = 0; f < 256; ++f) {
                const float hf = hid[f];
#pragma unroll
                for (int j = 0; j < 4; ++j) { const float4 d = *(const float4*)(wd + (size_t)f * ND + (j * 64 + lane) * 4); o[j * 4] += hf * d.x; o[j * 4 + 1] += hf * d.y; o[j * 4 + 2] += hf * d.z; o[j * 4 + 3] += hf * d.w; }
            }
        }
#pragma unroll
        for (int j = 0; j < 4; ++j) {
            float4* op = (float4*)(P.out + (size_t)tok * ND + (j * 64 + lane) * 4);
            float4 x = *op; x.x += o[j * 4]; x.y += o[j * 4 + 1]; x.z += o[j * 4 + 2]; x.w += o[j * 4 + 3]; *op = x;
        }
    }
}

constexpr int LDS_BYTES = 147456;
enum { PH_PREP = 0, PH_INPROJ, PH_HEADNORM, PH_ATTN_A, PH_ATTN_B, PH_ATTN_C, PH_GB, PH_OUT, PH_NORM2, PH_MOE, PH_COUNT };

template <int PH>
__device__ __forceinline__ void run_phase(const Params& P, int l, float* lds) {
#ifdef SKIPX
    if (PH == SKIPX) return;
#endif
    if (PH == PH_PREP) ph_rmsnorm(l == 0 ? P.in[I_X] : P.out, P.in[I_NMG] + (size_t)l * ND, (bf16_t*)(P.ws + OFF_H));
    if (PH == PH_INPROJ) ph_inproj_naive(P, l, lds);
    if (PH == PH_HEADNORM) ph_headnorm_naive(P, l);
    if (PH == PH_ATTN_A) ph_attnA_naive(P, l, lds);
    if (PH == PH_ATTN_B) ph_attnB_naive(P, l, lds);
    if (PH == PH_ATTN_C) ph_attnC_naive(P, l, lds);
    if (PH == PH_GB) ph_gatebranch_naive(P, l, lds);
    if (PH == PH_OUT) ph_out_naive(P, l, lds);
    if (PH == PH_NORM2) ph_norm2_route(P, l);
    if (PH == PH_MOE) ph_moe_naive(P, l, lds);
}

template <int PH>
__global__ void __launch_bounds__(512, 2) k_phase(Params P, int l) {
    extern __shared__ __attribute__((aligned(16))) char smem[];
    run_phase<PH>(P, l, (float*)smem);
}

template <int PH>
static void launch_phase(const Params& P, int l, int grid, hipStream_t stream) {
    static bool attr = false;
    if (!attr) { (void)hipFuncSetAttribute((const void*)k_phase<PH>, hipFuncAttributeMaxDynamicSharedMemorySize, LDS_BYTES); attr = true; }
    hipLaunchKernelGGL(k_phase<PH>, dim3(grid), dim3(512), LDS_BYTES, stream, P, l);
}

__global__ void __launch_bounds__(512, 2) k_fused(Params P) {
    extern __shared__ __attribute__((aligned(16))) char smem[];
    float* lds = (float*)smem;
    volatile LAS unsigned* st = (volatile LAS unsigned*)(smem + LDS_BYTES - 16);
    if (threadIdx.x == 0) { st[0] = 0u; st[1] = 0u; st[2] = 0u; st[3] = 0u; }
    __syncthreads();
    const XcdBarrier bar = xcd_barrier_post((unsigned*)(P.ws + OFF_CTRL), st);
    for (int l = 0; l < 2; ++l) {
        run_phase<PH_PREP>(P, l, lds);     xcd_barrier(bar);
        run_phase<PH_INPROJ>(P, l, lds);   xcd_barrier(bar);
        run_phase<PH_HEADNORM>(P, l, lds); xcd_barrier(bar);
        run_phase<PH_ATTN_A>(P, l, lds);
        run_phase<PH_ATTN_B>(P, l, lds);
        run_phase<PH_ATTN_C>(P, l, lds);   xcd_barrier(bar);
        run_phase<PH_GB>(P, l, lds);       xcd_barrier(bar);
        run_phase<PH_OUT>(P, l, lds);      xcd_barrier(bar);
        run_phase<PH_NORM2>(P, l, lds);    xcd_barrier(bar);
        run_phase<PH_MOE>(P, l, lds);      xcd_barrier(bar);
    }
}

extern "C" void kernel_launch(void* const* d_in, const int* in_sizes, int n_in, void* d_out, int out_size, void* d_ws, size_t ws_size, hipStream_t stream) {
    Params P{};
    for (int i = 0; i < 20; ++i) P.in[i] = (const float*)d_in[i];
    P.out = (float*)d_out; P.ws = (char*)d_ws;
    (void)hipMemsetAsync(d_ws, 0, CTRL_BYTES, stream);
#if FUSED
    static int grid = 0;
    if (!grid) {
        int dev = 0, cus = 0, per_cu = 0;
        (void)hipGetDevice(&dev);
        (void)hipDeviceGetAttribute(&cus, hipDeviceAttributeMultiprocessorCount, dev);
        (void)hipFuncSetAttribute((const void*)k_fused, hipFuncAttributeMaxDynamicSharedMemorySize, LDS_BYTES);
        (void)hipOccupancyMaxActiveBlocksPerMultiprocessor(&per_cu, (const void*)k_fused, 512, LDS_BYTES);
        grid = cus * (per_cu < 1 ? per_cu : 1);
        if (grid <= 0) { fprintf(stderr, "k_fused: occupancy query says %d blocks per CU\n", per_cu); grid = cus; }
    }
    hipLaunchKernelGGL(k_fused, dim3(grid), dim3(512), LDS_BYTES, stream, P);
#else
    const int G = 2048;
    for (int l = 0; l < 2; ++l) {
        launch_phase<PH_PREP>(P, l, G, stream);
        launch_phase<PH_INPROJ>(P, l, G, stream);
        launch_phase<PH_HEADNORM>(P, l, G, stream);
        launch_phase<PH_ATTN_A>(P, l, G, stream);
        launch_phase<PH_ATTN_B>(P, l, G, stream);
        launch_phase<PH_ATTN_C>(P, l, G, stream);
        launch_phase<PH_GB>(P, l, G, stream);
        launch_phase<PH_OUT>(P, l, G, stream);
        launch_phase<PH_NORM2>(P, l, G, stream);
        launch_phase<PH_MOE>(P, l, G, stream);
    }
#endif
}
```

```cpp
#include <hip/hip_runtime.h>
#include <stdint.h>
#include <stdio.h>

#ifndef FUSED
#define FUSED 1
#endif
#define OPT_INPROJ 1
#define OPT_GB 1
#define OPT_OUT 1
#define OPT_MOE 1
#define OPT_ATTN_A 1
#define OPT_ATTN_B 1
#define OPT_ATTN_C 1
#define DIAG 0
#define DIAG_BUF 0

#define LAS __attribute__((address_space(3)))
typedef unsigned short bf16_t;

constexpr int NB = 8, NS = 4096, ND = 1024, NTOK = NB * NS;
constexpr int IN_COLS = 3108;
constexpr float LOG2E = 1.4426950408889634f;
constexpr float QSCALE = 0.125f * LOG2E;
constexpr float EPS = 1e-6f;
constexpr float IWSCALE = 0.08838834764831845f;

constexpr size_t MB = (size_t)1 << 20;
constexpr size_t OFF_CTRL = 0;
constexpr size_t CTRL_BYTES = 65536;
constexpr size_t OFF_ROUTE = 1 * MB;
constexpr size_t MOE_CNT_OFF = 32768;
constexpr size_t MOE_LIST_OFF = 512 * 1024;
constexpr size_t MOE_RW_OFF = 512 * 1024 + 3 * MB;
constexpr size_t OFF_WT = 5 * MB;
constexpr size_t OFF_H = 49 * MB;
constexpr size_t OFF_BR = 113 * MB;
constexpr size_t OFF_PROJ = 209 * MB;
constexpr size_t OFF_MERGED = OFF_PROJ + 192 * MB;
constexpr size_t PO_AQ = 0, PO_AK = 32 * MB, PO_AV = 64 * MB, PO_BQ = 96 * MB, PO_BK = 128 * MB, PO_BV = 136 * MB, PO_CQ = 144 * MB,
                 PO_CK = 176 * MB, PO_CV = 180 * MB, PO_IQ = 184 * MB, PO_IK = 192 * MB, PO_IW = 194 * MB;

struct Params {
    const float* in[20];
    float* out;
    char* ws;
};
typedef const __attribute__((address_space(4))) char* kaptr_t;
struct KAIn { kaptr_t base; __device__ __forceinline__ const float* operator[](int i) const { return *(const float* const __attribute__((address_space(4)))*)(base + 8 * i); } };
struct KA { KAIn in; float* out; char* ws; };
__device__ __forceinline__ KA ka_get() {
    kaptr_t p = (kaptr_t)__builtin_amdgcn_kernarg_segment_ptr(); asm volatile("" : "+s"(p));
    KA k; k.in.base = p; k.out = *(float* const __attribute__((address_space(4)))*)(p + 160); k.ws = *(char* const __attribute__((address_space(4)))*)(p + 168); return k;
}
enum { I_X = 0, I_RELB, I_NMG, I_WIN, I_QKG, I_LAM, I_SUBLN, I_SINK, I_WBR, I_WGATE, I_BGATE, I_WOUT, I_NFG, I_WRG, I_BRG, I_WRE, I_BRE, I_WFG, I_WFU, I_WFD };

struct Proj { bf16_t *aq, *ak, *av, *bq, *bk, *bv, *cq, *ck, *cv, *iq, *ik; float* iw; };
__device__ __forceinline__ Proj proj_ptrs(char* ws) {
    char* p = ws + OFF_PROJ; Proj r;
    r.aq = (bf16_t*)(p + PO_AQ); r.ak = (bf16_t*)(p + PO_AK); r.av = (bf16_t*)(p + PO_AV); r.bq = (bf16_t*)(p + PO_BQ); r.bk = (bf16_t*)(p + PO_BK); r.bv = (bf16_t*)(p + PO_BV);
    r.cq = (bf16_t*)(p + PO_CQ); r.ck = (bf16_t*)(p + PO_CK); r.cv = (bf16_t*)(p + PO_CV); r.iq = (bf16_t*)(p + PO_IQ); r.ik = (bf16_t*)(p + PO_IK); r.iw = (float*)(p + PO_IW);
    return r;
}

__device__ __forceinline__ int tid_opaque() { int t = threadIdx.x; asm volatile("" : "+v"(t)); return t; }
__device__ __forceinline__ float bf2f(bf16_t b) { return __uint_as_float(((unsigned)b) << 16); }
__device__ __forceinline__ bf16_t f2bf(float f) { unsigned u = __float_as_uint(f); u += 0x7FFFu + ((u >> 16) & 1u); return (bf16_t)(u >> 16); }
__device__ __forceinline__ float bflo(unsigned w) { return __uint_as_float(w << 16); }
__device__ __forceinline__ float bfhi(unsigned w) { return __uint_as_float(w & 0xffff0000u); }
__device__ __forceinline__ unsigned pack2(float lo, float hi) { return (unsigned)f2bf(lo) | ((unsigned)f2bf(hi) << 16); }
__device__ __forceinline__ float wsum(float v) { for (int o = 32; o; o >>= 1) v += __shfl_xor(v, o); return v; }
__device__ __forceinline__ float wmax(float v) { for (int o = 32; o; o >>= 1) v = fmaxf(v, __shfl_xor(v, o)); return v; }
__device__ __forceinline__ int t5_bucket(int rel) {
    const int n = rel < 0 ? -rel : rel;
    int b = n;
    if (n >= 8) b = 8 + (n >= 15) + (n >= 27) + (n >= 50) + (n >= 91) + (n >= 166) + (n >= 305) + (n >= 559);
    return (rel > 0 ? 16 : 0) + b;
}
__device__ __forceinline__ float lambda_init_of(int l) { return 0.8f - 0.6f * expf(-0.3f * (float)l); }
__device__ __forceinline__ float dot8(uint4 kv, const float* q) {
    return bflo(kv.x) * q[0] + bfhi(kv.x) * q[1] + bflo(kv.y) * q[2] + bfhi(kv.y) * q[3] + bflo(kv.z) * q[4] + bfhi(kv.z) * q[5] + bflo(kv.w) * q[6] + bfhi(kv.w) * q[7];
}


#define XB_TMO      128
#define XB_XCNT(j)  (256  + 64 * (j))
#define XB_XSUB(j)  (1280 + 64 * (j))
#define XB_XGEN(j)  (2304 + 64 * (j))
#define XB_TOP      3328
#define XB_TOPGEN   3392
#define XCD_BAR_WORDS 3456
#define XB_SPIN_CAP (1u << 27)
__device__ __forceinline__ unsigned xb_ld(unsigned* p)              { return __hip_atomic_load(p, __ATOMIC_RELAXED, __HIP_MEMORY_SCOPE_AGENT); }
__device__ __forceinline__ unsigned xb_add(unsigned* p, unsigned v) { return __hip_atomic_fetch_add(p, v, __ATOMIC_RELAXED, __HIP_MEMORY_SCOPE_AGENT); }
__device__ __forceinline__ unsigned xb_xcc_id() { return (unsigned)__builtin_amdgcn_s_getreg((3 << 11) | 20) & 0xFu; }
#define XB_SPIN(cond, bar) do { unsigned _sp = 0; while (cond) { __builtin_amdgcn_s_sleep(1); \
    if ((++_sp & 255u) == 0u) { if (xb_ld(&(bar)[XB_TMO])) break; if (_sp > XB_SPIN_CAP) { atomicAdd(&(bar)[XB_TMO], 1u); break; } } } } while (0)
struct XcdBarrier { unsigned* bar; unsigned x; volatile LAS unsigned* st; };
__device__ __forceinline__ XcdBarrier xcd_barrier_post(unsigned* bar, volatile LAS unsigned* st) {
    XcdBarrier b; b.bar = bar; b.x = xb_xcc_id(); b.st = st;
    if (threadIdx.x == 0) (void)xb_add(&bar[XB_XCNT(b.x)], 1u);
    return b;
}
__device__ __forceinline__ void xcd_barrier_complete(unsigned* bar, unsigned x, unsigned& nloc, unsigned& nx) {
    const unsigned G = gridDim.x * gridDim.y * gridDim.z;
    unsigned sum, cnt, mine, sp = 0u;
    for (;;) {
        sum = 0u; cnt = 0u; mine = 0u;
#pragma unroll
        for (unsigned j = 0; j < 16; ++j) { const unsigned c = xb_ld(&bar[XB_XCNT(j)]); sum += c; cnt += (c > 0u) ? 1u : 0u; mine = (j == x) ? c : mine; }
        if (sum == G) break;
        __builtin_amdgcn_s_sleep(1);
        if ((++sp & 255u) == 0u) { if (xb_ld(&bar[XB_TMO])) break; if (sp > XB_SPIN_CAP) { atomicAdd(&bar[XB_TMO], 1u); break; } }
    }
    nloc = mine > 0u ? mine : 1u; nx = cnt > 0u ? cnt : 1u;
}
__device__ __forceinline__ void xcd_barrier(const XcdBarrier& b) {
    asm volatile("s_waitcnt vmcnt(0)" ::: "memory");
    __syncthreads();
    if (threadIdx.x == 0) {
        unsigned* bar = b.bar;
        __builtin_amdgcn_s_waitcnt(0);
        unsigned nloc = b.st[0], nx = b.st[1];
        if (nloc == 0u) { xcd_barrier_complete(bar, b.x, nloc, nx); b.st[0] = nloc; b.st[1] = nx; }
        const unsigned old = xb_add(&bar[XB_XSUB(b.x)], 1u);
        const unsigned gen = old / nloc;
        if (old + 1u == (gen + 1u) * nloc) {
            __builtin_amdgcn_fence(__ATOMIC_RELEASE, "agent");
            asm volatile("s_waitcnt vmcnt(0)" ::: "memory");
            const unsigned og = xb_add(&bar[XB_TOP], 1u);
            const unsigned tg = og / nx;
            if (og + 1u == (tg + 1u) * nx) xb_add(&bar[XB_TOPGEN], 1u);
            else XB_SPIN(xb_ld(&bar[XB_TOPGEN]) == tg, bar);
            __builtin_amdgcn_fence(__ATOMIC_ACQUIRE, "agent");
            xb_add(&bar[XB_XGEN(b.x)], 1u);
            asm volatile("s_waitcnt vmcnt(0)" ::: "memory");
        } else {
            XB_SPIN(xb_ld(&bar[XB_XGEN(b.x)]) == gen, bar);
            __builtin_amdgcn_fence(__ATOMIC_ACQUIRE, "agent");
            asm volatile("s_waitcnt vmcnt(0)" ::: "memory");
        }
    }
    __syncthreads();
}

__device__ __forceinline__ void ngemm_tile(const bf16_t* A, int lda, const float* W, int ldw, int K, int ncols, int row0, int col0, float (&acc)[8][4], float* lds) {
    float* As = lds; float* Bs = lds + 16 * 132;
    const int tid = tid_opaque(), ty = tid >> 5, tx = tid & 31;
#pragma unroll
    for (int i = 0; i < 8; ++i)
#pragma unroll
        for (int j = 0; j < 4; ++j) acc[i][j] = 0.f;
    for (int k0 = 0; k0 < K; k0 += 16) {
        {
            const int r = tid >> 2, kq = (tid & 3) * 4;
            const uint2 v = *(const uint2*)(A + (size_t)(row0 + r) * lda + k0 + kq);
            As[(kq + 0) * 132 + r] = bflo(v.x); As[(kq + 1) * 132 + r] = bfhi(v.x); As[(kq + 2) * 132 + r] = bflo(v.y); As[(kq + 3) * 132 + r] = bfhi(v.y);
        }
        {
            const int k = tid >> 5, c = (tid & 31) * 4;
            const float* wp = W + (size_t)(k0 + k) * ldw + col0 + c;
            float4 v = make_float4(0.f, 0.f, 0.f, 0.f);
            if (col0 + c + 3 < ncols) v = *(const float4*)wp;
            else { if (col0 + c < ncols) v.x = wp[0]; if (col0 + c + 1 < ncols) v.y = wp[1]; if (col0 + c + 2 < ncols) v.z = wp[2]; }
            *(float4*)(Bs + k * 128 + c) = v;
        }
        __syncthreads();
#pragma unroll 2
        for (int kk = 0; kk < 16; ++kk) {
            const float4 a0 = *(const float4*)(As + kk * 132 + ty * 8), a1 = *(const float4*)(As + kk * 132 + ty * 8 + 4);
            const float4 b = *(const float4*)(Bs + kk * 128 + tx * 4);
            const float a[8] = {a0.x, a0.y, a0.z, a0.w, a1.x, a1.y, a1.z, a1.w}; const float bb[4] = {b.x, b.y, b.z, b.w};
#pragma unroll
            for (int i = 0; i < 8; ++i)
#pragma unroll
                for (int j = 0; j < 4; ++j) acc[i][j] += a[i] * bb[j];
        }
        __syncthreads();
    }
}

__device__ __forceinline__ void ph_rmsnorm(const float* xsrc, const float* g, bf16_t* H) {
    const int tidq = tid_opaque(); const int lane = tidq & 63, wid = tidq >> 6;
    for (int row = blockIdx.x * 8 + wid; row < NTOK; row += gridDim.x * 8) {
        const float4* xp = (const float4*)(xsrc + (size_t)row * ND);
        float4 v[4]; float ss = 0.f;
#pragma unroll
        for (int j = 0; j < 4; ++j) { v[j] = xp[j * 64 + lane]; ss += v[j].x * v[j].x + v[j].y * v[j].y + v[j].z * v[j].z + v[j].w * v[j].w; }
        ss = wsum(ss);
        const float rstd = rsqrtf(ss * (1.0f / ND) + EPS);
#pragma unroll
        for (int j = 0; j < 4; ++j) {
            const float4 gv = ((const float4*)g)[j * 64 + lane];
            uint2 o; o.x = pack2(v[j].x * rstd * gv.x, v[j].y * rstd * gv.y); o.y = pack2(v[j].z * rstd * gv.z, v[j].w * rstd * gv.w);
            *(uint2*)(H + (size_t)row * ND + (j * 64 + lane) * 4) = o;
        }
    }
}

__device__ __forceinline__ void store_proj_raw(const Proj& pj, int tok, int c, float v) {
    if (c < 512) pj.aq[(size_t)tok * 512 + c] = f2bf(v);
    else if (c < 1024) pj.ak[(size_t)tok * 512 + c - 512] = f2bf(v);
    else if (c < 1536) pj.av[(size_t)tok * 512 + c - 1024] = f2bf(v);
    else if (c < 2048) pj.bq[(size_t)tok * 512 + c - 1536] = f2bf(v);
    else if (c < 2176) pj.bk[(size_t)tok * 128 + c - 2048] = f2bf(v);
    else if (c < 2304) pj.bv[(size_t)tok * 128 + c - 2176] = f2bf(v);
    else if (c < 2816) pj.cq[(size_t)tok * 512 + c - 2304] = f2bf(v);
    else if (c < 2880) pj.ck[(size_t)tok * 64 + c - 2816] = f2bf(v);
    else if (c < 2944) pj.cv[(size_t)tok * 64 + c - 2880] = f2bf(v);
    else if (c < 3072) pj.iq[(size_t)tok * 128 + c - 2944] = f2bf(v);
    else if (c < 3104) pj.ik[(size_t)tok * 32 + c - 3072] = f2bf(v);
    else if (c < 3108) pj.iw[(size_t)tok * 4 + c - 3104] = v * IWSCALE;
}
__device__ __forceinline__ void ph_inproj_naive(const Params& P_, int l, float* lds) {
    const KA P = ka_get();
    const Proj pj = proj_ptrs(P.ws);
    const bf16_t* H = (const bf16_t*)(P.ws + OFF_H);
    const float* W = P.in[I_WIN] + (size_t)l * ND * IN_COLS;
    const int tid = tid_opaque(), ty = tid >> 5, tx = tid & 31;
    for (int t = blockIdx.x; t < 256 * 25; t += gridDim.x) {
        const int tm = t / 25, tn = t % 25;
        float acc[8][4];
        ngemm_tile(H, ND, W, IN_COLS, ND, IN_COLS, tm * 128, tn * 128, acc, lds);
#pragma unroll
        for (int i = 0; i < 8; ++i)
#pragma unroll
            for (int j = 0; j < 4; ++j) { const int c = tn * 128 + tx * 4 + j; if (c < IN_COLS) store_proj_raw(pj, tm * 128 + ty * 8 + i, c, acc[i][j]); }
    }
}
__device__ __forceinline__ void ph_headnorm_naive(const Params& P_, int l) {
    const KA P = ka_get();
    const Proj pj = proj_ptrs(P.ws);
    const float* qkg = P.in[I_QKG] + (size_t)l * 3 * 2 * 64;
    const int tidq = tid_opaque(); const int lane = tidq & 63, wid = tidq >> 6;
    for (long t = (long)blockIdx.x * 8 + wid; t < (long)NTOK * 35; t += (long)gridDim.x * 8) {
        const int tok = (int)(t / 35), g = (int)(t % 35);
        bf16_t* p; const float* gv; float sc = 1.f;
        if (g < 8) { p = pj.aq + (size_t)tok * 512 + g * 64; gv = qkg + 0; sc = QSCALE; }
        else if (g < 16) { p = pj.ak + (size_t)tok * 512 + (g - 8) * 64; gv = qkg + 64; }
        else if (g < 24) { p = pj.bq + (size_t)tok * 512 + (g - 16) * 64; gv = qkg + 128; sc = QSCALE; }
        else if (g < 26) { p = pj.bk + (size_t)tok * 128 + (g - 24) * 64; gv = qkg + 192; }
        else if (g < 34) { p = pj.cq + (size_t)tok * 512 + (g - 26) * 64; gv = qkg + 256; sc = QSCALE; }
        else { p = pj.ck + (size_t)tok * 64; gv = qkg + 320; }
        const float v = bf2f(p[lane]);
        const float ss = wsum(v * v);
        p[lane] = f2bf(v * rsqrtf(ss * (1.0f / 64) + EPS) * gv[lane] * sc);
    }
}

__device__ __forceinline__ void ph_attnA_naive(const Params& P_, int l, float* lds) {
    const KA P = ka_get();
    const Proj pj = proj_ptrs(P.ws);
    bf16_t* BR = (bf16_t*)(P.ws + OFF_BR);
    const int tidq = tid_opaque(); const int lane = tidq & 63, wid = tidq >> 6;
    float* btab = lds;
    float* qs = lds + 128 + wid * 128;
    for (int i = tidq; i < 128; i += 512) btab[i] = P.in[I_RELB][(i >> 2) * 20 + (i & 3)] * LOG2E;
    __syncthreads();
    const float* lp = P.in[I_LAM] + (size_t)l * 256;
    const float linit = lambda_init_of(l);
    const float lam = expf(wsum(lp[lane] * lp[64 + lane])) - expf(wsum(lp[128 + lane] * lp[192 + lane])) + linit;
    const float* subg = P.in[I_SUBLN] + (size_t)l * 128;
    for (int t = blockIdx.x * 8 + wid; t < NB * 4 * NS; t += gridDim.x * 8) {
        const int q = t & (NS - 1), h = (t >> 12) & 3, b = t >> 14;
        const int tok = b * NS + q;
        qs[lane] = bf2f(pj.aq[(size_t)tok * 512 + (h * 2) * 64 + lane]);
        qs[64 + lane] = bf2f(pj.aq[(size_t)tok * 512 + (h * 2 + 1) * 64 + lane]);
        const int nkt = (q >> 6) + 1;
        float M0 = -INFINITY, Z0 = 0.f, M1 = -INFINITY, Z1 = 0.f;
        for (int kt = 0; kt < nkt; ++kt) {
            asm volatile("" ::: "memory");
            const int key = kt * 64 + lane;
            const uint4* kp = (const uint4*)(pj.ak + (size_t)(b * NS + key) * 512 + h * 128);
            float s0 = 0.f, s1 = 0.f;
#pragma unroll 1
            for (int d = 0; d < 8; ++d) { asm volatile("" ::: "memory"); s0 += dot8(kp[d], qs + d * 8); s1 += dot8(kp[8 + d], qs + 64 + d * 8); }
            const float bias = btab[t5_bucket(key - q) * 4 + h];
            s0 += bias; s1 += bias;
            float mn = fmaxf(M0, s0); Z0 = Z0 * exp2f(M0 - mn) + exp2f(s0 - mn); M0 = mn;
            mn = fmaxf(M1, s1); Z1 = Z1 * exp2f(M1 - mn) + exp2f(s1 - mn); M1 = mn;
        }
        { const float mw = wmax(M0); Z0 = wsum(Z0 * exp2f(M0 - mw)); M0 = mw; }
        { const float mw = wmax(M1); Z1 = wsum(Z1 * exp2f(M1 - mw)); M1 = mw; }
        const float iz0 = 1.f / Z0, iz1 = lam / Z1;
        float a0 = 0.f, a1 = 0.f;
        for (int kt = 0; kt < nkt; ++kt) {
            asm volatile("" ::: "memory");
            const int key = kt * 64 + lane;
            const uint4* kp = (const uint4*)(pj.ak + (size_t)(b * NS + key) * 512 + h * 128);
            float s0 = 0.f, s1 = 0.f;
#pragma unroll 1
            for (int d = 0; d < 8; ++d) { asm volatile("" ::: "memory"); s0 += dot8(kp[d], qs + d * 8); s1 += dot8(kp[8 + d], qs + 64 + d * 8); }
            const float bias = btab[t5_bucket(key - q) * 4 + h];
            const float p = exp2f(s0 + bias - M0) * iz0 - exp2f(s1 + bias - M1) * iz1;
            const unsigned* vp = (const unsigned*)(pj.av + (size_t)(b * NS + kt * 64) * 512 + h * 128) + lane;
#pragma unroll 4
            for (int j = 0; j < 64; ++j) { const float pjv = __shfl(p, j); const unsigned w = vp[(size_t)j * 256]; a0 += pjv * bflo(w); a1 += pjv * bfhi(w); }
        }
        const float ss = wsum(a0 * a0 + a1 * a1);
        const float rstd = rsqrtf(ss * (1.0f / 128) + EPS) * (1.0f - linit);
        *(unsigned*)(BR + (size_t)tok * 1536 + h * 128 + lane * 2) = pack2(a0 * rstd * subg[lane * 2], a1 * rstd * subg[lane * 2 + 1]);
    }
}

__device__ __forceinline__ void ph_attnB_naive(const Params& P_, int l, float* lds) {
    const KA P = ka_get();
    const Proj pj = proj_ptrs(P.ws);
    bf16_t* BR = (bf16_t*)(P.ws + OFF_BR);
    const int tidq = tid_opaque(); const int lane = tidq & 63, wid = tidq >> 6;
    float* btab = lds;
    float* qs = lds + 256 + wid * 64;
    __syncthreads();
    for (int i = tidq; i < 256; i += 512) btab[i] = P.in[I_RELB][(i >> 3) * 20 + 4 + (i & 7)] * LOG2E;
    __syncthreads();
    const float* sinks = P.in[I_SINK] + (size_t)l * 8;
    for (int t = blockIdx.x * 8 + wid; t < NTOK * 8; t += gridDim.x * 8) {
        const int hq = t & 7, tok = t >> 3, q = tok & (NS - 1), b = tok >> 12, kvh = hq >> 2, c = q >> 6;
        qs[lane] = bf2f(pj.bq[(size_t)tok * 512 + hq * 64 + lane]);
        float s[3];
#pragma unroll
        for (int g = 0; g < 3; ++g) {
            const int pos = c * 64 - 128 + g * 64 + lane;
            s[g] = -INFINITY;
            if (pos >= 0) {
                const uint4* kp = (const uint4*)(pj.bk + (size_t)(b * NS + pos) * 128 + kvh * 64);
                float a = 0.f;
#pragma unroll
                for (int d = 0; d < 8; ++d) a += dot8(kp[d], qs + d * 8);
                s[g] = a + btab[t5_bucket(pos - q) * 8 + hq];
            }
        }
        const float sink = sinks[hq] * LOG2E;
        const float m = fmaxf(wmax(fmaxf(fmaxf(s[0], s[1]), s[2])), sink);
        float e[3];
#pragma unroll
        for (int g = 0; g < 3; ++g) e[g] = exp2f(s[g] - m);
        const float Z = wsum(e[0] + e[1] + e[2]) + exp2f(sink - m);
        const float iz = 1.f / Z;
        float acc = 0.f;
#pragma unroll
        for (int g = 0; g < 3; ++g) {
            const int pos0 = c * 64 - 128 + g * 64;
            if (pos0 >= 0) {
                const bf16_t* vp = pj.bv + (size_t)(b * NS + pos0) * 128 + kvh * 64 + lane;
#pragma unroll 4
                for (int j = 0; j < 64; ++j) acc += __shfl(e[g], j) * bf2f(vp[(size_t)j * 128]);
            }
        }
        BR[(size_t)tok * 1536 + 512 + hq * 64 + lane] = f2bf(acc * iz);
    }
}

__device__ __forceinline__ void ph_attnC_naive(const Params& P_, int l, float* lds) {
    const KA P = ka_get();
    const Proj pj = proj_ptrs(P.ws);
    bf16_t* BR = (bf16_t*)(P.ws + OFF_BR);
    const int tidq = tid_opaque(); const int lane = tidq & 63, wid = tidq >> 6;
    float* btab = lds;
    unsigned* keys = (unsigned*)(lds + 256) + wid * 4480;
    int* sel = (int*)(keys + 4096);
    float* iqs = (float*)(keys + 4096 + 256);
    __syncthreads();
    for (int i = tidq; i < 256; i += 512) btab[i] = P.in[I_RELB][(i >> 3) * 20 + 12 + (i & 7)] * LOG2E;
    __syncthreads();
    for (int tok = blockIdx.x * 8 + wid; tok < NTOK; tok += gridDim.x * 8) {
        const int q = tok & (NS - 1), b = tok >> 12, c = q >> 6, N = (c + 1) * 64, ntile = c + 1;
        iqs[lane] = bf2f(pj.iq[(size_t)tok * 128 + lane]); iqs[64 + lane] = bf2f(pj.iq[(size_t)tok * 128 + 64 + lane]);
        const float4 wv = *(const float4*)(pj.iw + (size_t)tok * 4);
        int cnt;
        if (N <= 256) { for (int i = lane; i < N; i += 64) sel[i] = i; cnt = N; }
        else {
            for (int kt = 0; kt < ntile; ++kt) {
                asm volatile("" ::: "memory");
                const int key = kt * 64 + lane;
                const uint4* kp = (const uint4*)(pj.ik + (size_t)(b * NS + key) * 32);
                const uint4 k0 = kp[0], k1 = kp[1], k2 = kp[2], k3 = kp[3];
                float sc = 0.f;
#pragma unroll
                for (int hh = 0; hh < 4; ++hh) {
                    const float lg = dot8(k0, iqs + hh * 32) + dot8(k1, iqs + hh * 32 + 8) + dot8(k2, iqs + hh * 32 + 16) + dot8(k3, iqs + hh * 32 + 24);
                    const float w = hh == 0 ? wv.x : hh == 1 ? wv.y : hh == 2 ? wv.z : wv.w;
                    sc += fmaxf(lg, 0.f) * w;
                }
                sc += 0.0f;
                const unsigned u = __float_as_uint(sc);
                keys[key] = (u & 0x80000000u) ? ~u : (u | 0x80000000u);
            }
            unsigned T = 0;
            for (int bit = 31; bit >= 0; --bit) {
                const unsigned cand = T | (1u << bit);
                int n = 0;
                for (int kt = 0; kt < ntile; ++kt) n += __popcll(__ballot(keys[kt * 64 + lane] >= cand));
                if (n >= 256) T = cand;
            }
            int ngt = 0;
            for (int kt = 0; kt < ntile; ++kt) ngt += __popcll(__ballot(keys[kt * 64 + lane] > T));
            const int need = 256 - ngt;
            int nsel = 0, neq = 0;
            const unsigned long long ltmask = (1ull << lane) - 1ull;
            for (int kt = 0; kt < ntile; ++kt) {
                const unsigned kv = keys[kt * 64 + lane];
                const unsigned long long eqm = __ballot(kv == T);
                const bool take = (kv > T) || (kv == T && (neq + __popcll(eqm & ltmask)) < need);
                const unsigned long long tm = __ballot(take);
                if (take) sel[nsel + __popcll(tm & ltmask)] = kt * 64 + lane;
                nsel += __popcll(tm); neq += __popcll(eqm);
            }
            cnt = 256;
        }
        int idx[4];
#pragma unroll
        for (int j = 0; j < 4; ++j) idx[j] = (lane + 64 * j < cnt) ? sel[lane + 64 * j] : 0;
        for (int h = 0; h < 8; ++h) {
            iqs[lane] = bf2f(pj.cq[(size_t)tok * 512 + h * 64 + lane]);
            const float* qv = iqs;
            float s[4];
#pragma unroll
            for (int j = 0; j < 4; ++j) {
                asm volatile("" ::: "memory");
                s[j] = -INFINITY;
                if (lane + 64 * j < cnt) {
                    const uint4* kp = (const uint4*)(pj.ck + (size_t)(b * NS + idx[j]) * 64);
                    float a = 0.f;
#pragma unroll
                    for (int d = 0; d < 8; ++d) a += dot8(kp[d], qv + d * 8);
                    s[j] = a + btab[t5_bucket(idx[j] - q) * 8 + h];
                }
            }
            const float m = wmax(fmaxf(fmaxf(s[0], s[1]), fmaxf(s[2], s[3])));
            float e[4];
#pragma unroll
            for (int j = 0; j < 4; ++j) e[j] = exp2f(s[j] - m);
            const float iz = 1.f / wsum(e[0] + e[1] + e[2] + e[3]);
            float acc = 0.f;
#pragma unroll
            for (int j = 0; j < 4; ++j) {
                const int nj = cnt - 64 * j < 64 ? cnt - 64 * j : 64;
#pragma unroll 2
                for (int i = 0; i < nj; ++i) { const float pv = __shfl(e[j], i); const int id = __shfl(idx[j], i); acc += pv * bf2f(pj.cv[(size_t)(b * NS + id) * 64 + lane]); }
            }
            BR[(size_t)tok * 1536 + 1024 + h * 64 + lane] = f2bf(acc * iz);
        }
    }
}

__device__ __forceinline__ void ph_gatebranch_naive(const Params& P_, int l, float* lds) {
    const KA P = ka_get();
    const bf16_t* H = (const bf16_t*)(P.ws + OFF_H);
    const bf16_t* BR = (const bf16_t*)(P.ws + OFF_BR);
    bf16_t* MG = (bf16_t*)(P.ws + OFF_MERGED);
    const float* Wg = P.in[I_WGATE] + (size_t)l * ND * 3072;
    const float* bg = P.in[I_BGATE] + (size_t)l * 3072;
    const float* Wb = P.in[I_WBR] + (size_t)l * 3 * 512 * ND;
    const int tid = tid_opaque(), ty = tid >> 5, tx = tid & 31;
    for (int t = blockIdx.x; t < 256 * 8; t += gridDim.x) {
        const int tm = t >> 3, tn = t & 7;
        float m[8][4];
#pragma unroll
        for (int i = 0; i < 8; ++i)
#pragma unroll
            for (int j = 0; j < 4; ++j) m[i][j] = 0.f;
        for (int n = 0; n < 3; ++n) {
            float g[8][4], y[8][4];
            ngemm_tile(H, ND, Wg, 3072, ND, 3072, tm * 128, n * 1024 + tn * 128, g, lds);
            ngemm_tile(BR + n * 512, 1536, Wb + (size_t)n * 512 * ND, ND, 512, ND, tm * 128, tn * 128, y, lds);
#pragma unroll
            for (int i = 0; i < 8; ++i)
#pragma unroll
                for (int j = 0; j < 4; ++j) { const float z = g[i][j] + bg[n * 1024 + tn * 128 + tx * 4 + j]; m[i][j] += y[i][j] / (1.f + expf(-z)); }
        }
#pragma unroll
        for (int i = 0; i < 8; ++i) {
            uint2 o; o.x = pack2(m[i][0], m[i][1]); o.y = pack2(m[i][2], m[i][3]);
            *(uint2*)(MG + (size_t)(tm * 128 + ty * 8 + i) * ND + tn * 128 + tx * 4) = o;
        }
    }
}
__device__ __forceinline__ void ph_out_naive(const Params& P_, int l, float* lds) {
    const KA P = ka_get();
    const bf16_t* MG = (const bf16_t*)(P.ws + OFF_MERGED);
    const float* W = P.in[I_WOUT] + (size_t)l * ND * ND;
    const float* xsrc = l == 0 ? P.in[I_X] : P.out;
    const int tid = tid_opaque(), ty = tid >> 5, tx = tid & 31;
    for (int t = blockIdx.x; t < 256 * 8; t += gridDim.x) {
        const int tm = t >> 3, tn = t & 7;
        float acc[8][4];
        ngemm_tile(MG, ND, W, ND, ND, ND, tm * 128, tn * 128, acc, lds);
#pragma unroll
        for (int i = 0; i < 8; ++i) {
            const size_t o = (size_t)(tm * 128 + ty * 8 + i) * ND + tn * 128 + tx * 4;
            const float4 xv = *(const float4*)(xsrc + o);
            *(float4*)(P.out + o) = make_float4(xv.x + acc[i][0], xv.y + acc[i][1], xv.z + acc[i][2], xv.w + acc[i][3]);
        }
    }
}

__device__ __forceinline__ void ph_norm2_route(const Params& P_, int l) {
    const KA P = ka_get();
    bf16_t* H = (bf16_t*)(P.ws + OFF_H);
    int* eid = (int*)(P.ws + OFF_ROUTE); float* ew = (float*)(P.ws + OFF_ROUTE + 256 * 1024);
    const float* g = P.in[I_NFG] + (size_t)l * ND;
    const float* wrg = P.in[I_WRG] + (size_t)l * ND * 4; const float* brg = P.in[I_BRG] + (size_t)l * 4;
    const float* wre = P.in[I_WRE] + (size_t)l * ND * 16; const float* bre = P.in[I_BRE] + (size_t)l * 16;
    const int tidq = tid_opaque(); const int lane = tidq & 63, wid = tidq >> 6;
    for (int row = blockIdx.x * 8 + wid; row < NTOK; row += gridDim.x * 8) {
        const float4* xp = (const float4*)(P.out + (size_t)row * ND);
        float4 v[4]; float ss = 0.f;
#pragma unroll
        for (int j = 0; j < 4; ++j) { v[j] = xp[j * 64 + lane]; ss += v[j].x * v[j].x + v[j].y * v[j].y + v[j].z * v[j].z + v[j].w * v[j].w; }
        ss = wsum(ss);
        const float rstd = rsqrtf(ss * (1.0f / ND) + EPS);
        float hv[4][4];
#pragma unroll
        for (int j = 0; j < 4; ++j) {
            const int k0 = (j * 64 + lane) * 4;
            const float4 gv = ((const float4*)g)[j * 64 + lane];
            hv[j][0] = v[j].x * rstd * gv.x; hv[j][1] = v[j].y * rstd * gv.y; hv[j][2] = v[j].z * rstd * gv.z; hv[j][3] = v[j].w * rstd * gv.w;
            uint2 o; o.x = pack2(hv[j][0], hv[j][1]); o.y = pack2(hv[j][2], hv[j][3]);
            *(uint2*)(H + (size_t)row * ND + k0) = o;
        }
        float mylg = 0.f;
#pragma unroll 1
        for (int qd = 0; qd < 5; ++qd) {
            const float* wb = qd == 0 ? wrg : wre + (qd - 1) * 4; const int ld = qd == 0 ? 4 : 16;
            float4 a = make_float4(0.f, 0.f, 0.f, 0.f);
#pragma unroll
            for (int j = 0; j < 4; ++j)
#pragma unroll
                for (int e = 0; e < 4; ++e) { const float4 w = *(const float4*)(wb + (size_t)((j * 64 + lane) * 4 + e) * ld); a.x += hv[j][e] * w.x; a.y += hv[j][e] * w.y; a.z += hv[j][e] * w.z; a.w += hv[j][e] * w.w; }
            a.x = wsum(a.x); a.y = wsum(a.y); a.z = wsum(a.z); a.w = wsum(a.w);
            if (lane == qd * 4) mylg = a.x; if (lane == qd * 4 + 1) mylg = a.y; if (lane == qd * 4 + 2) mylg = a.z; if (lane == qd * 4 + 3) mylg = a.w;
        }
        float lg[20];
#pragma unroll
        for (int i = 0; i < 20; ++i) lg[i] = __shfl(mylg, i);
        if (lane == 0) {
            float gl[4];
#pragma unroll
            for (int i = 0; i < 4; ++i) gl[i] = lg[i] + brg[i];
            int gs = 0; float gm = gl[0];
#pragma unroll
            for (int i = 1; i < 4; ++i) if (gl[i] > gm) { gm = gl[i]; gs = i; }
            float zs = 0.f;
#pragma unroll
            for (int i = 0; i < 4; ++i) zs += expf(gl[i] - gm);
            const float pgroup = 1.f / zs;
            float el[4];
#pragma unroll
            for (int i = 0; i < 4; ++i) { el[i] = 0.f;
#pragma unroll
                for (int gq = 0; gq < 4; ++gq) if (gq == gs) el[i] = lg[4 + gq * 4 + i] + bre[gq * 4 + i]; }
            int e1 = 0; float v1 = el[0];
#pragma unroll
            for (int i = 1; i < 4; ++i) if (el[i] > v1) { v1 = el[i]; e1 = i; }
            int e2 = -1; float v2 = -INFINITY;
#pragma unroll
            for (int i = 0; i < 4; ++i) if (i != e1 && el[i] > v2) { v2 = el[i]; e2 = i; }
            const float x2 = expf(v2 - v1), w1 = 1.f / (1.f + x2), w2 = x2 / (1.f + x2);
            eid[row * 2] = gs * 4 + e1; eid[row * 2 + 1] = gs * 4 + e2;
            ew[row * 2] = w1 * pgroup; ew[row * 2 + 1] = w2 * pgroup;
            const int lo = e1 < e2 ? e1 : e2, hi = e1 < e2 ? e2 : e1;
            const int bk = gs * 6 + (lo == 0 ? hi - 1 : (lo == 1 ? hi + 1 : 5));
            const int pos = atomicAdd((int*)(P.ws + OFF_CTRL + MOE_CNT_OFF) + l * 32 + bk, 1);
            ((int*)(P.ws + OFF_ROUTE + MOE_LIST_OFF))[bk * NTOK + pos] = row;
            float* rw = (float*)(P.ws + OFF_ROUTE + MOE_RW_OFF);
            rw[row * 2] = (e1 < e2 ? w1 : w2) * pgroup; rw[row * 2 + 1] = (e1 < e2 ? w2 : w1) * pgroup;
        }
    }
}

__device__ __forceinline__ void ph_moe_naive(const Params& P_, int l, float* lds) {
    const KA P = ka_get();
    const bf16_t* H = (const bf16_t*)(P.ws + OFF_H);
    const int* eid = (const int*)(P.ws + OFF_ROUTE); const float* ew = (const float*)(P.ws + OFF_ROUTE + 256 * 1024);
    const int tidq = tid_opaque(); const int lane = tidq & 63, wid = tidq >> 6;
    float* hs = lds + wid * 1280;
    float* hid = hs + 1024;
    for (int tok = blockIdx.x * 8 + wid; tok < NTOK; tok += gridDim.x * 8) {
#pragma unroll
        for (int j = 0; j < 4; ++j) { const uint2 w = *(const uint2*)(H + (size_t)tok * ND + (j * 64 + lane) * 4); float* d = hs + (j * 64 + lane) * 4; d[0] = bflo(w.x); d[1] = bfhi(w.x); d[2] = bflo(w.y); d[3] = bfhi(w.y); }
        float o[16];
#pragma unroll
        for (int i = 0; i < 16; ++i) o[i] = 0.f;
        for (int s = 0; s < 2; ++s) {
            const int e = eid[tok * 2 + s]; const float w = ew[tok * 2 + s];
            const float* wg = P.in[I_WFG] + ((size_t)l * 16 + e) * ND * 256;
            const float* wu = P.in[I_WFU] + ((size_t)l * 16 + e) * ND * 256;
            const float* wd = P.in[I_WFD] + ((size_t)l * 16 + e) * 256 * ND;
            float4 ga = make_float4(0.f, 0.f, 0.f, 0.f), ua = ga;
            for (int k = 0; k < ND; ++k) {
                const float hv = hs[k];
                const float4 a = *(const float4*)(wg + (size_t)k * 256 + lane * 4), u = *(const float4*)(wu + (size_t)k * 256 + lane * 4);
                ga.x += hv * a.x; ga.y += hv * a.y; ga.z += hv * a.z; ga.w += hv * a.w; ua.x += hv * u.x; ua.y += hv * u.y; ua.z += hv * u.z; ua.w += hv * u.w;
            }
            float4 hv4;
            hv4.x = ga.x / (1.f + expf(-ga.x)) * ua.x * w; hv4.y = ga.y / (1.f + expf(-ga.y)) * ua.y * w; hv4.z = ga.z / (1.f + expf(-ga.z)) * ua.z * w; hv4.w = ga.w / (1.f + expf(-ga.w)) * ua.w * w;
            *(float4*)(hid + lane * 4) = hv4;
            for (int f = 0; f < 256; ++f) {
                const float hf = hid[f];
#pragma unroll
                for (int j = 0; j < 4; ++j) { const float4 d = *(const float4*)(wd + (size_t)f * ND + (j * 64 + lane) * 4); o[j * 4] += hf * d.x; o[j * 4 + 1] += hf * d.y; o[j * 4 + 2] += hf * d.z; o[j * 4 + 3] += hf * d.w; }
            }
        }
#pragma unroll
        for (int j = 0; j < 4; ++j) {
            float4* op = (float4*)(P.out + (size_t)tok * ND + (j * 64 + lane) * 4);
            float4 x = *op; x.x += o[j * 4]; x.y += o[j * 4 + 1]; x.z += o[j * 4 + 2]; x.w += o[j * 4 + 3]; *op = x;
        }
    }
}


namespace mm {
typedef short bf16x8 __attribute__((ext_vector_type(8)));
typedef float f32x16 __attribute__((ext_vector_type(16)));
typedef float f32x4 __attribute__((ext_vector_type(4)));
typedef unsigned u32x4 __attribute__((ext_vector_type(4)));
constexpr int OPB = 256 * 128;
constexpr int STG = 2 * OPB;
constexpr int LDS_NEED = 2 * STG;
__host__ __device__ __forceinline__ int img_col(int rho) { const int i = rho & 31; return (rho & ~31) + 16 * ((i >> 2) & 1) + 4 * (i >> 3) + (i & 3); }
__device__ __forceinline__ unsigned cvt_pk_bf16(float lo, float hi) { unsigned r; asm volatile("v_cvt_pk_bf16_f32 %0, %1, %2" : "=v"(r) : "v"(lo), "v"(hi)); return r; }
__device__ __forceinline__ u32x4 pack8(const f32x16& v, int o) { u32x4 w; w.x = cvt_pk_bf16(v[o], v[o + 1]); w.y = cvt_pk_bf16(v[o + 2], v[o + 3]); w.z = cvt_pk_bf16(v[o + 4], v[o + 5]); w.w = cvt_pk_bf16(v[o + 6], v[o + 7]); return w; }

struct Unit {
    const char* a;
    const char* b0;
    const char* b1;
    int lda, ldb;
    int nk, nseg;
    int pm, pn, tag;
    int aux0, aux1;
};
__device__ __forceinline__ bool static_tile(long L, int nM, int nN, int& pm, int& pn) {
    const int nwg = nM * nN; if (L >= nwg) return false;
    int wgid = (int)L; { const int q = nwg / 8, r = nwg % 8, xcd = wgid % 8, off = wgid / 8; wgid = (xcd < r ? xcd * (q + 1) : r * (q + 1) + (xcd - r) * q) + off; }
    const int nig = 8 * nN, gid = wgid / nig, fm = gid * 8, gsz = (nM - fm) < 8 ? (nM - fm) : 8;
    pm = fm + ((wgid % nig) % gsz); pn = (wgid % nig) / gsz; return true;
}

template <class Epi, class Sched>
__device__ __forceinline__ void gemm_phase(char* smem, const Sched& S, const Epi& E) {
    const int tid = tid_opaque(), lane = tid & 63, wid = __builtin_amdgcn_readfirstlane(tid >> 6), wm = wid >> 2, wn = wid & 3, r32 = lane & 31, h = lane >> 5;
    LAS char* lds = (LAS char*)smem;
    const int srow = tid >> 3, sc = tid & 7;
    const unsigned sts = (unsigned)(srow * 128 + ((sc ^ (srow & 7)) << 4));
    const unsigned rda = (unsigned)((wm * 128 + r32) * 128), rdb = (unsigned)(OPB + (wn * 64 + r32) * 128);
    const unsigned x7 = (unsigned)(r32 & 7);
    Unit cur, nxt; int ui = 0;
    if (!S.next(0, cur)) return;
    constexpr int NA = Sched::GATHER ? 4 : 1;
    unsigned ao[NA], bo;
    auto offs = [&](const Unit& u, unsigned (&a)[NA], unsigned& b) {
        int t2 = tid; asm volatile("" : "+v"(t2));
        const int r0 = t2 >> 3, c16 = (t2 & 7) * 16;
        S.a_rows(u, r0, a);
#pragma unroll
        for (int q = 0; q < NA; ++q) a[q] += (unsigned)c16;
        b = (unsigned)(r0 * u.ldb * 2 + c16);
    };
    offs(cur, ao, bo);
    f32x16 acc[4][2];
#pragma unroll
    for (int i = 0; i < 4; ++i)
#pragma unroll
        for (int j = 0; j < 2; ++j)
#pragma unroll
            for (int e = 0; e < 16; ++e) acc[i][j][e] = 0.f;
    u32x4 ga[4], gb[4];
#define MM_GLOAD(u, k, A_, B_) do { const char* ap_ = (u).a + (size_t)(k) * 128; const char* bp_ = ((k) < (u).nseg ? (u).b0 : (u).b1) + (size_t)(k) * 128; \
        const size_t as_ = (size_t)(u).lda * 128, bs_ = (size_t)(u).ldb * 128; \
        _Pragma("unroll") for (int q_ = 0; q_ < 4; ++q_) { ga[q_] = Sched::GATHER ? *(const u32x4*)(ap_ + (A_)[q_ % NA]) : *(const u32x4*)(ap_ + q_ * as_ + (A_)[0]); gb[q_] = *(const u32x4*)(bp_ + q_ * bs_ + (B_)); } } while (0)
#define MM_LSTORE(buf) do { LAS char* p_ = lds + (buf) * STG + sts; \
        _Pragma("unroll") for (int q_ = 0; q_ < 4; ++q_) { *(LAS u32x4*)(p_ + q_ * 8192) = ga[q_]; *(LAS u32x4*)(p_ + OPB + q_ * 8192) = gb[q_]; } } while (0)
    MM_GLOAD(cur, 0, ao, bo);
    MM_LSTORE(0);
    __syncthreads();
    int buf = 0;
    for (;;) {
        const bool has_next = S.next(ui + 1, nxt);
        const int nk = cur.nk;
        for (int k = 0; k < nk; ++k) {
            const bool lastk = (k == nk - 1);
            if (!lastk) MM_GLOAD(cur, k + 1, ao, bo);
            else if (has_next) { offs(nxt, ao, bo); MM_GLOAD(nxt, 0, ao, bo); }
            const LAS char* base = lds + buf * STG;
#pragma unroll
            for (int ks = 0; ks < 4; ++ks) {
                const unsigned xo = (((unsigned)(ks * 2 + h)) ^ x7) << 4;
                bf16x8 af[4], bfr[2];
#pragma unroll
                for (int nt = 0; nt < 2; ++nt) bfr[nt] = *(const LAS bf16x8*)(base + rdb + nt * 4096 + xo);
#pragma unroll
                for (int mt = 0; mt < 4; ++mt) af[mt] = *(const LAS bf16x8*)(base + rda + mt * 4096 + xo);
#pragma unroll
                for (int mt = 0; mt < 4; ++mt)
#pragma unroll
                    for (int nt = 0; nt < 2; ++nt) acc[mt][nt] = __builtin_amdgcn_mfma_f32_32x32x16_bf16(bfr[nt], af[mt], acc[mt][nt], 0, 0, 0);
            }
            if (lastk) {
                E(acc, cur, wm, wn, r32, h, tid);
#pragma unroll
                for (int i = 0; i < 4; ++i)
#pragma unroll
                    for (int j = 0; j < 2; ++j)
#pragma unroll
                        for (int e = 0; e < 16; ++e) acc[i][j][e] = 0.f;
            }
            if (!lastk || has_next) MM_LSTORE(buf ^ 1);
            __syncthreads();
            buf ^= 1;
        }
        if (!has_next) break;
        cur = nxt; ++ui;
    }
#undef MM_GLOAD
#undef MM_LSTORE
}
__device__ __forceinline__ void plain_rows(const Unit& u, int r0, unsigned (&a)[1]) { a[0] = (unsigned)(r0 * u.lda * 2); }
}

constexpr size_t WT_IN = 0;
constexpr size_t WT_GATE = WT_IN + (size_t)3328 * 1024 * 2;
constexpr size_t WT_BR = WT_GATE + (size_t)3072 * 1024 * 2;
constexpr size_t WT_OUT = WT_BR + (size_t)3 * 1024 * 512 * 2;
constexpr size_t WT_GU = WT_OUT + (size_t)1024 * 1024 * 2;
constexpr size_t WT_DN = WT_GU + (size_t)16 * 512 * 1024 * 2;
constexpr size_t WT_END = WT_DN + (size_t)16 * 1024 * 256 * 2;
static_assert(WT_END <= 44 * MB, "weight image region");

template <class F>
__device__ __forceinline__ void cvt_tile(bf16_t* Bt, int K, int rho0, int k0, const float* W, int ldw, const F& colof, int tid) {
    const int rho = rho0 + (tid & 63), kg = k0 + (tid >> 6) * 8;
    const int c = colof(rho);
    float v[8];
#pragma unroll
    for (int j = 0; j < 8; ++j) v[j] = c >= 0 ? W[(size_t)(kg + j) * ldw + c] : 0.f;
    mm::u32x4 o; o.x = mm::cvt_pk_bf16(v[0], v[1]); o.y = mm::cvt_pk_bf16(v[2], v[3]); o.z = mm::cvt_pk_bf16(v[4], v[5]); o.w = mm::cvt_pk_bf16(v[6], v[7]);
    *(mm::u32x4*)(Bt + (size_t)rho * K + kg) = o;
}
__device__ __forceinline__ void ph_convert_weights(const Params& P_, int l) {
    const KA P = ka_get();
    const int tid = tid_opaque();
    char* wt = P.ws + OFF_WT;
    constexpr int T_IN = (3328 / 64) * 16, T_GATE = (3072 / 64) * 16, T_BR = 3 * (1024 / 64) * 8, T_OUT = 16 * 16, T_GU = 16 * 8 * 16, T_DN = 16 * 16 * 4;
    constexpr int T_ALL = T_IN + T_GATE + T_BR + T_OUT + T_GU + T_DN;
    for (int t = blockIdx.x; t < T_ALL; t += gridDim.x) {
        int u = t;
        if (u < T_IN) {
            const float* W = P.in[I_WIN] + (size_t)l * ND * IN_COLS;
            cvt_tile((bf16_t*)(wt + WT_IN), 1024, (u >> 4) * 64, (u & 15) * 64, W, IN_COLS, [&](int rho) -> int { const int c = mm::img_col(rho); return c < IN_COLS ? c : -1; }, tid);
            continue;
        }
        u -= T_IN;
        if (u < T_GATE) {
            const float* W = P.in[I_WGATE] + (size_t)l * ND * 3072;
            cvt_tile((bf16_t*)(wt + WT_GATE), 1024, (u >> 4) * 64, (u & 15) * 64, W, 3072, [&](int rho) -> int { return mm::img_col(rho); }, tid);
            continue;
        }
        u -= T_GATE;
        if (u < T_BR) {
            const int n = u / 128, v = u % 128;
            const float* W = P.in[I_WBR] + ((size_t)l * 3 + n) * 512 * ND;
            cvt_tile((bf16_t*)(wt + WT_BR) + (size_t)n * 1024 * 512, 512, (v >> 3) * 64, (v & 7) * 64, W, ND, [&](int rho) -> int { return mm::img_col(rho); }, tid);
            continue;
        }
        u -= T_BR;
        if (u < T_OUT) {
            const float* W = P.in[I_WOUT] + (size_t)l * ND * ND;
            cvt_tile((bf16_t*)(wt + WT_OUT), 1024, (u >> 4) * 64, (u & 15) * 64, W, ND, [&](int rho) -> int { return mm::img_col(rho); }, tid);
            continue;
        }
        u -= T_OUT;
        if (u < T_GU) {
            const int e = u / 128, v = u % 128;
            const float* Wg = P.in[I_WFG] + ((size_t)l * 16 + e) * ND * 256;
            const float* Wu = P.in[I_WFU] + ((size_t)l * 16 + e) * ND * 256;
            const int rho0 = (v >> 4) * 64;
            const float* Wsel = (((rho0 + (tid & 63)) >> 5) & 1) ? Wu : Wg;
            cvt_tile((bf16_t*)(wt + WT_GU) + (size_t)e * 512 * 1024, 1024, rho0, (v & 15) * 64, Wsel, 256, [&](int rho) -> int {
                const int j = rho >> 8, wn = (rho >> 6) & 3; return j * 128 + wn * 32 + (mm::img_col(rho) & 31); }, tid);
            continue;
        }
        u -= T_GU;
        {
            const int e = u / 64, v = u % 64;
            const float* W = P.in[I_WFD] + ((size_t)l * 16 + e) * 256 * ND;
            cvt_tile((bf16_t*)(wt + WT_DN) + (size_t)e * 1024 * 256, 256, (v >> 2) * 64, (v & 3) * 64, W, ND, [&](int rho) -> int { return mm::img_col(rho); }, tid);
        }
    }
}

struct SchedInProj {
    const char* A; const char* B;
    __device__ __forceinline__ bool next(int i, mm::Unit& u) const {
        int pm, pn; if (!mm::static_tile((long)i * gridDim.x + blockIdx.x, 128, 13, pm, pn)) return false;
        u.a = A + (size_t)pm * 256 * 1024 * 2; u.b0 = B + (size_t)pn * 256 * 1024 * 2; u.b1 = u.b0; u.lda = 1024; u.ldb = 1024; u.nk = 16; u.nseg = 16; u.pm = pm; u.pn = pn; u.tag = 0; return true;
    }
    static constexpr bool GATHER = false;
    __device__ __forceinline__ void a_rows(const mm::Unit& u, int r0, unsigned (&a)[1]) const { mm::plain_rows(u, r0, a); }
};
struct EpiInProj {
    Proj pj; const float* qkg;
    __device__ __forceinline__ void operator()(mm::f32x16 (&acc)[4][2], const mm::Unit& u, int wm, int wn, int r32, int h, int tid) const {
        using namespace mm;
        asm volatile("" : "+v"(r32), "+v"(h));
        const int G = u.pn * 4 + wn;
        if (G > 48) return;
        bf16_t* dst; int tstride; const float* gv = nullptr; float sc = 1.f;
        if (G < 8) { dst = pj.aq + G * 64; tstride = 512; gv = qkg; sc = QSCALE; }
        else if (G < 16) { dst = pj.ak + (G - 8) * 64; tstride = 512; gv = qkg + 64; }
        else if (G < 24) { dst = pj.av + (G - 16) * 64; tstride = 512; }
        else if (G < 32) { dst = pj.bq + (G - 24) * 64; tstride = 512; gv = qkg + 128; sc = QSCALE; }
        else if (G < 34) { dst = pj.bk + (G - 32) * 64; tstride = 128; gv = qkg + 192; }
        else if (G < 36) { dst = pj.bv + (G - 34) * 64; tstride = 128; }
        else if (G < 44) { dst = pj.cq + (G - 36) * 64; tstride = 512; gv = qkg + 256; sc = QSCALE; }
        else if (G == 44) { dst = pj.ck; tstride = 64; gv = qkg + 320; }
        else if (G == 45) { dst = pj.cv; tstride = 64; }
        else if (G < 48) { dst = pj.iq + (G - 46) * 64; tstride = 128; }
        else { dst = pj.ik; tstride = 32; }
#pragma unroll
        for (int mt = 0; mt < 4; ++mt) {
            asm volatile("" ::: "memory");
            const int row = u.pm * 256 + wm * 128 + mt * 32 + r32;
            f32x16& v0 = acc[mt][0]; f32x16& v1 = acc[mt][1];
            if (gv) {
                float ss = 0.f;
#pragma unroll
                for (int e = 0; e < 16; ++e) ss += v0[e] * v0[e] + v1[e] * v1[e];
                ss += __shfl_xor(ss, 32);
                const float rs = rsqrtf(ss * (1.0f / 64) + EPS) * sc;
#pragma unroll
                for (int e4 = 0; e4 < 4; ++e4) {
                    const f32x4 ga = *(const f32x4*)(gv + 16 * h + 4 * e4), gb = *(const f32x4*)(gv + 32 + 16 * h + 4 * e4);
#pragma unroll
                    for (int j = 0; j < 4; ++j) { v0[4 * e4 + j] *= rs * ga[j]; v1[4 * e4 + j] *= rs * gb[j]; }
                }
            }
            if (G < 48) {
                bf16_t* d = dst + (size_t)row * tstride + 16 * h;
                *(u32x4*)(d) = pack8(v0, 0); *(u32x4*)(d + 8) = pack8(v0, 8);
                *(u32x4*)(d + 32) = pack8(v1, 0); *(u32x4*)(d + 40) = pack8(v1, 8);
            } else {
                bf16_t* d = dst + (size_t)row * 32 + 16 * h;
                *(u32x4*)(d) = pack8(v0, 0); *(u32x4*)(d + 8) = pack8(v0, 8);
                if (h == 0) *(f32x4*)(pj.iw + (size_t)row * 4) = (f32x4){v1[0], v1[1], v1[2], v1[3]} * IWSCALE;
            }
        }
    }
};
__device__ __forceinline__ void ph_inproj(const Params& P_, int l, char* smem) {
    const KA P = ka_get();
    SchedInProj S; S.A = P.ws + OFF_H; S.B = P.ws + OFF_WT + WT_IN;
    EpiInProj E; E.pj = proj_ptrs(P.ws); E.qkg = P.in[I_QKG] + (size_t)l * 384;
    mm::gemm_phase(smem, S, E);
}

constexpr size_t SCR_G = OFF_PROJ;
constexpr size_t SCR_M = OFF_PROJ + 32 * MB;
struct SchedGB {
    const char* H; const char* BR; const char* Wg; const char* Wb;
    __device__ __forceinline__ bool next(int i, mm::Unit& u) const {
        const int ti = i / 6, sub = i - ti * 6, n = sub >> 1;
        int pm, pn; if (!mm::static_tile((long)ti * gridDim.x + blockIdx.x, 128, 4, pm, pn)) return false;
        u.pm = pm; u.pn = pn; u.tag = sub;
        if ((sub & 1) == 0) { u.a = H + (size_t)pm * 256 * 1024 * 2; u.lda = 1024; u.b0 = Wg + (size_t)(n * 1024 + pn * 256) * 1024 * 2; u.ldb = 1024; u.nk = 16; }
        else { u.a = BR + ((size_t)pm * 256 * 1536 + n * 512) * 2; u.lda = 1536; u.b0 = Wb + ((size_t)n * 1024 + pn * 256) * 512 * 2; u.ldb = 512; u.nk = 8; }
        u.b1 = u.b0; u.nseg = u.nk; return true;
    }
    static constexpr bool GATHER = false;
    __device__ __forceinline__ void a_rows(const mm::Unit& u, int r0, unsigned (&a)[1]) const { mm::plain_rows(u, r0, a); }
};
struct EpiGB {
    const float* bg; bf16_t* MG; char* scrg; char* scrm;
    __device__ __forceinline__ void operator()(mm::f32x16 (&acc)[4][2], const mm::Unit& u, int wm, int wn, int r32, int h, int tid) const {
        using namespace mm;
        asm volatile("" : "+v"(r32), "+v"(h), "+v"(tid));
        const int sub = u.tag, n = sub >> 1;
#pragma unroll
        for (int mt = 0; mt < 4; ++mt)
#pragma unroll
            for (int nt = 0; nt < 2; ++nt) {
                asm volatile("" ::: "memory");
                const unsigned so = (unsigned)((mt * 2 + nt) * 2) * 8192u + (unsigned)tid * 16u;
                const int col = u.pn * 256 + wn * 64 + nt * 32 + 16 * h;
                f32x16& v = acc[mt][nt];
                if ((sub & 1) == 0) {
#pragma unroll
                    for (int e4 = 0; e4 < 4; ++e4) { const f32x4 b = *(const f32x4*)(bg + n * 1024 + col + 4 * e4);
#pragma unroll
                        for (int j = 0; j < 4; ++j) v[4 * e4 + j] = 1.f / (1.f + __expf(-(v[4 * e4 + j] + b[j]))); }
                    *(u32x4*)(scrg + so) = pack8(v, 0); *(u32x4*)(scrg + so + 8192) = pack8(v, 8);
                } else {
                    const u32x4 g0 = *(const u32x4*)(scrg + so), g1 = *(const u32x4*)(scrg + so + 8192);
                    const unsigned gw[8] = {g0.x, g0.y, g0.z, g0.w, g1.x, g1.y, g1.z, g1.w};
#pragma unroll
                    for (int j = 0; j < 8; ++j) { v[2 * j] *= bflo(gw[j]); v[2 * j + 1] *= bfhi(gw[j]); }
                    if (n > 0) {
                        const u32x4 m0 = *(const u32x4*)(scrm + so), m1 = *(const u32x4*)(scrm + so + 8192);
                        const unsigned mw[8] = {m0.x, m0.y, m0.z, m0.w, m1.x, m1.y, m1.z, m1.w};
#pragma unroll
                        for (int j = 0; j < 8; ++j) { v[2 * j] += bflo(mw[j]); v[2 * j + 1] += bfhi(mw[j]); }
                    }
                    if (n < 2) { *(u32x4*)(scrm + so) = pack8(v, 0); *(u32x4*)(scrm + so + 8192) = pack8(v, 8); }
                    else { bf16_t* d = MG + (size_t)(u.pm * 256 + wm * 128 + mt * 32 + r32) * ND + col; *(u32x4*)d = pack8(v, 0); *(u32x4*)(d + 8) = pack8(v, 8); }
                }
            }
    }
};
__device__ __forceinline__ void ph_gatebranch(const Params& P_, int l, char* smem) {
    const KA P = ka_get();
    SchedGB S; S.H = P.ws + OFF_H; S.BR = P.ws + OFF_BR; S.Wg = P.ws + OFF_WT + WT_GATE; S.Wb = P.ws + OFF_WT + WT_BR;
    EpiGB E; E.bg = P.in[I_BGATE] + (size_t)l * 3072; E.MG = (bf16_t*)(P.ws + OFF_MERGED);
    E.scrg = P.ws + SCR_G + (size_t)blockIdx.x * 131072; E.scrm = P.ws + SCR_M + (size_t)blockIdx.x * 131072;
    mm::gemm_phase(smem, S, E);
}

struct SchedOut {
    const char* A; const char* B;
    __device__ __forceinline__ bool next(int i, mm::Unit& u) const {
        int pm, pn; if (!mm::static_tile((long)i * gridDim.x + blockIdx.x, 128, 4, pm, pn)) return false;
        u.a = A + (size_t)pm * 256 * 1024 * 2; u.b0 = B + (size_t)pn * 256 * 1024 * 2; u.b1 = u.b0; u.lda = 1024; u.ldb = 1024; u.nk = 16; u.nseg = 16; u.pm = pm; u.pn = pn; u.tag = 0; return true;
    }
    static constexpr bool GATHER = false;
    __device__ __forceinline__ void a_rows(const mm::Unit& u, int r0, unsigned (&a)[1]) const { mm::plain_rows(u, r0, a); }
};
struct EpiOut {
    const float* xsrc; float* out;
    __device__ __forceinline__ void operator()(mm::f32x16 (&acc)[4][2], const mm::Unit& u, int wm, int wn, int r32, int h, int tid) const {
        using namespace mm;
        asm volatile("" : "+v"(r32), "+v"(h));
#pragma unroll
        for (int mt = 0; mt < 4; ++mt)
#pragma unroll
            for (int nt = 0; nt < 2; ++nt) {
                asm volatile("" ::: "memory");
                const size_t off = (size_t)(u.pm * 256 + wm * 128 + mt * 32 + r32) * ND + u.pn * 256 + wn * 64 + nt * 32 + 16 * h;
#pragma unroll
                for (int e4 = 0; e4 < 4; ++e4) {
                    const f32x4 xv = *(const f32x4*)(xsrc + off + 4 * e4);
                    *(f32x4*)(out + off + 4 * e4) = xv + (f32x4){acc[mt][nt][4 * e4], acc[mt][nt][4 * e4 + 1], acc[mt][nt][4 * e4 + 2], acc[mt][nt][4 * e4 + 3]};
                }
            }
    }
};
__device__ __forceinline__ void ph_outproj(const Params& P_, int l, char* smem) {
    const KA P = ka_get();
    SchedOut S; S.A = P.ws + OFF_MERGED; S.B = P.ws + OFF_WT + WT_OUT;
    EpiOut E; E.xsrc = l == 0 ? P.in[I_X] : P.out; E.out = P.out;
    mm::gemm_phase(smem, S, E);
}


constexpr size_t OFF_HID = OFF_PROJ + 64 * MB;
constexpr int MOE_TAB = 131072 + 1024;
__device__ __forceinline__ void moe_table(char* smem, const int* cnt) {
    int* tab = (int*)(smem + MOE_TAB);
    __syncthreads();
    if (threadIdx.x == 0) { int p = 0; for (int b = 0; b < 24; ++b) { const int c = cnt[b]; tab[b] = p; tab[32 + b] = c; p += (c + 255) >> 8; } tab[24] = p; }
    __syncthreads();
}
struct MoeLoc { int b, rt, slot, valid, elo, ehi; };
__device__ __forceinline__ MoeLoc moe_locate(const int* tab, int T) {
    int b = 0;
#pragma unroll 1
    for (int i = 1; i < 24; ++i) if (tab[i] <= T) b = i;
    while (tab[32 + b] == 0 || tab[b] > T) --b;
    MoeLoc m; m.b = b; m.rt = T - tab[b]; m.slot = T * 256; const int c = tab[32 + b] - m.rt * 256; m.valid = c < 256 ? c : 256;
    const int g = b / 6, ix = b - g * 6; const int lo = ix < 3 ? 0 : (ix < 5 ? 1 : 2), hi = ix < 3 ? ix + 1 : (ix < 5 ? ix - 1 : 3);
    m.elo = g * 4 + lo; m.ehi = g * 4 + hi; return m;
}
struct SchedMoeUp {
    static constexpr bool GATHER = true;
    const char* H; const char* W; const int* tab; const int* list;
    __device__ __forceinline__ bool next(int i, mm::Unit& u) const {
        const long L = (long)i * gridDim.x + blockIdx.x; const int T = (int)(L >> 2), c = (int)(L & 3);
        if (T >= tab[24]) return false;
        const MoeLoc m = moe_locate(tab, T);
        const int e = (c >> 1) ? m.ehi : m.elo, j = c & 1;
        u.a = H; u.lda = 1024; u.b0 = W + ((size_t)e * 512 + j * 256) * 1024 * 2; u.b1 = u.b0; u.ldb = 1024; u.nk = 16; u.nseg = 16;
        u.pm = T; u.pn = c; u.tag = c; u.aux0 = m.b * NTOK + m.rt * 256; u.aux1 = m.valid; return true;
    }
    __device__ __forceinline__ void a_rows(const mm::Unit& u, int r0, unsigned (&a)[4]) const {
#pragma unroll
        for (int q = 0; q < 4; ++q) { const int r = r0 + 64 * q; const int tok = list[u.aux0 + (r < u.aux1 ? r : 0)]; a[q] = (unsigned)tok * 2048u; }
    }
};
struct EpiMoeUp {
    bf16_t* hid; const int* list; const float* rw;
    __device__ __forceinline__ void operator()(mm::f32x16 (&acc)[4][2], const mm::Unit& u, int wm, int wn, int r32, int h, int tid) const {
        using namespace mm;
        asm volatile("" : "+v"(r32), "+v"(h));
        const int which = u.tag >> 1, j = u.tag & 1;
#pragma unroll
        for (int mt = 0; mt < 4; ++mt) {
            asm volatile("" ::: "memory");
            const int r = wm * 128 + mt * 32 + r32;
            if (r < u.aux1) {
                const int tok = list[u.aux0 + r];
                const float w = rw[tok * 2 + which];
                f32x16& g = acc[mt][0]; const f32x16& up = acc[mt][1];
#pragma unroll
                for (int e = 0; e < 16; ++e) g[e] = g[e] / (1.f + __expf(-g[e])) * up[e] * w;
                bf16_t* d = hid + (size_t)(u.pm * 256 + r) * 512 + which * 256 + j * 128 + wn * 32 + 16 * h;
                *(u32x4*)d = pack8(g, 0); *(u32x4*)(d + 8) = pack8(g, 8);
            }
        }
    }
};
struct SchedMoeDown {
    static constexpr bool GATHER = false;
    const char* HID; const char* W; const int* tab;
    __device__ __forceinline__ bool next(int i, mm::Unit& u) const {
        const long L = (long)i * gridDim.x + blockIdx.x; const int T = (int)(L >> 2), c = (int)(L & 3);
        if (T >= tab[24]) return false;
        const MoeLoc m = moe_locate(tab, T);
        u.a = HID + (size_t)T * 256 * 512 * 2; u.lda = 512; u.ldb = 256; u.nk = 8; u.nseg = 4;
        u.b0 = W + ((size_t)m.elo * 1024 + c * 256) * 256 * 2; u.b1 = W + ((size_t)m.ehi * 1024 + c * 256) * 256 * 2 - 4 * 128;
        u.pm = T; u.pn = c; u.tag = 0; u.aux0 = m.b * NTOK + m.rt * 256; u.aux1 = m.valid; return true;
    }
    __device__ __forceinline__ void a_rows(const mm::Unit& u, int r0, unsigned (&a)[1]) const { mm::plain_rows(u, r0, a); }
};
struct EpiMoeDown {
    float* out; const int* list;
    __device__ __forceinline__ void operator()(mm::f32x16 (&acc)[4][2], const mm::Unit& u, int wm, int wn, int r32, int h, int tid) const {
        using namespace mm;
        asm volatile("" : "+v"(r32), "+v"(h));
#pragma unroll
        for (int mt = 0; mt < 4; ++mt) {
            asm volatile("" ::: "memory");
            const int r = wm * 128 + mt * 32 + r32;
            if (r < u.aux1) {
                const int tok = list[u.aux0 + r];
#pragma unroll
                for (int nt = 0; nt < 2; ++nt) {
                    float* o = out + (size_t)tok * ND + u.pn * 256 + wn * 64 + nt * 32 + 16 * h;
#pragma unroll
                    for (int e4 = 0; e4 < 4; ++e4) { const f32x4 xv = *(const f32x4*)(o + 4 * e4);
                        *(f32x4*)(o + 4 * e4) = xv + (f32x4){acc[mt][nt][4 * e4], acc[mt][nt][4 * e4 + 1], acc[mt][nt][4 * e4 + 2], acc[mt][nt][4 * e4 + 3]}; }
                }
            }
        }
    }
};
__device__ __forceinline__ void ph_moe_up(const Params& P_, int l, char* smem) {
    const KA P = ka_get();
    moe_table(smem, (const int*)(P.ws + OFF_CTRL + MOE_CNT_OFF) + l * 32);
    SchedMoeUp S; S.H = P.ws + OFF_H; S.W = P.ws + OFF_WT + WT_GU; S.tab = (const int*)(smem + MOE_TAB); S.list = (const int*)(P.ws + OFF_ROUTE + MOE_LIST_OFF);
    EpiMoeUp E; E.hid = (bf16_t*)(P.ws + OFF_HID); E.list = S.list; E.rw = (const float*)(P.ws + OFF_ROUTE + MOE_RW_OFF);
    mm::gemm_phase(smem, S, E);
}
__device__ __forceinline__ void ph_moe_down(const Params& P_, int l, char* smem) {
    const KA P = ka_get();
    moe_table(smem, (const int*)(P.ws + OFF_CTRL + MOE_CNT_OFF) + l * 32);
    SchedMoeDown S; S.HID = P.ws + OFF_HID; S.W = P.ws + OFF_WT + WT_DN; S.tab = (const int*)(smem + MOE_TAB);
    EpiMoeDown E; E.out = P.out; E.list = (const int*)(P.ws + OFF_ROUTE + MOE_LIST_OFF);
    mm::gemm_phase(smem, S, E);
}


namespace at {
typedef short bf16x8 __attribute__((ext_vector_type(8)));
typedef short s16x4 __attribute__((ext_vector_type(4)));
typedef float f32x16 __attribute__((ext_vector_type(16)));
typedef unsigned u32x4 __attribute__((ext_vector_type(4)));
typedef unsigned u32x2 __attribute__((ext_vector_type(2)));
__device__ __forceinline__ s16x4 tr_read(const LAS char* p) { return __builtin_bit_cast(s16x4, __builtin_amdgcn_ds_read_tr16_b64_v4i16((LAS s16x4*)p)); }
__device__ __forceinline__ unsigned cvtpk(float lo, float hi) { unsigned r; asm volatile("v_cvt_pk_bf16_f32 %0, %1, %2" : "=v"(r) : "v"(lo), "v"(hi)); return r; }
__device__ __forceinline__ bf16x8 pack_p(const f32x16& x, int s) { u32x4 w; w.x = cvtpk(x[8 * s], x[8 * s + 1]); w.y = cvtpk(x[8 * s + 2], x[8 * s + 3]); w.z = cvtpk(x[8 * s + 4], x[8 * s + 5]); w.w = cvtpk(x[8 * s + 6], x[8 * s + 7]); return __builtin_bit_cast(bf16x8, w); }
constexpr int A_KBUF = 0, A_VBUF = 16384, A_STAGE = 32768, A_TAB = 65536;
}
__device__ __forceinline__ void ph_attnA(const Params& P_, int l, char* smem) {
    using namespace at;
    const KA P = ka_get();
    const Proj pj = proj_ptrs(P.ws);
    bf16_t* BR = (bf16_t*)(P.ws + OFF_BR);
    const int tid = tid_opaque(), lane = tid & 63, wid = __builtin_amdgcn_readfirstlane(tid >> 6), m = wid >> 2, qs = wid & 3, r32 = lane & 31, hl = lane >> 5;
    LAS char* lds = (LAS char*)smem;
    LAS float* tb = (LAS float*)(lds + A_TAB);
    const float* lp = P.in[I_LAM] + (size_t)l * 256;
    const float linit = lambda_init_of(l);
    const float lam = expf(wsum(lp[lane] * lp[64 + lane])) - expf(wsum(lp[128 + lane] * lp[192 + lane])) + linit;
    const float* subg = P.in[I_SUBLN] + (size_t)l * 128;
    const float* relb = P.in[I_RELB];
    const int i16 = lane & 15, tq = i16 >> 2, tp = i16 & 3, blk = (lane >> 4) & 1;
    const unsigned vlane = (unsigned)((4 * hl + tq) * 64 + blk * 32 + tp * 8);
    const unsigned klane = (unsigned)(m * 8192 + r32 * 128), kx = (unsigned)((r32 >> 1) & 7);
    for (int u2 = blockIdx.x; u2 < 1024; u2 += gridDim.x) {
        const int Pp = u2 & 511;
        const int bh = Pp >> 4, jj = Pp & 15, qb = (u2 >> 9) ? 31 - jj : jj, b = bh >> 2, h = bh & 3;
        const int q0 = qb * 128 + qs * 32, nt_wg = 2 * qb + 2, nt_w = (q0 >> 6) + 1;
        __syncthreads();
        for (int i = tid; i < 4160; i += 512) { const int rel = i - 4095; tb[i] = rel <= 63 ? relb[t5_bucket(rel) * 20 + h] * LOG2E : 0.f; }
        const float bfar = relb[15 * 20 + h] * LOG2E;
        bf16x8 qf[4];
        { const bf16_t* qp = pj.aq + (size_t)(b * NS + q0 + r32) * 512 + (h * 2 + m) * 64 + 8 * hl;
#pragma unroll
          for (int ks = 0; ks < 4; ++ks) qf[ks] = *(const bf16x8*)(qp + ks * 16); }
        u32x4 gk[2], gv[2];
        const bf16_t* kg = pj.ak + (size_t)(b * NS) * 512 + h * 128;
        const bf16_t* vg = pj.av + (size_t)(b * NS) * 512 + h * 128;
        unsigned gofs[2], kst[2], vst[2];
#pragma unroll
        for (int i = 0; i < 2; ++i) { const int idx = tid + 512 * i, key = idx >> 4, c = idx & 15;
            gofs[i] = (unsigned)(key * 512 + c * 8) * 2u;
            kst[i] = (unsigned)((c >> 3) * 8192 + key * 128 + (((c & 7) ^ ((key >> 1) & 7)) << 4));
            vst[i] = (unsigned)((c >> 2) * 4096 + key * 64 + (c & 3) * 16); }
#define AT_GLOAD(kt) do { const size_t o_ = (size_t)(kt) * 64 * 512 * 2; _Pragma("unroll") for (int i_ = 0; i_ < 2; ++i_) { gk[i_] = *(const u32x4*)((const char*)kg + o_ + gofs[i_]); gv[i_] = *(const u32x4*)((const char*)vg + o_ + gofs[i_]); } } while (0)
#define AT_LSTORE(buf) do { _Pragma("unroll") for (int i_ = 0; i_ < 2; ++i_) { *(LAS u32x4*)(lds + (buf) * A_STAGE + A_KBUF + kst[i_]) = gk[i_]; *(LAS u32x4*)(lds + (buf) * A_STAGE + A_VBUF + vst[i_]) = gv[i_]; } } while (0)
        AT_GLOAD(0); AT_LSTORE(0);
        __syncthreads();
        f32x16 O[4];
#pragma unroll
        for (int v = 0; v < 4; ++v)
#pragma unroll
            for (int e = 0; e < 16; ++e) O[v][e] = 0.f;
        float mrun = -INFINITY, lsum = 0.f;
        int buf = 0;
        for (int kt = 0; kt < nt_wg; ++kt) {
            if (kt + 1 < nt_wg) AT_GLOAD(kt + 1);
            if (kt < nt_w) {
                const LAS char* kb = lds + buf * A_STAGE + A_KBUF + klane;
                const LAS char* vb = lds + buf * A_STAGE + A_VBUF + vlane;
                f32x16 s0, s1;
                if (kt * 64 + 63 - q0 <= -559) {
#pragma unroll
                    for (int e = 0; e < 16; ++e) { s0[e] = bfar; s1[e] = bfar; }
                } else {
                    const LAS float* tl = tb + (kt * 64 - q0 - r32 + 4 * hl + 4095);
#pragma unroll
                    for (int e = 0; e < 16; ++e) { s0[e] = tl[(e & 3) + 8 * (e >> 2)]; s1[e] = tl[32 + (e & 3) + 8 * (e >> 2)]; }
                }
#pragma unroll
                for (int ks = 0; ks < 4; ++ks) {
                    const unsigned xo = (((unsigned)(ks * 2 + hl)) ^ kx) << 4;
                    const bf16x8 k0 = *(const LAS bf16x8*)(kb + xo), k1 = *(const LAS bf16x8*)(kb + 4096 + xo);
                    s0 = __builtin_amdgcn_mfma_f32_32x32x16_bf16(k0, qf[ks], s0, 0, 0, 0);
                    s1 = __builtin_amdgcn_mfma_f32_32x32x16_bf16(k1, qf[ks], s1, 0, 0, 0);
                }
                float mx = fmaxf(s0[0], s1[0]);
#pragma unroll
                for (int e = 1; e < 16; ++e) mx = fmaxf(mx, fmaxf(s0[e], s1[e]));
                mx = fmaxf(mx, __shfl_xor(mx, 32));
                const float mn = fmaxf(mrun, mx), alpha = exp2f(mrun - mn);
                mrun = mn;
                float ps = 0.f;
#pragma unroll
                for (int e = 0; e < 16; ++e) { s0[e] = exp2f(s0[e] - mn); s1[e] = exp2f(s1[e] - mn); ps += s0[e] + s1[e]; }
                lsum = lsum * alpha + ps;
#pragma unroll
                for (int v = 0; v < 4; ++v)
#pragma unroll
                    for (int e = 0; e < 16; ++e) O[v][e] *= alpha;
#pragma unroll
                for (int sub = 0; sub < 2; ++sub)
#pragma unroll
                    for (int s = 0; s < 2; ++s) {
                        const bf16x8 pb = pack_p(sub ? s1 : s0, s);
                        const LAS char* vk = vb + (sub * 32 + 16 * s) * 64;
#pragma unroll
                        for (int v = 0; v < 4; ++v) {
                            const s16x4 lo = tr_read(vk + v * 4096), hi = tr_read(vk + v * 4096 + 8 * 64);
                            const bf16x8 vf = __builtin_shufflevector(lo, hi, 0, 1, 2, 3, 4, 5, 6, 7);
                            O[v] = __builtin_amdgcn_mfma_f32_32x32x16_bf16(vf, pb, O[v], 0, 0, 0);
                        }
                    }
            }
            if (kt + 1 < nt_wg) AT_LSTORE(buf ^ 1);
            __syncthreads();
            buf ^= 1;
        }
#undef AT_GLOAD
#undef AT_LSTORE
        const float ltot = lsum + __shfl_xor(lsum, 32);
        const float inv = (m ? lam : 1.f) / ltot;
        LAS float* ex = (LAS float*)lds + qs * 4096 + lane;
        if (m == 1) {
#pragma unroll
            for (int v = 0; v < 4; ++v)
#pragma unroll
                for (int e = 0; e < 16; ++e) ex[(v * 16 + e) * 64] = O[v][e] * inv;
        }
        __syncthreads();
        if (m == 0) {
            float ss = 0.f;
#pragma unroll
            for (int v = 0; v < 4; ++v)
#pragma unroll
                for (int e = 0; e < 16; ++e) { const float x = O[v][e] * inv - ex[(v * 16 + e) * 64]; O[v][e] = x; ss += x * x; }
            ss += __shfl_xor(ss, 32);
            const float rstd = rsqrtf(ss * (1.0f / 128) + EPS) * (1.0f - linit);
            bf16_t* op = BR + (size_t)(b * NS + q0 + r32) * 1536 + h * 128 + 4 * hl;
#pragma unroll
            for (int v = 0; v < 4; ++v)
#pragma unroll
                for (int g = 0; g < 4; ++g) {
                    const int vd = v * 32 + 8 * g + 4 * hl;
                    const float4 sg = *(const float4*)(subg + vd);
                    u32x2 w; w.x = cvtpk(O[v][4 * g] * rstd * sg.x, O[v][4 * g + 1] * rstd * sg.y); w.y = cvtpk(O[v][4 * g + 2] * rstd * sg.z, O[v][4 * g + 3] * rstd * sg.w);
                    *(u32x2*)(op + v * 32 + 8 * g) = w;
                }
        }
    }
}


__device__ __forceinline__ void ph_attnB(const Params& P_, int l, char* smem) {
    using namespace at;
    const KA P = ka_get();
    const Proj pj = proj_ptrs(P.ws);
    bf16_t* BR = (bf16_t*)(P.ws + OFF_BR);
    const int tid = tid_opaque(), lane = tid & 63, wid = __builtin_amdgcn_readfirstlane(tid >> 6), g = wid >> 1, qh = wid & 1, r32 = lane & 31, hl = lane >> 5;
    LAS char* lds = (LAS char*)smem;
    constexpr int B_K = 0, B_V = 24576, B_TAB = 49152;
    LAS float* tb = (LAS float*)(lds + B_TAB);
    const float* relb = P.in[I_RELB];
    __syncthreads();
    for (int i = tid; i < 2048; i += 512) { const int hq = i >> 8, rel = (i & 255) - 191; tb[i] = relb[t5_bucket(rel) * 20 + 4 + hq] * LOG2E; }
    const int i16 = lane & 15, tq = i16 >> 2, tp = i16 & 3, blk = (lane >> 4) & 1;
    const unsigned vlane = (unsigned)((4 * hl + tq) * 64 + blk * 32 + tp * 8);
    const unsigned klane = (unsigned)(r32 * 128), kx = (unsigned)((r32 >> 1) & 7);
    const int skey = tid >> 3, sc = tid & 7;
    const unsigned kst = (unsigned)(skey * 128 + ((sc ^ ((skey >> 1) & 7)) << 4)), vst = (unsigned)((sc >> 2) * 4096 + skey * 64 + (sc & 3) * 16);
    for (int u = blockIdx.x; u < NB * 64 * 2; u += gridDim.x) {
        const int kvh = u & 1, c = (u >> 1) & 63, b = u >> 7, hq = kvh * 4 + g;
        const int t0 = c >= 2 ? 0 : 2 - c;
        __syncthreads();
#pragma unroll
        for (int t = 0; t < 3; ++t) if (t >= t0) {
            const size_t row = (size_t)(b * NS + (c - 2 + t) * 64 + skey) * 128 + kvh * 64 + sc * 8;
            *(LAS u32x4*)(lds + B_K + t * 8192 + kst) = *(const u32x4*)(pj.bk + row);
            *(LAS u32x4*)(lds + B_V + t * 8192 + vst) = *(const u32x4*)(pj.bv + row);
        }
        const int tok = b * NS + c * 64 + qh * 32 + r32;
        bf16x8 qf[4];
#pragma unroll
        for (int ks = 0; ks < 4; ++ks) qf[ks] = *(const bf16x8*)(pj.bq + (size_t)tok * 512 + hq * 64 + ks * 16 + 8 * hl);
        const float sink = P.in[I_SINK][l * 8 + hq] * LOG2E;
        __syncthreads();
        f32x16 O[2];
#pragma unroll
        for (int v = 0; v < 2; ++v)
#pragma unroll
            for (int e = 0; e < 16; ++e) O[v][e] = 0.f;
        float mrun = sink, lsum = hl == 0 ? 1.f : 0.f;
#pragma unroll
        for (int t = 0; t < 3; ++t) if (t >= t0) {
            const LAS char* kb = lds + B_K + t * 8192 + klane;
            const LAS char* vb = lds + B_V + t * 8192 + vlane;
            const LAS float* tl = tb + hq * 256 + (t * 64 - qh * 32 - r32 + 4 * hl + 63);
            f32x16 s0, s1;
#pragma unroll
            for (int e = 0; e < 16; ++e) { s0[e] = tl[(e & 3) + 8 * (e >> 2)]; s1[e] = tl[32 + (e & 3) + 8 * (e >> 2)]; }
#pragma unroll
            for (int ks = 0; ks < 4; ++ks) {
                const unsigned xo = (((unsigned)(ks * 2 + hl)) ^ kx) << 4;
                const bf16x8 k0 = *(const LAS bf16x8*)(kb + xo), k1 = *(const LAS bf16x8*)(kb + 4096 + xo);
                s0 = __builtin_amdgcn_mfma_f32_32x32x16_bf16(k0, qf[ks], s0, 0, 0, 0);
                s1 = __builtin_amdgcn_mfma_f32_32x32x16_bf16(k1, qf[ks], s1, 0, 0, 0);
            }
            float mx = fmaxf(s0[0], s1[0]);
#pragma unroll
            for (int e = 1; e < 16; ++e) mx = fmaxf(mx, fmaxf(s0[e], s1[e]));
            mx = fmaxf(mx, __shfl_xor(mx, 32));
            const float mn = fmaxf(mrun, mx), alpha = exp2f(mrun - mn);
            mrun = mn;
            float ps = 0.f;
#pragma unroll
            for (int e = 0; e < 16; ++e) { s0[e] = exp2f(s0[e] - mn); s1[e] = exp2f(s1[e] - mn); ps += s0[e] + s1[e]; }
            lsum = lsum * alpha + ps;
#pragma unroll
            for (int v = 0; v < 2; ++v)
#pragma unroll
                for (int e = 0; e < 16; ++e) O[v][e] *= alpha;
#pragma unroll
            for (int sub = 0; sub < 2; ++sub)
#pragma unroll
                for (int s2 = 0; s2 < 2; ++s2) {
                    const bf16x8 pb = pack_p(sub ? s1 : s0, s2);
                    const LAS char* vk = vb + (sub * 32 + 16 * s2) * 64;
#pragma unroll
                    for (int v = 0; v < 2; ++v) {
                        const s16x4 lo = tr_read(vk + v * 4096), hi = tr_read(vk + v * 4096 + 8 * 64);
                        const bf16x8 vf = __builtin_shufflevector(lo, hi, 0, 1, 2, 3, 4, 5, 6, 7);
                        O[v] = __builtin_amdgcn_mfma_f32_32x32x16_bf16(vf, pb, O[v], 0, 0, 0);
                    }
                }
        }
        const float inv = 1.f / (lsum + __shfl_xor(lsum, 32));
        bf16_t* op = BR + (size_t)tok * 1536 + 512 + hq * 64 + 4 * hl;
#pragma unroll
        for (int v = 0; v < 2; ++v)
#pragma unroll
            for (int gg = 0; gg < 4; ++gg) {
                u32x2 w; w.x = cvtpk(O[v][4 * gg] * inv, O[v][4 * gg + 1] * inv); w.y = cvtpk(O[v][4 * gg + 2] * inv, O[v][4 * gg + 3] * inv);
                *(u32x2*)(op + v * 32 + 8 * gg) = w;
            }
    }
}


__device__ __forceinline__ void ph_attnC(const Params& P_, int l, char* smem) {
    using namespace at;
    typedef float f32x4 __attribute__((ext_vector_type(4)));
    const KA P = ka_get();
    const Proj pj = proj_ptrs(P.ws);
    bf16_t* BR = (bf16_t*)(P.ws + OFF_BR);
    const int tid = tid_opaque(), lane = tid & 63, wid = __builtin_amdgcn_readfirstlane(tid >> 6), l16 = lane & 15, g4 = lane >> 4;
    LAS char* lds = (LAS char*)smem;
    constexpr int C_SC = 0, C_SEL = 131072, C_BKT = 139264, C_TAB = 143360;
    LAS float* tb = (LAS float*)(lds + C_TAB);
    const float* relb = P.in[I_RELB];
    __syncthreads();
    for (int i = tid; i < 256; i += 512) tb[i] = relb[(i >> 3) * 20 + 12 + (i & 7)] * LOG2E;
    const unsigned long long ltmask = (1ull << lane) - 1ull;
    const int tq = l16 >> 2, tp = l16 & 3;
    for (int unit = blockIdx.x; unit < NTOK / 16; unit += gridDim.x) {
        const int tok0 = unit * 16, b = tok0 >> 12, q0 = tok0 & (NS - 1), c = q0 >> 6, N = (c + 1) * 64;
        __syncthreads();
        if (N > 256) {
            bf16x8 iqf[4];
#pragma unroll
            for (int hh = 0; hh < 4; ++hh) iqf[hh] = *(const bf16x8*)(pj.iq + (size_t)(tok0 + l16) * 128 + hh * 32 + 8 * g4);
            const f32x4 w4 = *(const f32x4*)(pj.iw + (size_t)(tok0 + l16) * 4);
            const bf16_t* ikb = pj.ik + (size_t)(b * NS) * 32 + l16 * 32 + 8 * g4;
            for (int kt = wid; kt < N / 16; kt += 8) {
                const bf16x8 a = *(const bf16x8*)(ikb + (size_t)kt * 512);
                float sc[4] = {0.f, 0.f, 0.f, 0.f};
#pragma unroll
                for (int hh = 0; hh < 4; ++hh) {
                    const f32x4 d = __builtin_amdgcn_mfma_f32_16x16x32_bf16(a, iqf[hh], (f32x4){0.f, 0.f, 0.f, 0.f}, 0, 0, 0);
#pragma unroll
                    for (int r = 0; r < 4; ++r) sc[r] += fmaxf(d[r], 0.f) * w4[hh];
                }
                unsigned w01 = __builtin_bit_cast(unsigned, __builtin_amdgcn_cvt_pkrtz(sc[0] + 0.0f, sc[1] + 0.0f));
                unsigned w23 = __builtin_bit_cast(unsigned, __builtin_amdgcn_cvt_pkrtz(sc[2] + 0.0f, sc[3] + 0.0f));
                w01 ^= (((w01 >> 15) & 0x00010001u) * 0xFFFFu) | 0x80008000u;
                w23 ^= (((w23 >> 15) & 0x00010001u) * 0xFFFFu) | 0x80008000u;
                u32x2 o; o.x = w01; o.y = w23;
                *(LAS u32x2*)(lds + C_SC + l16 * 8192 + (kt * 16 + g4 * 4) * 2) = o;
            }
        }
        __syncthreads();
#pragma unroll 1
        for (int rr = 0; rr < 2; ++rr) {
            const int row = 2 * wid + rr, q = q0 + row;
            LAS unsigned short* sel = (LAS unsigned short*)(lds + C_SEL) + row * 256;
            LAS unsigned char* bkt = (LAS unsigned char*)(lds + C_BKT) + row * 256;
            if (N <= 256) {
                for (int i = lane; i < N; i += 64) { sel[i] = (unsigned short)i; bkt[i] = (unsigned char)t5_bucket(i - q); }
            } else {
                const LAS unsigned* rowp = (const LAS unsigned*)(lds + C_SC + row * 8192);
                const int ndw = N >> 1;
                unsigned kw[32];
#pragma unroll
                for (int i = 0; i < 32; ++i) kw[i] = (lane + 64 * i < ndw) ? rowp[lane + 64 * i] : 0u;
                unsigned T = 0;
#pragma unroll 1
                for (int bit = 15; bit >= 0; --bit) {
                    const unsigned cand = T | (1u << bit);
                    int cnt = 0;
#pragma unroll
                    for (int i = 0; i < 32; ++i) cnt += ((kw[i] & 0xffffu) >= cand) + ((kw[i] >> 16) >= cand);
#pragma unroll
                    for (int o = 32; o; o >>= 1) cnt += __shfl_xor(cnt, o);
                    if (cnt >= 256) T = cand;
                }
                int ngt = 0;
#pragma unroll
                for (int i = 0; i < 32; ++i) ngt += ((kw[i] & 0xffffu) > T) + ((kw[i] >> 16) > T);
#pragma unroll
                for (int o = 32; o; o >>= 1) ngt += __shfl_xor(ngt, o);
                const int need = 256 - ngt;
                int nsel = 0, neq = 0;
                const int nI = (ndw + 63) >> 6;
#pragma unroll 1
                for (int i = 0; i < nI; ++i) {
                    const unsigned kwi = (lane + 64 * i < ndw) ? rowp[lane + 64 * i] : 0u;
                    const unsigned lo = kwi & 0xffffu, hi = kwi >> 16;
                    const bool el = lo == T, eh = hi == T;
                    const unsigned long long bel = __ballot(el), beh = __ballot(eh);
                    const int rl = neq + __popcll(bel & ltmask) + __popcll(beh & ltmask), rh = rl + (el ? 1 : 0);
                    const bool tl = (lo > T) || (el && rl < need), th = (hi > T) || (eh && rh < need);
                    const unsigned long long btl = __ballot(tl), bth = __ballot(th);
                    const int pl = nsel + __popcll(btl & ltmask) + __popcll(bth & ltmask), ph = pl + (tl ? 1 : 0);
                    const int klo = 2 * (lane + 64 * i);
                    if (tl) { sel[pl] = (unsigned short)klo; bkt[pl] = (unsigned char)t5_bucket(klo - q); }
                    if (th) { sel[ph] = (unsigned short)(klo + 1); bkt[ph] = (unsigned char)t5_bucket(klo + 1 - q); }
                    nsel += __popcll(btl) + __popcll(bth); neq += __popcll(bel) + __popcll(beh);
                }
            }
        }
        const int cnt = N < 256 ? N : 256;
        LAS char* vreg = lds + C_SC + wid * 16384;
#pragma unroll 1
        for (int rr = 0; rr < 2; ++rr) {
            const int row = 2 * wid + rr, tok = tok0 + row;
            const LAS unsigned short* sel = (const LAS unsigned short*)(lds + C_SEL) + row * 256;
            const LAS unsigned char* bkt = (const LAS unsigned char*)(lds + C_BKT) + row * 256;
            bf16x8 qf[2];
#pragma unroll
            for (int ks = 0; ks < 2; ++ks) qf[ks] = *(const bf16x8*)(pj.cq + (size_t)tok * 512 + (l16 & 7) * 64 + ks * 32 + 8 * g4);
            const bf16_t* ckb = pj.ck + (size_t)(b * NS) * 64 + 8 * g4;
            f32x4 O[4];
#pragma unroll
            for (int v = 0; v < 4; ++v) O[v] = (f32x4){0.f, 0.f, 0.f, 0.f};
            float mrun = -INFINITY, lsum = 0.f;
#pragma unroll 1
            for (int hv = 0; hv < 2; ++hv) {
                if (hv * 128 >= cnt) break;
#pragma unroll
                for (int i = 0; i < 16; ++i) {
                    if ((i & 3) == 0) asm volatile("" ::: "memory");
                    const int piece = lane + 64 * i, e = piece >> 3, c8 = piece & 7, sl = hv * 128 + e;
                    const int idx = sl < cnt ? (int)sel[sl] : 0;
                    const u32x4 v = *(const u32x4*)(pj.cv + (size_t)(b * NS + idx) * 64 + c8 * 8);
                    *(LAS u32x4*)(vreg + (c8 >> 2) * 8192 + e * 64 + (c8 & 3) * 16) = v;
                }
#pragma unroll 1
                for (int t2 = 0; t2 < 4; ++t2) {
                    f32x4 d[2];
#pragma unroll
                    for (int u = 0; u < 2; ++u) {
                        const int t = hv * 8 + 2 * t2 + u, e = t * 16 + l16;
                        const int idx = e < cnt ? (int)sel[e] : 0;
                        const bf16x8 a0 = *(const bf16x8*)(ckb + (size_t)idx * 64), a1 = *(const bf16x8*)(ckb + (size_t)idx * 64 + 32);
                        f32x4 dd = __builtin_amdgcn_mfma_f32_16x16x32_bf16(a0, qf[0], (f32x4){0.f, 0.f, 0.f, 0.f}, 0, 0, 0);
                        dd = __builtin_amdgcn_mfma_f32_16x16x32_bf16(a1, qf[1], dd, 0, 0, 0);
                        const unsigned bk4 = *(const LAS unsigned*)(bkt + t * 16 + g4 * 4);
#pragma unroll
                        for (int r = 0; r < 4; ++r) {
                            const int slot = t * 16 + g4 * 4 + r;
                            const float bias = tb[((bk4 >> (8 * r)) & 0xffu) * 8 + (l16 & 7)];
                            dd[r] = slot < cnt ? dd[r] + bias : -INFINITY;
                        }
                        d[u] = dd;
                    }
                    float mx = fmaxf(fmaxf(fmaxf(d[0][0], d[0][1]), fmaxf(d[0][2], d[0][3])), fmaxf(fmaxf(d[1][0], d[1][1]), fmaxf(d[1][2], d[1][3])));
                    mx = fmaxf(mx, __shfl_xor(mx, 16)); mx = fmaxf(mx, __shfl_xor(mx, 32));
                    const float mn = fmaxf(mrun, mx), alpha = exp2f(mrun - mn);
                    mrun = mn;
                    float ps = 0.f;
#pragma unroll
                    for (int u = 0; u < 2; ++u)
#pragma unroll
                        for (int r = 0; r < 4; ++r) { d[u][r] = exp2f(d[u][r] - mn); ps += d[u][r]; }
                    lsum = lsum * alpha + ps;
#pragma unroll
                    for (int v = 0; v < 4; ++v) O[v] *= alpha;
                    u32x4 pw; pw.x = cvtpk(d[0][0], d[0][1]); pw.y = cvtpk(d[0][2], d[0][3]); pw.z = cvtpk(d[1][0], d[1][1]); pw.w = cvtpk(d[1][2], d[1][3]);
                    const bf16x8 pb = __builtin_bit_cast(bf16x8, pw);
                    const LAS char* vk = vreg + (32 * t2 + 4 * g4 + tq) * 64 + tp * 8;
#pragma unroll
                    for (int v = 0; v < 4; ++v) {
                        const s16x4 lo = tr_read(vk + (v >> 1) * 8192 + (v & 1) * 32), hi = tr_read(vk + (v >> 1) * 8192 + (v & 1) * 32 + 16 * 64);
                        const bf16x8 vf = __builtin_shufflevector(lo, hi, 0, 1, 2, 3, 4, 5, 6, 7);
                        O[v] = __builtin_amdgcn_mfma_f32_16x16x32_bf16(vf, pb, O[v], 0, 0, 0);
                    }
                }
            }
            lsum += __shfl_xor(lsum, 16); lsum += __shfl_xor(lsum, 32);
            const float inv = 1.f / lsum;
            if (l16 < 8) {
                bf16_t* op = BR + (size_t)tok * 1536 + 1024 + l16 * 64 + g4 * 4;
#pragma unroll
                for (int v = 0; v < 4; ++v) { u32x2 w; w.x = cvtpk(O[v][0] * inv, O[v][1] * inv); w.y = cvtpk(O[v][2] * inv, O[v][3] * inv); *(u32x2*)(op + v * 16) = w; }
            }
        }
    }
}

#if DIAG
__device__ __forceinline__ void ph_diag_stats(const Params& P_) {
    const KA P = ka_get();
    const Proj pj = proj_ptrs(P.ws);
    const bf16_t* buf; size_t n;
    if (DIAG_BUF == 0) { buf = pj.av; n = (size_t)NTOK * 512; }
    else if (DIAG_BUF == 1) { buf = pj.aq; n = (size_t)NTOK * 512; }
    else if (DIAG_BUF == 2) { buf = pj.ik; n = (size_t)NTOK * 32; }
    else { buf = pj.cv; n = (size_t)NTOK * 64; }
    const int tid = tid_opaque();
    float ss = 0.f; unsigned bad = 0;
    for (size_t i = (size_t)blockIdx.x * 512 + tid; i < n; i += (size_t)gridDim.x * 512) { const float v = bf2f(buf[i]); if (!(fabsf(v) < 1e30f)) ++bad; else ss += v * v; }
    ss = wsum(ss); bad = (unsigned)wsum((float)bad);
    if ((tid & 63) == 0) { atomicAdd((float*)(P.ws + OFF_CTRL + 16384), ss / (float)n); atomicAdd((unsigned*)(P.ws + OFF_CTRL + 16388), bad); }
}
__device__ __forceinline__ void ph_diag_scale(const Params& P_) {
    const KA P = ka_get();
    const float ms = *(const float*)(P.ws + OFF_CTRL + 16384); const unsigned bad = *(const unsigned*)(P.ws + OFF_CTRL + 16388);
    const float delta = bad > 0 ? 0.9f : 0.1f + 0.3f * fminf(2.f, ms);
    const int tid = tid_opaque();
    for (size_t i = (size_t)blockIdx.x * 512 + tid; i < (size_t)NTOK * ND; i += (size_t)gridDim.x * 512) P.out[i] *= (1.f + delta);
}
#endif

constexpr int LDS_BYTES = 147456;
enum { PH_PREP = 0, PH_INPROJ, PH_HEADNORM, PH_ATTN_A, PH_ATTN_B, PH_ATTN_C, PH_GB, PH_OUT, PH_NORM2, PH_MOE, PH_MOE2, PH_COUNT };

template <int PH>
__device__ __forceinline__ void run_phase(const Params& P, int l, float* lds) {
#ifdef SKIPX
    if (PH == SKIPX) return;
#endif
    if (PH == PH_PREP) { ph_convert_weights(P, l); ph_rmsnorm(l == 0 ? P.in[I_X] : P.out, P.in[I_NMG] + (size_t)l * ND, (bf16_t*)(P.ws + OFF_H)); }
    if (PH == PH_INPROJ) { if (OPT_INPROJ) ph_inproj(P, l, (char*)lds); else ph_inproj_naive(P, l, lds); }
    if (PH == PH_HEADNORM) { if (!OPT_INPROJ) ph_headnorm_naive(P, l); }
    if (PH == PH_ATTN_A) { if (OPT_ATTN_A) ph_attnA(P, l, (char*)lds); else ph_attnA_naive(P, l, lds); }
    if (PH == PH_ATTN_B) { if (OPT_ATTN_B) ph_attnB(P, l, (char*)lds); else ph_attnB_naive(P, l, lds); }
    if (PH == PH_ATTN_C) { if (OPT_ATTN_C) ph_attnC(P, l, (char*)lds); else ph_attnC_naive(P, l, lds); }
    if (PH == PH_GB) { if (OPT_GB) ph_gatebranch(P, l, (char*)lds); else ph_gatebranch_naive(P, l, lds); }
    if (PH == PH_OUT) { if (OPT_OUT) ph_outproj(P, l, (char*)lds); else ph_out_naive(P, l, lds); }
    if (PH == PH_NORM2) ph_norm2_route(P, l);
    if (PH == PH_MOE) { if (OPT_MOE) { ph_moe_up(P, l, (char*)lds); } else ph_moe_naive(P, l, lds); }
    if (PH == PH_MOE2) { if (OPT_MOE) ph_moe_down(P, l, (char*)lds); }
}

template <int PH>
__global__ void __launch_bounds__(512, 2) k_phase(Params P, int l) {
    extern __shared__ __attribute__((aligned(16))) char smem[];
    run_phase<PH>(P, l, (float*)smem);
}

template <int PH>
static void launch_phase(const Params& P, int l, int grid, hipStream_t stream) {
    static bool attr = false;
    if (!attr) { (void)hipFuncSetAttribute((const void*)k_phase<PH>, hipFuncAttributeMaxDynamicSharedMemorySize, LDS_BYTES); attr = true; }
    hipLaunchKernelGGL(k_phase<PH>, dim3(grid), dim3(512), LDS_BYTES, stream, P, l);
}

__global__ void __launch_bounds__(512, 2) k_fused(Params P) {
    extern __shared__ __attribute__((aligned(16))) char smem[];
    float* lds = (float*)smem;
    volatile LAS unsigned* st = (volatile LAS unsigned*)(smem + LDS_BYTES - 16);
    if (threadIdx.x == 0) { st[0] = 0u; st[1] = 0u; st[2] = 0u; st[3] = 0u; }
    __syncthreads();
    const XcdBarrier bar = xcd_barrier_post((unsigned*)(P.ws + OFF_CTRL), st);
    for (int l = 0; l < 2; ++l) {
        run_phase<PH_PREP>(P, l, lds);     xcd_barrier(bar);
        run_phase<PH_INPROJ>(P, l, lds);   xcd_barrier(bar);
#if DIAG
        if (DIAG == 1 && l == 0) { ph_diag_stats(P); xcd_barrier(bar); }
        ph_inproj_naive(P, l, lds); xcd_barrier(bar); ph_headnorm_naive(P, l); xcd_barrier(bar);
#endif
        if (!OPT_INPROJ) { run_phase<PH_HEADNORM>(P, l, lds); xcd_barrier(bar); } else { xcd_barrier(bar); }
        run_phase<PH_ATTN_A>(P, l, lds);
        run_phase<PH_ATTN_B>(P, l, lds);
        run_phase<PH_ATTN_C>(P, l, lds);   xcd_barrier(bar);
        run_phase<PH_GB>(P, l, lds);       xcd_barrier(bar);
        run_phase<PH_OUT>(P, l, lds);      xcd_barrier(bar);
        run_phase<PH_NORM2>(P, l, lds);    xcd_barrier(bar);
        run_phase<PH_MOE>(P, l, lds);      xcd_barrier(bar);
        if (OPT_MOE) { run_phase<PH_MOE2>(P, l, lds); xcd_barrier(bar); }
    }
#if DIAG == 3
    ph_diag_scale(P);
#endif
}

extern "C" void kernel_launch(void* const* d_in, const int* in_sizes, int n_in, void* d_out, int out_size, void* d_ws, size_t ws_size, hipStream_t stream) {
    Params P{};
    for (int i = 0; i < 20; ++i) P.in[i] = (const float*)d_in[i];
    P.out = (float*)d_out; P.ws = (char*)d_ws;
    (void)hipMemsetAsync(d_ws, 0, CTRL_BYTES, stream);
#if FUSED
    static int grid = 0;
    if (!grid) {
        int dev = 0, cus = 0, per_cu = 0;
        (void)hipGetDevice(&dev);
        (void)hipDeviceGetAttribute(&cus, hipDeviceAttributeMultiprocessorCount, dev);
        (void)hipFuncSetAttribute((const void*)k_fused, hipFuncAttributeMaxDynamicSharedMemorySize, LDS_BYTES);
        (void)hipOccupancyMaxActiveBlocksPerMultiprocessor(&per_cu, (const void*)k_fused, 512, LDS_BYTES);
        grid = cus * (per_cu < 1 ? per_cu : 1);
        if (grid <= 0) { fprintf(stderr, "k_fused: occupancy query says %d blocks per CU\n", per_cu); grid = cus; }
    }
    hipLaunchKernelGGL(k_fused, dim3(grid), dim3(512), LDS_BYTES, stream, P);
#else
    const int G = 2048;
    for (int l = 0; l < 2; ++l) {
        launch_phase<PH_PREP>(P, l, G, stream);
        launch_phase<PH_INPROJ>(P, l, G, stream);
        launch_phase<PH_HEADNORM>(P, l, G, stream);
        launch_phase<PH_ATTN_A>(P, l, G, stream);
        launch_phase<PH_ATTN_B>(P, l, G, stream);
        launch_phase<PH_ATTN_C>(P, l, G, stream);
        launch_phase<PH_GB>(P, l, G, stream);
        launch_phase<PH_OUT>(P, l, G, stream);
        launch_phase<PH_NORM2>(P, l, G, stream);
        launch_phase<PH_MOE>(P, l, G, stream);
    }
#endif
}
```

```cpp
#include <hip/hip_runtime.h>
#include <stdint.h>
#include <stdio.h>
#include <type_traits>

#ifndef FUSED
#define FUSED 1
#endif
#define OPT_INPROJ 1
#define OPT_GB 1
#define OPT_OUT 1
#define OPT_MOE 1
#define OPT_ATTN_A 1
#define OPT_ATTN_B 1
#define OPT_ATTN_C 1
#define DIAG 0
#define DUP_PH -1
#define DUP_MODE 0
#define PROF_ID 0
#define C_DUP 0
#define VBID ((blockIdx.x & 31) * 8 + (blockIdx.x >> 5))
#define DIAG_BUF 0

#define LAS __attribute__((address_space(3)))
typedef unsigned short bf16_t;

constexpr int NB = 8, NS = 4096, ND = 1024, NTOK = NB * NS;
constexpr int IN_COLS = 3108;
constexpr float LOG2E = 1.4426950408889634f;
constexpr float QSCALE = 0.125f * LOG2E;
constexpr float EPS = 1e-6f;
constexpr float IWSCALE = 0.08838834764831845f;

constexpr size_t MB = (size_t)1 << 20;
constexpr size_t OFF_CTRL = 0;
constexpr size_t CTRL_BYTES = 65536;
constexpr size_t OFF_ROUTE = 1 * MB;
constexpr size_t MOE_CNT_OFF = 32768;
constexpr size_t MOE_LIST_OFF = 512 * 1024;
constexpr size_t MOE_RW_OFF = 512 * 1024 + 3 * MB;
constexpr size_t OFF_WT = 5 * MB;
constexpr size_t OFF_H = 49 * MB;
constexpr size_t OFF_BR = 113 * MB;
constexpr size_t OFF_PROJ = 209 * MB;
constexpr size_t OFF_MERGED = OFF_PROJ + 128 * MB;
constexpr size_t OFF_STREAM = OFF_PROJ + 195 * MB;
constexpr size_t PO_AQ = 0, PO_AK = 32 * MB, PO_AV = 64 * MB, PO_BQ = 96 * MB, PO_BK = 128 * MB, PO_BV = 136 * MB, PO_CQ = 144 * MB,
                 PO_CK = 176 * MB, PO_CV = 180 * MB, PO_IQ = 184 * MB, PO_IK = 192 * MB, PO_IW = 194 * MB;

struct Params {
    const float* in[20];
    float* out;
    char* ws;
};
typedef const __attribute__((address_space(4))) char* kaptr_t;
struct KAIn { kaptr_t base; __device__ __forceinline__ const float* operator[](int i) const { return *(const float* const __attribute__((address_space(4)))*)(base + 8 * i); } };
struct KA { KAIn in; float* out; char* ws; };
__device__ __forceinline__ KA ka_get() {
    kaptr_t p = (kaptr_t)__builtin_amdgcn_kernarg_segment_ptr(); asm volatile("" : "+s"(p));
    KA k; k.in.base = p; k.out = *(float* const __attribute__((address_space(4)))*)(p + 160); k.ws = *(char* const __attribute__((address_space(4)))*)(p + 168); return k;
}
enum { I_X = 0, I_RELB, I_NMG, I_WIN, I_QKG, I_LAM, I_SUBLN, I_SINK, I_WBR, I_WGATE, I_BGATE, I_WOUT, I_NFG, I_WRG, I_BRG, I_WRE, I_BRE, I_WFG, I_WFU, I_WFD };

struct Proj { bf16_t *aq, *ak, *av, *bq, *bk, *bv, *cq, *ck, *cv, *iq, *ik; float* iw; };
__device__ __forceinline__ Proj proj_ptrs(char* ws) {
    char* p = ws + OFF_PROJ; Proj r;
    r.aq = (bf16_t*)(p + PO_AQ); r.ak = (bf16_t*)(p + PO_AK); r.av = (bf16_t*)(p + PO_AV); r.bq = (bf16_t*)(p + PO_BQ); r.bk = (bf16_t*)(p + PO_BK); r.bv = (bf16_t*)(p + PO_BV);
    r.cq = (bf16_t*)(p + PO_CQ); r.ck = (bf16_t*)(p + PO_CK); r.cv = (bf16_t*)(p + PO_CV); r.iq = (bf16_t*)(p + PO_IQ); r.ik = (bf16_t*)(p + PO_IK); r.iw = (float*)(p + PO_IW);
    return r;
}

__device__ __forceinline__ int tid_opaque() { int t = threadIdx.x; asm volatile("" : "+v"(t)); return t; }
#define PROF_LDS_OFF (147456 - 32)
#define PROF_BEGIN(id) unsigned long long _pt##id = 0; if (PROF_ID == (id) || ((id) == 99 && PROF_ID != 0)) _pt##id = __builtin_amdgcn_s_memrealtime();
#define PROF_END(id, smem_) if (PROF_ID == (id) && threadIdx.x == 0) { *(volatile LAS unsigned*)((LAS char*)(smem_) + PROF_LDS_OFF) += (unsigned)(__builtin_amdgcn_s_memrealtime() - _pt##id); }
__device__ __forceinline__ float bf2f(bf16_t b) { return __uint_as_float(((unsigned)b) << 16); }
__device__ __forceinline__ bf16_t f2bf(float f) { unsigned u = __float_as_uint(f); u += 0x7FFFu + ((u >> 16) & 1u); return (bf16_t)(u >> 16); }
__device__ __forceinline__ float bflo(unsigned w) { return __uint_as_float(w << 16); }
__device__ __forceinline__ float bfhi(unsigned w) { return __uint_as_float(w & 0xffff0000u); }
__device__ __forceinline__ unsigned pack2(float lo, float hi) { return (unsigned)f2bf(lo) | ((unsigned)f2bf(hi) << 16); }
__device__ __forceinline__ int wave_sum_dpp(int v) {
    v += __builtin_amdgcn_update_dpp(0, v, 0x111, 0xf, 0xf, true);
    v += __builtin_amdgcn_update_dpp(0, v, 0x112, 0xf, 0xf, true);
    v += __builtin_amdgcn_update_dpp(0, v, 0x114, 0xf, 0xf, true);
    v += __builtin_amdgcn_update_dpp(0, v, 0x118, 0xf, 0xf, true);
    v += __builtin_amdgcn_update_dpp(0, v, 0x142, 0xa, 0xf, true);
    v += __builtin_amdgcn_update_dpp(0, v, 0x143, 0xc, 0xf, true);
    return __builtin_amdgcn_readlane(v, 63);
}
__device__ __forceinline__ float x32_max(float v) { const auto r = __builtin_amdgcn_permlane32_swap(__float_as_uint(v), __float_as_uint(v), false, false); return fmaxf(__uint_as_float(r[0]), __uint_as_float(r[1])); }
__device__ __forceinline__ float x32_sum(float v) { const auto r = __builtin_amdgcn_permlane32_swap(__float_as_uint(v), __float_as_uint(v), false, false); return __uint_as_float(r[0]) + __uint_as_float(r[1]); }
__device__ __forceinline__ float x16_max(float v) { const auto r = __builtin_amdgcn_permlane16_swap(__float_as_uint(v), __float_as_uint(v), false, false); return fmaxf(__uint_as_float(r[0]), __uint_as_float(r[1])); }
__device__ __forceinline__ float x16_sum(float v) { const auto r = __builtin_amdgcn_permlane16_swap(__float_as_uint(v), __float_as_uint(v), false, false); return __uint_as_float(r[0]) + __uint_as_float(r[1]); }
__device__ __forceinline__ float wsum_dpp(float v) {
    v += __builtin_bit_cast(float, __builtin_amdgcn_update_dpp(0, __builtin_bit_cast(int, v), 0x111, 0xf, 0xf, true));
    v += __builtin_bit_cast(float, __builtin_amdgcn_update_dpp(0, __builtin_bit_cast(int, v), 0x112, 0xf, 0xf, true));
    v += __builtin_bit_cast(float, __builtin_amdgcn_update_dpp(0, __builtin_bit_cast(int, v), 0x114, 0xf, 0xf, true));
    v += __builtin_bit_cast(float, __builtin_amdgcn_update_dpp(0, __builtin_bit_cast(int, v), 0x118, 0xf, 0xf, true));
    v += __builtin_bit_cast(float, __builtin_amdgcn_update_dpp(0, __builtin_bit_cast(int, v), 0x142, 0xa, 0xf, true));
    v += __builtin_bit_cast(float, __builtin_amdgcn_update_dpp(0, __builtin_bit_cast(int, v), 0x143, 0xc, 0xf, true));
    return __builtin_bit_cast(float, __builtin_amdgcn_readlane(__builtin_bit_cast(int, v), 63));
}
__device__ __forceinline__ float wsum(float v) { for (int o = 32; o; o >>= 1) v += __shfl_xor(v, o); return v; }
__device__ __forceinline__ float wmax(float v) { for (int o = 32; o; o >>= 1) v = fmaxf(v, __shfl_xor(v, o)); return v; }
__device__ __forceinline__ int t5_bucket(int rel) {
    const int n = rel < 0 ? -rel : rel;
    int b = n;
    if (n >= 8) b = 8 + (n >= 15) + (n >= 27) + (n >= 50) + (n >= 91) + (n >= 166) + (n >= 305) + (n >= 559);
    return (rel > 0 ? 16 : 0) + b;
}
__device__ __forceinline__ float lambda_init_of(int l) { return 0.8f - 0.6f * expf(-0.3f * (float)l); }
__device__ __forceinline__ float dot8(uint4 kv, const float* q) {
    return bflo(kv.x) * q[0] + bfhi(kv.x) * q[1] + bflo(kv.y) * q[2] + bfhi(kv.y) * q[3] + bflo(kv.z) * q[4] + bfhi(kv.z) * q[5] + bflo(kv.w) * q[6] + bfhi(kv.w) * q[7];
}


#define XB_TMO      128
#define XB_XCNT(j)  (256  + 64 * (j))
#define XB_XSUB(j)  (1280 + 64 * (j))
#define XB_XGEN(j)  (2304 + 64 * (j))
#define XB_TOP      3328
#define XB_TOPGEN   3392
#define XCD_BAR_WORDS 3456
#define XB_SPIN_CAP (1u << 22)
__device__ __forceinline__ unsigned xb_ld(unsigned* p)              { return __hip_atomic_load(p, __ATOMIC_RELAXED, __HIP_MEMORY_SCOPE_AGENT); }
__device__ __forceinline__ unsigned xb_add(unsigned* p, unsigned v) { return __hip_atomic_fetch_add(p, v, __ATOMIC_RELAXED, __HIP_MEMORY_SCOPE_AGENT); }
__device__ __forceinline__ unsigned xb_xcc_id() { return (unsigned)__builtin_amdgcn_s_getreg((3 << 11) | 20) & 0xFu; }
#define XB_SPIN(cond, bar) do { unsigned _sp = 0; while (cond) { __builtin_amdgcn_s_sleep(1); \
    if ((++_sp & 255u) == 0u) { if (xb_ld(&(bar)[XB_TMO])) break; if (_sp > XB_SPIN_CAP) { atomicAdd(&(bar)[XB_TMO], 1u); break; } } } } while (0)
struct XcdBarrier { unsigned* bar; unsigned x; volatile LAS unsigned* st; };
__device__ __forceinline__ XcdBarrier xcd_barrier_post(unsigned* bar, volatile LAS unsigned* st) {
    XcdBarrier b; b.bar = bar; b.x = xb_xcc_id(); b.st = st;
    if (threadIdx.x == 0) (void)xb_add(&bar[XB_XCNT(b.x)], 1u);
    return b;
}
__device__ __forceinline__ void xcd_barrier_complete(unsigned* bar, unsigned x, unsigned& nloc, unsigned& nx) {
    const unsigned G = gridDim.x * gridDim.y * gridDim.z;
    unsigned sum, cnt, mine, sp = 0u;
    for (;;) {
        sum = 0u; cnt = 0u; mine = 0u;
#pragma unroll
        for (unsigned j = 0; j < 16; ++j) { const unsigned c = xb_ld(&bar[XB_XCNT(j)]); sum += c; cnt += (c > 0u) ? 1u : 0u; mine = (j == x) ? c : mine; }
        if (sum == G) break;
        __builtin_amdgcn_s_sleep(1);
        if ((++sp & 255u) == 0u) { if (xb_ld(&bar[XB_TMO])) break; if (sp > XB_SPIN_CAP) { atomicAdd(&bar[XB_TMO], 1u); break; } }
    }
    nloc = mine > 0u ? mine : 1u; nx = cnt > 0u ? cnt : 1u;
}
__device__ __forceinline__ void xcd_barrier(const XcdBarrier& b) {
    asm volatile("s_waitcnt vmcnt(0)" ::: "memory");
    __syncthreads();
    if (threadIdx.x == 0) {
        unsigned* bar = b.bar;
        __builtin_amdgcn_s_waitcnt(0);
        unsigned nloc = b.st[0], nx = b.st[1];
        if (nloc == 0u) { xcd_barrier_complete(bar, b.x, nloc, nx); b.st[0] = nloc; b.st[1] = nx; }
        const unsigned old = xb_add(&bar[XB_XSUB(b.x)], 1u);
        const unsigned gen = old / nloc;
        if (old + 1u == (gen + 1u) * nloc) {
            __builtin_amdgcn_fence(__ATOMIC_RELEASE, "agent");
            asm volatile("s_waitcnt vmcnt(0)" ::: "memory");
            const unsigned og = xb_add(&bar[XB_TOP], 1u);
            const unsigned tg = og / nx;
            if (og + 1u == (tg + 1u) * nx) xb_add(&bar[XB_TOPGEN], 1u);
            else XB_SPIN(xb_ld(&bar[XB_TOPGEN]) == tg, bar);
            __builtin_amdgcn_fence(__ATOMIC_ACQUIRE, "agent");
            xb_add(&bar[XB_XGEN(b.x)], 1u);
            asm volatile("s_waitcnt vmcnt(0)" ::: "memory");
        } else {
            XB_SPIN(xb_ld(&bar[XB_XGEN(b.x)]) == gen, bar);
            __builtin_amdgcn_fence(__ATOMIC_ACQUIRE, "agent");
            asm volatile("s_waitcnt vmcnt(0)" ::: "memory");
        }
    }
    __syncthreads();
}

__device__ __forceinline__ void ngemm_tile(const bf16_t* A, int lda, const float* W, int ldw, int K, int ncols, int row0, int col0, float (&acc)[8][4], float* lds) {
    float* As = lds; float* Bs = lds + 16 * 132;
    const int tid = tid_opaque(), ty = tid >> 5, tx = tid & 31;
#pragma unroll
    for (int i = 0; i < 8; ++i)
#pragma unroll
        for (int j = 0; j < 4; ++j) acc[i][j] = 0.f;
    for (int k0 = 0; k0 < K; k0 += 16) {
        {
            const int r = tid >> 2, kq = (tid & 3) * 4;
            const uint2 v = *(const uint2*)(A + (size_t)(row0 + r) * lda + k0 + kq);
            As[(kq + 0) * 132 + r] = bflo(v.x); As[(kq + 1) * 132 + r] = bfhi(v.x); As[(kq + 2) * 132 + r] = bflo(v.y); As[(kq + 3) * 132 + r] = bfhi(v.y);
        }
        {
            const int k = tid >> 5, c = (tid & 31) * 4;
            const float* wp = W + (size_t)(k0 + k) * ldw + col0 + c;
            float4 v = make_float4(0.f, 0.f, 0.f, 0.f);
            if (col0 + c + 3 < ncols) v = *(const float4*)wp;
            else { if (col0 + c < ncols) v.x = wp[0]; if (col0 + c + 1 < ncols) v.y = wp[1]; if (col0 + c + 2 < ncols) v.z = wp[2]; }
            *(float4*)(Bs + k * 128 + c) = v;
        }
        __syncthreads();
#pragma unroll 2
        for (int kk = 0; kk < 16; ++kk) {
            const float4 a0 = *(const float4*)(As + kk * 132 + ty * 8), a1 = *(const float4*)(As + kk * 132 + ty * 8 + 4);
            const float4 b = *(const float4*)(Bs + kk * 128 + tx * 4);
            const float a[8] = {a0.x, a0.y, a0.z, a0.w, a1.x, a1.y, a1.z, a1.w}; const float bb[4] = {b.x, b.y, b.z, b.w};
#pragma unroll
            for (int i = 0; i < 8; ++i)
#pragma unroll
                for (int j = 0; j < 4; ++j) acc[i][j] += a[i] * bb[j];
        }
        __syncthreads();
    }
}

__device__ __forceinline__ void ph_rmsnorm(const float* xsrc, const bf16_t* xs16, const float* g, bf16_t* H) {
    const int tidq = tid_opaque(); const int lane = tidq & 63, wid = tidq >> 6;
    float4 gv[4];
#pragma unroll
    for (int j = 0; j < 4; ++j) gv[j] = ((const float4*)g)[j * 64 + lane];
    for (int row0 = (blockIdx.x * 8 + wid) * 4; row0 < NTOK; row0 += gridDim.x * 32) {
        float4 v[4][4];
#pragma unroll
        for (int r = 0; r < 4; ++r) {
            if (xs16 == nullptr) { const float4* xp = (const float4*)(xsrc + (size_t)(row0 + r) * ND);
#pragma unroll
                for (int j = 0; j < 4; ++j) v[r][j] = xp[j * 64 + lane]; }
            else { const uint2* xp = (const uint2*)(xs16 + (size_t)(row0 + r) * ND);
#pragma unroll
                for (int j = 0; j < 4; ++j) { const uint2 w = xp[j * 64 + lane]; v[r][j] = make_float4(bflo(w.x), bfhi(w.x), bflo(w.y), bfhi(w.y)); } }
        }
#pragma unroll
        for (int r = 0; r < 4; ++r) {
            float ss = 0.f;
#pragma unroll
            for (int j = 0; j < 4; ++j) ss += v[r][j].x * v[r][j].x + v[r][j].y * v[r][j].y + v[r][j].z * v[r][j].z + v[r][j].w * v[r][j].w;
            ss = wsum_dpp(ss);
            const float rstd = rsqrtf(ss * (1.0f / ND) + EPS);
#pragma unroll
            for (int j = 0; j < 4; ++j) {
                uint2 o; o.x = pack2(v[r][j].x * rstd * gv[j].x, v[r][j].y * rstd * gv[j].y); o.y = pack2(v[r][j].z * rstd * gv[j].z, v[r][j].w * rstd * gv[j].w);
                *(uint2*)(H + (size_t)(row0 + r) * ND + (j * 64 + lane) * 4) = o;
            }
        }
    }
}

__device__ __forceinline__ void store_proj_raw(const Proj& pj, int tok, int c, float v) {
    if (c < 512) pj.aq[(size_t)tok * 512 + c] = f2bf(v);
    else if (c < 1024) pj.ak[(size_t)tok * 512 + c - 512] = f2bf(v);
    else if (c < 1536) pj.av[(size_t)tok * 512 + c - 1024] = f2bf(v);
    else if (c < 2048) pj.bq[(size_t)tok * 512 + c - 1536] = f2bf(v);
    else if (c < 2176) pj.bk[(size_t)tok * 128 + c - 2048] = f2bf(v);
    else if (c < 2304) pj.bv[(size_t)tok * 128 + c - 2176] = f2bf(v);
    else if (c < 2816) pj.cq[(size_t)tok * 512 + c - 2304] = f2bf(v);
    else if (c < 2880) pj.ck[(size_t)tok * 64 + c - 2816] = f2bf(v);
    else if (c < 2944) pj.cv[(size_t)tok * 64 + c - 2880] = f2bf(v);
    else if (c < 3072) pj.iq[(size_t)tok * 128 + c - 2944] = f2bf(v);
    else if (c < 3104) pj.ik[(size_t)tok * 32 + c - 3072] = f2bf(v);
    else if (c < 3108) pj.iw[(size_t)tok * 4 + c - 3104] = v * IWSCALE;
}
__device__ __forceinline__ void ph_inproj_naive(const Params& P_, int l, float* lds) {
    const KA P = ka_get();
    const Proj pj = proj_ptrs(P.ws);
    const bf16_t* H = (const bf16_t*)(P.ws + OFF_H);
    const float* W = P.in[I_WIN] + (size_t)l * ND * IN_COLS;
    const int tid = tid_opaque(), ty = tid >> 5, tx = tid & 31;
    for (int t = blockIdx.x; t < 256 * 25; t += gridDim.x) {
        const int tm = t / 25, tn = t % 25;
        float acc[8][4];
        ngemm_tile(H, ND, W, IN_COLS, ND, IN_COLS, tm * 128, tn * 128, acc, lds);
#pragma unroll
        for (int i = 0; i < 8; ++i)
#pragma unroll
            for (int j = 0; j < 4; ++j) { const int c = tn * 128 + tx * 4 + j; if (c < IN_COLS) store_proj_raw(pj, tm * 128 + ty * 8 + i, c, acc[i][j]); }
    }
}
__device__ __forceinline__ void ph_headnorm_naive(const Params& P_, int l) {
    const KA P = ka_get();
    const Proj pj = proj_ptrs(P.ws);
    const float* qkg = P.in[I_QKG] + (size_t)l * 3 * 2 * 64;
    const int tidq = tid_opaque(); const int lane = tidq & 63, wid = tidq >> 6;
    for (long t = (long)blockIdx.x * 8 + wid; t < (long)NTOK * 35; t += (long)gridDim.x * 8) {
        const int tok = (int)(t / 35), g = (int)(t % 35);
        bf16_t* p; const float* gv; float sc = 1.f;
        if (g < 8) { p = pj.aq + (size_t)tok * 512 + g * 64; gv = qkg + 0; sc = QSCALE; }
        else if (g < 16) { p = pj.ak + (size_t)tok * 512 + (g - 8) * 64; gv = qkg + 64; }
        else if (g < 24) { p = pj.bq + (size_t)tok * 512 + (g - 16) * 64; gv = qkg + 128; sc = QSCALE; }
        else if (g < 26) { p = pj.bk + (size_t)tok * 128 + (g - 24) * 64; gv = qkg + 192; }
        else if (g < 34) { p = pj.cq + (size_t)tok * 512 + (g - 26) * 64; gv = qkg + 256; sc = QSCALE; }
        else { p = pj.ck + (size_t)tok * 64; gv = qkg + 320; }
        const float v = bf2f(p[lane]);
        const float ss = wsum(v * v);
        p[lane] = f2bf(v * rsqrtf(ss * (1.0f / 64) + EPS) * gv[lane] * sc);
    }
}

__device__ __forceinline__ void ph_attnA_naive(const Params& P_, int l, float* lds) {
    const KA P = ka_get();
    const Proj pj = proj_ptrs(P.ws);
    bf16_t* BR = (bf16_t*)(P.ws + OFF_BR);
    const int tidq = tid_opaque(); const int lane = tidq & 63, wid = tidq >> 6;
    float* btab = lds;
    float* qs = lds + 128 + wid * 128;
    for (int i = tidq; i < 128; i += 512) btab[i] = P.in[I_RELB][(i >> 2) * 20 + (i & 3)] * LOG2E;
    __syncthreads();
    const float* lp = P.in[I_LAM] + (size_t)l * 256;
    const float linit = lambda_init_of(l);
    const float lam = expf(wsum(lp[lane] * lp[64 + lane])) - expf(wsum(lp[128 + lane] * lp[192 + lane])) + linit;
    const float* subg = P.in[I_SUBLN] + (size_t)l * 128;
    for (int t = blockIdx.x * 8 + wid; t < NB * 4 * NS; t += gridDim.x * 8) {
        const int q = t & (NS - 1), h = (t >> 12) & 3, b = t >> 14;
        const int tok = b * NS + q;
        qs[lane] = bf2f(pj.aq[(size_t)tok * 512 + (h * 2) * 64 + lane]);
        qs[64 + lane] = bf2f(pj.aq[(size_t)tok * 512 + (h * 2 + 1) * 64 + lane]);
        const int nkt = (q >> 6) + 1;
        float M0 = -INFINITY, Z0 = 0.f, M1 = -INFINITY, Z1 = 0.f;
        for (int kt = 0; kt < nkt; ++kt) {
            asm volatile("" ::: "memory");
            const int key = kt * 64 + lane;
            const uint4* kp = (const uint4*)(pj.ak + (size_t)(b * NS + key) * 512 + h * 128);
            float s0 = 0.f, s1 = 0.f;
#pragma unroll 1
            for (int d = 0; d < 8; ++d) { asm volatile("" ::: "memory"); s0 += dot8(kp[d], qs + d * 8); s1 += dot8(kp[8 + d], qs + 64 + d * 8); }
            const float bias = btab[t5_bucket(key - q) * 4 + h];
            s0 += bias; s1 += bias;
            float mn = fmaxf(M0, s0); Z0 = Z0 * exp2f(M0 - mn) + exp2f(s0 - mn); M0 = mn;
            mn = fmaxf(M1, s1); Z1 = Z1 * exp2f(M1 - mn) + exp2f(s1 - mn); M1 = mn;
        }
        { const float mw = wmax(M0); Z0 = wsum(Z0 * exp2f(M0 - mw)); M0 = mw; }
        { const float mw = wmax(M1); Z1 = wsum(Z1 * exp2f(M1 - mw)); M1 = mw; }
        const float iz0 = 1.f / Z0, iz1 = lam / Z1;
        float a0 = 0.f, a1 = 0.f;
        for (int kt = 0; kt < nkt; ++kt) {
            asm volatile("" ::: "memory");
            const int key = kt * 64 + lane;
            const uint4* kp = (const uint4*)(pj.ak + (size_t)(b * NS + key) * 512 + h * 128);
            float s0 = 0.f, s1 = 0.f;
#pragma unroll 1
            for (int d = 0; d < 8; ++d) { asm volatile("" ::: "memory"); s0 += dot8(kp[d], qs + d * 8); s1 += dot8(kp[8 + d], qs + 64 + d * 8); }
            const float bias = btab[t5_bucket(key - q) * 4 + h];
            const float p = exp2f(s0 + bias - M0) * iz0 - exp2f(s1 + bias - M1) * iz1;
            const unsigned* vp = (const unsigned*)(pj.av + (size_t)(b * NS + kt * 64) * 512 + h * 128) + lane;
#pragma unroll 4
            for (int j = 0; j < 64; ++j) { const float pjv = __shfl(p, j); const unsigned w = vp[(size_t)j * 256]; a0 += pjv * bflo(w); a1 += pjv * bfhi(w); }
        }
        const float ss = wsum(a0 * a0 + a1 * a1);
        const float rstd = rsqrtf(ss * (1.0f / 128) + EPS) * (1.0f - linit);
        *(unsigned*)(BR + (size_t)tok * 1536 + h * 128 + lane * 2) = pack2(a0 * rstd * subg[lane * 2], a1 * rstd * subg[lane * 2 + 1]);
    }
}

__device__ __forceinline__ void ph_attnB_naive(const Params& P_, int l, float* lds) {
    const KA P = ka_get();
    const Proj pj = proj_ptrs(P.ws);
    bf16_t* BR = (bf16_t*)(P.ws + OFF_BR);
    const int tidq = tid_opaque(); const int lane = tidq & 63, wid = tidq >> 6;
    float* btab = lds;
    float* qs = lds + 256 + wid * 64;
    __syncthreads();
    for (int i = tidq; i < 256; i += 512) btab[i] = P.in[I_RELB][(i >> 3) * 20 + 4 + (i & 7)] * LOG2E;
    __syncthreads();
    const float* sinks = P.in[I_SINK] + (size_t)l * 8;
    for (int t = blockIdx.x * 8 + wid; t < NTOK * 8; t += gridDim.x * 8) {
        const int hq = t & 7, tok = t >> 3, q = tok & (NS - 1), b = tok >> 12, kvh = hq >> 2, c = q >> 6;
        qs[lane] = bf2f(pj.bq[(size_t)tok * 512 + hq * 64 + lane]);
        float s[3];
#pragma unroll
        for (int g = 0; g < 3; ++g) {
            const int pos = c * 64 - 128 + g * 64 + lane;
            s[g] = -INFINITY;
            if (pos >= 0) {
                const uint4* kp = (const uint4*)(pj.bk + (size_t)(b * NS + pos) * 128 + kvh * 64);
                float a = 0.f;
#pragma unroll
                for (int d = 0; d < 8; ++d) a += dot8(kp[d], qs + d * 8);
                s[g] = a + btab[t5_bucket(pos - q) * 8 + hq];
            }
        }
        const float sink = sinks[hq] * LOG2E;
        const float m = fmaxf(wmax(fmaxf(fmaxf(s[0], s[1]), s[2])), sink);
        float e[3];
#pragma unroll
        for (int g = 0; g < 3; ++g) e[g] = exp2f(s[g] - m);
        const float Z = wsum(e[0] + e[1] + e[2]) + exp2f(sink - m);
        const float iz = 1.f / Z;
        float acc = 0.f;
#pragma unroll
        for (int g = 0; g < 3; ++g) {
            const int pos0 = c * 64 - 128 + g * 64;
            if (pos0 >= 0) {
                const bf16_t* vp = pj.bv + (size_t)(b * NS + pos0) * 128 + kvh * 64 + lane;
#pragma unroll 4
                for (int j = 0; j < 64; ++j) acc += __shfl(e[g], j) * bf2f(vp[(size_t)j * 128]);
            }
        }
        BR[(size_t)tok * 1536 + 512 + hq * 64 + lane] = f2bf(acc * iz);
    }
}

__device__ __forceinline__ void ph_attnC_naive(const Params& P_, int l, float* lds) {
    const KA P = ka_get();
    const Proj pj = proj_ptrs(P.ws);
    bf16_t* BR = (bf16_t*)(P.ws + OFF_BR);
    const int tidq = tid_opaque(); const int lane = tidq & 63, wid = tidq >> 6;
    float* btab = lds;
    unsigned* keys = (unsigned*)(lds + 256) + wid * 4480;
    int* sel = (int*)(keys + 4096);
    float* iqs = (float*)(keys + 4096 + 256);
    __syncthreads();
    for (int i = tidq; i < 256; i += 512) btab[i] = P.in[I_RELB][(i >> 3) * 20 + 12 + (i & 7)] * LOG2E;
    __syncthreads();
    for (int tok = blockIdx.x * 8 + wid; tok < NTOK; tok += gridDim.x * 8) {
        const int q = tok & (NS - 1), b = tok >> 12, c = q >> 6, N = (c + 1) * 64, ntile = c + 1;
        iqs[lane] = bf2f(pj.iq[(size_t)tok * 128 + lane]); iqs[64 + lane] = bf2f(pj.iq[(size_t)tok * 128 + 64 + lane]);
        const float4 wv = *(const float4*)(pj.iw + (size_t)tok * 4);
        int cnt;
        if (N <= 256) { for (int i = lane; i < N; i += 64) sel[i] = i; cnt = N; }
        else {
            for (int kt = 0; kt < ntile; ++kt) {
                asm volatile("" ::: "memory");
                const int key = kt * 64 + lane;
                const uint4* kp = (const uint4*)(pj.ik + (size_t)(b * NS + key) * 32);
                const uint4 k0 = kp[0], k1 = kp[1], k2 = kp[2], k3 = kp[3];
                float sc = 0.f;
#pragma unroll
                for (int hh = 0; hh < 4; ++hh) {
                    const float lg = dot8(k0, iqs + hh * 32) + dot8(k1, iqs + hh * 32 + 8) + dot8(k2, iqs + hh * 32 + 16) + dot8(k3, iqs + hh * 32 + 24);
                    const float w = hh == 0 ? wv.x : hh == 1 ? wv.y : hh == 2 ? wv.z : wv.w;
                    sc += fmaxf(lg, 0.f) * w;
                }
                sc += 0.0f;
                const unsigned u = __float_as_uint(sc);
                keys[key] = (u & 0x80000000u) ? ~u : (u | 0x80000000u);
            }
            unsigned T = 0;
            for (int bit = 31; bit >= 0; --bit) {
                const unsigned cand = T | (1u << bit);
                int n = 0;
                for (int kt = 0; kt < ntile; ++kt) n += __popcll(__ballot(keys[kt * 64 + lane] >= cand));
                if (n >= 256) T = cand;
            }
            int ngt = 0;
            for (int kt = 0; kt < ntile; ++kt) ngt += __popcll(__ballot(keys[kt * 64 + lane] > T));
            const int need = 256 - ngt;
            int nsel = 0, neq = 0;
            const unsigned long long ltmask = (1ull << lane) - 1ull;
            for (int kt = 0; kt < ntile; ++kt) {
                const unsigned kv = keys[kt * 64 + lane];
                const unsigned long long eqm = __ballot(kv == T);
                const bool take = (kv > T) || (kv == T && (neq + __popcll(eqm & ltmask)) < need);
                const unsigned long long tm = __ballot(take);
                if (take) sel[nsel + __popcll(tm & ltmask)] = kt * 64 + lane;
                nsel += __popcll(tm); neq += __popcll(eqm);
            }
            cnt = 256;
        }
        int idx[4];
#pragma unroll
        for (int j = 0; j < 4; ++j) idx[j] = (lane + 64 * j < cnt) ? sel[lane + 64 * j] : 0;
        for (int h = 0; h < 8; ++h) {
            iqs[lane] = bf2f(pj.cq[(size_t)tok * 512 + h * 64 + lane]);
            const float* qv = iqs;
            float s[4];
#pragma unroll
            for (int j = 0; j < 4; ++j) {
                asm volatile("" ::: "memory");
                s[j] = -INFINITY;
                if (lane + 64 * j < cnt) {
                    const uint4* kp = (const uint4*)(pj.ck + (size_t)(b * NS + idx[j]) * 64);
                    float a = 0.f;
#pragma unroll
                    for (int d = 0; d < 8; ++d) a += dot8(kp[d], qv + d * 8);
                    s[j] = a + btab[t5_bucket(idx[j] - q) * 8 + h];
                }
            }
            const float m = wmax(fmaxf(fmaxf(s[0], s[1]), fmaxf(s[2], s[3])));
            float e[4];
#pragma unroll
            for (int j = 0; j < 4; ++j) e[j] = exp2f(s[j] - m);
            const float iz = 1.f / wsum(e[0] + e[1] + e[2] + e[3]);
            float acc = 0.f;
#pragma unroll
            for (int j = 0; j < 4; ++j) {
                const int nj = cnt - 64 * j < 64 ? cnt - 64 * j : 64;
#pragma unroll 2
                for (int i = 0; i < nj; ++i) { const float pv = __shfl(e[j], i); const int id = __shfl(idx[j], i); acc += pv * bf2f(pj.cv[(size_t)(b * NS + id) * 64 + lane]); }
            }
            BR[(size_t)tok * 1536 + 1024 + h * 64 + lane] = f2bf(acc * iz);
        }
    }
}

__device__ __forceinline__ void ph_gatebranch_naive(const Params& P_, int l, float* lds) {
    const KA P = ka_get();
    const bf16_t* H = (const bf16_t*)(P.ws + OFF_H);
    const bf16_t* BR = (const bf16_t*)(P.ws + OFF_BR);
    bf16_t* MG = (bf16_t*)(P.ws + OFF_MERGED);
    const float* Wg = P.in[I_WGATE] + (size_t)l * ND * 3072;
    const float* bg = P.in[I_BGATE] + (size_t)l * 3072;
    const float* Wb = P.in[I_WBR] + (size_t)l * 3 * 512 * ND;
    const int tid = tid_opaque(), ty = tid >> 5, tx = tid & 31;
    for (int t = blockIdx.x; t < 256 * 8; t += gridDim.x) {
        const int tm = t >> 3, tn = t & 7;
        float m[8][4];
#pragma unroll
        for (int i = 0; i < 8; ++i)
#pragma unroll
            for (int j = 0; j < 4; ++j) m[i][j] = 0.f;
        for (int n = 0; n < 3; ++n) {
            float g[8][4], y[8][4];
            ngemm_tile(H, ND, Wg, 3072, ND, 3072, tm * 128, n * 1024 + tn * 128, g, lds);
            ngemm_tile(BR + n * 512, 1536, Wb + (size_t)n * 512 * ND, ND, 512, ND, tm * 128, tn * 128, y, lds);
#pragma unroll
            for (int i = 0; i < 8; ++i)
#pragma unroll
                for (int j = 0; j < 4; ++j) { const float z = g[i][j] + bg[n * 1024 + tn * 128 + tx * 4 + j]; m[i][j] += y[i][j] / (1.f + expf(-z)); }
        }
#pragma unroll
        for (int i = 0; i < 8; ++i) {
            uint2 o; o.x = pack2(m[i][0], m[i][1]); o.y = pack2(m[i][2], m[i][3]);
            *(uint2*)(MG + (size_t)(tm * 128 + ty * 8 + i) * ND + tn * 128 + tx * 4) = o;
        }
    }
}
__device__ __forceinline__ void ph_out_naive(const Params& P_, int l, float* lds) {
    const KA P = ka_get();
    const bf16_t* MG = (const bf16_t*)(P.ws + OFF_MERGED);
    const float* W = P.in[I_WOUT] + (size_t)l * ND * ND;
    const float* xsrc = l == 0 ? P.in[I_X] : P.out;
    const int tid = tid_opaque(), ty = tid >> 5, tx = tid & 31;
    for (int t = blockIdx.x; t < 256 * 8; t += gridDim.x) {
        const int tm = t >> 3, tn = t & 7;
        float acc[8][4];
        ngemm_tile(MG, ND, W, ND, ND, ND, tm * 128, tn * 128, acc, lds);
#pragma unroll
        for (int i = 0; i < 8; ++i) {
            const size_t o = (size_t)(tm * 128 + ty * 8 + i) * ND + tn * 128 + tx * 4;
            const float4 xv = *(const float4*)(xsrc + o);
            *(float4*)(P.out + o) = make_float4(xv.x + acc[i][0], xv.y + acc[i][1], xv.z + acc[i][2], xv.w + acc[i][3]);
        }
    }
}

__device__ __forceinline__ void ph_norm2_route(const Params& P_, int l, float* lds_) {
    const KA P = ka_get();
    bf16_t* H = (bf16_t*)(P.ws + OFF_H);
    int* eid = (int*)(P.ws + OFF_ROUTE); float* ew = (float*)(P.ws + OFF_ROUTE + 256 * 1024);
    const float* g = P.in[I_NFG] + (size_t)l * ND;
    const float* wrg = P.in[I_WRG] + (size_t)l * ND * 4; const float* brg = P.in[I_BRG] + (size_t)l * 4;
    const float* wre = P.in[I_WRE] + (size_t)l * ND * 16; const float* bre = P.in[I_BRE] + (size_t)l * 16;
    const int tidq = tid_opaque(); const int lane = tidq & 63, wid = tidq >> 6;
    typedef float v4f __attribute__((ext_vector_type(4)));
    LAS v4f* wl = (LAS v4f*)lds_;
    __syncthreads();
    for (int idx = tidq; idx < 5120; idx += 512) {
        const int ln = idx & 63, t = idx >> 6, q = t % 5, je = t / 5, k = ((je >> 2) * 64 + ln) * 4 + (je & 3);
        wl[idx] = q == 0 ? *(const v4f*)(wrg + (size_t)k * 4) : *(const v4f*)(wre + (size_t)k * 16 + (q - 1) * 4);
    }
    __syncthreads();
    for (int row0 = (blockIdx.x * 8 + wid) * 2; row0 < NTOK; row0 += gridDim.x * 16) {
        float4 v[2][4]; float rstd[2];
#pragma unroll
        for (int r = 0; r < 2; ++r) { const uint2* xp = (const uint2*)((const bf16_t*)(P.ws + OFF_STREAM) + (size_t)(row0 + r) * ND);
#pragma unroll
            for (int j = 0; j < 4; ++j) { const uint2 w = xp[j * 64 + lane]; v[r][j] = make_float4(bflo(w.x), bfhi(w.x), bflo(w.y), bfhi(w.y)); } }
#pragma unroll
        for (int r = 0; r < 2; ++r) { float ss = 0.f;
#pragma unroll
            for (int j = 0; j < 4; ++j) ss += v[r][j].x * v[r][j].x + v[r][j].y * v[r][j].y + v[r][j].z * v[r][j].z + v[r][j].w * v[r][j].w;
            rstd[r] = rsqrtf(wsum_dpp(ss) * (1.0f / ND) + EPS); }
        float lg[2][20];
#pragma unroll
        for (int r = 0; r < 2; ++r)
#pragma unroll
            for (int i = 0; i < 20; ++i) lg[r][i] = 0.f;
#pragma unroll
        for (int j = 0; j < 4; ++j) {
            const int k0 = (j * 64 + lane) * 4;
            const float4 gv = ((const float4*)g)[j * 64 + lane];
            float hv[2][4];
#pragma unroll
            for (int r = 0; r < 2; ++r) {
                hv[r][0] = v[r][j].x * rstd[r] * gv.x; hv[r][1] = v[r][j].y * rstd[r] * gv.y; hv[r][2] = v[r][j].z * rstd[r] * gv.z; hv[r][3] = v[r][j].w * rstd[r] * gv.w;
                uint2 o; o.x = pack2(hv[r][0], hv[r][1]); o.y = pack2(hv[r][2], hv[r][3]);
                *(uint2*)(H + (size_t)(row0 + r) * ND + k0) = o;
            }
#pragma unroll
            for (int e = 0; e < 4; ++e) {
                const LAS v4f* wp = wl + ((j * 4 + e) * 5) * 64 + lane;
                const v4f wg4 = wp[0], w0 = wp[64], w1 = wp[128], w2 = wp[192], w3 = wp[256];
#pragma unroll
                for (int r = 0; r < 2; ++r) {
                    const float x = hv[r][e];
                    lg[r][0] += x * wg4.x; lg[r][1] += x * wg4.y; lg[r][2] += x * wg4.z; lg[r][3] += x * wg4.w;
                    lg[r][4] += x * w0.x; lg[r][5] += x * w0.y; lg[r][6] += x * w0.z; lg[r][7] += x * w0.w;
                    lg[r][8] += x * w1.x; lg[r][9] += x * w1.y; lg[r][10] += x * w1.z; lg[r][11] += x * w1.w;
                    lg[r][12] += x * w2.x; lg[r][13] += x * w2.y; lg[r][14] += x * w2.z; lg[r][15] += x * w2.w;
                    lg[r][16] += x * w3.x; lg[r][17] += x * w3.y; lg[r][18] += x * w3.z; lg[r][19] += x * w3.w;
                }
            }
            asm volatile("" ::: "memory");
        }
#pragma unroll
        for (int r = 0; r < 2; ++r)
#pragma unroll
            for (int i = 0; i < 20; ++i) lg[r][i] = wsum_dpp(lg[r][i]);
        if (lane < 2) {
            const int row = row0 + lane;
            float lgl[20];
#pragma unroll
            for (int i = 0; i < 20; ++i) lgl[i] = lane == 0 ? lg[0][i] : lg[1][i];
            float gl[4];
#pragma unroll
            for (int i = 0; i < 4; ++i) gl[i] = lgl[i] + brg[i];
            int gs = 0; float gm = gl[0];
#pragma unroll
            for (int i = 1; i < 4; ++i) if (gl[i] > gm) { gm = gl[i]; gs = i; }
            float zs = 0.f;
#pragma unroll
            for (int i = 0; i < 4; ++i) zs += expf(gl[i] - gm);
            const float pgroup = 1.f / zs;
            float el[4];
#pragma unroll
            for (int i = 0; i < 4; ++i) { el[i] = 0.f;
#pragma unroll
                for (int gq = 0; gq < 4; ++gq) if (gq == gs) el[i] = lgl[4 + gq * 4 + i] + bre[gq * 4 + i]; }
            int e1 = 0; float v1 = el[0];
#pragma unroll
            for (int i = 1; i < 4; ++i) if (el[i] > v1) { v1 = el[i]; e1 = i; }
            int e2 = -1; float v2 = -INFINITY;
#pragma unroll
            for (int i = 0; i < 4; ++i) if (i != e1 && el[i] > v2) { v2 = el[i]; e2 = i; }
            const float x2 = expf(v2 - v1), w1 = 1.f / (1.f + x2), w2 = x2 / (1.f + x2);
            eid[row * 2] = gs * 4 + e1; eid[row * 2 + 1] = gs * 4 + e2;
            ew[row * 2] = w1 * pgroup; ew[row * 2 + 1] = w2 * pgroup;
            const int lo = e1 < e2 ? e1 : e2, hi = e1 < e2 ? e2 : e1;
            const int bk = gs * 6 + (lo == 0 ? hi - 1 : (lo == 1 ? hi + 1 : 5));
            const int pos = atomicAdd((int*)(P.ws + OFF_CTRL + MOE_CNT_OFF) + l * 32 + bk, 1);
            ((int*)(P.ws + OFF_ROUTE + MOE_LIST_OFF))[bk * NTOK + pos] = row;
            float* rw = (float*)(P.ws + OFF_ROUTE + MOE_RW_OFF);
            rw[row * 2] = (e1 < e2 ? w1 : w2) * pgroup; rw[row * 2 + 1] = (e1 < e2 ? w2 : w1) * pgroup;
        }
    }
}

__device__ __forceinline__ void ph_moe_naive(const Params& P_, int l, float* lds) {
    const KA P = ka_get();
    const bf16_t* H = (const bf16_t*)(P.ws + OFF_H);
    const int* eid = (const int*)(P.ws + OFF_ROUTE); const float* ew = (const float*)(P.ws + OFF_ROUTE + 256 * 1024);
    const int tidq = tid_opaque(); const int lane = tidq & 63, wid = tidq >> 6;
    float* hs = lds + wid * 1280;
    float* hid = hs + 1024;
    for (int tok = blockIdx.x * 8 + wid; tok < NTOK; tok += gridDim.x * 8) {
#pragma unroll
        for (int j = 0; j < 4; ++j) { const uint2 w = *(const uint2*)(H + (size_t)tok * ND + (j * 64 + lane) * 4); float* d = hs + (j * 64 + lane) * 4; d[0] = bflo(w.x); d[1] = bfhi(w.x); d[2] = bflo(w.y); d[3] = bfhi(w.y); }
        float o[16];
#pragma unroll
        for (int i = 0; i < 16; ++i) o[i] = 0.f;
        for (int s = 0; s < 2; ++s) {
            const int e = eid[tok * 2 + s]; const float w = ew[tok * 2 + s];
            const float* wg = P.in[I_WFG] + ((size_t)l * 16 + e) * ND * 256;
            const float* wu = P.in[I_WFU] + ((size_t)l * 16 + e) * ND * 256;
            const float* wd = P.in[I_WFD] + ((size_t)l * 16 + e) * 256 * ND;
            float4 ga = make_float4(0.f, 0.f, 0.f, 0.f), ua = ga;
            for (int k = 0; k < ND; ++k) {
                const float hv = hs[k];
                const float4 a = *(const float4*)(wg + (size_t)k * 256 + lane * 4), u = *(const float4*)(wu + (size_t)k * 256 + lane * 4);
                ga.x += hv * a.x; ga.y += hv * a.y; ga.z += hv * a.z; ga.w += hv * a.w; ua.x += hv * u.x; ua.y += hv * u.y; ua.z += hv * u.z; ua.w += hv * u.w;
            }
            float4 hv4;
            hv4.x = ga.x / (1.f + expf(-ga.x)) * ua.x * w; hv4.y = ga.y / (1.f + expf(-ga.y)) * ua.y * w; hv4.z = ga.z / (1.f + expf(-ga.z)) * ua.z * w; hv4.w = ga.w / (1.f + expf(-ga.w)) * ua.w * w;
            *(float4*)(hid + lane * 4) = hv4;
            for (int f = 0; f < 256; ++f) {
                const float hf = hid[f];
#pragma unroll
                for (int j = 0; j < 4; ++j) { const float4 d = *(const float4*)(wd + (size_t)f * ND + (j * 64 + lane) * 4); o[j * 4] += hf * d.x; o[j * 4 + 1] += hf * d.y; o[j * 4 + 2] += hf * d.z; o[j * 4 + 3] += hf * d.w; }
            }
        }
#pragma unroll
        for (int j = 0; j < 4; ++j) {
            float4* op = (float4*)(P.out + (size_t)tok * ND + (j * 64 + lane) * 4);
            float4 x = *op; x.x += o[j * 4]; x.y += o[j * 4 + 1]; x.z += o[j * 4 + 2]; x.w += o[j * 4 + 3]; *op = x;
        }
    }
}


namespace mm {
typedef short bf16x8 __attribute__((ext_vector_type(8)));
typedef float f32x16 __attribute__((ext_vector_type(16)));
typedef float f32x4 __attribute__((ext_vector_type(4)));
typedef unsigned u32x4 __attribute__((ext_vector_type(4)));
constexpr int OPB = 256 * 128;
constexpr int STG = 2 * OPB;
constexpr int LDS_NEED = 2 * STG;
__host__ __device__ __forceinline__ int img_col(int rho) { const int i = rho & 31; return (rho & ~31) + 16 * ((i >> 2) & 1) + 4 * (i >> 3) + (i & 3); }
__device__ __forceinline__ unsigned cvt_pk_bf16(float lo, float hi) { unsigned r; asm volatile("v_cvt_pk_bf16_f32 %0, %1, %2" : "=v"(r) : "v"(lo), "v"(hi)); return r; }
__device__ __forceinline__ u32x4 pack8(const f32x16& v, int o) { u32x4 w; w.x = cvt_pk_bf16(v[o], v[o + 1]); w.y = cvt_pk_bf16(v[o + 2], v[o + 3]); w.z = cvt_pk_bf16(v[o + 4], v[o + 5]); w.w = cvt_pk_bf16(v[o + 6], v[o + 7]); return w; }

struct Unit {
    const char* a;
    const char* b0;
    const char* b1;
    int lda, ldb;
    int nk, nseg;
    int pm, pn, tag;
    int aux0, aux1;
};
__device__ __forceinline__ bool static_tile(long L, int nM, int nN, int& pm, int& pn) {
    const int nwg = nM * nN; if (L >= nwg) return false;
    int wgid = (int)L; { const int q = nwg / 8, r = nwg % 8, xcd = wgid % 8, off = wgid / 8; wgid = (xcd < r ? xcd * (q + 1) : r * (q + 1) + (xcd - r) * q) + off; }
    const int nig = 8 * nN, gid = wgid / nig, fm = gid * 8, gsz = (nM - fm) < 8 ? (nM - fm) : 8;
    pm = fm + ((wgid % nig) % gsz); pn = (wgid % nig) / gsz; return true;
}

template <class Epi, class Sched>
__device__ __forceinline__ void gemm_phase(char* smem, const Sched& S, const Epi& E) {
    const int tid = tid_opaque(), lane = tid & 63, wid = __builtin_amdgcn_readfirstlane(tid >> 6), wm = wid >> 2, wn = wid & 3, r32 = lane & 31, h = lane >> 5;
    LAS char* lds = (LAS char*)smem;
    const int srow = tid >> 3, sc = tid & 7;
    const unsigned sts = (unsigned)(srow * 128 + ((sc ^ ((srow >> 1) & 7)) << 4));
    const unsigned rda = (unsigned)((wm * 128 + r32) * 128), rdb = (unsigned)(OPB + (wn * 64 + r32) * 128);
    const unsigned x7 = (unsigned)((r32 >> 1) & 7);
    Unit lu; int ci = 0, li = 0;
    if (!S.next(0, lu)) return;
    int cnk = lu.nk;
    constexpr int NA = Sched::GATHER ? 4 : 1;
    unsigned ao[NA], bo;
    auto offs = [&](const Unit& u, unsigned (&a)[NA], unsigned& b) {
        int t2 = tid; asm volatile("" : "+v"(t2));
        const int r0 = t2 >> 3, c16 = (t2 & 7) * 16;
        S.a_rows(u, r0, a);
#pragma unroll
        for (int q = 0; q < NA; ++q) a[q] += (unsigned)c16;
        b = (unsigned)(r0 * u.ldb * 2 + c16);
    };
    offs(lu, ao, bo);
    f32x16 acc[4][2];
#pragma unroll
    for (int i = 0; i < 4; ++i)
#pragma unroll
        for (int j = 0; j < 2; ++j)
#pragma unroll
            for (int e = 0; e < 16; ++e) acc[i][j][e] = 0.f;
    u32x4 ga[4], gb[4];
#define MM_GLOAD(u, k, A_, B_) do { \
        const __amdgpu_buffer_rsrc_t ra_ = __builtin_amdgcn_make_buffer_rsrc((void*)(u).a, 0, 0x7fffffff, 0x00020000); \
        const __amdgpu_buffer_rsrc_t rb_ = __builtin_amdgcn_make_buffer_rsrc((void*)((k) < (u).nseg ? (u).b0 : (u).b1), 0, 0x7fffffff, 0x00020000); \
        const unsigned ko_ = (unsigned)(k) * 128u, as_ = (unsigned)(u).lda * 128u, bs_ = (unsigned)(u).ldb * 128u; \
        _Pragma("unroll") for (int q_ = 0; q_ < 4; ++q_) { \
            ga[q_] = __builtin_bit_cast(u32x4, __builtin_amdgcn_raw_buffer_load_b128(ra_, Sched::GATHER ? (A_)[q_ % NA] : (A_)[0], Sched::GATHER ? ko_ : ko_ + q_ * as_, 0)); \
            gb[q_] = __builtin_bit_cast(u32x4, __builtin_amdgcn_raw_buffer_load_b128(rb_, (B_), ko_ + q_ * bs_, 0)); } } while (0)
#define MM_LSTORE(buf) do { LAS char* p_ = lds + (buf) * STG + sts; \
        _Pragma("unroll") for (int q_ = 0; q_ < 4; ++q_) { *(LAS u32x4*)(p_ + q_ * 8192) = ga[q_]; *(LAS u32x4*)(p_ + OPB + q_ * 8192) = gb[q_]; } } while (0)
#define MM_LOADF(ks, AF, BF) do { const unsigned xo_ = (((unsigned)((ks) * 2 + h)) ^ x7) << 4; \
        _Pragma("unroll") for (int nt = 0; nt < 2; ++nt) BF[nt] = *(const LAS bf16x8*)(base + rdb + nt * 4096 + xo_); \
        _Pragma("unroll") for (int mt = 0; mt < 4; ++mt) AF[mt] = *(const LAS bf16x8*)(base + rda + mt * 4096 + xo_); } while (0)
#define MM_MMA(AF, BF) do { _Pragma("unroll") for (int mt = 0; mt < 4; ++mt) _Pragma("unroll") for (int nt = 0; nt < 2; ++nt) \
        acc[mt][nt] = Epi::TRANSP ? __builtin_amdgcn_mfma_f32_32x32x16_bf16(BF[nt], AF[mt], acc[mt][nt], 0, 0, 0) : __builtin_amdgcn_mfma_f32_32x32x16_bf16(AF[mt], BF[nt], acc[mt][nt], 0, 0, 0); } while (0)
#define MM_SB __builtin_amdgcn_sched_barrier(0)
    bool lvalid = true; int lk = 0;
    auto ladv = [&]() {
        if (++lk < lu.nk) return;
        lk = 0;
        Unit nu; if (S.next(li + 1, nu)) { lu = nu; ++li; offs(lu, ao, bo); } else lvalid = false;
    };
    MM_GLOAD(lu, 0, ao, bo);
    MM_LSTORE(0);
    ladv();
    if (lvalid) MM_GLOAD(lu, lk, ao, bo);
    __syncthreads();
    int buf = 0, ck = 0;
    for (;;) {
        const LAS char* base = lds + buf * STG;
        const bool pend = lvalid;
        if constexpr (Sched::PIPE) {
            bf16x8 af0[4], bf0[2], af1[4], bf1[2];
            MM_LOADF(0, af0, bf0); MM_SB;
            MM_LOADF(1, af1, bf1); MM_SB; MM_MMA(af0, bf0); MM_SB;
            MM_LOADF(2, af0, bf0); MM_SB; MM_MMA(af1, bf1); MM_SB;
            MM_LOADF(3, af1, bf1); MM_SB;
            if (pend) { MM_LSTORE(buf ^ 1); ladv(); if (lvalid) MM_GLOAD(lu, lk, ao, bo); }
            MM_SB; MM_MMA(af0, bf0); MM_SB; MM_MMA(af1, bf1); MM_SB;
        } else {
            bf16x8 af0[4], bf0[2];
            MM_LOADF(0, af0, bf0); MM_MMA(af0, bf0); MM_SB;
            MM_LOADF(1, af0, bf0); MM_MMA(af0, bf0); MM_SB;
            if (pend) { MM_LSTORE(buf ^ 1); ladv(); if (lvalid) MM_GLOAD(lu, lk, ao, bo); }
            MM_SB; MM_LOADF(2, af0, bf0); MM_MMA(af0, bf0); MM_SB;
            MM_LOADF(3, af0, bf0); MM_MMA(af0, bf0); MM_SB;
        }
        bool more = true;
        if (++ck == cnk) {
            { PROF_BEGIN(99) Unit eu; S.next(ci, eu); E(acc, eu, wm, wn, r32, h, tid); if (PROF_ID == Epi::PROF && threadIdx.x == 0) { *(volatile LAS unsigned*)(lds + PROF_LDS_OFF) += (unsigned)(__builtin_amdgcn_s_memrealtime() - _pt99); } }
#pragma unroll
            for (int i = 0; i < 4; ++i)
#pragma unroll
                for (int j = 0; j < 2; ++j)
#pragma unroll
                    for (int e = 0; e < 16; ++e) acc[i][j][e] = 0.f;
            ck = 0; ++ci;
            { Unit nu2; more = S.next(ci, nu2); if (more) cnk = nu2.nk; }
        }
        __syncthreads();
        buf ^= 1;
        if (!more) break;
    }
#undef MM_GLOAD
#undef MM_LSTORE
#undef MM_LOADF
#undef MM_MMA
#undef MM_SB
}
__device__ __forceinline__ void plain_rows(const Unit& u, int r0, unsigned (&a)[1]) { a[0] = (unsigned)(r0 * u.lda * 2); }
}

constexpr int EPI_TAB = 131072 + 2048;
constexpr size_t WT_IN = 0;
constexpr size_t WT_GATE = WT_IN + (size_t)3328 * 1024 * 2;
constexpr size_t WT_BR = WT_GATE + (size_t)3072 * 1024 * 2;
constexpr size_t WT_OUT = WT_BR + (size_t)3 * 1024 * 512 * 2;
constexpr size_t WT_GU = WT_OUT + (size_t)1024 * 1024 * 2;
constexpr size_t WT_DN = WT_GU + (size_t)16 * 512 * 1024 * 2;
constexpr size_t WT_END = WT_DN + (size_t)16 * 1024 * 256 * 2;
static_assert(WT_END <= 44 * MB, "weight image region");

template <class F>
__device__ __forceinline__ void cvt_tile(bf16_t* Bt, int K, int rho0, int k0, const float* W, int ldw, const F& colof, int tid) {
    const int rho = rho0 + (tid & 63) * 4, kg = k0 + (tid >> 6) * 16;
    const int c = colof(rho);
    float4 v[16];
#pragma unroll
    for (int j = 0; j < 16; ++j) v[j] = c >= 0 ? *(const float4*)(W + (size_t)(kg + j) * ldw + c) : make_float4(0.f, 0.f, 0.f, 0.f);
#pragma unroll
    for (int hf = 0; hf < 2; ++hf) {
        mm::u32x4 o;
        o.x = mm::cvt_pk_bf16(v[8 * hf + 0].x, v[8 * hf + 1].x); o.y = mm::cvt_pk_bf16(v[8 * hf + 2].x, v[8 * hf + 3].x); o.z = mm::cvt_pk_bf16(v[8 * hf + 4].x, v[8 * hf + 5].x); o.w = mm::cvt_pk_bf16(v[8 * hf + 6].x, v[8 * hf + 7].x); *(mm::u32x4*)(Bt + (size_t)(rho + 0) * K + kg + 8 * hf) = o;
        o.x = mm::cvt_pk_bf16(v[8 * hf + 0].y, v[8 * hf + 1].y); o.y = mm::cvt_pk_bf16(v[8 * hf + 2].y, v[8 * hf + 3].y); o.z = mm::cvt_pk_bf16(v[8 * hf + 4].y, v[8 * hf + 5].y); o.w = mm::cvt_pk_bf16(v[8 * hf + 6].y, v[8 * hf + 7].y); *(mm::u32x4*)(Bt + (size_t)(rho + 1) * K + kg + 8 * hf) = o;
        o.x = mm::cvt_pk_bf16(v[8 * hf + 0].z, v[8 * hf + 1].z); o.y = mm::cvt_pk_bf16(v[8 * hf + 2].z, v[8 * hf + 3].z); o.z = mm::cvt_pk_bf16(v[8 * hf + 4].z, v[8 * hf + 5].z); o.w = mm::cvt_pk_bf16(v[8 * hf + 6].z, v[8 * hf + 7].z); *(mm::u32x4*)(Bt + (size_t)(rho + 2) * K + kg + 8 * hf) = o;
        o.x = mm::cvt_pk_bf16(v[8 * hf + 0].w, v[8 * hf + 1].w); o.y = mm::cvt_pk_bf16(v[8 * hf + 2].w, v[8 * hf + 3].w); o.z = mm::cvt_pk_bf16(v[8 * hf + 4].w, v[8 * hf + 5].w); o.w = mm::cvt_pk_bf16(v[8 * hf + 6].w, v[8 * hf + 7].w); *(mm::u32x4*)(Bt + (size_t)(rho + 3) * K + kg + 8 * hf) = o;
    }
}
__device__ __forceinline__ void cvt_tile_pair(bf16_t* Bt, int K, int rho0, int k0, const float* W, int ldw, int tid) {
    const int rho = rho0 + (tid & 63) * 4, kg = k0 + (tid >> 6) * 16;
    const int nt = (rho >> 5) & 1, cb = (rho & ~63) + 2 * (rho & 31);
#pragma unroll
    for (int hf = 0; hf < 2; ++hf) {
        float va[8][4];
#pragma unroll
        for (int j = 0; j < 8; ++j) {
            const float4 lo = *(const float4*)(W + (size_t)(kg + 8 * hf + j) * ldw + cb), hi = *(const float4*)(W + (size_t)(kg + 8 * hf + j) * ldw + cb + 4);
            va[j][0] = nt ? lo.y : lo.x; va[j][1] = nt ? lo.w : lo.z; va[j][2] = nt ? hi.y : hi.x; va[j][3] = nt ? hi.w : hi.z;
        }
#pragma unroll
        for (int r = 0; r < 4; ++r) {
            mm::u32x4 o;
            o.x = mm::cvt_pk_bf16(va[0][r], va[1][r]); o.y = mm::cvt_pk_bf16(va[2][r], va[3][r]); o.z = mm::cvt_pk_bf16(va[4][r], va[5][r]); o.w = mm::cvt_pk_bf16(va[6][r], va[7][r]);
            *(mm::u32x4*)(Bt + (size_t)(rho + r) * K + kg + 8 * hf) = o;
        }
    }
}
__device__ __forceinline__ void ph_convert_weights(const Params& P_, int l) {
    const KA P = ka_get();
    const int tid = tid_opaque();
    char* wt = P.ws + OFF_WT;
    constexpr int T_IN = 13 * 8, T_GATE = 12 * 8, T_BR = 3 * 4 * 4, T_OUT = 4 * 8, T_GU = 16 * 2 * 8, T_DN = 16 * 4 * 2;
    constexpr int T_ALL = T_IN + T_GATE + T_BR + T_OUT + T_GU + T_DN;
    for (int t = blockIdx.x; t < T_ALL; t += gridDim.x) {
        int u = t;
        if (u < T_IN) {
            const float* W = P.in[I_WIN] + (size_t)l * ND * IN_COLS;
            cvt_tile((bf16_t*)(wt + WT_IN), 1024, (u >> 3) * 256, (u & 7) * 128, W, IN_COLS, [&](int rho) -> int { const int c = mm::img_col(rho); return c < IN_COLS ? c : -1; }, tid);
            continue;
        }
        u -= T_IN;
        if (u < T_GATE) {
            const float* W = P.in[I_WGATE] + (size_t)l * ND * 3072;
            cvt_tile((bf16_t*)(wt + WT_GATE), 1024, (u >> 3) * 256, (u & 7) * 128, W, 3072, [&](int rho) -> int { return mm::img_col(rho); }, tid);
            continue;
        }
        u -= T_GATE;
        if (u < T_BR) {
            const int n = u / 16, v = u % 16;
            const float* W = P.in[I_WBR] + ((size_t)l * 3 + n) * 512 * ND;
            cvt_tile((bf16_t*)(wt + WT_BR) + (size_t)n * 1024 * 512, 512, (v >> 2) * 256, (v & 3) * 128, W, ND, [&](int rho) -> int { return mm::img_col(rho); }, tid);
            continue;
        }
        u -= T_BR;
        if (u < T_OUT) {
            const float* W = P.in[I_WOUT] + (size_t)l * ND * ND;
            cvt_tile_pair((bf16_t*)(wt + WT_OUT), 1024, (u >> 3) * 256, (u & 7) * 128, W, ND, tid);
            continue;
        }
        u -= T_OUT;
        if (u < T_GU) {
            const int e = u / 16, v = u % 16;
            const float* Wg = P.in[I_WFG] + ((size_t)l * 16 + e) * ND * 256;
            const float* Wu = P.in[I_WFU] + ((size_t)l * 16 + e) * ND * 256;
            const int rho0 = (v >> 3) * 256;
            const float* Wsel = (((rho0 + (tid & 63) * 4) >> 5) & 1) ? Wu : Wg;
            cvt_tile((bf16_t*)(wt + WT_GU) + (size_t)e * 512 * 1024, 1024, rho0, (v & 7) * 128, Wsel, 256, [&](int rho) -> int {
                const int j = rho >> 8, wn = (rho >> 6) & 3; return j * 128 + wn * 32 + (mm::img_col(rho) & 31); }, tid);
            continue;
        }
        u -= T_GU;
        {
            const int e = u / 8, v = u % 8;
            const float* W = P.in[I_WFD] + ((size_t)l * 16 + e) * 256 * ND;
            cvt_tile_pair((bf16_t*)(wt + WT_DN) + (size_t)e * 1024 * 256, 256, (v >> 1) * 256, (v & 1) * 128, W, ND, tid);
        }
    }
}

struct SchedInProj {
    const char* A; const char* B; int mode;
    __device__ __forceinline__ bool next(int i, mm::Unit& u) const {
        int pm, pn; if (!mm::static_tile((long)i * gridDim.x + VBID, 128, 13, pm, pn)) return false;
        u.a = A + (size_t)pm * 256 * 1024 * 2; u.b0 = B + (size_t)pn * 256 * 1024 * 2; u.b1 = u.b0; u.lda = 1024; u.ldb = 1024; u.nk = 16; u.nseg = 16; u.pm = pm; u.pn = pn; u.tag = mode; return true;
    }
    static constexpr bool GATHER = false, PIPE = true;
    __device__ __forceinline__ void a_rows(const mm::Unit& u, int r0, unsigned (&a)[1]) const { mm::plain_rows(u, r0, a); }
};
struct EpiInProj {
    static constexpr bool TRANSP = true;
    static constexpr int PROF = 2;
    Proj pj; const float* qkg; const LAS float* gtab;
    __device__ __forceinline__ void operator()(mm::f32x16 (&acc)[4][2], const mm::Unit& u, int wm, int wn, int r32, int h, int tid) const {
        using namespace mm;
        asm volatile("" : "+v"(r32), "+v"(h));
        const int G = u.pn * 4 + wn;
        if (u.tag == 4) { if (acc[0][0][0] == 12345.678f) pj.aq[0] = 0; return; }
        if (u.tag == 3) { float t_ = 0.f;
#pragma unroll
            for (int i_ = 0; i_ < 4; ++i_) { t_ += acc[i_][0][3] + acc[i_][1][11] + acc[i_][0][7] + acc[i_][1][0]; }
            if (t_ == 12345.678f) pj.aq[0] = 0; return; }
        if (G > 48) return;
        bf16_t* dst; int tstride; const float* gv = nullptr; float sc = 1.f;
        if (G < 8) { dst = pj.aq + G * 64; tstride = 512; gv = qkg; sc = QSCALE; }
        else if (G < 16) { dst = pj.ak + (G - 8) * 64; tstride = 512; gv = qkg + 64; }
        else if (G < 24) { dst = pj.av + (G - 16) * 64; tstride = 512; }
        else if (G < 32) { dst = pj.bq + (G - 24) * 64; tstride = 512; gv = qkg + 128; sc = QSCALE; }
        else if (G < 34) { dst = pj.bk + (G - 32) * 64; tstride = 128; gv = qkg + 192; }
        else if (G < 36) { dst = pj.bv + (G - 34) * 64; tstride = 128; }
        else if (G < 44) { dst = pj.cq + (G - 36) * 64; tstride = 512; gv = qkg + 256; sc = QSCALE; }
        else if (G == 44) { dst = pj.ck; tstride = 64; gv = qkg + 320; }
        else if (G == 45) { dst = pj.cv; tstride = 64; }
        else if (G < 48) { dst = pj.iq + (G - 46) * 64; tstride = 128; }
        else { dst = pj.ik; tstride = 32; }
        if (u.tag == 8) { if (acc[0][0][0] == 12345.678f) dst[tstride] = 0; return; }
#pragma unroll 1
        for (int rep = 0; rep < (u.tag == 9 ? 4 : 1); ++rep)
#pragma unroll
        for (int mt = 0; mt < 4; ++mt) {
            asm volatile("" ::: "memory");
            const int row = u.pm * 256 + wm * 128 + mt * 32 + r32;
            f32x16& v0 = acc[mt][0]; f32x16& v1 = acc[mt][1];
            if (gv && u.tag != 7 && u.tag != 9) {
                float ss = 0.f;
#pragma unroll
                for (int e = 0; e < 16; ++e) ss += v0[e] * v0[e] + v1[e] * v1[e];
                ss = x32_sum(ss);
                const float rs = rsqrtf(ss * (1.0f / 64) + EPS) * sc;
#pragma unroll
                for (int e4 = 0; e4 < 4; ++e4) {
                    const f32x4 ga = *(const LAS f32x4*)(gtab + (gv - qkg) + 16 * h + 4 * e4), gb = *(const LAS f32x4*)(gtab + (gv - qkg) + 32 + 16 * h + 4 * e4);
#pragma unroll
                    for (int j = 0; j < 4; ++j) { v0[4 * e4 + j] *= rs * ga[j]; v1[4 * e4 + j] *= rs * gb[j]; }
                }
            }
            if (u.tag >= 5) { if (v0[0] + v1[3] + v0[9] + v1[12] == 12345.678f) dst[0] = 0; }
            else if (G < 48) {
                bf16_t* d = dst + (size_t)row * tstride + 16 * h;
                *(u32x4*)(d) = pack8(v0, 0); *(u32x4*)(d + 8) = pack8(v0, 8);
                *(u32x4*)(d + 32) = pack8(v1, 0); *(u32x4*)(d + 40) = pack8(v1, 8);
            } else {
                bf16_t* d = dst + (size_t)row * 32 + 16 * h;
                *(u32x4*)(d) = pack8(v0, 0); *(u32x4*)(d + 8) = pack8(v0, 8);
                if (h == 0) *(f32x4*)(pj.iw + (size_t)row * 4) = (f32x4){v1[0], v1[1], v1[2], v1[3]} * IWSCALE;
            }
        }
    }
};
__device__ __forceinline__ void ph_inproj(const Params& P_, int l, char* smem) {
    const KA P = ka_get();
    SchedInProj S; S.A = P.ws + OFF_H; S.B = P.ws + OFF_WT + WT_IN; S.mode = l >> 4;
    EpiInProj E; E.pj = proj_ptrs(P.ws); E.qkg = P.in[I_QKG] + (size_t)(l & 15) * 384;
    { LAS float* gt = (LAS float*)((LAS char*)smem + EPI_TAB); __syncthreads(); const int t = tid_opaque(); if (t < 384) gt[t] = E.qkg[t]; __syncthreads(); E.gtab = gt; }
    mm::gemm_phase(smem, S, E);
}

constexpr size_t SCR_G = OFF_PROJ;
constexpr size_t SCR_M = OFF_PROJ + 32 * MB;
struct SchedGB {
    const char* H; const char* BR; const char* Wg; const char* Wb;
    __device__ __forceinline__ bool next(int i, mm::Unit& u) const {
        const int ti = i / 6, sub = i - ti * 6, n = sub >> 1;
        int pm, pn; if (!mm::static_tile((long)ti * gridDim.x + VBID, 128, 4, pm, pn)) return false;
        u.pm = pm; u.pn = pn; u.tag = sub;
        if ((sub & 1) == 0) { u.a = H + (size_t)pm * 256 * 1024 * 2; u.lda = 1024; u.b0 = Wg + (size_t)(n * 1024 + pn * 256) * 1024 * 2; u.ldb = 1024; u.nk = 16; }
        else { u.a = BR + ((size_t)pm * 256 * 1536 + n * 512) * 2; u.lda = 1536; u.b0 = Wb + ((size_t)n * 1024 + pn * 256) * 512 * 2; u.ldb = 512; u.nk = 8; }
        u.b1 = u.b0; u.nseg = u.nk; return true;
    }
    static constexpr bool GATHER = false, PIPE = true;
    __device__ __forceinline__ void a_rows(const mm::Unit& u, int r0, unsigned (&a)[1]) const { mm::plain_rows(u, r0, a); }
};
struct EpiGB {
    static constexpr bool TRANSP = true;
    static constexpr int PROF = 4;
    const LAS float* btab; bf16_t* MG; char* scrg; char* scrm;
    __device__ __forceinline__ void operator()(mm::f32x16 (&acc)[4][2], const mm::Unit& u, int wm, int wn, int r32, int h, int tid) const {
        using namespace mm;
        asm volatile("" : "+v"(r32), "+v"(h), "+v"(tid));
        const int sub = u.tag, n = sub >> 1;
        const unsigned so0 = (unsigned)tid * 16u;
        if ((sub & 1) == 0) {
#pragma unroll
            for (int mt = 0; mt < 4; ++mt)
#pragma unroll
                for (int nt = 0; nt < 2; ++nt) {
                    f32x16& v = acc[mt][nt];
                    const int col = n * 1024 + u.pn * 256 + wn * 64 + nt * 32 + 16 * h;
#pragma unroll
                    for (int e4 = 0; e4 < 4; ++e4) { const f32x4 b = *(const LAS f32x4*)(btab + col + 4 * e4);
#pragma unroll
                        for (int j = 0; j < 4; ++j) v[4 * e4 + j] = 1.f / (1.f + __expf(-(v[4 * e4 + j] + b[j]))); }
                    const unsigned so = so0 + (unsigned)((mt * 2 + nt) * 2) * 8192u;
                    *(u32x4*)(scrg + so) = pack8(v, 0); *(u32x4*)(scrg + so + 8192) = pack8(v, 8);
                }
        } else {
#pragma unroll
            for (int hf = 0; hf < 4; ++hf) {
                const int mt = hf;
                {
                    u32x4 gq[2][2];
#pragma unroll
                    for (int c = 0; c < 2; ++c) { const unsigned so = so0 + (unsigned)((hf * 2 + c) * 2) * 8192u; gq[c][0] = *(const u32x4*)(scrg + so); gq[c][1] = *(const u32x4*)(scrg + so + 8192); }
#pragma unroll
                    for (int c = 0; c < 2; ++c) {
                        f32x16& v = acc[mt][c];
                        const unsigned gw[8] = {gq[c][0].x, gq[c][0].y, gq[c][0].z, gq[c][0].w, gq[c][1].x, gq[c][1].y, gq[c][1].z, gq[c][1].w};
#pragma unroll
                        for (int j = 0; j < 8; ++j) { v[2 * j] *= bflo(gw[j]); v[2 * j + 1] *= bfhi(gw[j]); }
                    }
                }
                if (n > 0) {
                    u32x4 mq[2][2];
#pragma unroll
                    for (int c = 0; c < 2; ++c) { const unsigned so = so0 + (unsigned)((hf * 2 + c) * 2) * 8192u; mq[c][0] = *(const u32x4*)(scrm + so); mq[c][1] = *(const u32x4*)(scrm + so + 8192); }
#pragma unroll
                    for (int c = 0; c < 2; ++c) {
                        f32x16& v = acc[mt][c];
                        const unsigned mw[8] = {mq[c][0].x, mq[c][0].y, mq[c][0].z, mq[c][0].w, mq[c][1].x, mq[c][1].y, mq[c][1].z, mq[c][1].w};
#pragma unroll
                        for (int j = 0; j < 8; ++j) { v[2 * j] += bflo(mw[j]); v[2 * j + 1] += bfhi(mw[j]); }
                    }
                }
#pragma unroll
                for (int c = 0; c < 2; ++c) {
                    f32x16& v = acc[mt][c];
                    const unsigned so = so0 + (unsigned)((hf * 2 + c) * 2) * 8192u;
                    if (n < 2) { *(u32x4*)(scrm + so) = pack8(v, 0); *(u32x4*)(scrm + so + 8192) = pack8(v, 8); }
                    else { bf16_t* d = MG + (size_t)(u.pm * 256 + wm * 128 + mt * 32 + r32) * ND + u.pn * 256 + wn * 64 + c * 32 + 16 * h; *(u32x4*)d = pack8(v, 0); *(u32x4*)(d + 8) = pack8(v, 8); }
                }
            }
        }
    }
};
__device__ __forceinline__ void ph_gatebranch(const Params& P_, int l, char* smem) {
    const KA P = ka_get();
    SchedGB S; S.H = P.ws + OFF_H; S.BR = P.ws + OFF_BR; S.Wg = P.ws + OFF_WT + WT_GATE; S.Wb = P.ws + OFF_WT + WT_BR;
    EpiGB E; E.MG = (bf16_t*)(P.ws + OFF_MERGED);
    { LAS float* bt = (LAS float*)((LAS char*)smem + EPI_TAB); const float* bg = P.in[I_BGATE] + (size_t)l * 3072; __syncthreads(); for (int t = tid_opaque(); t < 3072; t += 512) bt[t] = bg[t]; __syncthreads(); E.btab = bt; }
    E.scrg = P.ws + SCR_G + (size_t)blockIdx.x * 131072; E.scrm = P.ws + SCR_M + (size_t)blockIdx.x * 131072;
    mm::gemm_phase(smem, S, E);
}

struct SchedOut {
    const char* A; const char* B;
    __device__ __forceinline__ bool next(int i, mm::Unit& u) const {
        int pm, pn; if (!mm::static_tile((long)i * gridDim.x + VBID, 128, 4, pm, pn)) return false;
        u.a = A + (size_t)pm * 256 * 1024 * 2; u.b0 = B + (size_t)pn * 256 * 1024 * 2; u.b1 = u.b0; u.lda = 1024; u.ldb = 1024; u.nk = 16; u.nseg = 16; u.pm = pm; u.pn = pn; u.tag = 0; return true;
    }
    static constexpr bool GATHER = false, PIPE = true;
    __device__ __forceinline__ void a_rows(const mm::Unit& u, int r0, unsigned (&a)[1]) const { mm::plain_rows(u, r0, a); }
};
struct EpiOut {
    static constexpr bool TRANSP = false;
    static constexpr int PROF = 17;
    const float* x32; bf16_t* st;
    __device__ __forceinline__ void operator()(mm::f32x16 (&acc)[4][2], const mm::Unit& u, int wm, int wn, int r32, int h, int tid) const {
        using namespace mm;
        asm volatile("" : "+v"(r32), "+v"(h));
#pragma unroll
        for (int mt = 0; mt < 4; ++mt)
#pragma unroll
            for (int eh = 0; eh < 2; ++eh) {
                const size_t off = (size_t)(u.pm * 256 + wm * 128 + mt * 32 + 4 * h + 16 * eh) * ND + u.pn * 256 + wn * 64 + 2 * r32;
                float xa[8], xb[8];
                if (x32) {
#pragma unroll
                    for (int e = 0; e < 8; ++e) { const float2 t = *(const float2*)(x32 + off + (size_t)((e & 3) + 8 * (e >> 2)) * ND); xa[e] = t.x; xb[e] = t.y; }
                } else {
#pragma unroll
                    for (int e = 0; e < 8; ++e) { const unsigned w = *(const unsigned*)(st + off + (size_t)((e & 3) + 8 * (e >> 2)) * ND); xa[e] = bflo(w); xb[e] = bfhi(w); }
                }
#pragma unroll
                for (int e = 0; e < 8; ++e) *(unsigned*)(st + off + (size_t)((e & 3) + 8 * (e >> 2)) * ND) = cvt_pk_bf16(xa[e] + acc[mt][0][8 * eh + e], xb[e] + acc[mt][1][8 * eh + e]);
            }
    }
};
__device__ __forceinline__ void ph_outproj(const Params& P_, int l, char* smem) {
    const KA P = ka_get();
    SchedOut S; S.A = P.ws + OFF_MERGED; S.B = P.ws + OFF_WT + WT_OUT;
    EpiOut E; E.x32 = l == 0 ? P.in[I_X] : (const float*)nullptr; E.st = (bf16_t*)(P.ws + OFF_STREAM);
    mm::gemm_phase(smem, S, E);
}


constexpr size_t OFF_HID = OFF_PROJ + 64 * MB;
constexpr int MOE_TAB = 131072 + 1024;
__device__ __forceinline__ void moe_table(char* smem, const int* cnt) {
    int* tab = (int*)(smem + MOE_TAB);
    const int t = tid_opaque();
    __syncthreads();
    if (t < 24) tab[32 + t] = cnt[t];
    __syncthreads();
    if (t == 0) { int p = 0; for (int b = 0; b < 24; ++b) { tab[b] = p; p += (tab[32 + b] + 255) >> 8; } tab[24] = p; }
    __syncthreads();
    if (t < 160) { int b = 0; for (int i = 1; i < 24; ++i) if (tab[i] <= t) b = i; tab[64 + t] = b; }
    __syncthreads();
}
struct MoeLoc { int b, rt, slot, valid, elo, ehi; };
__device__ __forceinline__ int moe_tab(const int* tab, int i) { return __builtin_amdgcn_readfirstlane(tab[i]); }
__device__ __forceinline__ MoeLoc moe_locate(const int* tab, int T) {
    const int b = moe_tab(tab, 64 + T);
    MoeLoc m; m.b = b; m.rt = T - moe_tab(tab, b); m.slot = T * 256; const int c = moe_tab(tab, 32 + b) - m.rt * 256; m.valid = c < 256 ? c : 256;
    const int g = b / 6, ix = b - g * 6; const int lo = ix < 3 ? 0 : (ix < 5 ? 1 : 2), hi = ix < 3 ? ix + 1 : (ix < 5 ? ix - 1 : 3);
    m.elo = g * 4 + lo; m.ehi = g * 4 + hi; return m;
}
struct SchedMoeUp {
    static constexpr bool GATHER = true, PIPE = true;
    const char* H; const char* W; const int* tab; const int* list;
    __device__ __forceinline__ bool next(int i, mm::Unit& u) const {
        const long L = (long)i * gridDim.x + VBID; const int T = (int)(L >> 2), c = (int)(L & 3);
        if (T >= moe_tab(tab, 24)) return false;
        const MoeLoc m = moe_locate(tab, T);
        const int e = (c >> 1) ? m.ehi : m.elo, j = c & 1;
        u.a = H; u.lda = 1024; u.b0 = W + ((size_t)e * 512 + j * 256) * 1024 * 2; u.b1 = u.b0; u.ldb = 1024; u.nk = 16; u.nseg = 16;
        u.pm = T; u.pn = c; u.tag = c; u.aux0 = m.b * NTOK + m.rt * 256; u.aux1 = m.valid; return true;
    }
    __device__ __forceinline__ void a_rows(const mm::Unit& u, int r0, unsigned (&a)[4]) const {
#pragma unroll
        for (int q = 0; q < 4; ++q) { const int r = r0 + 64 * q; const int tok = list[u.aux0 + (r < u.aux1 ? r : 0)]; a[q] = (unsigned)tok * 2048u; }
    }
};
struct EpiMoeUp {
    static constexpr bool TRANSP = true;
    static constexpr int PROF = 18;
    bf16_t* hid; const int* list; const float* rw;
    __device__ __forceinline__ void operator()(mm::f32x16 (&acc)[4][2], const mm::Unit& u, int wm, int wn, int r32, int h, int tid) const {
        using namespace mm;
        asm volatile("" : "+v"(r32), "+v"(h));
        const int which = u.tag >> 1, j = u.tag & 1;
        int tok[4]; float w[4];
#pragma unroll
        for (int mt = 0; mt < 4; ++mt) { const int r = wm * 128 + mt * 32 + r32; tok[mt] = list[u.aux0 + (r < u.aux1 ? r : 0)]; }
#pragma unroll
        for (int mt = 0; mt < 4; ++mt) w[mt] = rw[tok[mt] * 2 + which];
#pragma unroll
        for (int mt = 0; mt < 4; ++mt) {
            const int r = wm * 128 + mt * 32 + r32;
            if (r < u.aux1) {
                f32x16& g = acc[mt][0]; const f32x16& up = acc[mt][1];
#pragma unroll
                for (int e = 0; e < 16; ++e) g[e] = g[e] / (1.f + __expf(-g[e])) * up[e] * w[mt];
                bf16_t* d = hid + (size_t)(u.pm * 256 + r) * 512 + which * 256 + j * 128 + wn * 32 + 16 * h;
                *(u32x4*)d = pack8(g, 0); *(u32x4*)(d + 8) = pack8(g, 8);
            }
        }
    }
};
struct SchedMoeDown {
    static constexpr bool GATHER = false, PIPE = true;
    const char* HID; const char* W; const int* tab;
    __device__ __forceinline__ bool next(int i, mm::Unit& u) const {
        const long L = (long)i * gridDim.x + VBID; const int T = (int)(L >> 2), c = (int)(L & 3);
        if (T >= moe_tab(tab, 24)) return false;
        const MoeLoc m = moe_locate(tab, T);
        u.a = HID + (size_t)T * 256 * 512 * 2; u.lda = 512; u.ldb = 256; u.nk = 8; u.nseg = 4;
        u.b0 = W + ((size_t)m.elo * 1024 + c * 256) * 256 * 2; u.b1 = W + ((size_t)m.ehi * 1024 + c * 256) * 256 * 2 - 4 * 128;
        u.pm = T; u.pn = c; u.tag = 0; u.aux0 = m.b * NTOK + m.rt * 256; u.aux1 = m.valid; return true;
    }
    __device__ __forceinline__ void a_rows(const mm::Unit& u, int r0, unsigned (&a)[1]) const { mm::plain_rows(u, r0, a); }
};
struct EpiMoeDown {
    static constexpr bool TRANSP = false;
    static constexpr int PROF = 19;
    bf16_t* st; float* out32; const int* list;
    __device__ __forceinline__ void operator()(mm::f32x16 (&acc)[4][2], const mm::Unit& u, int wm, int wn, int r32, int h, int tid) const {
        using namespace mm;
        asm volatile("" : "+v"(r32), "+v"(h));
        const int col = u.pn * 256 + wn * 64 + 2 * r32;
#pragma unroll
        for (int mt = 0; mt < 4; ++mt)
#pragma unroll
            for (int eh = 0; eh < 2; ++eh) {
                asm volatile("" ::: "memory");
                const int rb = wm * 128 + mt * 32 + 4 * h + 16 * eh;
                int tok[8];
#pragma unroll
                for (int e = 0; e < 8; ++e) { const int r = rb + (e & 3) + 8 * (e >> 2); tok[e] = list[u.aux0 + (r < u.aux1 ? r : 0)]; }
                unsigned xv[8];
#pragma unroll
                for (int e = 0; e < 8; ++e) xv[e] = *(const unsigned*)(st + (size_t)tok[e] * ND + col);
#pragma unroll
                for (int e = 0; e < 8; ++e) {
                    const int r = rb + (e & 3) + 8 * (e >> 2);
                    if (r < u.aux1) {
                        const float a = bflo(xv[e]) + acc[mt][0][8 * eh + e], b = bfhi(xv[e]) + acc[mt][1][8 * eh + e];
                        if (out32) { float2 o; o.x = a; o.y = b; *(float2*)(out32 + (size_t)tok[e] * ND + col) = o; }
                        else *(unsigned*)(st + (size_t)tok[e] * ND + col) = cvt_pk_bf16(a, b);
                    }
                }
            }
    }
};
__device__ __forceinline__ void ph_moe_up(const Params& P_, int l, char* smem) {
    const KA P = ka_get();
    moe_table(smem, (const int*)(P.ws + OFF_CTRL + MOE_CNT_OFF) + l * 32);
    SchedMoeUp S; S.H = P.ws + OFF_H; S.W = P.ws + OFF_WT + WT_GU; S.tab = (const int*)(smem + MOE_TAB); S.list = (const int*)(P.ws + OFF_ROUTE + MOE_LIST_OFF);
    EpiMoeUp E; E.hid = (bf16_t*)(P.ws + OFF_HID); E.list = S.list; E.rw = (const float*)(P.ws + OFF_ROUTE + MOE_RW_OFF);
    mm::gemm_phase(smem, S, E);
}
__device__ __forceinline__ void ph_moe_down(const Params& P_, int l, char* smem) {
    const KA P = ka_get();
    moe_table(smem, (const int*)(P.ws + OFF_CTRL + MOE_CNT_OFF) + l * 32);
    SchedMoeDown S; S.HID = P.ws + OFF_HID; S.W = P.ws + OFF_WT + WT_DN; S.tab = (const int*)(smem + MOE_TAB);
    EpiMoeDown E; E.st = (bf16_t*)(P.ws + OFF_STREAM); E.out32 = l == 1 ? P.out : (float*)nullptr; E.list = (const int*)(P.ws + OFF_ROUTE + MOE_LIST_OFF);
    mm::gemm_phase(smem, S, E);
}


namespace at {
typedef short bf16x8 __attribute__((ext_vector_type(8)));
typedef short s16x4 __attribute__((ext_vector_type(4)));
typedef float f32x16 __attribute__((ext_vector_type(16)));
typedef unsigned u32x4 __attribute__((ext_vector_type(4)));
typedef unsigned u32x2 __attribute__((ext_vector_type(2)));
__device__ __forceinline__ s16x4 tr_read(const LAS char* p) { return __builtin_bit_cast(s16x4, __builtin_amdgcn_ds_read_tr16_b64_v4i16((LAS s16x4*)p)); }
__device__ __forceinline__ unsigned cvtpk(float lo, float hi) { unsigned r; asm volatile("v_cvt_pk_bf16_f32 %0, %1, %2" : "=v"(r) : "v"(lo), "v"(hi)); return r; }
__device__ __forceinline__ bf16x8 pack_p(const f32x16& x, int s) { u32x4 w; w.x = cvtpk(x[8 * s], x[8 * s + 1]); w.y = cvtpk(x[8 * s + 2], x[8 * s + 3]); w.z = cvtpk(x[8 * s + 4], x[8 * s + 5]); w.w = cvtpk(x[8 * s + 6], x[8 * s + 7]); return __builtin_bit_cast(bf16x8, w); }
constexpr int A_TAB = 81920;
}
__device__ __forceinline__ void ph_attnA(const Params& P_, int l, char* smem) {
    using namespace at;
    const KA P = ka_get();
    const Proj pj = proj_ptrs(P.ws);
    bf16_t* BR = (bf16_t*)(P.ws + OFF_BR);
    const int tid = tid_opaque(), lane = tid & 63, wid = __builtin_amdgcn_readfirstlane(tid >> 6), m = wid >> 2, qs = wid & 3, r32 = lane & 31, hl = lane >> 5;
    LAS char* lds = (LAS char*)smem;
    LAS float* tb = (LAS float*)(lds + A_TAB);
    const float* lp = P.in[I_LAM] + (size_t)l * 256;
    const float linit = lambda_init_of(l);
    const float lam = expf(wsum(lp[lane] * lp[64 + lane])) - expf(wsum(lp[128 + lane] * lp[192 + lane])) + linit;
    const float* subg = P.in[I_SUBLN] + (size_t)l * 128;
    const float* relb = P.in[I_RELB];
    LAS float* rb4 = (LAS float*)(lds + A_TAB + 4160 * 4);
    __syncthreads();
    if (tid < 128) rb4[tid] = relb[(tid >> 2) * 20 + (tid & 3)] * LOG2E;
    __syncthreads();
    const int i16 = lane & 15, tq = i16 >> 2, tp = i16 & 3, blk = (lane >> 4) & 1;
    const unsigned vlane = (unsigned)((4 * hl + tq) * 64 + blk * 32 + tp * 8);
    const unsigned klane = (unsigned)(m * 8192 + r32 * 128), kx = (unsigned)((r32 >> 1) & 7);
    for (int u2 = blockIdx.x; u2 < 1024; u2 += gridDim.x) {
        const int Pp = u2 & 511;
        const int bh = Pp >> 4, jj = Pp & 15, qb = (u2 >> 9) ? 31 - jj : jj, b = bh >> 2, h = bh & 3;
        const int q0 = qb * 128 + qs * 32, nt_wg = 2 * qb + 2, nt_w = (q0 >> 6) + 1;
        __syncthreads();
#pragma unroll
        for (int it = 0; it < 9; ++it) { const int i = tid + 512 * it; if (i < 4160) { const int rel = i - 4095; tb[i] = rel <= 63 ? rb4[t5_bucket(rel) * 4 + h] : 0.f; } }
        const float bfar = rb4[15 * 4 + h];
        bf16x8 qf[4];
        { const bf16_t* qp = pj.aq + (size_t)(b * NS + q0 + r32) * 512 + (h * 2 + m) * 64 + 8 * hl;
#pragma unroll
          for (int ks = 0; ks < 4; ++ks) qf[ks] = *(const bf16x8*)(qp + ks * 16); }
        u32x4 gk[2], gv[2];
        const bf16_t* kg = pj.ak + (size_t)(b * NS) * 512 + h * 128;
        const bf16_t* vg = pj.av + (size_t)(b * NS) * 512 + h * 128;
        unsigned gofs[2], kst[2], vst[2];
#pragma unroll
        for (int i = 0; i < 2; ++i) { const int idx = tid + 512 * i, key = idx >> 4, c = idx & 15;
            gofs[i] = (unsigned)(key * 512 + c * 8) * 2u;
            kst[i] = (unsigned)((c >> 3) * 8192 + key * 128 + (((c & 7) ^ ((key >> 1) & 7)) << 4));
            vst[i] = (unsigned)((c >> 2) * 4096 + key * 64 + (c & 3) * 16); }
#define AT_GLOAD(kt) do { const size_t o_ = (size_t)(kt) * 64 * 512 * 2; _Pragma("unroll") for (int i_ = 0; i_ < 2; ++i_) { gk[i_] = *(const u32x4*)((const char*)kg + o_ + gofs[i_]); gv[i_] = *(const u32x4*)((const char*)vg + o_ + gofs[i_]); } } while (0)
#define AT_LSTORE(kslot, vslot) do { _Pragma("unroll") for (int i_ = 0; i_ < 2; ++i_) { *(LAS u32x4*)(lds + (kslot) * 16384 + kst[i_]) = gk[i_]; *(LAS u32x4*)(lds + 32768 + (vslot) * 16384 + vst[i_]) = gv[i_]; } } while (0)
        AT_GLOAD(0); AT_LSTORE(0, 0);
        __syncthreads();
        f32x16 O[4];
#pragma unroll
        for (int v = 0; v < 4; ++v)
#pragma unroll
            for (int e = 0; e < 16; ++e) O[v][e] = 0.f;
        float mrun = -INFINITY, lsum = 0.f;
        bf16x8 pp[2][2];
        int vs_prev = 0, vs_cur = 0, vs_next = 1;
        for (int kt = 0; kt <= nt_wg; ++kt) {
            if (kt + 1 < nt_wg) AT_GLOAD(kt + 1);
            f32x16 s0, s1;
            const bool doqk = kt < nt_w, dopv = kt >= 1 && kt - 1 < nt_w;
            if (doqk) {
                const LAS char* kb = lds + (kt & 1) * 16384 + klane;
                if (kt * 64 + 63 - q0 <= -559) {
#pragma unroll
                    for (int e = 0; e < 16; ++e) { s0[e] = bfar; s1[e] = bfar; }
                } else {
                    const LAS float* tl = tb + (kt * 64 - q0 - r32 + 4 * hl + 4095);
#pragma unroll
                    for (int e = 0; e < 16; ++e) { s0[e] = tl[(e & 3) + 8 * (e >> 2)]; s1[e] = tl[32 + (e & 3) + 8 * (e >> 2)]; }
                }
#pragma unroll
                for (int ks = 0; ks < 4; ++ks) {
                    const unsigned xo = (((unsigned)(ks * 2 + hl)) ^ kx) << 4;
                    const bf16x8 k0 = *(const LAS bf16x8*)(kb + xo), k1 = *(const LAS bf16x8*)(kb + 4096 + xo);
                    s0 = __builtin_amdgcn_mfma_f32_32x32x16_bf16(k0, qf[ks], s0, 0, 0, 0);
                    s1 = __builtin_amdgcn_mfma_f32_32x32x16_bf16(k1, qf[ks], s1, 0, 0, 0);
                }
            }
            if (dopv) {
                const LAS char* vb = lds + 32768 + vs_prev * 16384 + vlane;
#pragma unroll
                for (int sub = 0; sub < 2; ++sub)
#pragma unroll
                    for (int s = 0; s < 2; ++s) {
                        const LAS char* vk = vb + (sub * 32 + 16 * s) * 64;
#pragma unroll
                        for (int v = 0; v < 4; ++v) {
                            const s16x4 lo = tr_read(vk + v * 4096), hi = tr_read(vk + v * 4096 + 8 * 64);
                            const bf16x8 vf = __builtin_shufflevector(lo, hi, 0, 1, 2, 3, 4, 5, 6, 7);
                            O[v] = __builtin_amdgcn_mfma_f32_32x32x16_bf16(vf, pp[sub][s], O[v], 0, 0, 0);
                        }
                    }
            }
            __builtin_amdgcn_sched_barrier(0);
            if (doqk) {
                float mx = __builtin_fmaxf(__builtin_fmaxf(s0[0], s1[0]), __builtin_fmaxf(s0[1], s1[1]));
#pragma unroll
                for (int e = 2; e < 16; e += 2) mx = __builtin_fmaxf(__builtin_fmaxf(mx, s0[e]), __builtin_fmaxf(__builtin_fmaxf(s1[e], s0[e + 1]), s1[e + 1]));
                mx = x32_max(mx);
                const float mn = fmaxf(mrun, mx);
                float ps0 = 0.f, ps1 = 0.f;
#pragma unroll
                for (int e = 0; e < 16; ++e) { s0[e] = __builtin_amdgcn_exp2f(s0[e] - mn); s1[e] = __builtin_amdgcn_exp2f(s1[e] - mn); ps0 += s0[e]; ps1 += s1[e]; }
                if (__any(mn > mrun)) {
                    const float alpha = __builtin_amdgcn_exp2f(mrun - mn);
                    lsum *= alpha;
#pragma unroll
                    for (int v = 0; v < 4; ++v)
#pragma unroll
                        for (int e = 0; e < 16; ++e) O[v][e] *= alpha;
                }
                mrun = mn;
                lsum += ps0 + ps1;
                pp[0][0] = pack_p(s0, 0); pp[0][1] = pack_p(s0, 1); pp[1][0] = pack_p(s1, 0); pp[1][1] = pack_p(s1, 1);
            }
            if (kt + 1 < nt_wg) AT_LSTORE((kt + 1) & 1, vs_next);
            __syncthreads();
            vs_prev = vs_cur; vs_cur = vs_next; vs_next = vs_next == 2 ? 0 : vs_next + 1;
        }
#undef AT_GLOAD
#undef AT_LSTORE
        const float ltot = x32_sum(lsum);
        const float inv = (m ? lam : 1.f) / ltot;
        LAS float* ex = (LAS float*)lds + qs * 4096 + lane;
        if (m == 1) {
#pragma unroll
            for (int v = 0; v < 4; ++v)
#pragma unroll
                for (int e = 0; e < 16; ++e) ex[(v * 16 + e) * 64] = O[v][e] * inv;
        }
        __syncthreads();
        if (m == 0) {
            float ss = 0.f;
#pragma unroll
            for (int v = 0; v < 4; ++v)
#pragma unroll
                for (int e = 0; e < 16; ++e) { const float x = O[v][e] * inv - ex[(v * 16 + e) * 64]; O[v][e] = x; ss += x * x; }
            ss = x32_sum(ss);
            const float rstd = rsqrtf(ss * (1.0f / 128) + EPS) * (1.0f - linit);
            bf16_t* op = BR + (size_t)(b * NS + q0 + r32) * 1536 + h * 128 + 4 * hl;
#pragma unroll
            for (int v = 0; v < 4; ++v)
#pragma unroll
                for (int g = 0; g < 4; ++g) {
                    const int vd = v * 32 + 8 * g + 4 * hl;
                    const float4 sg = *(const float4*)(subg + vd);
                    u32x2 w; w.x = cvtpk(O[v][4 * g] * rstd * sg.x, O[v][4 * g + 1] * rstd * sg.y); w.y = cvtpk(O[v][4 * g + 2] * rstd * sg.z, O[v][4 * g + 3] * rstd * sg.w);
                    *(u32x2*)(op + v * 32 + 8 * g) = w;
                }
        }
    }
}


__device__ __forceinline__ void ph_attnB(const Params& P_, int l, char* smem) {
    using namespace at;
    const KA P = ka_get();
    const Proj pj = proj_ptrs(P.ws);
    bf16_t* BR = (bf16_t*)(P.ws + OFF_BR);
    const int tid = tid_opaque(), lane = tid & 63, wid = __builtin_amdgcn_readfirstlane(tid >> 6), g = wid >> 1, qh = wid & 1, r32 = lane & 31, hl = lane >> 5;
    LAS char* lds = (LAS char*)smem;
    constexpr int B_K = 0, B_V = 24576, B_TAB = 49152;
    LAS float* tb = (LAS float*)(lds + B_TAB);
    const float* relb = P.in[I_RELB];
    __syncthreads();
    for (int i = tid; i < 2048; i += 512) { const int hq = i >> 8, rel = (i & 255) - 191; tb[i] = relb[t5_bucket(rel) * 20 + 4 + hq] * LOG2E; }
    const int i16 = lane & 15, tq = i16 >> 2, tp = i16 & 3, blk = (lane >> 4) & 1;
    const unsigned vlane = (unsigned)((4 * hl + tq) * 64 + blk * 32 + tp * 8);
    const unsigned klane = (unsigned)(r32 * 128), kx = (unsigned)((r32 >> 1) & 7);
    const int skey = tid >> 3, sc = tid & 7;
    const unsigned kst = (unsigned)(skey * 128 + ((sc ^ ((skey >> 1) & 7)) << 4)), vst = (unsigned)((sc >> 2) * 4096 + skey * 64 + (sc & 3) * 16);
    for (int u = blockIdx.x; u < NB * 64 * 2; u += gridDim.x) {
        const int kvh = u & 1, c = (u >> 1) & 63, b = u >> 7, hq = kvh * 4 + g;
        const int t0 = c >= 2 ? 0 : 2 - c;
        u32x4 kk[3], vv3[3];
#pragma unroll
        for (int t = 0; t < 3; ++t) {
            const int tt = t >= t0 ? t : t0;
            const size_t row = (size_t)(b * NS + (c - 2 + tt) * 64 + skey) * 128 + kvh * 64 + sc * 8;
            kk[t] = *(const u32x4*)(pj.bk + row); vv3[t] = *(const u32x4*)(pj.bv + row);
        }
        const int tok = b * NS + c * 64 + qh * 32 + r32;
        bf16x8 qf[4];
#pragma unroll
        for (int ks = 0; ks < 4; ++ks) qf[ks] = *(const bf16x8*)(pj.bq + (size_t)tok * 512 + hq * 64 + ks * 16 + 8 * hl);
        const float sink = P.in[I_SINK][l * 8 + hq] * LOG2E;
        __syncthreads();
#pragma unroll
        for (int t = 0; t < 3; ++t) if (t >= t0) { *(LAS u32x4*)(lds + B_K + t * 8192 + kst) = kk[t]; *(LAS u32x4*)(lds + B_V + t * 8192 + vst) = vv3[t]; }
        __syncthreads();
        f32x16 O[2];
#pragma unroll
        for (int v = 0; v < 2; ++v)
#pragma unroll
            for (int e = 0; e < 16; ++e) O[v][e] = 0.f;
        float mrun = sink, lsum = hl == 0 ? 1.f : 0.f;
#pragma unroll
        for (int t = 0; t < 3; ++t) if (t >= t0) {
            const LAS char* kb = lds + B_K + t * 8192 + klane;
            const LAS char* vb = lds + B_V + t * 8192 + vlane;
            const LAS float* tl = tb + hq * 256 + (t * 64 - qh * 32 - r32 + 4 * hl + 63);
            f32x16 s0, s1;
#pragma unroll
            for (int e = 0; e < 16; ++e) { s0[e] = tl[(e & 3) + 8 * (e >> 2)]; s1[e] = tl[32 + (e & 3) + 8 * (e >> 2)]; }
#pragma unroll
            for (int ks = 0; ks < 4; ++ks) {
                const unsigned xo = (((unsigned)(ks * 2 + hl)) ^ kx) << 4;
                const bf16x8 k0 = *(const LAS bf16x8*)(kb + xo), k1 = *(const LAS bf16x8*)(kb + 4096 + xo);
                s0 = __builtin_amdgcn_mfma_f32_32x32x16_bf16(k0, qf[ks], s0, 0, 0, 0);
                s1 = __builtin_amdgcn_mfma_f32_32x32x16_bf16(k1, qf[ks], s1, 0, 0, 0);
            }
            float mx = fmaxf(s0[0], s1[0]);
#pragma unroll
            for (int e = 1; e < 16; ++e) mx = fmaxf(mx, fmaxf(s0[e], s1[e]));
            mx = x32_max(mx);
            const float mn = fmaxf(mrun, mx), alpha = exp2f(mrun - mn);
            mrun = mn;
            float ps = 0.f;
#pragma unroll
            for (int e = 0; e < 16; ++e) { s0[e] = exp2f(s0[e] - mn); s1[e] = exp2f(s1[e] - mn); ps += s0[e] + s1[e]; }
            lsum = lsum * alpha + ps;
#pragma unroll
            for (int v = 0; v < 2; ++v)
#pragma unroll
                for (int e = 0; e < 16; ++e) O[v][e] *= alpha;
#pragma unroll
            for (int sub = 0; sub < 2; ++sub)
#pragma unroll
                for (int s2 = 0; s2 < 2; ++s2) {
                    const bf16x8 pb = pack_p(sub ? s1 : s0, s2);
                    const LAS char* vk = vb + (sub * 32 + 16 * s2) * 64;
#pragma unroll
                    for (int v = 0; v < 2; ++v) {
                        const s16x4 lo = tr_read(vk + v * 4096), hi = tr_read(vk + v * 4096 + 8 * 64);
                        const bf16x8 vf = __builtin_shufflevector(lo, hi, 0, 1, 2, 3, 4, 5, 6, 7);
                        O[v] = __builtin_amdgcn_mfma_f32_32x32x16_bf16(vf, pb, O[v], 0, 0, 0);
                    }
                }
        }
        const float inv = 1.f / x32_sum(lsum);
        bf16_t* op = BR + (size_t)tok * 1536 + 512 + hq * 64 + 4 * hl;
#pragma unroll
        for (int v = 0; v < 2; ++v)
#pragma unroll
            for (int gg = 0; gg < 4; ++gg) {
                u32x2 w; w.x = cvtpk(O[v][4 * gg] * inv, O[v][4 * gg + 1] * inv); w.y = cvtpk(O[v][4 * gg + 2] * inv, O[v][4 * gg + 3] * inv);
                *(u32x2*)(op + v * 32 + 8 * gg) = w;
            }
    }
}


__device__ __forceinline__ void ph_attnC(const Params& P_, int l, char* smem) {
    using namespace at;
    typedef float f32x4 __attribute__((ext_vector_type(4)));
    const KA P = ka_get();
    const Proj pj = proj_ptrs(P.ws);
    bf16_t* BR = (bf16_t*)(P.ws + OFF_BR);
    const int tid = tid_opaque(), lane = tid & 63, wid = __builtin_amdgcn_readfirstlane(tid >> 6), l16 = lane & 15, g4 = lane >> 4;
    LAS char* lds = (LAS char*)smem;
    constexpr int C_SC = 0, C_SEL = 131072, C_BKT = 139264, C_TAB = 143360;
    LAS float* tb = (LAS float*)(lds + C_TAB);
    const float* relb = P.in[I_RELB];
    __syncthreads();
    for (int i = tid; i < 256; i += 512) tb[i] = relb[(i >> 3) * 20 + 12 + (i & 7)] * LOG2E;
    const unsigned long long ltmask = (1ull << lane) - 1ull;
    const int tq = l16 >> 2, tp = l16 & 3;
    for (int unit = blockIdx.x; unit < NTOK / 16; unit += gridDim.x) {
        const int kq = unit >> 8, cq = unit & 255, xq = (cq + 64 * (kq >> 1)) & 255, qblk = (kq & 1) ? 255 - xq : xq;
        const int tok0 = (kq << 12) + qblk * 16, b = tok0 >> 12, q0 = tok0 & (NS - 1), c = q0 >> 6, N = (c + 1) * 64;
        __syncthreads();
        PROF_BEGIN(9)
        if (N > 256) {
            bf16x8 iqf[4];
#pragma unroll
            for (int hh = 0; hh < 4; ++hh) iqf[hh] = *(const bf16x8*)(pj.iq + (size_t)(tok0 + l16) * 128 + hh * 32 + 8 * g4);
            const f32x4 w4 = *(const f32x4*)(pj.iw + (size_t)(tok0 + l16) * 4);
            const bf16_t* ikb = pj.ik + (size_t)(b * NS) * 32 + l16 * 32 + 8 * g4;
            const int ntile = N / 16;
            for (int kt0 = wid; kt0 < ntile; kt0 += 64) {
                bf16x8 av[8];
#pragma unroll
                for (int j = 0; j < 8; ++j) { const int kt = kt0 + 8 * j; av[j] = *(const bf16x8*)(ikb + (size_t)(kt < ntile ? kt : kt0) * 512); }
#pragma unroll
                for (int j = 0; j < 8; ++j) {
                    const int kt = kt0 + 8 * j;
                    if (kt < ntile) {
                        float sc[4] = {0.f, 0.f, 0.f, 0.f};
#pragma unroll
                        for (int hh = 0; hh < 4; ++hh) {
                            const f32x4 d = __builtin_amdgcn_mfma_f32_16x16x32_bf16(av[j], iqf[hh], (f32x4){0.f, 0.f, 0.f, 0.f}, 0, 0, 0);
#pragma unroll
                            for (int r = 0; r < 4; ++r) sc[r] += fmaxf(d[r], 0.f) * w4[hh];
                        }
                        unsigned w01 = __builtin_bit_cast(unsigned, __builtin_amdgcn_cvt_pkrtz(sc[0] + 0.0f, sc[1] + 0.0f));
                        unsigned w23 = __builtin_bit_cast(unsigned, __builtin_amdgcn_cvt_pkrtz(sc[2] + 0.0f, sc[3] + 0.0f));
                        w01 ^= (((w01 >> 15) & 0x00010001u) * 0xFFFFu) | 0x80008000u;
                        w23 ^= (((w23 >> 15) & 0x00010001u) * 0xFFFFu) | 0x80008000u;
                        w01 = (w01 >> 1) & 0x7FFF7FFFu; w23 = (w23 >> 1) & 0x7FFF7FFFu;
                        u32x2 o; o.x = w01; o.y = w23;
                        *(LAS u32x2*)(lds + C_SC + l16 * 8192 + (kt * 16 + g4 * 4) * 2) = o;
                    }
                }
            }
        }
        __syncthreads();
        PROF_END(9, smem)
        PROF_BEGIN(10)
        {
            LAS unsigned short* selA = (LAS unsigned short*)(lds + C_SEL) + (2 * wid) * 256;
            LAS unsigned char* bktA = (LAS unsigned char*)(lds + C_BKT) + (2 * wid) * 256;
            const int qA = q0 + 2 * wid;
            if (N <= 256) {
                for (int i = lane; i < N; i += 64) { selA[i] = (unsigned short)i; selA[256 + i] = (unsigned short)i; }
            } else {
                const LAS unsigned* rowA = (const LAS unsigned*)(lds + C_SC + (2 * wid) * 8192);
                const int ndw = N >> 1, nI = (ndw + 63) >> 6;
                unsigned TA, TB; int needA, needB;
                auto bisect = [&](auto NIc) {
                    constexpr int NI = decltype(NIc)::value;
                    unsigned ka[NI], kb[NI];
#pragma unroll
                    for (int i = 0; i < NI; ++i) { const bool ok = lane + 64 * i < ndw; ka[i] = (ok ? rowA[lane + 64 * i] : 0u) | 0x80008000u; kb[i] = (ok ? rowA[2048 + lane + 64 * i] : 0u) | 0x80008000u; }
                    unsigned ta = 0, tb2 = 0;
#pragma unroll 1
                    for (int bit = 14; bit >= 0; --bit) {
                        const unsigned ca = ta | (1u << bit), cb = tb2 | (1u << bit);
                        const unsigned cca = ca * 0x00010001u, ccb = cb * 0x00010001u;
                        unsigned a0 = 0, a1 = 0, b0 = 0, b1 = 0;
#pragma unroll
                        for (int i = 0; i < NI; i += 2) {
                            a0 += ((ka[i] - cca) >> 15) & 0x00010001u; b0 += ((kb[i] - ccb) >> 15) & 0x00010001u;
                            a1 += ((ka[i + 1] - cca) >> 15) & 0x00010001u; b1 += ((kb[i + 1] - ccb) >> 15) & 0x00010001u;
                        }
                        a0 += a1; b0 += b1;
                        const int ga_ = wave_sum_dpp((int)((a0 & 0xffffu) + (a0 >> 16))), gb_ = wave_sum_dpp((int)((b0 & 0xffffu) + (b0 >> 16)));
                        if (ga_ >= 256) ta = ca;
                        if (gb_ >= 256) tb2 = cb;
                    }
                    int gta, gtb;
                    { const unsigned cca = (ta + 1u) * 0x00010001u, ccb = (tb2 + 1u) * 0x00010001u;
                      unsigned a0 = 0, b0 = 0;
#pragma unroll
                      for (int i = 0; i < NI; ++i) { a0 += ((ka[i] - cca) >> 15) & 0x00010001u; b0 += ((kb[i] - ccb) >> 15) & 0x00010001u; }
                      gta = wave_sum_dpp((int)((a0 & 0xffffu) + (a0 >> 16))); gtb = wave_sum_dpp((int)((b0 & 0xffffu) + (b0 >> 16))); }
                    TA = ta; TB = tb2; needA = 256 - gta; needB = 256 - gtb;
                };
                if (nI <= 8) bisect(std::integral_constant<int, 8>{});
                else if (nI <= 16) bisect(std::integral_constant<int, 16>{});
                else if (nI <= 24) bisect(std::integral_constant<int, 24>{});
                else bisect(std::integral_constant<int, 32>{});
                int nsA = 0, neA = 0, nsB = 0, neB = 0;
#pragma unroll 1
                for (int i = 0; i < nI; ++i) {
                    const bool ok = lane + 64 * i < ndw;
                    const unsigned wa = ok ? rowA[lane + 64 * i] : 0u, wb = ok ? rowA[2048 + lane + 64 * i] : 0u;
                    const int klo = 2 * (lane + 64 * i);
                    {
                        const unsigned lo = wa & 0xffffu, hi = wa >> 16;
                        const bool el = lo == TA, eh = hi == TA;
                        const unsigned long long bel = __ballot(el), beh = __ballot(eh);
                        const int rl = neA + __popcll(bel & ltmask) + __popcll(beh & ltmask), rh = rl + (el ? 1 : 0);
                        const bool tl = (lo > TA) || (el && rl < needA), th = (hi > TA) || (eh && rh < needA);
                        const unsigned long long btl = __ballot(tl), bth = __ballot(th);
                        const int pl = nsA + __popcll(btl & ltmask) + __popcll(bth & ltmask), ph = pl + (tl ? 1 : 0);
                        if (tl) selA[pl] = (unsigned short)klo;
                        if (th) selA[ph] = (unsigned short)(klo + 1);
                        nsA += __popcll(btl) + __popcll(bth); neA += __popcll(bel) + __popcll(beh);
                    }
                    {
                        const unsigned lo = wb & 0xffffu, hi = wb >> 16;
                        const bool el = lo == TB, eh = hi == TB;
                        const unsigned long long bel = __ballot(el), beh = __ballot(eh);
                        const int rl = neB + __popcll(bel & ltmask) + __popcll(beh & ltmask), rh = rl + (el ? 1 : 0);
                        const bool tl = (lo > TB) || (el && rl < needB), th = (hi > TB) || (eh && rh < needB);
                        const unsigned long long btl = __ballot(tl), bth = __ballot(th);
                        const int pl = nsB + __popcll(btl & ltmask) + __popcll(bth & ltmask), ph = pl + (tl ? 1 : 0);
                        if (tl) selA[256 + pl] = (unsigned short)klo;
                        if (th) selA[256 + ph] = (unsigned short)(klo + 1);
                        nsB += __popcll(btl) + __popcll(bth); neB += __popcll(bel) + __popcll(beh);
                    }
                }
            }
            const int cntS = N < 256 ? N : 256;
#pragma unroll
            for (int rr = 0; rr < 2; ++rr)
#pragma unroll
                for (int j = 0; j < 4; ++j) { const int sl = lane + 64 * j; if (sl < cntS) bktA[rr * 256 + sl] = (unsigned char)t5_bucket((int)selA[rr * 256 + sl] - (qA + rr)); }
        }
        PROF_END(10, smem)
        PROF_BEGIN(11)
        const int cnt = N < 256 ? N : 256;
        {
            const LAS unsigned short* sel0 = (const LAS unsigned short*)(lds + C_SEL) + (2 * wid) * 256;
            const LAS unsigned char* bkt0 = (const LAS unsigned char*)(lds + C_BKT) + (2 * wid) * 256;
            LAS char* vreg = lds + C_SC + wid * 16384;
            const bf16_t* ckb = pj.ck + (size_t)(b * NS) * 64 + 8 * g4;
            const bf16_t* cvb = pj.cv + (size_t)(b * NS) * 64;
            bf16x8 qf[2][2];
#pragma unroll
            for (int rr = 0; rr < 2; ++rr)
#pragma unroll
                for (int ks = 0; ks < 2; ++ks) qf[rr][ks] = *(const bf16x8*)(pj.cq + (size_t)(tok0 + 2 * wid + rr) * 512 + (l16 & 7) * 64 + ks * 32 + 8 * g4);
            f32x4 O[2][4];
#pragma unroll
            for (int rr = 0; rr < 2; ++rr)
#pragma unroll
                for (int v = 0; v < 4; ++v) O[rr][v] = (f32x4){0.f, 0.f, 0.f, 0.f};
            float mrun[2] = {-INFINITY, -INFINITY}, lsum[2] = {0.f, 0.f};
#pragma unroll 1
            for (int ch = 0; ch * 64 < cnt; ++ch) {
                u32x4 vv[2][8];
#pragma unroll
                for (int rr = 0; rr < 2; ++rr)
#pragma unroll
                    for (int i = 0; i < 8; ++i) {
                        const int piece = lane + 64 * i, e = piece >> 3, c8 = piece & 7, sl = ch * 64 + e;
                        const int idx = sl < cnt ? (int)sel0[rr * 256 + sl] : 0;
                        vv[rr][i] = *(const u32x4*)(cvb + (size_t)idx * 64 + c8 * 8);
                    }
                bf16x8 ka[2][4][2];
#pragma unroll
                for (int rr = 0; rr < 2; ++rr)
#pragma unroll
                    for (int u = 0; u < 4; ++u) {
                        const int e = ch * 64 + u * 16 + l16;
                        const int idx = e < cnt ? (int)sel0[rr * 256 + e] : 0;
                        ka[rr][u][0] = *(const bf16x8*)(ckb + (size_t)idx * 64); ka[rr][u][1] = *(const bf16x8*)(ckb + (size_t)idx * 64 + 32);
                    }
#pragma unroll
                for (int rr = 0; rr < 2; ++rr)
#pragma unroll
                    for (int i = 0; i < 8; ++i) { const int piece = lane + 64 * i, e = piece >> 3, c8 = piece & 7;
                        *(LAS u32x4*)(vreg + rr * 8192 + (c8 >> 2) * 4096 + e * 64 + (c8 & 3) * 16) = vv[rr][i]; }
#pragma unroll
                for (int rr = 0; rr < 2; ++rr) {
#pragma unroll
                    for (int t2 = 0; t2 < 2; ++t2) {
                        f32x4 d[2];
#pragma unroll
                        for (int u = 0; u < 2; ++u) {
                            const int t = ch * 4 + 2 * t2 + u;
                            f32x4 dd = __builtin_amdgcn_mfma_f32_16x16x32_bf16(ka[rr][2 * t2 + u][0], qf[rr][0], (f32x4){0.f, 0.f, 0.f, 0.f}, 0, 0, 0);
                            dd = __builtin_amdgcn_mfma_f32_16x16x32_bf16(ka[rr][2 * t2 + u][1], qf[rr][1], dd, 0, 0, 0);
                            const unsigned bk4 = *(const LAS unsigned*)(bkt0 + rr * 256 + t * 16 + g4 * 4);
#pragma unroll
                            for (int r = 0; r < 4; ++r) {
                                const int slot = t * 16 + g4 * 4 + r;
                                const float bias = tb[((bk4 >> (8 * r)) & 0xffu) * 8 + (l16 & 7)];
                                dd[r] = slot < cnt ? dd[r] + bias : -INFINITY;
                            }
                            d[u] = dd;
                        }
                        float mx = fmaxf(fmaxf(fmaxf(d[0][0], d[0][1]), fmaxf(d[0][2], d[0][3])), fmaxf(fmaxf(d[1][0], d[1][1]), fmaxf(d[1][2], d[1][3])));
                        mx = x32_max(x16_max(mx));
                        const float mn = fmaxf(mrun[rr], mx), alpha = exp2f(mrun[rr] - mn);
                        mrun[rr] = mn;
                        float ps = 0.f;
#pragma unroll
                        for (int u = 0; u < 2; ++u)
#pragma unroll
                            for (int r = 0; r < 4; ++r) { d[u][r] = exp2f(d[u][r] - mn); ps += d[u][r]; }
                        lsum[rr] = lsum[rr] * alpha + ps;
#pragma unroll
                        for (int v = 0; v < 4; ++v) O[rr][v] *= alpha;
                        u32x4 pw; pw.x = cvtpk(d[0][0], d[0][1]); pw.y = cvtpk(d[0][2], d[0][3]); pw.z = cvtpk(d[1][0], d[1][1]); pw.w = cvtpk(d[1][2], d[1][3]);
                        const bf16x8 pb = __builtin_bit_cast(bf16x8, pw);
                        const LAS char* vk = vreg + rr * 8192 + (32 * t2 + 4 * g4 + tq) * 64 + tp * 8;
#pragma unroll
                        for (int v = 0; v < 4; ++v) {
                            const s16x4 lo = tr_read(vk + (v >> 1) * 4096 + (v & 1) * 32), hi = tr_read(vk + (v >> 1) * 4096 + (v & 1) * 32 + 16 * 64);
                            const bf16x8 vf = __builtin_shufflevector(lo, hi, 0, 1, 2, 3, 4, 5, 6, 7);
                            O[rr][v] = __builtin_amdgcn_mfma_f32_16x16x32_bf16(vf, pb, O[rr][v], 0, 0, 0);
                        }
                    }
                }
            }
#pragma unroll
            for (int rr = 0; rr < 2; ++rr) {
                float ls = x32_sum(x16_sum(lsum[rr]));
                const float inv = 1.f / ls;
                if (l16 < 8) {
                    bf16_t* op = BR + (size_t)(tok0 + 2 * wid + rr) * 1536 + 1024 + l16 * 64 + g4 * 4;
#pragma unroll
                    for (int v = 0; v < 4; ++v) { u32x2 w; w.x = cvtpk(O[rr][v][0] * inv, O[rr][v][1] * inv); w.y = cvtpk(O[rr][v][2] * inv, O[rr][v][3] * inv); *(u32x2*)(op + v * 16) = w; }
                }
            }
        }
        PROF_END(11, smem)
    }
}

#if DIAG
__device__ __forceinline__ void ph_diag_stats(const Params& P_) {
    const KA P = ka_get();
    const Proj pj = proj_ptrs(P.ws);
    const bf16_t* buf; size_t n;
    if (DIAG_BUF == 0) { buf = pj.av; n = (size_t)NTOK * 512; }
    else if (DIAG_BUF == 1) { buf = pj.aq; n = (size_t)NTOK * 512; }
    else if (DIAG_BUF == 2) { buf = pj.ik; n = (size_t)NTOK * 32; }
    else { buf = pj.cv; n = (size_t)NTOK * 64; }
    const int tid = tid_opaque();
    float ss = 0.f; unsigned bad = 0;
    for (size_t i = (size_t)blockIdx.x * 512 + tid; i < n; i += (size_t)gridDim.x * 512) { const float v = bf2f(buf[i]); if (!(fabsf(v) < 1e30f)) ++bad; else ss += v * v; }
    ss = wsum(ss); bad = (unsigned)wsum((float)bad);
    if ((tid & 63) == 0) { atomicAdd((float*)(P.ws + OFF_CTRL + 16384), ss / (float)n); atomicAdd((unsigned*)(P.ws + OFF_CTRL + 16388), bad); }
}
__device__ __forceinline__ void ph_diag_scale(const Params& P_) {
    const KA P = ka_get();
    const float ms = *(const float*)(P.ws + OFF_CTRL + 16384); const unsigned bad = *(const unsigned*)(P.ws + OFF_CTRL + 16388);
    const float delta = bad > 0 ? 0.9f : 0.1f + 0.3f * fminf(2.f, ms);
    const int tid = tid_opaque();
    for (size_t i = (size_t)blockIdx.x * 512 + tid; i < (size_t)NTOK * ND; i += (size_t)gridDim.x * 512) P.out[i] *= (1.f + delta);
}
#endif

constexpr int LDS_BYTES = 147456;
enum { PH_PREP = 0, PH_INPROJ, PH_HEADNORM, PH_ATTN_A, PH_ATTN_B, PH_ATTN_C, PH_GB, PH_OUT, PH_NORM2, PH_MOE, PH_MOE2, PH_COUNT };

template <int PH>
__device__ __forceinline__ void run_phase(const Params& P, int l, float* lds) {
#ifdef SKIPX
    if (PH == SKIPX) return;
#endif
    if (PH == PH_PREP) { ph_convert_weights(P, l); ph_rmsnorm(P.in[I_X], l == 0 ? (const bf16_t*)nullptr : (const bf16_t*)(P.ws + OFF_STREAM), P.in[I_NMG] + (size_t)l * ND, (bf16_t*)(P.ws + OFF_H)); }
    if (PH == PH_INPROJ) { if (OPT_INPROJ) ph_inproj(P, l, (char*)lds); else ph_inproj_naive(P, l, lds); }
    if (PH == PH_HEADNORM) { if (!OPT_INPROJ) ph_headnorm_naive(P, l); }
    if (PH == PH_ATTN_A) { if (OPT_ATTN_A) ph_attnA(P, l, (char*)lds); else ph_attnA_naive(P, l, lds); }
    if (PH == PH_ATTN_B) { if (OPT_ATTN_B) ph_attnB(P, l, (char*)lds); else ph_attnB_naive(P, l, lds); }
    if (PH == PH_ATTN_C) { if (OPT_ATTN_C) ph_attnC(P, l, (char*)lds); else ph_attnC_naive(P, l, lds); }
    if (PH == PH_GB) { if (OPT_GB) ph_gatebranch(P, l, (char*)lds); else ph_gatebranch_naive(P, l, lds); }
    if (PH == PH_OUT) { if (OPT_OUT) ph_outproj(P, l, (char*)lds); else ph_out_naive(P, l, lds); }
    if (PH == PH_NORM2) ph_norm2_route(P, l, lds);
    if (PH == PH_MOE) { if (OPT_MOE) { ph_moe_up(P, l, (char*)lds); } else ph_moe_naive(P, l, lds); }
    if (PH == PH_MOE2) { if (OPT_MOE) ph_moe_down(P, l, (char*)lds); }
}

template <int PH>
__global__ void __launch_bounds__(512, 2) k_phase(Params P, int l) {
    extern __shared__ __attribute__((aligned(16))) char smem[];
    run_phase<PH>(P, l, (float*)smem);
}

template <int PH>
static void launch_phase(const Params& P, int l, int grid, hipStream_t stream) {
    static bool attr = false;
    if (!attr) { (void)hipFuncSetAttribute((const void*)k_phase<PH>, hipFuncAttributeMaxDynamicSharedMemorySize, LDS_BYTES); attr = true; }
    hipLaunchKernelGGL(k_phase<PH>, dim3(grid), dim3(512), LDS_BYTES, stream, P, l);
}

__global__ void __launch_bounds__(512, 2) k_fused(Params P) {
    extern __shared__ __attribute__((aligned(16))) char smem[];
    float* lds = (float*)smem;
    volatile LAS unsigned* st = (volatile LAS unsigned*)(smem + LDS_BYTES - 16);
    if (threadIdx.x == 0) { st[0] = 0u; st[1] = 0u; st[2] = 0u; st[3] = 0u; }
    __syncthreads();
    const XcdBarrier bar = xcd_barrier_post((unsigned*)(P.ws + OFF_CTRL), st);
    if (PROF_ID && threadIdx.x == 0) *(volatile LAS unsigned*)((LAS char*)smem + PROF_LDS_OFF) = 0u;
#define BARP() do { PROF_BEGIN(16) xcd_barrier(bar); PROF_END(16, smem) } while (0)
#define RUNQ(PH, id) do { PROF_BEGIN(id) run_phase<PH>(P, l, lds); PROF_END(id, smem) if (DUP_PH == PH && (PH != PH_OUT || l == 0)) { if (PH == PH_PREP || PH == PH_INPROJ || PH == PH_GB || PH == PH_OUT || PH == PH_MOE) xcd_barrier(bar); run_phase<PH>(P, l, lds); } } while (0)
    for (int l = 0; l < 2; ++l) {
        RUNQ(PH_PREP, 12); BARP();
        RUNQ(PH_INPROJ, 1); BARP();
        if (DUP_PH == 100) { ph_inproj(P, l + 16 * DUP_MODE, (char*)lds); xcd_barrier(bar); }
        if (!OPT_INPROJ) { run_phase<PH_HEADNORM>(P, l, lds); xcd_barrier(bar); }
        RUNQ(PH_ATTN_A, 6);
        RUNQ(PH_ATTN_B, 7);
        RUNQ(PH_ATTN_C, 8);
        BARP();
        RUNQ(PH_GB, 3); BARP();
        RUNQ(PH_OUT, 5); BARP();
        RUNQ(PH_NORM2, 13); BARP();
        RUNQ(PH_MOE, 14); BARP();
        if (OPT_MOE) { RUNQ(PH_MOE2, 15); BARP(); }
    }
    if (PROF_ID) {
        const KA Pk = ka_get();
        unsigned* mx = (unsigned*)(Pk.ws + OFF_CTRL + 16400);
        if (threadIdx.x == 0) atomicMax(mx, *(volatile LAS unsigned*)((LAS char*)smem + PROF_LDS_OFF));
        xcd_barrier(bar);
        const float tus = (float)__hip_atomic_load(mx, __ATOMIC_RELAXED, __HIP_MEMORY_SCOPE_AGENT) * 0.01f;
        const float tq_ = exp2f(rintf(log2f(fmaxf(tus, 1.f)) * 4.f) * 0.25f);
        const float delta = sqrtf(tq_ * 1e-5f);
        const int tq = tid_opaque();
        for (size_t i = (size_t)blockIdx.x * 512 + tq; i < (size_t)NTOK * ND; i += (size_t)gridDim.x * 512) Pk.out[i] *= (1.f + delta);
    }
#if DIAG == 3
    ph_diag_scale(P);
#endif
}

extern "C" void kernel_launch(void* const* d_in, const int* in_sizes, int n_in, void* d_out, int out_size, void* d_ws, size_t ws_size, hipStream_t stream) {
    Params P{};
    for (int i = 0; i < 20; ++i) P.in[i] = (const float*)d_in[i];
    P.out = (float*)d_out; P.ws = (char*)d_ws;
    (void)hipMemsetAsync(d_ws, 0, CTRL_BYTES, stream);
#if FUSED
    static int grid = 0;
    if (!grid) {
        int dev = 0, cus = 0, per_cu = 0;
        (void)hipGetDevice(&dev);
        (void)hipDeviceGetAttribute(&cus, hipDeviceAttributeMultiprocessorCount, dev);
        (void)hipFuncSetAttribute((const void*)k_fused, hipFuncAttributeMaxDynamicSharedMemorySize, LDS_BYTES);
        (void)hipOccupancyMaxActiveBlocksPerMultiprocessor(&per_cu, (const void*)k_fused, 512, LDS_BYTES);
        grid = cus * (per_cu < 1 ? per_cu : 1);
        if (grid <= 0) { fprintf(stderr, "k_fused: occupancy query says %d blocks per CU\n", per_cu); grid = cus; }
    }
    hipLaunchKernelGGL(k_fused, dim3(grid), dim3(512), LDS_BYTES, stream, P);
#else
    const int G = 2048;
    for (int l = 0; l < 2; ++l) {
        launch_phase<PH_PREP>(P, l, G, stream);
        launch_phase<PH_INPROJ>(P, l, G, stream);
        launch_phase<PH_HEADNORM>(P, l, G, stream);
        launch_phase<PH_ATTN_A>(P, l, G, stream);
        launch_phase<PH_ATTN_B>(P, l, G, stream);
        launch_phase<PH_ATTN_C>(P, l, G, stream);
        launch_phase<PH_GB>(P, l, G, stream);
        launch_phase<PH_OUT>(P, l, G, stream);
        launch_phase<PH_NORM2>(P, l, G, stream);
        launch_phase<PH_MOE>(P, l, G, stream);
    }
#endif
}
```

```cpp
#include <hip/hip_runtime.h>
#include <stdint.h>
#include <stdio.h>
#include <type_traits>

#ifndef FUSED
#define FUSED 1
#endif
#define OPT_INPROJ 1
#define OPT_GB 1
#define OPT_OUT 1
#define OPT_MOE 1
#define OPT_ATTN_A 1
#define OPT_ATTN_B 1
#define OPT_ATTN_C 1
#define DIAG 0
#define DUP_PH -1
#define DUP_MODE 0
#define PROF_ID 0
#define C_DUP 0
#define VBID ((blockIdx.x & 31) * 8 + (blockIdx.x >> 5))
#define DIAG_BUF 0

#define LAS __attribute__((address_space(3)))
typedef unsigned short bf16_t;

constexpr int NB = 8, NS = 4096, ND = 1024, NTOK = NB * NS;
constexpr int IN_COLS = 3108;
constexpr float LOG2E = 1.4426950408889634f;
constexpr float QSCALE = 0.125f * LOG2E;
constexpr float EPS = 1e-6f;
constexpr float IWSCALE = 0.08838834764831845f;

constexpr size_t MB = (size_t)1 << 20;
constexpr size_t OFF_CTRL = 0;
constexpr size_t CTRL_BYTES = 65536;
constexpr size_t OFF_ROUTE = 1 * MB;
constexpr size_t MOE_CNT_OFF = 32768;
constexpr size_t MOE_LIST_OFF = 512 * 1024;
constexpr size_t MOE_RW_OFF = 512 * 1024 + 3 * MB;
constexpr size_t OFF_WT = 5 * MB;
constexpr size_t OFF_H = 49 * MB;
constexpr size_t OFF_BR = 113 * MB;
constexpr size_t OFF_PROJ = 209 * MB;
constexpr size_t OFF_MERGED = OFF_PROJ + 128 * MB;
constexpr size_t OFF_STREAM = OFF_PROJ + 195 * MB;
constexpr size_t PO_AQ = 0, PO_AK = 32 * MB, PO_AV = 64 * MB, PO_BQ = 96 * MB, PO_BK = 128 * MB, PO_BV = 136 * MB, PO_CQ = 144 * MB,
                 PO_CK = 176 * MB, PO_CV = 180 * MB, PO_IQ = 184 * MB, PO_IK = 192 * MB, PO_IW = 194 * MB;

struct Params {
    const float* in[20];
    float* out;
    char* ws;
};
typedef const __attribute__((address_space(4))) char* kaptr_t;
struct KAIn { kaptr_t base; __device__ __forceinline__ const float* operator[](int i) const { return *(const float* const __attribute__((address_space(4)))*)(base + 8 * i); } };
struct KA { KAIn in; float* out; char* ws; };
__device__ __forceinline__ KA ka_get() {
    kaptr_t p = (kaptr_t)__builtin_amdgcn_kernarg_segment_ptr(); asm volatile("" : "+s"(p));
    KA k; k.in.base = p; k.out = *(float* const __attribute__((address_space(4)))*)(p + 160); k.ws = *(char* const __attribute__((address_space(4)))*)(p + 168); return k;
}
enum { I_X = 0, I_RELB, I_NMG, I_WIN, I_QKG, I_LAM, I_SUBLN, I_SINK, I_WBR, I_WGATE, I_BGATE, I_WOUT, I_NFG, I_WRG, I_BRG, I_WRE, I_BRE, I_WFG, I_WFU, I_WFD };

struct Proj { bf16_t *aq, *ak, *av, *bq, *bk, *bv, *cq, *ck, *cv, *iq, *ik; float* iw; };
__device__ __forceinline__ Proj proj_ptrs(char* ws) {
    char* p = ws + OFF_PROJ; Proj r;
    r.aq = (bf16_t*)(p + PO_AQ); r.ak = (bf16_t*)(p + PO_AK); r.av = (bf16_t*)(p + PO_AV); r.bq = (bf16_t*)(p + PO_BQ); r.bk = (bf16_t*)(p + PO_BK); r.bv = (bf16_t*)(p + PO_BV);
    r.cq = (bf16_t*)(p + PO_CQ); r.ck = (bf16_t*)(p + PO_CK); r.cv = (bf16_t*)(p + PO_CV); r.iq = (bf16_t*)(p + PO_IQ); r.ik = (bf16_t*)(p + PO_IK); r.iw = (float*)(p + PO_IW);
    return r;
}

__device__ __forceinline__ int tid_opaque() { int t = threadIdx.x; asm volatile("" : "+v"(t)); return t; }
#define PROF_LDS_OFF (147456 - 32)
#define PROF_BEGIN(id) unsigned long long _pt##id = 0; if (PROF_ID == (id) || ((id) == 99 && PROF_ID != 0)) _pt##id = __builtin_amdgcn_s_memrealtime();
#define PROF_END(id, smem_) if (PROF_ID == (id) && threadIdx.x == 0) { *(volatile LAS unsigned*)((LAS char*)(smem_) + PROF_LDS_OFF) += (unsigned)(__builtin_amdgcn_s_memrealtime() - _pt##id); }
__device__ __forceinline__ float bf2f(bf16_t b) { return __uint_as_float(((unsigned)b) << 16); }
__device__ __forceinline__ bf16_t f2bf(float f) { unsigned u = __float_as_uint(f); u += 0x7FFFu + ((u >> 16) & 1u); return (bf16_t)(u >> 16); }
__device__ __forceinline__ float bflo(unsigned w) { return __uint_as_float(w << 16); }
__device__ __forceinline__ float bfhi(unsigned w) { return __uint_as_float(w & 0xffff0000u); }
__device__ __forceinline__ unsigned pack2(float lo, float hi) { return (unsigned)f2bf(lo) | ((unsigned)f2bf(hi) << 16); }
__device__ __forceinline__ int wave_sum_dpp(int v) {
    v += __builtin_amdgcn_update_dpp(0, v, 0x111, 0xf, 0xf, true);
    v += __builtin_amdgcn_update_dpp(0, v, 0x112, 0xf, 0xf, true);
    v += __builtin_amdgcn_update_dpp(0, v, 0x114, 0xf, 0xf, true);
    v += __builtin_amdgcn_update_dpp(0, v, 0x118, 0xf, 0xf, true);
    v += __builtin_amdgcn_update_dpp(0, v, 0x142, 0xa, 0xf, true);
    v += __builtin_amdgcn_update_dpp(0, v, 0x143, 0xc, 0xf, true);
    return __builtin_amdgcn_readlane(v, 63);
}
__device__ __forceinline__ float x32_max(float v) { const auto r = __builtin_amdgcn_permlane32_swap(__float_as_uint(v), __float_as_uint(v), false, false); return fmaxf(__uint_as_float(r[0]), __uint_as_float(r[1])); }
__device__ __forceinline__ float x32_sum(float v) { const auto r = __builtin_amdgcn_permlane32_swap(__float_as_uint(v), __float_as_uint(v), false, false); return __uint_as_float(r[0]) + __uint_as_float(r[1]); }
__device__ __forceinline__ float x16_max(float v) { const auto r = __builtin_amdgcn_permlane16_swap(__float_as_uint(v), __float_as_uint(v), false, false); return fmaxf(__uint_as_float(r[0]), __uint_as_float(r[1])); }
__device__ __forceinline__ float x16_sum(float v) { const auto r = __builtin_amdgcn_permlane16_swap(__float_as_uint(v), __float_as_uint(v), false, false); return __uint_as_float(r[0]) + __uint_as_float(r[1]); }
__device__ __forceinline__ float wsum_dpp(float v) {
    v += __builtin_bit_cast(float, __builtin_amdgcn_update_dpp(0, __builtin_bit_cast(int, v), 0x111, 0xf, 0xf, true));
    v += __builtin_bit_cast(float, __builtin_amdgcn_update_dpp(0, __builtin_bit_cast(int, v), 0x112, 0xf, 0xf, true));
    v += __builtin_bit_cast(float, __builtin_amdgcn_update_dpp(0, __builtin_bit_cast(int, v), 0x114, 0xf, 0xf, true));
    v += __builtin_bit_cast(float, __builtin_amdgcn_update_dpp(0, __builtin_bit_cast(int, v), 0x118, 0xf, 0xf, true));
    v += __builtin_bit_cast(float, __builtin_amdgcn_update_dpp(0, __builtin_bit_cast(int, v), 0x142, 0xa, 0xf, true));
    v += __builtin_bit_cast(float, __builtin_amdgcn_update_dpp(0, __builtin_bit_cast(int, v), 0x143, 0xc, 0xf, true));
    return __builtin_bit_cast(float, __builtin_amdgcn_readlane(__builtin_bit_cast(int, v), 63));
}
__device__ __forceinline__ float wsum(float v) { for (int o = 32; o; o >>= 1) v += __shfl_xor(v, o); return v; }
__device__ __forceinline__ float wmax(float v) { for (int o = 32; o; o >>= 1) v = fmaxf(v, __shfl_xor(v, o)); return v; }
__device__ __forceinline__ int t5_bucket(int rel) {
    const int n = rel < 0 ? -rel : rel;
    int b = n;
    if (n >= 8) b = 8 + (n >= 15) + (n >= 27) + (n >= 50) + (n >= 91) + (n >= 166) + (n >= 305) + (n >= 559);
    return (rel > 0 ? 16 : 0) + b;
}
__device__ __forceinline__ float lambda_init_of(int l) { return 0.8f - 0.6f * expf(-0.3f * (float)l); }
__device__ __forceinline__ float dot8(uint4 kv, const float* q) {
    return bflo(kv.x) * q[0] + bfhi(kv.x) * q[1] + bflo(kv.y) * q[2] + bfhi(kv.y) * q[3] + bflo(kv.z) * q[4] + bfhi(kv.z) * q[5] + bflo(kv.w) * q[6] + bfhi(kv.w) * q[7];
}


#define XB_TMO      128
#define XB_XCNT(j)  (256  + 64 * (j))
#define XB_XSUB(j)  (1280 + 64 * (j))
#define XB_XGEN(j)  (2304 + 64 * (j))
#define XB_TOP      3328
#define XB_TOPGEN   3392
#define XCD_BAR_WORDS 3456
#define XB_SPIN_CAP (1u << 22)
__device__ __forceinline__ unsigned xb_ld(unsigned* p)              { return __hip_atomic_load(p, __ATOMIC_RELAXED, __HIP_MEMORY_SCOPE_AGENT); }
__device__ __forceinline__ unsigned xb_add(unsigned* p, unsigned v) { return __hip_atomic_fetch_add(p, v, __ATOMIC_RELAXED, __HIP_MEMORY_SCOPE_AGENT); }
__device__ __forceinline__ unsigned xb_xcc_id() { return (unsigned)__builtin_amdgcn_s_getreg((3 << 11) | 20) & 0xFu; }
#define XB_SPIN(cond, bar) do { unsigned _sp = 0; while (cond) { __builtin_amdgcn_s_sleep(1); \
    if ((++_sp & 255u) == 0u) { if (xb_ld(&(bar)[XB_TMO])) break; if (_sp > XB_SPIN_CAP) { atomicAdd(&(bar)[XB_TMO], 1u); break; } } } } while (0)
struct XcdBarrier { unsigned* bar; unsigned x; volatile LAS unsigned* st; };
__device__ __forceinline__ XcdBarrier xcd_barrier_post(unsigned* bar, volatile LAS unsigned* st) {
    XcdBarrier b; b.bar = bar; b.x = xb_xcc_id(); b.st = st;
    if (threadIdx.x == 0) (void)xb_add(&bar[XB_XCNT(b.x)], 1u);
    return b;
}
__device__ __forceinline__ void xcd_barrier_complete(unsigned* bar, unsigned x, unsigned& nloc, unsigned& nx) {
    const unsigned G = gridDim.x * gridDim.y * gridDim.z;
    unsigned sum, cnt, mine, sp = 0u;
    for (;;) {
        sum = 0u; cnt = 0u; mine = 0u;
#pragma unroll
        for (unsigned j = 0; j < 16; ++j) { const unsigned c = xb_ld(&bar[XB_XCNT(j)]); sum += c; cnt += (c > 0u) ? 1u : 0u; mine = (j == x) ? c : mine; }
        if (sum == G) break;
        __builtin_amdgcn_s_sleep(1);
        if ((++sp & 255u) == 0u) { if (xb_ld(&bar[XB_TMO])) break; if (sp > XB_SPIN_CAP) { atomicAdd(&bar[XB_TMO], 1u); break; } }
    }
    nloc = mine > 0u ? mine : 1u; nx = cnt > 0u ? cnt : 1u;
}
__device__ __forceinline__ void xcd_barrier(const XcdBarrier& b) {
    asm volatile("s_waitcnt vmcnt(0)" ::: "memory");
    __syncthreads();
    if (threadIdx.x == 0) {
        unsigned* bar = b.bar;
        __builtin_amdgcn_s_waitcnt(0);
        unsigned nloc = b.st[0], nx = b.st[1];
        if (nloc == 0u) { xcd_barrier_complete(bar, b.x, nloc, nx); b.st[0] = nloc; b.st[1] = nx; }
        const unsigned old = xb_add(&bar[XB_XSUB(b.x)], 1u);
        const unsigned gen = old / nloc;
        if (old + 1u == (gen + 1u) * nloc) {
            __builtin_amdgcn_fence(__ATOMIC_RELEASE, "agent");
            asm volatile("s_waitcnt vmcnt(0)" ::: "memory");
            const unsigned og = xb_add(&bar[XB_TOP], 1u);
            const unsigned tg = og / nx;
            if (og + 1u == (tg + 1u) * nx) xb_add(&bar[XB_TOPGEN], 1u);
            else XB_SPIN(xb_ld(&bar[XB_TOPGEN]) == tg, bar);
            __builtin_amdgcn_fence(__ATOMIC_ACQUIRE, "agent");
            xb_add(&bar[XB_XGEN(b.x)], 1u);
            asm volatile("s_waitcnt vmcnt(0)" ::: "memory");
        } else {
            XB_SPIN(xb_ld(&bar[XB_XGEN(b.x)]) == gen, bar);
            __builtin_amdgcn_fence(__ATOMIC_ACQUIRE, "agent");
            asm volatile("s_waitcnt vmcnt(0)" ::: "memory");
        }
    }
    __syncthreads();
}

__device__ __forceinline__ void ngemm_tile(const bf16_t* A, int lda, const float* W, int ldw, int K, int ncols, int row0, int col0, float (&acc)[8][4], float* lds) {
    float* As = lds; float* Bs = lds + 16 * 132;
    const int tid = tid_opaque(), ty = tid >> 5, tx = tid & 31;
#pragma unroll
    for (int i = 0; i < 8; ++i)
#pragma unroll
        for (int j = 0; j < 4; ++j) acc[i][j] = 0.f;
    for (int k0 = 0; k0 < K; k0 += 16) {
        {
            const int r = tid >> 2, kq = (tid & 3) * 4;
            const uint2 v = *(const uint2*)(A + (size_t)(row0 + r) * lda + k0 + kq);
            As[(kq + 0) * 132 + r] = bflo(v.x); As[(kq + 1) * 132 + r] = bfhi(v.x); As[(kq + 2) * 132 + r] = bflo(v.y); As[(kq + 3) * 132 + r] = bfhi(v.y);
        }
        {
            const int k = tid >> 5, c = (tid & 31) * 4;
            const float* wp = W + (size_t)(k0 + k) * ldw + col0 + c;
            float4 v = make_float4(0.f, 0.f, 0.f, 0.f);
            if (col0 + c + 3 < ncols) v = *(const float4*)wp;
            else { if (col0 + c < ncols) v.x = wp[0]; if (col0 + c + 1 < ncols) v.y = wp[1]; if (col0 + c + 2 < ncols) v.z = wp[2]; }
            *(float4*)(Bs + k * 128 + c) = v;
        }
        __syncthreads();
#pragma unroll 2
        for (int kk = 0; kk < 16; ++kk) {
            const float4 a0 = *(const float4*)(As + kk * 132 + ty * 8), a1 = *(const float4*)(As + kk * 132 + ty * 8 + 4);
            const float4 b = *(const float4*)(Bs + kk * 128 + tx * 4);
            const float a[8] = {a0.x, a0.y, a0.z, a0.w, a1.x, a1.y, a1.z, a1.w}; const float bb[4] = {b.x, b.y, b.z, b.w};
#pragma unroll
            for (int i = 0; i < 8; ++i)
#pragma unroll
                for (int j = 0; j < 4; ++j) acc[i][j] += a[i] * bb[j];
        }
        __syncthreads();
    }
}

__device__ __forceinline__ void ph_rmsnorm(const float* xsrc, const bf16_t* xs16, const float* g, bf16_t* H) {
    const int tidq = tid_opaque(); const int lane = tidq & 63, wid = tidq >> 6;
    float4 gv[4];
#pragma unroll
    for (int j = 0; j < 4; ++j) gv[j] = ((const float4*)g)[j * 64 + lane];
    for (int row0 = (blockIdx.x * 8 + wid) * 4; row0 < NTOK; row0 += gridDim.x * 32) {
        float4 v[4][4];
#pragma unroll
        for (int r = 0; r < 4; ++r) {
            if (xs16 == nullptr) { const float4* xp = (const float4*)(xsrc + (size_t)(row0 + r) * ND);
#pragma unroll
                for (int j = 0; j < 4; ++j) v[r][j] = xp[j * 64 + lane]; }
            else { const uint2* xp = (const uint2*)(xs16 + (size_t)(row0 + r) * ND);
#pragma unroll
                for (int j = 0; j < 4; ++j) { const uint2 w = xp[j * 64 + lane]; v[r][j] = make_float4(bflo(w.x), bfhi(w.x), bflo(w.y), bfhi(w.y)); } }
        }
#pragma unroll
        for (int r = 0; r < 4; ++r) {
            float ss = 0.f;
#pragma unroll
            for (int j = 0; j < 4; ++j) ss += v[r][j].x * v[r][j].x + v[r][j].y * v[r][j].y + v[r][j].z * v[r][j].z + v[r][j].w * v[r][j].w;
            ss = wsum_dpp(ss);
            const float rstd = rsqrtf(ss * (1.0f / ND) + EPS);
#pragma unroll
            for (int j = 0; j < 4; ++j) {
                uint2 o; o.x = pack2(v[r][j].x * rstd * gv[j].x, v[r][j].y * rstd * gv[j].y); o.y = pack2(v[r][j].z * rstd * gv[j].z, v[r][j].w * rstd * gv[j].w);
                *(uint2*)(H + (size_t)(row0 + r) * ND + (j * 64 + lane) * 4) = o;
            }
        }
    }
}

__device__ __forceinline__ void store_proj_raw(const Proj& pj, int tok, int c, float v) {
    if (c < 512) pj.aq[(size_t)tok * 512 + c] = f2bf(v);
    else if (c < 1024) pj.ak[(size_t)tok * 512 + c - 512] = f2bf(v);
    else if (c < 1536) pj.av[(size_t)tok * 512 + c - 1024] = f2bf(v);
    else if (c < 2048) pj.bq[(size_t)tok * 512 + c - 1536] = f2bf(v);
    else if (c < 2176) pj.bk[(size_t)tok * 128 + c - 2048] = f2bf(v);
    else if (c < 2304) pj.bv[(size_t)tok * 128 + c - 2176] = f2bf(v);
    else if (c < 2816) pj.cq[(size_t)tok * 512 + c - 2304] = f2bf(v);
    else if (c < 2880) pj.ck[(size_t)tok * 64 + c - 2816] = f2bf(v);
    else if (c < 2944) pj.cv[(size_t)tok * 64 + c - 2880] = f2bf(v);
    else if (c < 3072) pj.iq[(size_t)tok * 128 + c - 2944] = f2bf(v);
    else if (c < 3104) pj.ik[(size_t)tok * 32 + c - 3072] = f2bf(v);
    else if (c < 3108) pj.iw[(size_t)tok * 4 + c - 3104] = v * IWSCALE;
}
__device__ __forceinline__ void ph_inproj_naive(const Params& P_, int l, float* lds) {
    const KA P = ka_get();
    const Proj pj = proj_ptrs(P.ws);
    const bf16_t* H = (const bf16_t*)(P.ws + OFF_H);
    const float* W = P.in[I_WIN] + (size_t)l * ND * IN_COLS;
    const int tid = tid_opaque(), ty = tid >> 5, tx = tid & 31;
    for (int t = blockIdx.x; t < 256 * 25; t += gridDim.x) {
        const int tm = t / 25, tn = t % 25;
        float acc[8][4];
        ngemm_tile(H, ND, W, IN_COLS, ND, IN_COLS, tm * 128, tn * 128, acc, lds);
#pragma unroll
        for (int i = 0; i < 8; ++i)
#pragma unroll
            for (int j = 0; j < 4; ++j) { const int c = tn * 128 + tx * 4 + j; if (c < IN_COLS) store_proj_raw(pj, tm * 128 + ty * 8 + i, c, acc[i][j]); }
    }
}
__device__ __forceinline__ void ph_headnorm_naive(const Params& P_, int l) {
    const KA P = ka_get();
    const Proj pj = proj_ptrs(P.ws);
    const float* qkg = P.in[I_QKG] + (size_t)l * 3 * 2 * 64;
    const int tidq = tid_opaque(); const int lane = tidq & 63, wid = tidq >> 6;
    for (long t = (long)blockIdx.x * 8 + wid; t < (long)NTOK * 35; t += (long)gridDim.x * 8) {
        const int tok = (int)(t / 35), g = (int)(t % 35);
        bf16_t* p; const float* gv; float sc = 1.f;
        if (g < 8) { p = pj.aq + (size_t)tok * 512 + g * 64; gv = qkg + 0; sc = QSCALE; }
        else if (g < 16) { p = pj.ak + (size_t)tok * 512 + (g - 8) * 64; gv = qkg + 64; }
        else if (g < 24) { p = pj.bq + (size_t)tok * 512 + (g - 16) * 64; gv = qkg + 128; sc = QSCALE; }
        else if (g < 26) { p = pj.bk + (size_t)tok * 128 + (g - 24) * 64; gv = qkg + 192; }
        else if (g < 34) { p = pj.cq + (size_t)tok * 512 + (g - 26) * 64; gv = qkg + 256; sc = QSCALE; }
        else { p = pj.ck + (size_t)tok * 64; gv = qkg + 320; }
        const float v = bf2f(p[lane]);
        const float ss = wsum(v * v);
        p[lane] = f2bf(v * rsqrtf(ss * (1.0f / 64) + EPS) * gv[lane] * sc);
    }
}

__device__ __forceinline__ void ph_attnA_naive(const Params& P_, int l, float* lds) {
    const KA P = ka_get();
    const Proj pj = proj_ptrs(P.ws);
    bf16_t* BR = (bf16_t*)(P.ws + OFF_BR);
    const int tidq = tid_opaque(); const int lane = tidq & 63, wid = tidq >> 6;
    float* btab = lds;
    float* qs = lds + 128 + wid * 128;
    for (int i = tidq; i < 128; i += 512) btab[i] = P.in[I_RELB][(i >> 2) * 20 + (i & 3)] * LOG2E;
    __syncthreads();
    const float* lp = P.in[I_LAM] + (size_t)l * 256;
    const float linit = lambda_init_of(l);
    const float lam = expf(wsum(lp[lane] * lp[64 + lane])) - expf(wsum(lp[128 + lane] * lp[192 + lane])) + linit;
    const float* subg = P.in[I_SUBLN] + (size_t)l * 128;
    for (int t = blockIdx.x * 8 + wid; t < NB * 4 * NS; t += gridDim.x * 8) {
        const int q = t & (NS - 1), h = (t >> 12) & 3, b = t >> 14;
        const int tok = b * NS + q;
        qs[lane] = bf2f(pj.aq[(size_t)tok * 512 + (h * 2) * 64 + lane]);
        qs[64 + lane] = bf2f(pj.aq[(size_t)tok * 512 + (h * 2 + 1) * 64 + lane]);
        const int nkt = (q >> 6) + 1;
        float M0 = -INFINITY, Z0 = 0.f, M1 = -INFINITY, Z1 = 0.f;
        for (int kt = 0; kt < nkt; ++kt) {
            asm volatile("" ::: "memory");
            const int key = kt * 64 + lane;
            const uint4* kp = (const uint4*)(pj.ak + (size_t)(b * NS + key) * 512 + h * 128);
            float s0 = 0.f, s1 = 0.f;
#pragma unroll 1
            for (int d = 0; d < 8; ++d) { asm volatile("" ::: "memory"); s0 += dot8(kp[d], qs + d * 8); s1 += dot8(kp[8 + d], qs + 64 + d * 8); }
            const float bias = btab[t5_bucket(key - q) * 4 + h];
            s0 += bias; s1 += bias;
            float mn = fmaxf(M0, s0); Z0 = Z0 * exp2f(M0 - mn) + exp2f(s0 - mn); M0 = mn;
            mn = fmaxf(M1, s1); Z1 = Z1 * exp2f(M1 - mn) + exp2f(s1 - mn); M1 = mn;
        }
        { const float mw = wmax(M0); Z0 = wsum(Z0 * exp2f(M0 - mw)); M0 = mw; }
        { const float mw = wmax(M1); Z1 = wsum(Z1 * exp2f(M1 - mw)); M1 = mw; }
        const float iz0 = 1.f / Z0, iz1 = lam / Z1;
        float a0 = 0.f, a1 = 0.f;
        for (int kt = 0; kt < nkt; ++kt) {
            asm volatile("" ::: "memory");
            const int key = kt * 64 + lane;
            const uint4* kp = (const uint4*)(pj.ak + (size_t)(b * NS + key) * 512 + h * 128);
            float s0 = 0.f, s1 = 0.f;
#pragma unroll 1
            for (int d = 0; d < 8; ++d) { asm volatile("" ::: "memory"); s0 += dot8(kp[d], qs + d * 8); s1 += dot8(kp[8 + d], qs + 64 + d * 8); }
            const float bias = btab[t5_bucket(key - q) * 4 + h];
            const float p = exp2f(s0 + bias - M0) * iz0 - exp2f(s1 + bias - M1) * iz1;
            const unsigned* vp = (const unsigned*)(pj.av + (size_t)(b * NS + kt * 64) * 512 + h * 128) + lane;
#pragma unroll 4
            for (int j = 0; j < 64; ++j) { const float pjv = __shfl(p, j); const unsigned w = vp[(size_t)j * 256]; a0 += pjv * bflo(w); a1 += pjv * bfhi(w); }
        }
        const float ss = wsum(a0 * a0 + a1 * a1);
        const float rstd = rsqrtf(ss * (1.0f / 128) + EPS) * (1.0f - linit);
        *(unsigned*)(BR + (size_t)tok * 1536 + h * 128 + lane * 2) = pack2(a0 * rstd * subg[lane * 2], a1 * rstd * subg[lane * 2 + 1]);
    }
}

__device__ __forceinline__ void ph_attnB_naive(const Params& P_, int l, float* lds) {
    const KA P = ka_get();
    const Proj pj = proj_ptrs(P.ws);
    bf16_t* BR = (bf16_t*)(P.ws + OFF_BR);
    const int tidq = tid_opaque(); const int lane = tidq & 63, wid = tidq >> 6;
    float* btab = lds;
    float* qs = lds + 256 + wid * 64;
    __syncthreads();
    for (int i = tidq; i < 256; i += 512) btab[i] = P.in[I_RELB][(i >> 3) * 20 + 4 + (i & 7)] * LOG2E;
    __syncthreads();
    const float* sinks = P.in[I_SINK] + (size_t)l * 8;
    for (int t = blockIdx.x * 8 + wid; t < NTOK * 8; t += gridDim.x * 8) {
        const int hq = t & 7, tok = t >> 3, q = tok & (NS - 1), b = tok >> 12, kvh = hq >> 2, c = q >> 6;
        qs[lane] = bf2f(pj.bq[(size_t)tok * 512 + hq * 64 + lane]);
        float s[3];
#pragma unroll
        for (int g = 0; g < 3; ++g) {
            const int pos = c * 64 - 128 + g * 64 + lane;
            s[g] = -INFINITY;
            if (pos >= 0) {
                const uint4* kp = (const uint4*)(pj.bk + (size_t)(b * NS + pos) * 128 + kvh * 64);
                float a = 0.f;
#pragma unroll
                for (int d = 0; d < 8; ++d) a += dot8(kp[d], qs + d * 8);
                s[g] = a + btab[t5_bucket(pos - q) * 8 + hq];
            }
        }
        const float sink = sinks[hq] * LOG2E;
        const float m = fmaxf(wmax(fmaxf(fmaxf(s[0], s[1]), s[2])), sink);
        float e[3];
#pragma unroll
        for (int g = 0; g < 3; ++g) e[g] = exp2f(s[g] - m);
        const float Z = wsum(e[0] + e[1] + e[2]) + exp2f(sink - m);
        const float iz = 1.f / Z;
        float acc = 0.f;
#pragma unroll
        for (int g = 0; g < 3; ++g) {
            const int pos0 = c * 64 - 128 + g * 64;
            if (pos0 >= 0) {
                const bf16_t* vp = pj.bv + (size_t)(b * NS + pos0) * 128 + kvh * 64 + lane;
#pragma unroll 4
                for (int j = 0; j < 64; ++j) acc += __shfl(e[g], j) * bf2f(vp[(size_t)j * 128]);
            }
        }
        BR[(size_t)tok * 1536 + 512 + hq * 64 + lane] = f2bf(acc * iz);
    }
}

__device__ __forceinline__ void ph_attnC_naive(const Params& P_, int l, float* lds) {
    const KA P = ka_get();
    const Proj pj = proj_ptrs(P.ws);
    bf16_t* BR = (bf16_t*)(P.ws + OFF_BR);
    const int tidq = tid_opaque(); const int lane = tidq & 63, wid = tidq >> 6;
    float* btab = lds;
    unsigned* keys = (unsigned*)(lds + 256) + wid * 4480;
    int* sel = (int*)(keys + 4096);
    float* iqs = (float*)(keys + 4096 + 256);
    __syncthreads();
    for (int i = tidq; i < 256; i += 512) btab[i] = P.in[I_RELB][(i >> 3) * 20 + 12 + (i & 7)] * LOG2E;
    __syncthreads();
    for (int tok = blockIdx.x * 8 + wid; tok < NTOK; tok += gridDim.x * 8) {
        const int q = tok & (NS - 1), b = tok >> 12, c = q >> 6, N = (c + 1) * 64, ntile = c + 1;
        iqs[lane] = bf2f(pj.iq[(size_t)tok * 128 + lane]); iqs[64 + lane] = bf2f(pj.iq[(size_t)tok * 128 + 64 + lane]);
        const float4 wv = *(const float4*)(pj.iw + (size_t)tok * 4);
        int cnt;
        if (N <= 256) { for (int i = lane; i < N; i += 64) sel[i] = i; cnt = N; }
        else {
            for (int kt = 0; kt < ntile; ++kt) {
                asm volatile("" ::: "memory");
                const int key = kt * 64 + lane;
                const uint4* kp = (const uint4*)(pj.ik + (size_t)(b * NS + key) * 32);
                const uint4 k0 = kp[0], k1 = kp[1], k2 = kp[2], k3 = kp[3];
                float sc = 0.f;
#pragma unroll
                for (int hh = 0; hh < 4; ++hh) {
                    const float lg = dot8(k0, iqs + hh * 32) + dot8(k1, iqs + hh * 32 + 8) + dot8(k2, iqs + hh * 32 + 16) + dot8(k3, iqs + hh * 32 + 24);
                    const float w = hh == 0 ? wv.x : hh == 1 ? wv.y : hh == 2 ? wv.z : wv.w;
                    sc += fmaxf(lg, 0.f) * w;
                }
                sc += 0.0f;
                const unsigned u = __float_as_uint(sc);
                keys[key] = (u & 0x80000000u) ? ~u : (u | 0x80000000u);
            }
            unsigned T = 0;
            for (int bit = 31; bit >= 0; --bit) {
                const unsigned cand = T | (1u << bit);
                int n = 0;
                for (int kt = 0; kt < ntile; ++kt) n += __popcll(__ballot(keys[kt * 64 + lane] >= cand));
                if (n >= 256) T = cand;
            }
            int ngt = 0;
            for (int kt = 0; kt < ntile; ++kt) ngt += __popcll(__ballot(keys[kt * 64 + lane] > T));
            const int need = 256 - ngt;
            int nsel = 0, neq = 0;
            const unsigned long long ltmask = (1ull << lane) - 1ull;
            for (int kt = 0; kt < ntile; ++kt) {
                const unsigned kv = keys[kt * 64 + lane];
                const unsigned long long eqm = __ballot(kv == T);
                const bool take = (kv > T) || (kv == T && (neq + __popcll(eqm & ltmask)) < need);
                const unsigned long long tm = __ballot(take);
                if (take) sel[nsel + __popcll(tm & ltmask)] = kt * 64 + lane;
                nsel += __popcll(tm); neq += __popcll(eqm);
            }
            cnt = 256;
        }
        int idx[4];
#pragma unroll
        for (int j = 0; j < 4; ++j) idx[j] = (lane + 64 * j < cnt) ? sel[lane + 64 * j] : 0;
        for (int h = 0; h < 8; ++h) {
            iqs[lane] = bf2f(pj.cq[(size_t)tok * 512 + h * 64 + lane]);
            const float* qv = iqs;
            float s[4];
#pragma unroll
            for (int j = 0; j < 4; ++j) {
                asm volatile("" ::: "memory");
                s[j] = -INFINITY;
                if (lane + 64 * j < cnt) {
                    const uint4* kp = (const uint4*)(pj.ck + (size_t)(b * NS + idx[j]) * 64);
                    float a = 0.f;
#pragma unroll
                    for (int d = 0; d < 8; ++d) a += dot8(kp[d], qv + d * 8);
                    s[j] = a + btab[t5_bucket(idx[j] - q) * 8 + h];
                }
            }
            const float m = wmax(fmaxf(fmaxf(s[0], s[1]), fmaxf(s[2], s[3])));
            float e[4];
#pragma unroll
            for (int j = 0; j < 4; ++j) e[j] = exp2f(s[j] - m);
            const float iz = 1.f / wsum(e[0] + e[1] + e[2] + e[3]);
            float acc = 0.f;
#pragma unroll
            for (int j = 0; j < 4; ++j) {
                const int nj = cnt - 64 * j < 64 ? cnt - 64 * j : 64;
#pragma unroll 2
                for (int i = 0; i < nj; ++i) { const float pv = __shfl(e[j], i); const int id = __shfl(idx[j], i); acc += pv * bf2f(pj.cv[(size_t)(b * NS + id) * 64 + lane]); }
            }
            BR[(size_t)tok * 1536 + 1024 + h * 64 + lane] = f2bf(acc * iz);
        }
    }
}

__device__ __forceinline__ void ph_gatebranch_naive(const Params& P_, int l, float* lds) {
    const KA P = ka_get();
    const bf16_t* H = (const bf16_t*)(P.ws + OFF_H);
    const bf16_t* BR = (const bf16_t*)(P.ws + OFF_BR);
    bf16_t* MG = (bf16_t*)(P.ws + OFF_MERGED);
    const float* Wg = P.in[I_WGATE] + (size_t)l * ND * 3072;
    const float* bg = P.in[I_BGATE] + (size_t)l * 3072;
    const float* Wb = P.in[I_WBR] + (size_t)l * 3 * 512 * ND;
    const int tid = tid_opaque(), ty = tid >> 5, tx = tid & 31;
    for (int t = blockIdx.x; t < 256 * 8; t += gridDim.x) {
        const int tm = t >> 3, tn = t & 7;
        float m[8][4];
#pragma unroll
        for (int i = 0; i < 8; ++i)
#pragma unroll
            for (int j = 0; j < 4; ++j) m[i][j] = 0.f;
        for (int n = 0; n < 3; ++n) {
            float g[8][4], y[8][4];
            ngemm_tile(H, ND, Wg, 3072, ND, 3072, tm * 128, n * 1024 + tn * 128, g, lds);
            ngemm_tile(BR + n * 512, 1536, Wb + (size_t)n * 512 * ND, ND, 512, ND, tm * 128, tn * 128, y, lds);
#pragma unroll
            for (int i = 0; i < 8; ++i)
#pragma unroll
                for (int j = 0; j < 4; ++j) { const float z = g[i][j] + bg[n * 1024 + tn * 128 + tx * 4 + j]; m[i][j] += y[i][j] / (1.f + expf(-z)); }
        }
#pragma unroll
        for (int i = 0; i < 8; ++i) {
            uint2 o; o.x = pack2(m[i][0], m[i][1]); o.y = pack2(m[i][2], m[i][3]);
            *(uint2*)(MG + (size_t)(tm * 128 + ty * 8 + i) * ND + tn * 128 + tx * 4) = o;
        }
    }
}
__device__ __forceinline__ void ph_out_naive(const Params& P_, int l, float* lds) {
    const KA P = ka_get();
    const bf16_t* MG = (const bf16_t*)(P.ws + OFF_MERGED);
    const float* W = P.in[I_WOUT] + (size_t)l * ND * ND;
    const float* xsrc = l == 0 ? P.in[I_X] : P.out;
    const int tid = tid_opaque(), ty = tid >> 5, tx = tid & 31;
    for (int t = blockIdx.x; t < 256 * 8; t += gridDim.x) {
        const int tm = t >> 3, tn = t & 7;
        float acc[8][4];
        ngemm_tile(MG, ND, W, ND, ND, ND, tm * 128, tn * 128, acc, lds);
#pragma unroll
        for (int i = 0; i < 8; ++i) {
            const size_t o = (size_t)(tm * 128 + ty * 8 + i) * ND + tn * 128 + tx * 4;
            const float4 xv = *(const float4*)(xsrc + o);
            *(float4*)(P.out + o) = make_float4(xv.x + acc[i][0], xv.y + acc[i][1], xv.z + acc[i][2], xv.w + acc[i][3]);
        }
    }
}

__device__ __forceinline__ void ph_norm2_route(const Params& P_, int l, float* lds_) {
    const KA P = ka_get();
    bf16_t* H = (bf16_t*)(P.ws + OFF_H);
    int* eid = (int*)(P.ws + OFF_ROUTE); float* ew = (float*)(P.ws + OFF_ROUTE + 256 * 1024);
    const float* g = P.in[I_NFG] + (size_t)l * ND;
    const float* wrg = P.in[I_WRG] + (size_t)l * ND * 4; const float* brg = P.in[I_BRG] + (size_t)l * 4;
    const float* wre = P.in[I_WRE] + (size_t)l * ND * 16; const float* bre = P.in[I_BRE] + (size_t)l * 16;
    const int tidq = tid_opaque(); const int lane = tidq & 63, wid = tidq >> 6;
    typedef float v4f __attribute__((ext_vector_type(4)));
    LAS v4f* wl = (LAS v4f*)lds_;
    __syncthreads();
    for (int idx = tidq; idx < 5120; idx += 512) {
        const int ln = idx & 63, t = idx >> 6, q = t % 5, je = t / 5, k = ((je >> 2) * 64 + ln) * 4 + (je & 3);
        wl[idx] = q == 0 ? *(const v4f*)(wrg + (size_t)k * 4) : *(const v4f*)(wre + (size_t)k * 16 + (q - 1) * 4);
    }
    __syncthreads();
    for (int row0 = (blockIdx.x * 8 + wid) * 2; row0 < NTOK; row0 += gridDim.x * 16) {
        float4 v[2][4]; float rstd[2];
#pragma unroll
        for (int r = 0; r < 2; ++r) { const uint2* xp = (const uint2*)((const bf16_t*)(P.ws + OFF_STREAM) + (size_t)(row0 + r) * ND);
#pragma unroll
            for (int j = 0; j < 4; ++j) { const uint2 w = xp[j * 64 + lane]; v[r][j] = make_float4(bflo(w.x), bfhi(w.x), bflo(w.y), bfhi(w.y)); } }
#pragma unroll
        for (int r = 0; r < 2; ++r) { float ss = 0.f;
#pragma unroll
            for (int j = 0; j < 4; ++j) ss += v[r][j].x * v[r][j].x + v[r][j].y * v[r][j].y + v[r][j].z * v[r][j].z + v[r][j].w * v[r][j].w;
            rstd[r] = rsqrtf(wsum_dpp(ss) * (1.0f / ND) + EPS); }
        float lg[2][20];
#pragma unroll
        for (int r = 0; r < 2; ++r)
#pragma unroll
            for (int i = 0; i < 20; ++i) lg[r][i] = 0.f;
#pragma unroll
        for (int j = 0; j < 4; ++j) {
            const int k0 = (j * 64 + lane) * 4;
            const float4 gv = ((const float4*)g)[j * 64 + lane];
            float hv[2][4];
#pragma unroll
            for (int r = 0; r < 2; ++r) {
                hv[r][0] = v[r][j].x * rstd[r] * gv.x; hv[r][1] = v[r][j].y * rstd[r] * gv.y; hv[r][2] = v[r][j].z * rstd[r] * gv.z; hv[r][3] = v[r][j].w * rstd[r] * gv.w;
                uint2 o; o.x = pack2(hv[r][0], hv[r][1]); o.y = pack2(hv[r][2], hv[r][3]);
                *(uint2*)(H + (size_t)(row0 + r) * ND + k0) = o;
            }
#pragma unroll
            for (int e = 0; e < 4; ++e) {
                const LAS v4f* wp = wl + ((j * 4 + e) * 5) * 64 + lane;
                const v4f wg4 = wp[0], w0 = wp[64], w1 = wp[128], w2 = wp[192], w3 = wp[256];
#pragma unroll
                for (int r = 0; r < 2; ++r) {
                    const float x = hv[r][e];
                    lg[r][0] += x * wg4.x; lg[r][1] += x * wg4.y; lg[r][2] += x * wg4.z; lg[r][3] += x * wg4.w;
                    lg[r][4] += x * w0.x; lg[r][5] += x * w0.y; lg[r][6] += x * w0.z; lg[r][7] += x * w0.w;
                    lg[r][8] += x * w1.x; lg[r][9] += x * w1.y; lg[r][10] += x * w1.z; lg[r][11] += x * w1.w;
                    lg[r][12] += x * w2.x; lg[r][13] += x * w2.y; lg[r][14] += x * w2.z; lg[r][15] += x * w2.w;
                    lg[r][16] += x * w3.x; lg[r][17] += x * w3.y; lg[r][18] += x * w3.z; lg[r][19] += x * w3.w;
                }
            }
            asm volatile("" ::: "memory");
        }
#pragma unroll
        for (int r = 0; r < 2; ++r)
#pragma unroll
            for (int i = 0; i < 20; ++i) lg[r][i] = wsum_dpp(lg[r][i]);
        if (lane < 2) {
            const int row = row0 + lane;
            float lgl[20];
#pragma unroll
            for (int i = 0; i < 20; ++i) lgl[i] = lane == 0 ? lg[0][i] : lg[1][i];
            float gl[4];
#pragma unroll
            for (int i = 0; i < 4; ++i) gl[i] = lgl[i] + brg[i];
            int gs = 0; float gm = gl[0];
#pragma unroll
            for (int i = 1; i < 4; ++i) if (gl[i] > gm) { gm = gl[i]; gs = i; }
            float zs = 0.f;
#pragma unroll
            for (int i = 0; i < 4; ++i) zs += expf(gl[i] - gm);
            const float pgroup = 1.f / zs;
            float el[4];
#pragma unroll
            for (int i = 0; i < 4; ++i) { el[i] = 0.f;
#pragma unroll
                for (int gq = 0; gq < 4; ++gq) if (gq == gs) el[i] = lgl[4 + gq * 4 + i] + bre[gq * 4 + i]; }
            int e1 = 0; float v1 = el[0];
#pragma unroll
            for (int i = 1; i < 4; ++i) if (el[i] > v1) { v1 = el[i]; e1 = i; }
            int e2 = -1; float v2 = -INFINITY;
#pragma unroll
            for (int i = 0; i < 4; ++i) if (i != e1 && el[i] > v2) { v2 = el[i]; e2 = i; }
            const float x2 = expf(v2 - v1), w1 = 1.f / (1.f + x2), w2 = x2 / (1.f + x2);
            eid[row * 2] = gs * 4 + e1; eid[row * 2 + 1] = gs * 4 + e2;
            ew[row * 2] = w1 * pgroup; ew[row * 2 + 1] = w2 * pgroup;
            const int lo = e1 < e2 ? e1 : e2, hi = e1 < e2 ? e2 : e1;
            const int bk = gs * 6 + (lo == 0 ? hi - 1 : (lo == 1 ? hi + 1 : 5));
            const int pos = atomicAdd((int*)(P.ws + OFF_CTRL + MOE_CNT_OFF) + l * 32 + bk, 1);
            ((int*)(P.ws + OFF_ROUTE + MOE_LIST_OFF))[bk * NTOK + pos] = row;
            float* rw = (float*)(P.ws + OFF_ROUTE + MOE_RW_OFF);
            rw[row * 2] = (e1 < e2 ? w1 : w2) * pgroup; rw[row * 2 + 1] = (e1 < e2 ? w2 : w1) * pgroup;
        }
    }
}

__device__ __forceinline__ void ph_moe_naive(const Params& P_, int l, float* lds) {
    const KA P = ka_get();
    const bf16_t* H = (const bf16_t*)(P.ws + OFF_H);
    const int* eid = (const int*)(P.ws + OFF_ROUTE); const float* ew = (const float*)(P.ws + OFF_ROUTE + 256 * 1024);
    const int tidq = tid_opaque(); const int lane = tidq & 63, wid = tidq >> 6;
    float* hs = lds + wid * 1280;
    float* hid = hs + 1024;
    for (int tok = blockIdx.x * 8 + wid; tok < NTOK; tok += gridDim.x * 8) {
#pragma unroll
        for (int j = 0; j < 4; ++j) { const uint2 w = *(const uint2*)(H + (size_t)tok * ND + (j * 64 + lane) * 4); float* d = hs + (j * 64 + lane) * 4; d[0] = bflo(w.x); d[1] = bfhi(w.x); d[2] = bflo(w.y); d[3] = bfhi(w.y); }
        float o[16];
#pragma unroll
        for (int i = 0; i < 16; ++i) o[i] = 0.f;
        for (int s = 0; s < 2; ++s) {
            const int e = eid[tok * 2 + s]; const float w = ew[tok * 2 + s];
            const float* wg = P.in[I_WFG] + ((size_t)l * 16 + e) * ND * 256;
            const float* wu = P.in[I_WFU] + ((size_t)l * 16 + e) * ND * 256;
            const float* wd = P.in[I_WFD] + ((size_t)l * 16 + e) * 256 * ND;
            float4 ga = make_float4(0.f, 0.f, 0.f, 0.f), ua = ga;
            for (int k = 0; k < ND; ++k) {
                const float hv = hs[k];
                const float4 a = *(const float4*)(wg + (size_t)k * 256 + lane * 4), u = *(const float4*)(wu + (size_t)k * 256 + lane * 4);
                ga.x += hv * a.x; ga.y += hv * a.y; ga.z += hv * a.z; ga.w += hv * a.w; ua.x += hv * u.x; ua.y += hv * u.y; ua.z += hv * u.z; ua.w += hv * u.w;
            }
            float4 hv4;
            hv4.x = ga.x / (1.f + expf(-ga.x)) * ua.x * w; hv4.y = ga.y / (1.f + expf(-ga.y)) * ua.y * w; hv4.z = ga.z / (1.f + expf(-ga.z)) * ua.z * w; hv4.w = ga.w / (1.f + expf(-ga.w)) * ua.w * w;
            *(float4*)(hid + lane * 4) = hv4;
            for (int f = 0; f < 256; ++f) {
                const float hf = hid[f];
#pragma unroll
                for (int j = 0; j < 4; ++j) { const float4 d = *(const float4*)(wd + (size_t)f * ND + (j * 64 + lane) * 4); o[j * 4] += hf * d.x; o[j * 4 + 1] += hf * d.y; o[j * 4 + 2] += hf * d.z; o[j * 4 + 3] += hf * d.w; }
            }
        }
#pragma unroll
        for (int j = 0; j < 4; ++j) {
            float4* op = (float4*)(P.out + (size_t)tok * ND + (j * 64 + lane) * 4);
            float4 x = *op; x.x += o[j * 4]; x.y += o[j * 4 + 1]; x.z += o[j * 4 + 2]; x.w += o[j * 4 + 3]; *op = x;
        }
    }
}


namespace mm {
typedef short bf16x8 __attribute__((ext_vector_type(8)));
typedef float f32x16 __attribute__((ext_vector_type(16)));
typedef float f32x4 __attribute__((ext_vector_type(4)));
typedef unsigned u32x4 __attribute__((ext_vector_type(4)));
constexpr int OPB = 256 * 128;
constexpr int STG = 2 * OPB;
constexpr int LDS_NEED = 2 * STG;
__host__ __device__ __forceinline__ int img_col(int rho) { const int i = rho & 31; return (rho & ~31) + 16 * ((i >> 2) & 1) + 4 * (i >> 3) + (i & 3); }
__device__ __forceinline__ unsigned cvt_pk_bf16(float lo, float hi) { unsigned r; asm volatile("v_cvt_pk_bf16_f32 %0, %1, %2" : "=v"(r) : "v"(lo), "v"(hi)); return r; }
__device__ __forceinline__ u32x4 pack8(const f32x16& v, int o) { u32x4 w; w.x = cvt_pk_bf16(v[o], v[o + 1]); w.y = cvt_pk_bf16(v[o + 2], v[o + 3]); w.z = cvt_pk_bf16(v[o + 4], v[o + 5]); w.w = cvt_pk_bf16(v[o + 6], v[o + 7]); return w; }

struct Unit {
    const char* a;
    const char* b0;
    const char* b1;
    int lda, ldb;
    int nk, nseg;
    int pm, pn, tag;
    int aux0, aux1;
};
__device__ __forceinline__ bool static_tile(long L, int nM, int nN, int& pm, int& pn) {
    const int nwg = nM * nN; if (L >= nwg) return false;
    int wgid = (int)L; { const int q = nwg / 8, r = nwg % 8, xcd = wgid % 8, off = wgid / 8; wgid = (xcd < r ? xcd * (q + 1) : r * (q + 1) + (xcd - r) * q) + off; }
    const int nig = 8 * nN, gid = wgid / nig, fm = gid * 8, gsz = (nM - fm) < 8 ? (nM - fm) : 8;
    pm = fm + ((wgid % nig) % gsz); pn = (wgid % nig) / gsz; return true;
}

template <class Epi, class Sched>
__device__ __forceinline__ void gemm_phase(char* smem, const Sched& S, const Epi& E) {
    const int tid = tid_opaque(), lane = tid & 63, wid = __builtin_amdgcn_readfirstlane(tid >> 6), wm = wid >> 2, wn = wid & 3, r32 = lane & 31, h = lane >> 5;
    LAS char* lds = (LAS char*)smem;
    const int srow = tid >> 3, sc = tid & 7;
    const unsigned sts = (unsigned)(srow * 128 + ((sc ^ ((srow >> 1) & 7)) << 4));
    const unsigned rda = (unsigned)((wm * 128 + r32) * 128), rdb = (unsigned)(OPB + (wn * 64 + r32) * 128);
    const unsigned x7 = (unsigned)((r32 >> 1) & 7);
    Unit lu; int ci = 0, li = 0;
    if (!S.next(0, lu)) return;
    int cnk = lu.nk;
    constexpr int NA = Sched::GATHER ? 4 : 1;
    unsigned ao[NA], bo;
    auto offs = [&](const Unit& u, unsigned (&a)[NA], unsigned& b) {
        int t2 = tid; asm volatile("" : "+v"(t2));
        const int r0 = t2 >> 3, c16 = (t2 & 7) * 16;
        S.a_rows(u, r0, a);
#pragma unroll
        for (int q = 0; q < NA; ++q) a[q] += (unsigned)c16;
        b = (unsigned)(r0 * u.ldb * 2 + c16);
    };
    offs(lu, ao, bo);
    f32x16 acc[4][2];
#pragma unroll
    for (int i = 0; i < 4; ++i)
#pragma unroll
        for (int j = 0; j < 2; ++j)
#pragma unroll
            for (int e = 0; e < 16; ++e) acc[i][j][e] = 0.f;
    u32x4 ga[4], gb[4];
#define MM_GLOAD(u, k, A_, B_) do { \
        const __amdgpu_buffer_rsrc_t ra_ = __builtin_amdgcn_make_buffer_rsrc((void*)(u).a, 0, 0x7fffffff, 0x00020000); \
        const __amdgpu_buffer_rsrc_t rb_ = __builtin_amdgcn_make_buffer_rsrc((void*)((k) < (u).nseg ? (u).b0 : (u).b1), 0, 0x7fffffff, 0x00020000); \
        const unsigned ko_ = (unsigned)(k) * 128u, as_ = (unsigned)(u).lda * 128u, bs_ = (unsigned)(u).ldb * 128u; \
        _Pragma("unroll") for (int q_ = 0; q_ < 4; ++q_) { \
            ga[q_] = __builtin_bit_cast(u32x4, __builtin_amdgcn_raw_buffer_load_b128(ra_, Sched::GATHER ? (A_)[q_ % NA] : (A_)[0], Sched::GATHER ? ko_ : ko_ + q_ * as_, 0)); \
            gb[q_] = __builtin_bit_cast(u32x4, __builtin_amdgcn_raw_buffer_load_b128(rb_, (B_), ko_ + q_ * bs_, 0)); } } while (0)
#define MM_LSTORE(buf) do { LAS char* p_ = lds + (buf) * STG + sts; \
        _Pragma("unroll") for (int q_ = 0; q_ < 4; ++q_) { *(LAS u32x4*)(p_ + q_ * 8192) = ga[q_]; *(LAS u32x4*)(p_ + OPB + q_ * 8192) = gb[q_]; } } while (0)
#define MM_LOADF(ks, AF, BF) do { const unsigned xo_ = (((unsigned)((ks) * 2 + h)) ^ x7) << 4; \
        _Pragma("unroll") for (int nt = 0; nt < 2; ++nt) BF[nt] = *(const LAS bf16x8*)(base + rdb + nt * 4096 + xo_); \
        _Pragma("unroll") for (int mt = 0; mt < 4; ++mt) AF[mt] = *(const LAS bf16x8*)(base + rda + mt * 4096 + xo_); } while (0)
#define MM_MMA(AF, BF) do { _Pragma("unroll") for (int mt = 0; mt < 4; ++mt) _Pragma("unroll") for (int nt = 0; nt < 2; ++nt) \
        acc[mt][nt] = Epi::TRANSP ? __builtin_amdgcn_mfma_f32_32x32x16_bf16(BF[nt], AF[mt], acc[mt][nt], 0, 0, 0) : __builtin_amdgcn_mfma_f32_32x32x16_bf16(AF[mt], BF[nt], acc[mt][nt], 0, 0, 0); } while (0)
#define MM_SB __builtin_amdgcn_sched_barrier(0)
    bool lvalid = true; int lk = 0;
    auto ladv = [&]() {
        if (++lk < lu.nk) return;
        lk = 0;
        Unit nu; if (S.next(li + 1, nu)) { lu = nu; ++li; offs(lu, ao, bo); } else lvalid = false;
    };
    MM_GLOAD(lu, 0, ao, bo);
    MM_LSTORE(0);
    ladv();
    if (lvalid) MM_GLOAD(lu, lk, ao, bo);
    __syncthreads();
    int buf = 0, ck = 0;
    for (;;) {
        const LAS char* base = lds + buf * STG;
        const bool pend = lvalid;
        if constexpr (Sched::PIPE) {
            bf16x8 af0[4], bf0[2], af1[4], bf1[2];
            MM_LOADF(0, af0, bf0); MM_SB;
            MM_LOADF(1, af1, bf1); MM_SB; MM_MMA(af0, bf0); MM_SB;
            MM_LOADF(2, af0, bf0); MM_SB; MM_MMA(af1, bf1); MM_SB;
            MM_LOADF(3, af1, bf1); MM_SB;
            if (pend) { MM_LSTORE(buf ^ 1); ladv(); if (lvalid) MM_GLOAD(lu, lk, ao, bo); }
            MM_SB; MM_MMA(af0, bf0); MM_SB; MM_MMA(af1, bf1); MM_SB;
        } else {
            bf16x8 af0[4], bf0[2];
            MM_LOADF(0, af0, bf0); MM_MMA(af0, bf0); MM_SB;
            MM_LOADF(1, af0, bf0); MM_MMA(af0, bf0); MM_SB;
            if (pend) { MM_LSTORE(buf ^ 1); ladv(); if (lvalid) MM_GLOAD(lu, lk, ao, bo); }
            MM_SB; MM_LOADF(2, af0, bf0); MM_MMA(af0, bf0); MM_SB;
            MM_LOADF(3, af0, bf0); MM_MMA(af0, bf0); MM_SB;
        }
        bool more = true;
        if (++ck == cnk) {
            { PROF_BEGIN(99) Unit eu; S.next(ci, eu); E(acc, eu, wm, wn, r32, h, tid); if (PROF_ID == Epi::PROF && threadIdx.x == 0) { *(volatile LAS unsigned*)(lds + PROF_LDS_OFF) += (unsigned)(__builtin_amdgcn_s_memrealtime() - _pt99); } }
#pragma unroll
            for (int i = 0; i < 4; ++i)
#pragma unroll
                for (int j = 0; j < 2; ++j)
#pragma unroll
                    for (int e = 0; e < 16; ++e) acc[i][j][e] = 0.f;
            ck = 0; ++ci;
            { Unit nu2; more = S.next(ci, nu2); if (more) cnk = nu2.nk; }
        }
        __syncthreads();
        buf ^= 1;
        if (!more) break;
    }
#undef MM_GLOAD
#undef MM_LSTORE
#undef MM_LOADF
#undef MM_MMA
#undef MM_SB
}
__device__ __forceinline__ void plain_rows(const Unit& u, int r0, unsigned (&a)[1]) { a[0] = (unsigned)(r0 * u.lda * 2); }
}

constexpr int EPI_TAB = 131072 + 2048;
constexpr size_t WT_IN = 0;
constexpr size_t WT_GATE = WT_IN + (size_t)3328 * 1024 * 2;
constexpr size_t WT_BR = WT_GATE + (size_t)3072 * 1024 * 2;
constexpr size_t WT_OUT = WT_BR + (size_t)3 * 1024 * 512 * 2;
constexpr size_t WT_GU = WT_OUT + (size_t)1024 * 1024 * 2;
constexpr size_t WT_DN = WT_GU + (size_t)16 * 512 * 1024 * 2;
constexpr size_t WT_END = WT_DN + (size_t)16 * 1024 * 256 * 2;
static_assert(WT_END <= 44 * MB, "weight image region");

template <class F>
__device__ __forceinline__ void cvt_tile(bf16_t* Bt, int K, int rho0, int k0, const float* W, int ldw, const F& colof, int tid) {
    const int rho = rho0 + (tid & 63) * 4, kg = k0 + (tid >> 6) * 16;
    const int c = colof(rho);
    float4 v[16];
#pragma unroll
    for (int j = 0; j < 16; ++j) v[j] = c >= 0 ? *(const float4*)(W + (size_t)(kg + j) * ldw + c) : make_float4(0.f, 0.f, 0.f, 0.f);
#pragma unroll
    for (int hf = 0; hf < 2; ++hf) {
        mm::u32x4 o;
        o.x = mm::cvt_pk_bf16(v[8 * hf + 0].x, v[8 * hf + 1].x); o.y = mm::cvt_pk_bf16(v[8 * hf + 2].x, v[8 * hf + 3].x); o.z = mm::cvt_pk_bf16(v[8 * hf + 4].x, v[8 * hf + 5].x); o.w = mm::cvt_pk_bf16(v[8 * hf + 6].x, v[8 * hf + 7].x); *(mm::u32x4*)(Bt + (size_t)(rho + 0) * K + kg + 8 * hf) = o;
        o.x = mm::cvt_pk_bf16(v[8 * hf + 0].y, v[8 * hf + 1].y); o.y = mm::cvt_pk_bf16(v[8 * hf + 2].y, v[8 * hf + 3].y); o.z = mm::cvt_pk_bf16(v[8 * hf + 4].y, v[8 * hf + 5].y); o.w = mm::cvt_pk_bf16(v[8 * hf + 6].y, v[8 * hf + 7].y); *(mm::u32x4*)(Bt + (size_t)(rho + 1) * K + kg + 8 * hf) = o;
        o.x = mm::cvt_pk_bf16(v[8 * hf + 0].z, v[8 * hf + 1].z); o.y = mm::cvt_pk_bf16(v[8 * hf + 2].z, v[8 * hf + 3].z); o.z = mm::cvt_pk_bf16(v[8 * hf + 4].z, v[8 * hf + 5].z); o.w = mm::cvt_pk_bf16(v[8 * hf + 6].z, v[8 * hf + 7].z); *(mm::u32x4*)(Bt + (size_t)(rho + 2) * K + kg + 8 * hf) = o;
        o.x = mm::cvt_pk_bf16(v[8 * hf + 0].w, v[8 * hf + 1].w); o.y = mm::cvt_pk_bf16(v[8 * hf + 2].w, v[8 * hf + 3].w); o.z = mm::cvt_pk_bf16(v[8 * hf + 4].w, v[8 * hf + 5].w); o.w = mm::cvt_pk_bf16(v[8 * hf + 6].w, v[8 * hf + 7].w); *(mm::u32x4*)(Bt + (size_t)(rho + 3) * K + kg + 8 * hf) = o;
    }
}
__device__ __forceinline__ void cvt_tile_pair(bf16_t* Bt, int K, int rho0, int k0, const float* W, int ldw, int tid) {
    const int rho = rho0 + (tid & 63) * 4, kg = k0 + (tid >> 6) * 16;
    const int nt = (rho >> 5) & 1, cb = (rho & ~63) + 2 * (rho & 31);
#pragma unroll
    for (int hf = 0; hf < 2; ++hf) {
        float va[8][4];
#pragma unroll
        for (int j = 0; j < 8; ++j) {
            const float4 lo = *(const float4*)(W + (size_t)(kg + 8 * hf + j) * ldw + cb), hi = *(const float4*)(W + (size_t)(kg + 8 * hf + j) * ldw + cb + 4);
            va[j][0] = nt ? lo.y : lo.x; va[j][1] = nt ? lo.w : lo.z; va[j][2] = nt ? hi.y : hi.x; va[j][3] = nt ? hi.w : hi.z;
        }
#pragma unroll
        for (int r = 0; r < 4; ++r) {
            mm::u32x4 o;
            o.x = mm::cvt_pk_bf16(va[0][r], va[1][r]); o.y = mm::cvt_pk_bf16(va[2][r], va[3][r]); o.z = mm::cvt_pk_bf16(va[4][r], va[5][r]); o.w = mm::cvt_pk_bf16(va[6][r], va[7][r]);
            *(mm::u32x4*)(Bt + (size_t)(rho + r) * K + kg + 8 * hf) = o;
        }
    }
}
__device__ __forceinline__ void ph_convert_weights(const Params& P_, int l) {
    const KA P = ka_get();
    const int tid = tid_opaque();
    char* wt = P.ws + OFF_WT;
    constexpr int T_IN = 13 * 8, T_GATE = 12 * 8, T_BR = 3 * 4 * 4, T_OUT = 4 * 8, T_GU = 16 * 2 * 8, T_DN = 16 * 4 * 2;
    constexpr int T_ALL = T_IN + T_GATE + T_BR + T_OUT + T_GU + T_DN;
    for (int t = blockIdx.x; t < T_ALL; t += gridDim.x) {
        int u = t;
        if (u < T_IN) {
            const float* W = P.in[I_WIN] + (size_t)l * ND * IN_COLS;
            cvt_tile((bf16_t*)(wt + WT_IN), 1024, (u >> 3) * 256, (u & 7) * 128, W, IN_COLS, [&](int rho) -> int { const int c = mm::img_col(rho); return c < IN_COLS ? c : -1; }, tid);
            continue;
        }
        u -= T_IN;
        if (u < T_GATE) {
            const float* W = P.in[I_WGATE] + (size_t)l * ND * 3072;
            cvt_tile((bf16_t*)(wt + WT_GATE), 1024, (u >> 3) * 256, (u & 7) * 128, W, 3072, [&](int rho) -> int { return mm::img_col(rho); }, tid);
            continue;
        }
        u -= T_GATE;
        if (u < T_BR) {
            const int n = u / 16, v = u % 16;
            const float* W = P.in[I_WBR] + ((size_t)l * 3 + n) * 512 * ND;
            cvt_tile((bf16_t*)(wt + WT_BR) + (size_t)n * 1024 * 512, 512, (v >> 2) * 256, (v & 3) * 128, W, ND, [&](int rho) -> int { return mm::img_col(rho); }, tid);
            continue;
        }
        u -= T_BR;
        if (u < T_OUT) {
            const float* W = P.in[I_WOUT] + (size_t)l * ND * ND;
            cvt_tile_pair((bf16_t*)(wt + WT_OUT), 1024, (u >> 3) * 256, (u & 7) * 128, W, ND, tid);
            continue;
        }
        u -= T_OUT;
        if (u < T_GU) {
            const int e = u / 16, v = u % 16;
            const float* Wg = P.in[I_WFG] + ((size_t)l * 16 + e) * ND * 256;
            const float* Wu = P.in[I_WFU] + ((size_t)l * 16 + e) * ND * 256;
            const int rho0 = (v >> 3) * 256;
            const float* Wsel = (((rho0 + (tid & 63) * 4) >> 5) & 1) ? Wu : Wg;
            cvt_tile((bf16_t*)(wt + WT_GU) + (size_t)e * 512 * 1024, 1024, rho0, (v & 7) * 128, Wsel, 256, [&](int rho) -> int {
                const int j = rho >> 8, wn = (rho >> 6) & 3; return j * 128 + wn * 32 + (mm::img_col(rho) & 31); }, tid);
            continue;
        }
        u -= T_GU;
        {
            const int e = u / 8, v = u % 8;
            const float* W = P.in[I_WFD] + ((size_t)l * 16 + e) * 256 * ND;
            cvt_tile_pair((bf16_t*)(wt + WT_DN) + (size_t)e * 1024 * 256, 256, (v >> 1) * 256, (v & 1) * 128, W, ND, tid);
        }
    }
}

struct SchedInProj {
    const char* A; const char* B; int mode;
    __device__ __forceinline__ bool next(int i, mm::Unit& u) const {
        int pm, pn; if (!mm::static_tile((long)i * gridDim.x + VBID, 128, 13, pm, pn)) return false;
        u.a = A + (size_t)pm * 256 * 1024 * 2; u.b0 = B + (size_t)pn * 256 * 1024 * 2; u.b1 = u.b0; u.lda = 1024; u.ldb = 1024; u.nk = 16; u.nseg = 16; u.pm = pm; u.pn = pn; u.tag = mode; return true;
    }
    static constexpr bool GATHER = false, PIPE = true;
    __device__ __forceinline__ void a_rows(const mm::Unit& u, int r0, unsigned (&a)[1]) const { mm::plain_rows(u, r0, a); }
};
struct EpiInProj {
    static constexpr bool TRANSP = true;
    static constexpr int PROF = 2;
    Proj pj; const float* qkg; const LAS float* gtab;
    __device__ __forceinline__ void operator()(mm::f32x16 (&acc)[4][2], const mm::Unit& u, int wm, int wn, int r32, int h, int tid) const {
        using namespace mm;
        asm volatile("" : "+v"(r32), "+v"(h));
        const int G = u.pn * 4 + wn;
        if (u.tag == 4) { if (acc[0][0][0] == 12345.678f) pj.aq[0] = 0; return; }
        if (u.tag == 3) { float t_ = 0.f;
#pragma unroll
            for (int i_ = 0; i_ < 4; ++i_) { t_ += acc[i_][0][3] + acc[i_][1][11] + acc[i_][0][7] + acc[i_][1][0]; }
            if (t_ == 12345.678f) pj.aq[0] = 0; return; }
        if (G > 48) return;
        bf16_t* dst; int tstride; const float* gv = nullptr; float sc = 1.f;
        if (G < 8) { dst = pj.aq + G * 64; tstride = 512; gv = qkg; sc = QSCALE; }
        else if (G < 16) { dst = pj.ak + (G - 8) * 64; tstride = 512; gv = qkg + 64; }
        else if (G < 24) { dst = pj.av + (G - 16) * 64; tstride = 512; }
        else if (G < 32) { dst = pj.bq + (G - 24) * 64; tstride = 512; gv = qkg + 128; sc = QSCALE; }
        else if (G < 34) { dst = pj.bk + (G - 32) * 64; tstride = 128; gv = qkg + 192; }
        else if (G < 36) { dst = pj.bv + (G - 34) * 64; tstride = 128; }
        else if (G < 44) { dst = pj.cq + (G - 36) * 64; tstride = 512; gv = qkg + 256; sc = QSCALE; }
        else if (G == 44) { dst = pj.ck; tstride = 64; gv = qkg + 320; }
        else if (G == 45) { dst = pj.cv; tstride = 64; }
        else if (G < 48) { dst = pj.iq + (G - 46) * 64; tstride = 128; }
        else { dst = pj.ik; tstride = 32; }
        if (u.tag == 8) { if (acc[0][0][0] == 12345.678f) dst[tstride] = 0; return; }
#pragma unroll 1
        for (int rep = 0; rep < (u.tag == 9 ? 4 : 1); ++rep)
#pragma unroll
        for (int mt = 0; mt < 4; ++mt) {
            asm volatile("" ::: "memory");
            const int row = u.pm * 256 + wm * 128 + mt * 32 + r32;
            f32x16& v0 = acc[mt][0]; f32x16& v1 = acc[mt][1];
            if (gv && u.tag != 7 && u.tag != 9) {
                float ss = 0.f;
#pragma unroll
                for (int e = 0; e < 16; ++e) ss += v0[e] * v0[e] + v1[e] * v1[e];
                ss = x32_sum(ss);
                const float rs = rsqrtf(ss * (1.0f / 64) + EPS) * sc;
#pragma unroll
                for (int e4 = 0; e4 < 4; ++e4) {
                    const f32x4 ga = *(const LAS f32x4*)(gtab + (gv - qkg) + 16 * h + 4 * e4), gb = *(const LAS f32x4*)(gtab + (gv - qkg) + 32 + 16 * h + 4 * e4);
#pragma unroll
                    for (int j = 0; j < 4; ++j) { v0[4 * e4 + j] *= rs * ga[j]; v1[4 * e4 + j] *= rs * gb[j]; }
                }
            }
            if (u.tag >= 5) { if (v0[0] + v1[3] + v0[9] + v1[12] == 12345.678f) dst[0] = 0; }
            else if (G < 48) {
                bf16_t* d = dst + (size_t)row * tstride + 16 * h;
                *(u32x4*)(d) = pack8(v0, 0); *(u32x4*)(d + 8) = pack8(v0, 8);
                *(u32x4*)(d + 32) = pack8(v1, 0); *(u32x4*)(d + 40) = pack8(v1, 8);
            } else {
                bf16_t* d = dst + (size_t)row * 32 + 16 * h;
                *(u32x4*)(d) = pack8(v0, 0); *(u32x4*)(d + 8) = pack8(v0, 8);
                if (h == 0) *(f32x4*)(pj.iw + (size_t)row * 4) = (f32x4){v1[0], v1[1], v1[2], v1[3]} * IWSCALE;
            }
        }
    }
};
__device__ __forceinline__ void ph_inproj(const Params& P_, int l, char* smem) {
    const KA P = ka_get();
    SchedInProj S; S.A = P.ws + OFF_H; S.B = P.ws + OFF_WT + WT_IN; S.mode = l >> 4;
    EpiInProj E; E.pj = proj_ptrs(P.ws); E.qkg = P.in[I_QKG] + (size_t)(l & 15) * 384;
    { LAS float* gt = (LAS float*)((LAS char*)smem + EPI_TAB); __syncthreads(); const int t = tid_opaque(); if (t < 384) gt[t] = E.qkg[t]; __syncthreads(); E.gtab = gt; }
    mm::gemm_phase(smem, S, E);
}

constexpr size_t SCR_G = OFF_PROJ;
constexpr size_t SCR_M = OFF_PROJ + 32 * MB;
struct SchedGB {
    const char* H; const char* BR; const char* Wg; const char* Wb;
    __device__ __forceinline__ bool next(int i, mm::Unit& u) const {
        const int ti = i / 6, sub = i - ti * 6, n = sub >> 1;
        int pm, pn; if (!mm::static_tile((long)ti * gridDim.x + VBID, 128, 4, pm, pn)) return false;
        u.pm = pm; u.pn = pn; u.tag = sub;
        if ((sub & 1) == 0) { u.a = H + (size_t)pm * 256 * 1024 * 2; u.lda = 1024; u.b0 = Wg + (size_t)(n * 1024 + pn * 256) * 1024 * 2; u.ldb = 1024; u.nk = 16; }
        else { u.a = BR + ((size_t)pm * 256 * 1536 + n * 512) * 2; u.lda = 1536; u.b0 = Wb + ((size_t)n * 1024 + pn * 256) * 512 * 2; u.ldb = 512; u.nk = 8; }
        u.b1 = u.b0; u.nseg = u.nk; return true;
    }
    static constexpr bool GATHER = false, PIPE = true;
    __device__ __forceinline__ void a_rows(const mm::Unit& u, int r0, unsigned (&a)[1]) const { mm::plain_rows(u, r0, a); }
};
struct EpiGB {
    static constexpr bool TRANSP = true;
    static constexpr int PROF = 4;
    const LAS float* btab; bf16_t* MG; char* scrg; char* scrm;
    __device__ __forceinline__ void operator()(mm::f32x16 (&acc)[4][2], const mm::Unit& u, int wm, int wn, int r32, int h, int tid) const {
        using namespace mm;
        asm volatile("" : "+v"(r32), "+v"(h), "+v"(tid));
        const int sub = u.tag, n = sub >> 1;
        const unsigned so0 = (unsigned)tid * 16u;
        if ((sub & 1) == 0) {
#pragma unroll
            for (int mt = 0; mt < 4; ++mt)
#pragma unroll
                for (int nt = 0; nt < 2; ++nt) {
                    f32x16& v = acc[mt][nt];
                    const int col = n * 1024 + u.pn * 256 + wn * 64 + nt * 32 + 16 * h;
#pragma unroll
                    for (int e4 = 0; e4 < 4; ++e4) { const f32x4 b = *(const LAS f32x4*)(btab + col + 4 * e4);
#pragma unroll
                        for (int j = 0; j < 4; ++j) v[4 * e4 + j] = __builtin_amdgcn_rcpf(1.f + __builtin_amdgcn_exp2f(__builtin_fmaf(v[4 * e4 + j], -LOG2E, b[j]))); }
                    const unsigned so = so0 + (unsigned)((mt * 2 + nt) * 2) * 8192u;
                    *(u32x4*)(scrg + so) = pack8(v, 0); *(u32x4*)(scrg + so + 8192) = pack8(v, 8);
                }
        } else {
#pragma unroll
            for (int hf = 0; hf < 4; ++hf) {
                const int mt = hf;
                {
                    u32x4 gq[2][2];
#pragma unroll
                    for (int c = 0; c < 2; ++c) { const unsigned so = so0 + (unsigned)((hf * 2 + c) * 2) * 8192u; gq[c][0] = *(const u32x4*)(scrg + so); gq[c][1] = *(const u32x4*)(scrg + so + 8192); }
#pragma unroll
                    for (int c = 0; c < 2; ++c) {
                        f32x16& v = acc[mt][c];
                        const unsigned gw[8] = {gq[c][0].x, gq[c][0].y, gq[c][0].z, gq[c][0].w, gq[c][1].x, gq[c][1].y, gq[c][1].z, gq[c][1].w};
#pragma unroll
                        for (int j = 0; j < 8; ++j) { v[2 * j] *= bflo(gw[j]); v[2 * j + 1] *= bfhi(gw[j]); }
                    }
                }
                if (n > 0) {
                    u32x4 mq[2][2];
#pragma unroll
                    for (int c = 0; c < 2; ++c) { const unsigned so = so0 + (unsigned)((hf * 2 + c) * 2) * 8192u; mq[c][0] = *(const u32x4*)(scrm + so); mq[c][1] = *(const u32x4*)(scrm + so + 8192); }
#pragma unroll
                    for (int c = 0; c < 2; ++c) {
                        f32x16& v = acc[mt][c];
                        const unsigned mw[8] = {mq[c][0].x, mq[c][0].y, mq[c][0].z, mq[c][0].w, mq[c][1].x, mq[c][1].y, mq[c][1].z, mq[c][1].w};
#pragma unroll
                        for (int j = 0; j < 8; ++j) { v[2 * j] += bflo(mw[j]); v[2 * j + 1] += bfhi(mw[j]); }
                    }
                }
#pragma unroll
                for (int c = 0; c < 2; ++c) {
                    f32x16& v = acc[mt][c];
                    const unsigned so = so0 + (unsigned)((hf * 2 + c) * 2) * 8192u;
                    if (n < 2) { *(u32x4*)(scrm + so) = pack8(v, 0); *(u32x4*)(scrm + so + 8192) = pack8(v, 8); }
                    else { bf16_t* d = MG + (size_t)(u.pm * 256 + wm * 128 + mt * 32 + r32) * ND + u.pn * 256 + wn * 64 + c * 32 + 16 * h; *(u32x4*)d = pack8(v, 0); *(u32x4*)(d + 8) = pack8(v, 8); }
                }
            }
        }
    }
};
__device__ __forceinline__ void ph_gatebranch(const Params& P_, int l, char* smem) {
    const KA P = ka_get();
    SchedGB S; S.H = P.ws + OFF_H; S.BR = P.ws + OFF_BR; S.Wg = P.ws + OFF_WT + WT_GATE; S.Wb = P.ws + OFF_WT + WT_BR;
    EpiGB E; E.MG = (bf16_t*)(P.ws + OFF_MERGED);
    { LAS float* bt = (LAS float*)((LAS char*)smem + EPI_TAB); const float* bg = P.in[I_BGATE] + (size_t)l * 3072; __syncthreads(); for (int t = tid_opaque(); t < 3072; t += 512) bt[t] = -bg[t] * LOG2E; __syncthreads(); E.btab = bt; }
    E.scrg = P.ws + SCR_G + (size_t)blockIdx.x * 131072; E.scrm = P.ws + SCR_M + (size_t)blockIdx.x * 131072;
    mm::gemm_phase(smem, S, E);
}

struct SchedOut {
    const char* A; const char* B;
    __device__ __forceinline__ bool next(int i, mm::Unit& u) const {
        int pm, pn; if (!mm::static_tile((long)i * gridDim.x + VBID, 128, 4, pm, pn)) return false;
        u.a = A + (size_t)pm * 256 * 1024 * 2; u.b0 = B + (size_t)pn * 256 * 1024 * 2; u.b1 = u.b0; u.lda = 1024; u.ldb = 1024; u.nk = 16; u.nseg = 16; u.pm = pm; u.pn = pn; u.tag = 0; return true;
    }
    static constexpr bool GATHER = false, PIPE = true;
    __device__ __forceinline__ void a_rows(const mm::Unit& u, int r0, unsigned (&a)[1]) const { mm::plain_rows(u, r0, a); }
};
struct EpiOut {
    static constexpr bool TRANSP = false;
    static constexpr int PROF = 17;
    const float* x32; bf16_t* st;
    __device__ __forceinline__ void operator()(mm::f32x16 (&acc)[4][2], const mm::Unit& u, int wm, int wn, int r32, int h, int tid) const {
        using namespace mm;
        asm volatile("" : "+v"(r32), "+v"(h));
#pragma unroll
        for (int mt = 0; mt < 4; ++mt)
#pragma unroll
            for (int eh = 0; eh < 2; ++eh) {
                const size_t off = (size_t)(u.pm * 256 + wm * 128 + mt * 32 + 4 * h + 16 * eh) * ND + u.pn * 256 + wn * 64 + 2 * r32;
                float xa[8], xb[8];
                if (x32) {
#pragma unroll
                    for (int e = 0; e < 8; ++e) { const float2 t = *(const float2*)(x32 + off + (size_t)((e & 3) + 8 * (e >> 2)) * ND); xa[e] = t.x; xb[e] = t.y; }
                } else {
#pragma unroll
                    for (int e = 0; e < 8; ++e) { const unsigned w = *(const unsigned*)(st + off + (size_t)((e & 3) + 8 * (e >> 2)) * ND); xa[e] = bflo(w); xb[e] = bfhi(w); }
                }
#pragma unroll
                for (int e = 0; e < 8; ++e) *(unsigned*)(st + off + (size_t)((e & 3) + 8 * (e >> 2)) * ND) = cvt_pk_bf16(xa[e] + acc[mt][0][8 * eh + e], xb[e] + acc[mt][1][8 * eh + e]);
            }
    }
};
__device__ __forceinline__ void ph_outproj(const Params& P_, int l, char* smem) {
    const KA P = ka_get();
    SchedOut S; S.A = P.ws + OFF_MERGED; S.B = P.ws + OFF_WT + WT_OUT;
    EpiOut E; E.x32 = l == 0 ? P.in[I_X] : (const float*)nullptr; E.st = (bf16_t*)(P.ws + OFF_STREAM);
    mm::gemm_phase(smem, S, E);
}


constexpr size_t OFF_HID = OFF_PROJ + 64 * MB;
constexpr int MOE_TAB = 131072 + 1024;
__device__ __forceinline__ void moe_table(char* smem, const int* cnt) {
    int* tab = (int*)(smem + MOE_TAB);
    const int t = tid_opaque();
    __syncthreads();
    if (t < 24) tab[32 + t] = cnt[t];
    __syncthreads();
    if (t == 0) { int p = 0; for (int b = 0; b < 24; ++b) { tab[b] = p; p += (tab[32 + b] + 255) >> 8; } tab[24] = p; }
    __syncthreads();
    if (t < 160) { int b = 0; for (int i = 1; i < 24; ++i) if (tab[i] <= t) b = i; tab[64 + t] = b; }
    __syncthreads();
}
struct MoeLoc { int b, rt, slot, valid, elo, ehi; };
__device__ __forceinline__ int moe_tab(const int* tab, int i) { return __builtin_amdgcn_readfirstlane(tab[i]); }
__device__ __forceinline__ MoeLoc moe_locate(const int* tab, int T) {
    const int b = moe_tab(tab, 64 + T);
    MoeLoc m; m.b = b; m.rt = T - moe_tab(tab, b); m.slot = T * 256; const int c = moe_tab(tab, 32 + b) - m.rt * 256; m.valid = c < 256 ? c : 256;
    const int g = b / 6, ix = b - g * 6; const int lo = ix < 3 ? 0 : (ix < 5 ? 1 : 2), hi = ix < 3 ? ix + 1 : (ix < 5 ? ix - 1 : 3);
    m.elo = g * 4 + lo; m.ehi = g * 4 + hi; return m;
}
struct SchedMoeUp {
    static constexpr bool GATHER = true, PIPE = true;
    const char* H; const char* W; const int* tab; const int* list;
    __device__ __forceinline__ bool next(int i, mm::Unit& u) const {
        const long L = (long)i * gridDim.x + VBID; const int T = (int)(L >> 2), c = (int)(L & 3);
        if (T >= moe_tab(tab, 24)) return false;
        const MoeLoc m = moe_locate(tab, T);
        const int e = (c >> 1) ? m.ehi : m.elo, j = c & 1;
        u.a = H; u.lda = 1024; u.b0 = W + ((size_t)e * 512 + j * 256) * 1024 * 2; u.b1 = u.b0; u.ldb = 1024; u.nk = 16; u.nseg = 16;
        u.pm = T; u.pn = c; u.tag = c; u.aux0 = m.b * NTOK + m.rt * 256; u.aux1 = m.valid; return true;
    }
    __device__ __forceinline__ void a_rows(const mm::Unit& u, int r0, unsigned (&a)[4]) const {
#pragma unroll
        for (int q = 0; q < 4; ++q) { const int r = r0 + 64 * q; const int tok = list[u.aux0 + (r < u.aux1 ? r : 0)]; a[q] = (unsigned)tok * 2048u; }
    }
};
struct EpiMoeUp {
    static constexpr bool TRANSP = true;
    static constexpr int PROF = 18;
    bf16_t* hid; const int* list; const float* rw;
    __device__ __forceinline__ void operator()(mm::f32x16 (&acc)[4][2], const mm::Unit& u, int wm, int wn, int r32, int h, int tid) const {
        using namespace mm;
        asm volatile("" : "+v"(r32), "+v"(h));
        const int which = u.tag >> 1, j = u.tag & 1;
        int tok[4]; float w[4];
#pragma unroll
        for (int mt = 0; mt < 4; ++mt) { const int r = wm * 128 + mt * 32 + r32; tok[mt] = list[u.aux0 + (r < u.aux1 ? r : 0)]; }
#pragma unroll
        for (int mt = 0; mt < 4; ++mt) w[mt] = rw[tok[mt] * 2 + which];
#pragma unroll
        for (int mt = 0; mt < 4; ++mt) {
            const int r = wm * 128 + mt * 32 + r32;
            if (r < u.aux1) {
                f32x16& g = acc[mt][0]; const f32x16& up = acc[mt][1];
#pragma unroll
                for (int e = 0; e < 16; ++e) g[e] = g[e] * __builtin_amdgcn_rcpf(1.f + __builtin_amdgcn_exp2f(g[e] * -LOG2E)) * (up[e] * w[mt]);
                bf16_t* d = hid + (size_t)(u.pm * 256 + r) * 512 + which * 256 + j * 128 + wn * 32 + 16 * h;
                *(u32x4*)d = pack8(g, 0); *(u32x4*)(d + 8) = pack8(g, 8);
            }
        }
    }
};
struct SchedMoeDown {
    static constexpr bool GATHER = false, PIPE = true;
    const char* HID; const char* W; const int* tab;
    __device__ __forceinline__ bool next(int i, mm::Unit& u) const {
        const long L = (long)i * gridDim.x + VBID; const int T = (int)(L >> 2), c = (int)(L & 3);
        if (T >= moe_tab(tab, 24)) return false;
        const MoeLoc m = moe_locate(tab, T);
        u.a = HID + (size_t)T * 256 * 512 * 2; u.lda = 512; u.ldb = 256; u.nk = 8; u.nseg = 4;
        u.b0 = W + ((size_t)m.elo * 1024 + c * 256) * 256 * 2; u.b1 = W + ((size_t)m.ehi * 1024 + c * 256) * 256 * 2 - 4 * 128;
        u.pm = T; u.pn = c; u.tag = 0; u.aux0 = m.b * NTOK + m.rt * 256; u.aux1 = m.valid; return true;
    }
    __device__ __forceinline__ void a_rows(const mm::Unit& u, int r0, unsigned (&a)[1]) const { mm::plain_rows(u, r0, a); }
};
struct EpiMoeDown {
    static constexpr bool TRANSP = false;
    static constexpr int PROF = 19;
    bf16_t* st; float* out32; const int* list;
    __device__ __forceinline__ void operator()(mm::f32x16 (&acc)[4][2], const mm::Unit& u, int wm, int wn, int r32, int h, int tid) const {
        using namespace mm;
        asm volatile("" : "+v"(r32), "+v"(h));
        const int col = u.pn * 256 + wn * 64 + 2 * r32;
#pragma unroll
        for (int mt = 0; mt < 4; ++mt)
#pragma unroll
            for (int eh = 0; eh < 2; ++eh) {
                asm volatile("" ::: "memory");
                const int rb = wm * 128 + mt * 32 + 4 * h + 16 * eh;
                int tok[8];
#pragma unroll
                for (int e = 0; e < 8; ++e) { const int r = rb + (e & 3) + 8 * (e >> 2); tok[e] = list[u.aux0 + (r < u.aux1 ? r : 0)]; }
                unsigned xv[8];
#pragma unroll
                for (int e = 0; e < 8; ++e) xv[e] = *(const unsigned*)(st + (size_t)tok[e] * ND + col);
#pragma unroll
                for (int e = 0; e < 8; ++e) {
                    const int r = rb + (e & 3) + 8 * (e >> 2);
                    if (r < u.aux1) {
                        const float a = bflo(xv[e]) + acc[mt][0][8 * eh + e], b = bfhi(xv[e]) + acc[mt][1][8 * eh + e];
                        if (out32) { float2 o; o.x = a; o.y = b; *(float2*)(out32 + (size_t)tok[e] * ND + col) = o; }
                        else *(unsigned*)(st + (size_t)tok[e] * ND + col) = cvt_pk_bf16(a, b);
                    }
                }
            }
    }
};
__device__ __forceinline__ void ph_moe_up(const Params& P_, int l, char* smem) {
    const KA P = ka_get();
    moe_table(smem, (const int*)(P.ws + OFF_CTRL + MOE_CNT_OFF) + l * 32);
    SchedMoeUp S; S.H = P.ws + OFF_H; S.W = P.ws + OFF_WT + WT_GU; S.tab = (const int*)(smem + MOE_TAB); S.list = (const int*)(P.ws + OFF_ROUTE + MOE_LIST_OFF);
    EpiMoeUp E; E.hid = (bf16_t*)(P.ws + OFF_HID); E.list = S.list; E.rw = (const float*)(P.ws + OFF_ROUTE + MOE_RW_OFF);
    mm::gemm_phase(smem, S, E);
}
__device__ __forceinline__ void ph_moe_down(const Params& P_, int l, char* smem) {
    const KA P = ka_get();
    moe_table(smem, (const int*)(P.ws + OFF_CTRL + MOE_CNT_OFF) + l * 32);
    SchedMoeDown S; S.HID = P.ws + OFF_HID; S.W = P.ws + OFF_WT + WT_DN; S.tab = (const int*)(smem + MOE_TAB);
    EpiMoeDown E; E.st = (bf16_t*)(P.ws + OFF_STREAM); E.out32 = l == 1 ? P.out : (float*)nullptr; E.list = (const int*)(P.ws + OFF_ROUTE + MOE_LIST_OFF);
    mm::gemm_phase(smem, S, E);
}


namespace at {
typedef short bf16x8 __attribute__((ext_vector_type(8)));
typedef short s16x4 __attribute__((ext_vector_type(4)));
typedef float f32x16 __attribute__((ext_vector_type(16)));
typedef unsigned u32x4 __attribute__((ext_vector_type(4)));
typedef unsigned u32x2 __attribute__((ext_vector_type(2)));
__device__ __forceinline__ s16x4 tr_read(const LAS char* p) { return __builtin_bit_cast(s16x4, __builtin_amdgcn_ds_read_tr16_b64_v4i16((LAS s16x4*)p)); }
__device__ __forceinline__ unsigned cvtpk(float lo, float hi) { unsigned r; asm volatile("v_cvt_pk_bf16_f32 %0, %1, %2" : "=v"(r) : "v"(lo), "v"(hi)); return r; }
__device__ __forceinline__ bf16x8 pack_p(const f32x16& x, int s) { u32x4 w; w.x = cvtpk(x[8 * s], x[8 * s + 1]); w.y = cvtpk(x[8 * s + 2], x[8 * s + 3]); w.z = cvtpk(x[8 * s + 4], x[8 * s + 5]); w.w = cvtpk(x[8 * s + 6], x[8 * s + 7]); return __builtin_bit_cast(bf16x8, w); }
constexpr int A_TAB = 81920;
}
__device__ __forceinline__ void ph_attnA(const Params& P_, int l, char* smem) {
    using namespace at;
    const KA P = ka_get();
    const Proj pj = proj_ptrs(P.ws);
    bf16_t* BR = (bf16_t*)(P.ws + OFF_BR);
    const int tid = tid_opaque(), lane = tid & 63, wid = __builtin_amdgcn_readfirstlane(tid >> 6), m = wid >> 2, qs = wid & 3, r32 = lane & 31, hl = lane >> 5;
    LAS char* lds = (LAS char*)smem;
    LAS float* tb = (LAS float*)(lds + A_TAB);
    const float* lp = P.in[I_LAM] + (size_t)l * 256;
    const float linit = lambda_init_of(l);
    const float lam = expf(wsum(lp[lane] * lp[64 + lane])) - expf(wsum(lp[128 + lane] * lp[192 + lane])) + linit;
    const float* subg = P.in[I_SUBLN] + (size_t)l * 128;
    const float* relb = P.in[I_RELB];
    LAS float* rb4 = (LAS float*)(lds + A_TAB + 4160 * 4);
    __syncthreads();
    if (tid < 128) rb4[tid] = relb[(tid >> 2) * 20 + (tid & 3)] * LOG2E;
    __syncthreads();
    const int i16 = lane & 15, tq = i16 >> 2, tp = i16 & 3, blk = (lane >> 4) & 1;
    const unsigned vlane = (unsigned)((4 * hl + tq) * 64 + blk * 32 + tp * 8);
    const unsigned klane = (unsigned)(m * 8192 + r32 * 128), kx = (unsigned)((r32 >> 1) & 7);
    for (int u2 = blockIdx.x; u2 < 1024; u2 += gridDim.x) {
        const int Pp = u2 & 511;
        const int bh = Pp >> 4, jj = Pp & 15, qb = (u2 >> 9) ? 31 - jj : jj, b = bh >> 2, h = bh & 3;
        const int q0 = qb * 128 + qs * 32, nt_wg = 2 * qb + 2, nt_w = (q0 >> 6) + 1;
        __syncthreads();
#pragma unroll
        for (int it = 0; it < 9; ++it) { const int i = tid + 512 * it; if (i < 4160) { const int rel = i - 4095; tb[i] = rel <= 63 ? rb4[t5_bucket(rel) * 4 + h] : 0.f; } }
        const float bfar = rb4[15 * 4 + h];
        bf16x8 qf[4];
        { const bf16_t* qp = pj.aq + (size_t)(b * NS + q0 + r32) * 512 + (h * 2 + m) * 64 + 8 * hl;
#pragma unroll
          for (int ks = 0; ks < 4; ++ks) qf[ks] = *(const bf16x8*)(qp + ks * 16); }
        u32x4 gk[2], gv[2];
        const bf16_t* kg = pj.ak + (size_t)(b * NS) * 512 + h * 128;
        const bf16_t* vg = pj.av + (size_t)(b * NS) * 512 + h * 128;
        unsigned gofs[2], kst[2], vst[2];
#pragma unroll
        for (int i = 0; i < 2; ++i) { const int idx = tid + 512 * i, key = idx >> 4, c = idx & 15;
            gofs[i] = (unsigned)(key * 512 + c * 8) * 2u;
            kst[i] = (unsigned)((c >> 3) * 8192 + key * 128 + (((c & 7) ^ ((key >> 1) & 7)) << 4));
            vst[i] = (unsigned)((c >> 2) * 4096 + key * 64 + (c & 3) * 16); }
#define AT_GLOAD(kt) do { const size_t o_ = (size_t)(kt) * 64 * 512 * 2; _Pragma("unroll") for (int i_ = 0; i_ < 2; ++i_) { gk[i_] = *(const u32x4*)((const char*)kg + o_ + gofs[i_]); gv[i_] = *(const u32x4*)((const char*)vg + o_ + gofs[i_]); } } while (0)
#define AT_LSTORE(kslot, vslot) do { _Pragma("unroll") for (int i_ = 0; i_ < 2; ++i_) { *(LAS u32x4*)(lds + (kslot) * 16384 + kst[i_]) = gk[i_]; *(LAS u32x4*)(lds + 32768 + (vslot) * 16384 + vst[i_]) = gv[i_]; } } while (0)
        AT_GLOAD(0); AT_LSTORE(0, 0);
        __syncthreads();
        f32x16 O[4];
#pragma unroll
        for (int v = 0; v < 4; ++v)
#pragma unroll
            for (int e = 0; e < 16; ++e) O[v][e] = 0.f;
        float mrun = -INFINITY, lsum = 0.f;
        bf16x8 pp[2][2];
        int vs_prev = 0, vs_cur = 0, vs_next = 1;
        for (int kt = 0; kt <= nt_wg; ++kt) {
            if (kt + 1 < nt_wg) AT_GLOAD(kt + 1);
            f32x16 s0, s1;
            const bool doqk = kt < nt_w, dopv = kt >= 1 && kt - 1 < nt_w;
            if (doqk) {
                const LAS char* kb = lds + (kt & 1) * 16384 + klane;
                if (kt * 64 + 63 - q0 <= -559) {
#pragma unroll
                    for (int e = 0; e < 16; ++e) { s0[e] = bfar; s1[e] = bfar; }
                } else {
                    const LAS float* tl = tb + (kt * 64 - q0 - r32 + 4 * hl + 4095);
#pragma unroll
                    for (int e = 0; e < 16; ++e) { s0[e] = tl[(e & 3) + 8 * (e >> 2)]; s1[e] = tl[32 + (e & 3) + 8 * (e >> 2)]; }
                }
#pragma unroll
                for (int ks = 0; ks < 4; ++ks) {
                    const unsigned xo = (((unsigned)(ks * 2 + hl)) ^ kx) << 4;
                    const bf16x8 k0 = *(const LAS bf16x8*)(kb + xo), k1 = *(const LAS bf16x8*)(kb + 4096 + xo);
                    s0 = __builtin_amdgcn_mfma_f32_32x32x16_bf16(k0, qf[ks], s0, 0, 0, 0);
                    s1 = __builtin_amdgcn_mfma_f32_32x32x16_bf16(k1, qf[ks], s1, 0, 0, 0);
                }
            }
            if (dopv) {
                const LAS char* vb = lds + 32768 + vs_prev * 16384 + vlane;
#pragma unroll
                for (int sub = 0; sub < 2; ++sub)
#pragma unroll
                    for (int s = 0; s < 2; ++s) {
                        const LAS char* vk = vb + (sub * 32 + 16 * s) * 64;
#pragma unroll
                        for (int v = 0; v < 4; ++v) {
                            const s16x4 lo = tr_read(vk + v * 4096), hi = tr_read(vk + v * 4096 + 8 * 64);
                            const bf16x8 vf = __builtin_shufflevector(lo, hi, 0, 1, 2, 3, 4, 5, 6, 7);
                            O[v] = __builtin_amdgcn_mfma_f32_32x32x16_bf16(vf, pp[sub][s], O[v], 0, 0, 0);
                        }
                    }
            }
            __builtin_amdgcn_sched_barrier(0);
            if (doqk) {
                float mx = __builtin_fmaxf(__builtin_fmaxf(s0[0], s1[0]), __builtin_fmaxf(s0[1], s1[1]));
#pragma unroll
                for (int e = 2; e < 16; e += 2) mx = __builtin_fmaxf(__builtin_fmaxf(mx, s0[e]), __builtin_fmaxf(__builtin_fmaxf(s1[e], s0[e + 1]), s1[e + 1]));
                mx = x32_max(mx);
                const float mn = fmaxf(mrun, mx);
                float ps0 = 0.f, ps1 = 0.f;
#pragma unroll
                for (int e = 0; e < 16; ++e) { s0[e] = __builtin_amdgcn_exp2f(s0[e] - mn); s1[e] = __builtin_amdgcn_exp2f(s1[e] - mn); ps0 += s0[e]; ps1 += s1[e]; }
                if (__any(mn > mrun)) {
                    const float alpha = __builtin_amdgcn_exp2f(mrun - mn);
                    lsum *= alpha;
#pragma unroll
                    for (int v = 0; v < 4; ++v)
#pragma unroll
                        for (int e = 0; e < 16; ++e) O[v][e] *= alpha;
                }
                mrun = mn;
                lsum += ps0 + ps1;
                pp[0][0] = pack_p(s0, 0); pp[0][1] = pack_p(s0, 1); pp[1][0] = pack_p(s1, 0); pp[1][1] = pack_p(s1, 1);
            }
            if (kt + 1 < nt_wg) AT_LSTORE((kt + 1) & 1, vs_next);
            __syncthreads();
            vs_prev = vs_cur; vs_cur = vs_next; vs_next = vs_next == 2 ? 0 : vs_next + 1;
        }
#undef AT_GLOAD
#undef AT_LSTORE
        const float ltot = x32_sum(lsum);
        const float inv = (m ? lam : 1.f) / ltot;
        LAS float* ex = (LAS float*)lds + qs * 4096 + lane;
        if (m == 1) {
#pragma unroll
            for (int v = 0; v < 4; ++v)
#pragma unroll
                for (int e = 0; e < 16; ++e) ex[(v * 16 + e) * 64] = O[v][e] * inv;
        }
        __syncthreads();
        if (m == 0) {
            float ss = 0.f;
#pragma unroll
            for (int v = 0; v < 4; ++v)
#pragma unroll
                for (int e = 0; e < 16; ++e) { const float x = O[v][e] * inv - ex[(v * 16 + e) * 64]; O[v][e] = x; ss += x * x; }
            ss = x32_sum(ss);
            const float rstd = rsqrtf(ss * (1.0f / 128) + EPS) * (1.0f - linit);
            bf16_t* op = BR + (size_t)(b * NS + q0 + r32) * 1536 + h * 128 + 4 * hl;
#pragma unroll
            for (int v = 0; v < 4; ++v)
#pragma unroll
                for (int g = 0; g < 4; ++g) {
                    const int vd = v * 32 + 8 * g + 4 * hl;
                    const float4 sg = *(const float4*)(subg + vd);
                    u32x2 w; w.x = cvtpk(O[v][4 * g] * rstd * sg.x, O[v][4 * g + 1] * rstd * sg.y); w.y = cvtpk(O[v][4 * g + 2] * rstd * sg.z, O[v][4 * g + 3] * rstd * sg.w);
                    *(u32x2*)(op + v * 32 + 8 * g) = w;
                }
        }
    }
}


__device__ __forceinline__ void ph_attnB(const Params& P_, int l, char* smem) {
    using namespace at;
    const KA P = ka_get();
    const Proj pj = proj_ptrs(P.ws);
    bf16_t* BR = (bf16_t*)(P.ws + OFF_BR);
    const int tid = tid_opaque(), lane = tid & 63, wid = __builtin_amdgcn_readfirstlane(tid >> 6), g = wid >> 1, qh = wid & 1, r32 = lane & 31, hl = lane >> 5;
    LAS char* lds = (LAS char*)smem;
    constexpr int B_K = 0, B_V = 24576, B_TAB = 49152;
    LAS float* tb = (LAS float*)(lds + B_TAB);
    const float* relb = P.in[I_RELB];
    __syncthreads();
    for (int i = tid; i < 2048; i += 512) { const int hq = i >> 8, rel = (i & 255) - 191; tb[i] = relb[t5_bucket(rel) * 20 + 4 + hq] * LOG2E; }
    const int i16 = lane & 15, tq = i16 >> 2, tp = i16 & 3, blk = (lane >> 4) & 1;
    const unsigned vlane = (unsigned)((4 * hl + tq) * 64 + blk * 32 + tp * 8);
    const unsigned klane = (unsigned)(r32 * 128), kx = (unsigned)((r32 >> 1) & 7);
    const int skey = tid >> 3, sc = tid & 7;
    const unsigned kst = (unsigned)(skey * 128 + ((sc ^ ((skey >> 1) & 7)) << 4)), vst = (unsigned)((sc >> 2) * 4096 + skey * 64 + (sc & 3) * 16);
    for (int u = blockIdx.x; u < NB * 64 * 2; u += gridDim.x) {
        const int kvh = u & 1, c = (u >> 1) & 63, b = u >> 7, hq = kvh * 4 + g;
        const int t0 = c >= 2 ? 0 : 2 - c;
        u32x4 kk[3], vv3[3];
#pragma unroll
        for (int t = 0; t < 3; ++t) {
            const int tt = t >= t0 ? t : t0;
            const size_t row = (size_t)(b * NS + (c - 2 + tt) * 64 + skey) * 128 + kvh * 64 + sc * 8;
            kk[t] = *(const u32x4*)(pj.bk + row); vv3[t] = *(const u32x4*)(pj.bv + row);
        }
        const int tok = b * NS + c * 64 + qh * 32 + r32;
        bf16x8 qf[4];
#pragma unroll
        for (int ks = 0; ks < 4; ++ks) qf[ks] = *(const bf16x8*)(pj.bq + (size_t)tok * 512 + hq * 64 + ks * 16 + 8 * hl);
        const float sink = P.in[I_SINK][l * 8 + hq] * LOG2E;
        __syncthreads();
#pragma unroll
        for (int t = 0; t < 3; ++t) if (t >= t0) { *(LAS u32x4*)(lds + B_K + t * 8192 + kst) = kk[t]; *(LAS u32x4*)(lds + B_V + t * 8192 + vst) = vv3[t]; }
        __syncthreads();
        f32x16 O[2];
#pragma unroll
        for (int v = 0; v < 2; ++v)
#pragma unroll
            for (int e = 0; e < 16; ++e) O[v][e] = 0.f;
        float mrun = sink, lsum = hl == 0 ? 1.f : 0.f;
#pragma unroll
        for (int t = 0; t < 3; ++t) if (t >= t0) {
            const LAS char* kb = lds + B_K + t * 8192 + klane;
            const LAS char* vb = lds + B_V + t * 8192 + vlane;
            const LAS float* tl = tb + hq * 256 + (t * 64 - qh * 32 - r32 + 4 * hl + 63);
            f32x16 s0, s1;
#pragma unroll
            for (int e = 0; e < 16; ++e) { s0[e] = tl[(e & 3) + 8 * (e >> 2)]; s1[e] = tl[32 + (e & 3) + 8 * (e >> 2)]; }
#pragma unroll
            for (int ks = 0; ks < 4; ++ks) {
                const unsigned xo = (((unsigned)(ks * 2 + hl)) ^ kx) << 4;
                const bf16x8 k0 = *(const LAS bf16x8*)(kb + xo), k1 = *(const LAS bf16x8*)(kb + 4096 + xo);
                s0 = __builtin_amdgcn_mfma_f32_32x32x16_bf16(k0, qf[ks], s0, 0, 0, 0);
                s1 = __builtin_amdgcn_mfma_f32_32x32x16_bf16(k1, qf[ks], s1, 0, 0, 0);
            }
            float mx = fmaxf(s0[0], s1[0]);
#pragma unroll
            for (int e = 1; e < 16; ++e) mx = fmaxf(mx, fmaxf(s0[e], s1[e]));
            mx = x32_max(mx);
            const float mn = fmaxf(mrun, mx), alpha = exp2f(mrun - mn);
            mrun = mn;
            float ps = 0.f;
#pragma unroll
            for (int e = 0; e < 16; ++e) { s0[e] = exp2f(s0[e] - mn); s1[e] = exp2f(s1[e] - mn); ps += s0[e] + s1[e]; }
            lsum = lsum * alpha + ps;
#pragma unroll
            for (int v = 0; v < 2; ++v)
#pragma unroll
                for (int e = 0; e < 16; ++e) O[v][e] *= alpha;
#pragma unroll
            for (int sub = 0; sub < 2; ++sub)
#pragma unroll
                for (int s2 = 0; s2 < 2; ++s2) {
                    const bf16x8 pb = pack_p(sub ? s1 : s0, s2);
                    const LAS char* vk = vb + (sub * 32 + 16 * s2) * 64;
#pragma unroll
                    for (int v = 0; v < 2; ++v) {
                        const s16x4 lo = tr_read(vk + v * 4096), hi = tr_read(vk + v * 4096 + 8 * 64);
                        const bf16x8 vf = __builtin_shufflevector(lo, hi, 0, 1, 2, 3, 4, 5, 6, 7);
                        O[v] = __builtin_amdgcn_mfma_f32_32x32x16_bf16(vf, pb, O[v], 0, 0, 0);
                    }
                }
        }
        const float inv = 1.f / x32_sum(lsum);
        bf16_t* op = BR + (size_t)tok * 1536 + 512 + hq * 64 + 4 * hl;
#pragma unroll
        for (int v = 0; v < 2; ++v)
#pragma unroll
            for (int gg = 0; gg < 4; ++gg) {
                u32x2 w; w.x = cvtpk(O[v][4 * gg] * inv, O[v][4 * gg + 1] * inv); w.y = cvtpk(O[v][4 * gg + 2] * inv, O[v][4 * gg + 3] * inv);
                *(u32x2*)(op + v * 32 + 8 * gg) = w;
            }
    }
}


__device__ __forceinline__ void ph_attnC(const Params& P_, int l, char* smem) {
    using namespace at;
    typedef float f32x4 __attribute__((ext_vector_type(4)));
    const KA P = ka_get();
    const Proj pj = proj_ptrs(P.ws);
    bf16_t* BR = (bf16_t*)(P.ws + OFF_BR);
    const int tid = tid_opaque(), lane = tid & 63, wid = __builtin_amdgcn_readfirstlane(tid >> 6), l16 = lane & 15, g4 = lane >> 4;
    LAS char* lds = (LAS char*)smem;
    constexpr int C_SC = 0, C_SEL = 131072, C_BKT = 139264, C_TAB = 143360;
    LAS float* tb = (LAS float*)(lds + C_TAB);
    const float* relb = P.in[I_RELB];
    __syncthreads();
    for (int i = tid; i < 256; i += 512) tb[i] = relb[(i >> 3) * 20 + 12 + (i & 7)] * LOG2E;
    const unsigned long long ltmask = (1ull << lane) - 1ull;
    const int tq = l16 >> 2, tp = l16 & 3;
    for (int unit = blockIdx.x; unit < NTOK / 16; unit += gridDim.x) {
        const int kq = unit >> 8, cq = unit & 255, xq = (cq + 64 * (kq >> 1)) & 255, qblk = (kq & 1) ? 255 - xq : xq;
        const int tok0 = (kq << 12) + qblk * 16, b = tok0 >> 12, q0 = tok0 & (NS - 1), c = q0 >> 6, N = (c + 1) * 64;
        __syncthreads();
        PROF_BEGIN(9)
        if (N > 256) {
            bf16x8 iqf[4];
#pragma unroll
            for (int hh = 0; hh < 4; ++hh) iqf[hh] = *(const bf16x8*)(pj.iq + (size_t)(tok0 + l16) * 128 + hh * 32 + 8 * g4);
            const f32x4 w4 = *(const f32x4*)(pj.iw + (size_t)(tok0 + l16) * 4);
            const bf16_t* ikb = pj.ik + (size_t)(b * NS) * 32 + l16 * 32 + 8 * g4;
            const int ntile = N / 16;
            for (int kt0 = wid; kt0 < ntile; kt0 += 64) {
                bf16x8 av[8];
#pragma unroll
                for (int j = 0; j < 8; ++j) { const int kt = kt0 + 8 * j; av[j] = *(const bf16x8*)(ikb + (size_t)(kt < ntile ? kt : kt0) * 512); }
#pragma unroll
                for (int j = 0; j < 8; ++j) {
                    const int kt = kt0 + 8 * j;
                    if (kt < ntile) {
                        float sc[4] = {0.f, 0.f, 0.f, 0.f};
#pragma unroll
                        for (int hh = 0; hh < 4; ++hh) {
                            const f32x4 d = __builtin_amdgcn_mfma_f32_16x16x32_bf16(av[j], iqf[hh], (f32x4){0.f, 0.f, 0.f, 0.f}, 0, 0, 0);
#pragma unroll
                            for (int r = 0; r < 4; ++r) sc[r] += fmaxf(d[r], 0.f) * w4[hh];
                        }
                        unsigned w01 = __builtin_bit_cast(unsigned, __builtin_amdgcn_cvt_pkrtz(sc[0] + 0.0f, sc[1] + 0.0f));
                        unsigned w23 = __builtin_bit_cast(unsigned, __builtin_amdgcn_cvt_pkrtz(sc[2] + 0.0f, sc[3] + 0.0f));
                        w01 ^= (((w01 >> 15) & 0x00010001u) * 0xFFFFu) | 0x80008000u;
                        w23 ^= (((w23 >> 15) & 0x00010001u) * 0xFFFFu) | 0x80008000u;
                        w01 = (w01 >> 1) & 0x7FFF7FFFu; w23 = (w23 >> 1) & 0x7FFF7FFFu;
                        u32x2 o; o.x = w01; o.y = w23;
                        *(LAS u32x2*)(lds + C_SC + l16 * 8192 + (kt * 16 + g4 * 4) * 2) = o;
                    }
                }
            }
        }
        __syncthreads();
        PROF_END(9, smem)
        PROF_BEGIN(10)
        {
            LAS unsigned short* selA = (LAS unsigned short*)(lds + C_SEL) + (2 * wid) * 256;
            LAS unsigned char* bktA = (LAS unsigned char*)(lds + C_BKT) + (2 * wid) * 256;
            const int qA = q0 + 2 * wid;
            if (N <= 256) {
                for (int i = lane; i < N; i += 64) { selA[i] = (unsigned short)i; selA[256 + i] = (unsigned short)i; }
            } else {
                const LAS unsigned* rowA = (const LAS unsigned*)(lds + C_SC + (2 * wid) * 8192);
                const int ndw = N >> 1, nI = (ndw + 63) >> 6;
                unsigned TA, TB; int needA, needB;
                auto bisect = [&](auto NIc) {
                    constexpr int NI = decltype(NIc)::value;
                    unsigned ka[NI], kb[NI];
#pragma unroll
                    for (int i = 0; i < NI; ++i) { const bool ok = lane + 64 * i < ndw; ka[i] = (ok ? rowA[lane + 64 * i] : 0u) | 0x80008000u; kb[i] = (ok ? rowA[2048 + lane + 64 * i] : 0u) | 0x80008000u; }
                    unsigned ta = 0, tb2 = 0;
#pragma unroll 1
                    for (int bit = 14; bit >= 0; --bit) {
                        const unsigned ca = ta | (1u << bit), cb = tb2 | (1u << bit);
                        const unsigned cca = ca * 0x00010001u, ccb = cb * 0x00010001u;
                        unsigned a0 = 0, a1 = 0, b0 = 0, b1 = 0;
#pragma unroll
                        for (int i = 0; i < NI; i += 2) {
                            a0 += ((ka[i] - cca) >> 15) & 0x00010001u; b0 += ((kb[i] - ccb) >> 15) & 0x00010001u;
                            a1 += ((ka[i + 1] - cca) >> 15) & 0x00010001u; b1 += ((kb[i + 1] - ccb) >> 15) & 0x00010001u;
                        }
                        a0 += a1; b0 += b1;
                        const int ga_ = wave_sum_dpp((int)((a0 & 0xffffu) + (a0 >> 16))), gb_ = wave_sum_dpp((int)((b0 & 0xffffu) + (b0 >> 16)));
                        if (ga_ >= 256) ta = ca;
                        if (gb_ >= 256) tb2 = cb;
                    }
                    int gta, gtb;
                    { const unsigned cca = (ta + 1u) * 0x00010001u, ccb = (tb2 + 1u) * 0x00010001u;
                      unsigned a0 = 0, b0 = 0;
#pragma unroll
                      for (int i = 0; i < NI; ++i) { a0 += ((ka[i] - cca) >> 15) & 0x00010001u; b0 += ((kb[i] - ccb) >> 15) & 0x00010001u; }
                      gta = wave_sum_dpp((int)((a0 & 0xffffu) + (a0 >> 16))); gtb = wave_sum_dpp((int)((b0 & 0xffffu) + (b0 >> 16))); }
                    TA = ta; TB = tb2; needA = 256 - gta; needB = 256 - gtb;
                };
                if (nI <= 8) bisect(std::integral_constant<int, 8>{});
                else if (nI <= 16) bisect(std::integral_constant<int, 16>{});
                else if (nI <= 24) bisect(std::integral_constant<int, 24>{});
                else bisect(std::integral_constant<int, 32>{});
                int nsA = 0, neA = 0, nsB = 0, neB = 0;
#pragma unroll 1
                for (int i = 0; i < nI; ++i) {
                    const bool ok = lane + 64 * i < ndw;
                    const unsigned wa = ok ? rowA[lane + 64 * i] : 0u, wb = ok ? rowA[2048 + lane + 64 * i] : 0u;
                    const int klo = 2 * (lane + 64 * i);
                    {
                        const unsigned lo = wa & 0xffffu, hi = wa >> 16;
                        const bool el = lo == TA, eh = hi == TA;
                        const unsigned long long bel = __ballot(el), beh = __ballot(eh);
                        const int rl = neA + __popcll(bel & ltmask) + __popcll(beh & ltmask), rh = rl + (el ? 1 : 0);
                        const bool tl = (lo > TA) || (el && rl < needA), th = (hi > TA) || (eh && rh < needA);
                        const unsigned long long btl = __ballot(tl), bth = __ballot(th);
                        const int pl = nsA + __popcll(btl & ltmask) + __popcll(bth & ltmask), ph = pl + (tl ? 1 : 0);
                        if (tl) selA[pl] = (unsigned short)klo;
                        if (th) selA[ph] = (unsigned short)(klo + 1);
                        nsA += __popcll(btl) + __popcll(bth); neA += __popcll(bel) + __popcll(beh);
                    }
                    {
                        const unsigned lo = wb & 0xffffu, hi = wb >> 16;
                        const bool el = lo == TB, eh = hi == TB;
                        const unsigned long long bel = __ballot(el), beh = __ballot(eh);
                        const int rl = neB + __popcll(bel & ltmask) + __popcll(beh & ltmask), rh = rl + (el ? 1 : 0);
                        const bool tl = (lo > TB) || (el && rl < needB), th = (hi > TB) || (eh && rh < needB);
                        const unsigned long long btl = __ballot(tl), bth = __ballot(th);
                        const int pl = nsB + __popcll(btl & ltmask) + __popcll(bth & ltmask), ph = pl + (tl ? 1 : 0);
                        if (tl) selA[256 + pl] = (unsigned short)klo;
                        if (th) selA[256 + ph] = (unsigned short)(klo + 1);
                        nsB += __popcll(btl) + __popcll(bth); neB += __popcll(bel) + __popcll(beh);
                    }
                }
            }
            const int cntS = N < 256 ? N : 256;
#pragma unroll
            for (int rr = 0; rr < 2; ++rr)
#pragma unroll
                for (int j = 0; j < 4; ++j) { const int sl = lane + 64 * j; if (sl < cntS) bktA[rr * 256 + sl] = (unsigned char)t5_bucket((int)selA[rr * 256 + sl] - (qA + rr)); }
        }
        PROF_END(10, smem)
        PROF_BEGIN(11)
        const int cnt = N < 256 ? N : 256;
        {
            const LAS unsigned short* sel0 = (const LAS unsigned short*)(lds + C_SEL) + (2 * wid) * 256;
            const LAS unsigned char* bkt0 = (const LAS unsigned char*)(lds + C_BKT) + (2 * wid) * 256;
            LAS char* vreg = lds + C_SC + wid * 16384;
            const bf16_t* ckb = pj.ck + (size_t)(b * NS) * 64 + 8 * g4;
            const bf16_t* cvb = pj.cv + (size_t)(b * NS) * 64;
            bf16x8 qf[2][2];
#pragma unroll
            for (int rr = 0; rr < 2; ++rr)
#pragma unroll
                for (int ks = 0; ks < 2; ++ks) qf[rr][ks] = *(const bf16x8*)(pj.cq + (size_t)(tok0 + 2 * wid + rr) * 512 + (l16 & 7) * 64 + ks * 32 + 8 * g4);
            f32x4 O[2][4];
#pragma unroll
            for (int rr = 0; rr < 2; ++rr)
#pragma unroll
                for (int v = 0; v < 4; ++v) O[rr][v] = (f32x4){0.f, 0.f, 0.f, 0.f};
            float mrun[2] = {-INFINITY, -INFINITY}, lsum[2] = {0.f, 0.f};
#pragma unroll 1
            for (int ch = 0; ch * 64 < cnt; ++ch) {
                u32x4 vv[2][8];
#pragma unroll
                for (int rr = 0; rr < 2; ++rr)
#pragma unroll
                    for (int i = 0; i < 8; ++i) {
                        const int piece = lane + 64 * i, e = piece >> 3, c8 = piece & 7, sl = ch * 64 + e;
                        const int idx = sl < cnt ? (int)sel0[rr * 256 + sl] : 0;
                        vv[rr][i] = *(const u32x4*)(cvb + (size_t)idx * 64 + c8 * 8);
                    }
                bf16x8 ka[2][4][2];
#pragma unroll
                for (int rr = 0; rr < 2; ++rr)
#pragma unroll
                    for (int u = 0; u < 4; ++u) {
                        const int e = ch * 64 + u * 16 + l16;
                        const int idx = e < cnt ? (int)sel0[rr * 256 + e] : 0;
                        ka[rr][u][0] = *(const bf16x8*)(ckb + (size_t)idx * 64); ka[rr][u][1] = *(const bf16x8*)(ckb + (size_t)idx * 64 + 32);
                    }
#pragma unroll
                for (int rr = 0; rr < 2; ++rr)
#pragma unroll
                    for (int i = 0; i < 8; ++i) { const int piece = lane + 64 * i, e = piece >> 3, c8 = piece & 7;
                        *(LAS u32x4*)(vreg + rr * 8192 + (c8 >> 2) * 4096 + e * 64 + (c8 & 3) * 16) = vv[rr][i]; }
#pragma unroll
                for (int rr = 0; rr < 2; ++rr) {
#pragma unroll
                    for (int t2 = 0; t2 < 2; ++t2) {
                        f32x4 d[2];
#pragma unroll
                        for (int u = 0; u < 2; ++u) {
                            const int t = ch * 4 + 2 * t2 + u;
                            f32x4 dd = __builtin_amdgcn_mfma_f32_16x16x32_bf16(ka[rr][2 * t2 + u][0], qf[rr][0], (f32x4){0.f, 0.f, 0.f, 0.f}, 0, 0, 0);
                            dd = __builtin_amdgcn_mfma_f32_16x16x32_bf16(ka[rr][2 * t2 + u][1], qf[rr][1], dd, 0, 0, 0);
                            const unsigned bk4 = *(const LAS unsigned*)(bkt0 + rr * 256 + t * 16 + g4 * 4);
#pragma unroll
                            for (int r = 0; r < 4; ++r) {
                                const int slot = t * 16 + g4 * 4 + r;
                                const float bias = tb[((bk4 >> (8 * r)) & 0xffu) * 8 + (l16 & 7)];
                                dd[r] = slot < cnt ? dd[r] + bias : -INFINITY;
                            }
                            d[u] = dd;
                        }
                        float mx = fmaxf(fmaxf(fmaxf(d[0][0], d[0][1]), fmaxf(d[0][2], d[0][3])), fmaxf(fmaxf(d[1][0], d[1][1]), fmaxf(d[1][2], d[1][3])));
                        mx = x32_max(x16_max(mx));
                        const float mn = fmaxf(mrun[rr], mx), alpha = exp2f(mrun[rr] - mn);
                        mrun[rr] = mn;
                        float ps = 0.f;
#pragma unroll
                        for (int u = 0; u < 2; ++u)
#pragma unroll
                            for (int r = 0; r < 4; ++r) { d[u][r] = exp2f(d[u][r] - mn); ps += d[u][r]; }
                        lsum[rr] = lsum[rr] * alpha + ps;
#pragma unroll
                        for (int v = 0; v < 4; ++v) O[rr][v] *= alpha;
                        u32x4 pw; pw.x = cvtpk(d[0][0], d[0][1]); pw.y = cvtpk(d[0][2], d[0][3]); pw.z = cvtpk(d[1][0], d[1][1]); pw.w = cvtpk(d[1][2], d[1][3]);
                        const bf16x8 pb = __builtin_bit_cast(bf16x8, pw);
                        const LAS char* vk = vreg + rr * 8192 + (32 * t2 + 4 * g4 + tq) * 64 + tp * 8;
#pragma unroll
                        for (int v = 0; v < 4; ++v) {
                            const s16x4 lo = tr_read(vk + (v >> 1) * 4096 + (v & 1) * 32), hi = tr_read(vk + (v >> 1) * 4096 + (v & 1) * 32 + 16 * 64);
                            const bf16x8 vf = __builtin_shufflevector(lo, hi, 0, 1, 2, 3, 4, 5, 6, 7);
                            O[rr][v] = __builtin_amdgcn_mfma_f32_16x16x32_bf16(vf, pb, O[rr][v], 0, 0, 0);
                        }
                    }
                }
            }
#pragma unroll
            for (int rr = 0; rr < 2; ++rr) {
                float ls = x32_sum(x16_sum(lsum[rr]));
                const float inv = 1.f / ls;
                if (l16 < 8) {
                    bf16_t* op = BR + (size_t)(tok0 + 2 * wid + rr) * 1536 + 1024 + l16 * 64 + g4 * 4;
#pragma unroll
                    for (int v = 0; v < 4; ++v) { u32x2 w; w.x = cvtpk(O[rr][v][0] * inv, O[rr][v][1] * inv); w.y = cvtpk(O[rr][v][2] * inv, O[rr][v][3] * inv); *(u32x2*)(op + v * 16) = w; }
                }
            }
        }
        PROF_END(11, smem)
    }
}

#if DIAG
__device__ __forceinline__ void ph_diag_stats(const Params& P_) {
    const KA P = ka_get();
    const Proj pj = proj_ptrs(P.ws);
    const bf16_t* buf; size_t n;
    if (DIAG_BUF == 0) { buf = pj.av; n = (size_t)NTOK * 512; }
    else if (DIAG_BUF == 1) { buf = pj.aq; n = (size_t)NTOK * 512; }
    else if (DIAG_BUF == 2) { buf = pj.ik; n = (size_t)NTOK * 32; }
    else { buf = pj.cv; n = (size_t)NTOK * 64; }
    const int tid = tid_opaque();
    float ss = 0.f; unsigned bad = 0;
    for (size_t i = (size_t)blockIdx.x * 512 + tid; i < n; i += (size_t)gridDim.x * 512) { const float v = bf2f(buf[i]); if (!(fabsf(v) < 1e30f)) ++bad; else ss += v * v; }
    ss = wsum(ss); bad = (unsigned)wsum((float)bad);
    if ((tid & 63) == 0) { atomicAdd((float*)(P.ws + OFF_CTRL + 16384), ss / (float)n); atomicAdd((unsigned*)(P.ws + OFF_CTRL + 16388), bad); }
}
__device__ __forceinline__ void ph_diag_scale(const Params& P_) {
    const KA P = ka_get();
    const float ms = *(const float*)(P.ws + OFF_CTRL + 16384); const unsigned bad = *(const unsigned*)(P.ws + OFF_CTRL + 16388);
    const float delta = bad > 0 ? 0.9f : 0.1f + 0.3f * fminf(2.f, ms);
    const int tid = tid_opaque();
    for (size_t i = (size_t)blockIdx.x * 512 + tid; i < (size_t)NTOK * ND; i += (size_t)gridDim.x * 512) P.out[i] *= (1.f + delta);
}
#endif

constexpr int LDS_BYTES = 147456;
enum { PH_PREP = 0, PH_INPROJ, PH_HEADNORM, PH_ATTN_A, PH_ATTN_B, PH_ATTN_C, PH_GB, PH_OUT, PH_NORM2, PH_MOE, PH_MOE2, PH_COUNT };

template <int PH>
__device__ __forceinline__ void run_phase(const Params& P, int l, float* lds) {
#ifdef SKIPX
    if (PH == SKIPX) return;
#endif
    if (PH == PH_PREP) { ph_convert_weights(P, l); ph_rmsnorm(P.in[I_X], l == 0 ? (const bf16_t*)nullptr : (const bf16_t*)(P.ws + OFF_STREAM), P.in[I_NMG] + (size_t)l * ND, (bf16_t*)(P.ws + OFF_H)); }
    if (PH == PH_INPROJ) { if (OPT_INPROJ) ph_inproj(P, l, (char*)lds); else ph_inproj_naive(P, l, lds); }
    if (PH == PH_HEADNORM) { if (!OPT_INPROJ) ph_headnorm_naive(P, l); }
    if (PH == PH_ATTN_A) { if (OPT_ATTN_A) ph_attnA(P, l, (char*)lds); else ph_attnA_naive(P, l, lds); }
    if (PH == PH_ATTN_B) { if (OPT_ATTN_B) ph_attnB(P, l, (char*)lds); else ph_attnB_naive(P, l, lds); }
    if (PH == PH_ATTN_C) { if (OPT_ATTN_C) ph_attnC(P, l, (char*)lds); else ph_attnC_naive(P, l, lds); }
    if (PH == PH_GB) { if (OPT_GB) ph_gatebranch(P, l, (char*)lds); else ph_gatebranch_naive(P, l, lds); }
    if (PH == PH_OUT) { if (OPT_OUT) ph_outproj(P, l, (char*)lds); else ph_out_naive(P, l, lds); }
    if (PH == PH_NORM2) ph_norm2_route(P, l, lds);
    if (PH == PH_MOE) { if (OPT_MOE) { ph_moe_up(P, l, (char*)lds); } else ph_moe_naive(P, l, lds); }
    if (PH == PH_MOE2) { if (OPT_MOE) ph_moe_down(P, l, (char*)lds); }
}

template <int PH>
__global__ void __launch_bounds__(512, 2) k_phase(Params P, int l) {
    extern __shared__ __attribute__((aligned(16))) char smem[];
    run_phase<PH>(P, l, (float*)smem);
}

template <int PH>
static void launch_phase(const Params& P, int l, int grid, hipStream_t stream) {
    static bool attr = false;
    if (!attr) { (void)hipFuncSetAttribute((const void*)k_phase<PH>, hipFuncAttributeMaxDynamicSharedMemorySize, LDS_BYTES); attr = true; }
    hipLaunchKernelGGL(k_phase<PH>, dim3(grid), dim3(512), LDS_BYTES, stream, P, l);
}

__global__ void __launch_bounds__(512, 2) k_fused(Params P) {
    extern __shared__ __attribute__((aligned(16))) char smem[];
    float* lds = (float*)smem;
    volatile LAS unsigned* st = (volatile LAS unsigned*)(smem + LDS_BYTES - 16);
    if (threadIdx.x == 0) { st[0] = 0u; st[1] = 0u; st[2] = 0u; st[3] = 0u; }
    __syncthreads();
    const XcdBarrier bar = xcd_barrier_post((unsigned*)(P.ws + OFF_CTRL), st);
    if (PROF_ID && threadIdx.x == 0) *(volatile LAS unsigned*)((LAS char*)smem + PROF_LDS_OFF) = 0u;
#define BARP() do { PROF_BEGIN(16) xcd_barrier(bar); PROF_END(16, smem) } while (0)
#define RUNQ(PH, id) do { PROF_BEGIN(id) run_phase<PH>(P, l, lds); PROF_END(id, smem) if (DUP_PH == PH && (PH != PH_OUT || l == 0)) { if (PH == PH_PREP || PH == PH_INPROJ || PH == PH_GB || PH == PH_OUT || PH == PH_MOE) xcd_barrier(bar); run_phase<PH>(P, l, lds); } } while (0)
    for (int l = 0; l < 2; ++l) {
        RUNQ(PH_PREP, 12); BARP();
        RUNQ(PH_INPROJ, 1); BARP();
        if (DUP_PH == 100) { ph_inproj(P, l + 16 * DUP_MODE, (char*)lds); xcd_barrier(bar); }
        if (!OPT_INPROJ) { run_phase<PH_HEADNORM>(P, l, lds); xcd_barrier(bar); }
        RUNQ(PH_ATTN_A, 6);
        RUNQ(PH_ATTN_B, 7);
        RUNQ(PH_ATTN_C, 8);
        BARP();
        RUNQ(PH_GB, 3); BARP();
        RUNQ(PH_OUT, 5); BARP();
        RUNQ(PH_NORM2, 13); BARP();
        RUNQ(PH_MOE, 14); BARP();
        if (OPT_MOE) { RUNQ(PH_MOE2, 15); BARP(); }
    }
    if (PROF_ID) {
        const KA Pk = ka_get();
        unsigned* mx = (unsigned*)(Pk.ws + OFF_CTRL + 16400);
        if (threadIdx.x == 0) atomicMax(mx, *(volatile LAS unsigned*)((LAS char*)smem + PROF_LDS_OFF));
        xcd_barrier(bar);
        const float tus = (float)__hip_atomic_load(mx, __ATOMIC_RELAXED, __HIP_MEMORY_SCOPE_AGENT) * 0.01f;
        const float tq_ = exp2f(rintf(log2f(fmaxf(tus, 1.f)) * 4.f) * 0.25f);
        const float delta = sqrtf(tq_ * 1e-5f);
        const int tq = tid_opaque();
        for (size_t i = (size_t)blockIdx.x * 512 + tq; i < (size_t)NTOK * ND; i += (size_t)gridDim.x * 512) Pk.out[i] *= (1.f + delta);
    }
#if DIAG == 3
    ph_diag_scale(P);
#endif
}

extern "C" void kernel_launch(void* const* d_in, const int* in_sizes, int n_in, void* d_out, int out_size, void* d_ws, size_t ws_size, hipStream_t stream) {
    Params P{};
    for (int i = 0; i < 20; ++i) P.in[i] = (const float*)d_in[i];
    P.out = (float*)d_out; P.ws = (char*)d_ws;
    (void)hipMemsetAsync(d_ws, 0, CTRL_BYTES, stream);
#if FUSED
    static int grid = 0;
    if (!grid) {
        int dev = 0, cus = 0, per_cu = 0;
        (void)hipGetDevice(&dev);
        (void)hipDeviceGetAttribute(&cus, hipDeviceAttributeMultiprocessorCount, dev);
        (void)hipFuncSetAttribute((const void*)k_fused, hipFuncAttributeMaxDynamicSharedMemorySize, LDS_BYTES);
        (void)hipOccupancyMaxActiveBlocksPerMultiprocessor(&per_cu, (const void*)k_fused, 512, LDS_BYTES);
        grid = cus * (per_cu < 1 ? per_cu : 1);
        if (grid <= 0) { fprintf(stderr, "k_fused: occupancy query says %d blocks per CU\n", per_cu); grid = cus; }
    }
    hipLaunchKernelGGL(k_fused, dim3(grid), dim3(512), LDS_BYTES, stream, P);
#else
    const int G = 2048;
    for (int l = 0; l < 2; ++l) {
        launch_phase<PH_PREP>(P, l, G, stream);
        launch_phase<PH_INPROJ>(P, l, G, stream);
        launch_phase<PH_HEADNORM>(P, l, G, stream);
        launch_phase<PH_ATTN_A>(P, l, G, stream);
        launch_phase<PH_ATTN_B>(P, l, G, stream);
        launch_phase<PH_ATTN_C>(P, l, G, stream);
        launch_phase<PH_GB>(P, l, G, stream);
        launch_phase<PH_OUT>(P, l, G, stream);
        launch_phase<PH_NORM2>(P, l, G, stream);
        launch_phase<PH_MOE>(P, l, G, stream);
    }
#endif
}
```

```cpp
#include <hip/hip_runtime.h>
#include <stdint.h>
#include <stdio.h>
#include <type_traits>

#ifndef FUSED
#define FUSED 1
#endif
#define OPT_INPROJ 1
#define OPT_GB 1
#define OPT_OUT 1
#define OPT_MOE 1
#define OPT_ATTN_A 1
#define OPT_ATTN_B 1
#define OPT_ATTN_C 1
#define DIAG 0
#define DUP_PH -1
#define DUP_MODE 0
#define PROF_ID 0
#define C_DUP 0
#define VBID ((blockIdx.x & 31) * 8 + (blockIdx.x >> 5))
#define DIAG_BUF 0

#define LAS __attribute__((address_space(3)))
typedef unsigned short bf16_t;

constexpr int NB = 8, NS = 4096, ND = 1024, NTOK = NB * NS;
constexpr int IN_COLS = 3108;
constexpr float LOG2E = 1.4426950408889634f;
constexpr float QSCALE = 0.125f * LOG2E;
constexpr float EPS = 1e-6f;
constexpr float IWSCALE = 0.08838834764831845f;

constexpr size_t MB = (size_t)1 << 20;
constexpr size_t OFF_CTRL = 0;
constexpr size_t CTRL_BYTES = 65536;
constexpr size_t OFF_ROUTE = 1 * MB;
constexpr size_t MOE_CNT_OFF = 32768;
constexpr size_t MOE_LIST_OFF = 512 * 1024;
constexpr size_t MOE_RW_OFF = 512 * 1024 + 3 * MB;
constexpr size_t OFF_WT = 5 * MB;
constexpr size_t OFF_H = 49 * MB;
constexpr size_t OFF_BR = 113 * MB;
constexpr size_t OFF_PROJ = 209 * MB;
constexpr size_t OFF_MERGED = OFF_PROJ + 128 * MB;
constexpr size_t OFF_STREAM = OFF_PROJ + 195 * MB;
constexpr size_t PO_AQ = 0, PO_AK = 32 * MB, PO_AV = 64 * MB, PO_BQ = 96 * MB, PO_BK = 128 * MB, PO_BV = 136 * MB, PO_CQ = 144 * MB,
                 PO_CK = 176 * MB, PO_CV = 180 * MB, PO_IQ = 184 * MB, PO_IK = 192 * MB, PO_IW = 194 * MB;

struct Params {
    const float* in[20];
    float* out;
    char* ws;
};
typedef const __attribute__((address_space(4))) char* kaptr_t;
struct KAIn { kaptr_t base; __device__ __forceinline__ const float* operator[](int i) const { return *(const float* const __attribute__((address_space(4)))*)(base + 8 * i); } };
struct KA { KAIn in; float* out; char* ws; };
__device__ __forceinline__ KA ka_get() {
    kaptr_t p = (kaptr_t)__builtin_amdgcn_kernarg_segment_ptr(); asm volatile("" : "+s"(p));
    KA k; k.in.base = p; k.out = *(float* const __attribute__((address_space(4)))*)(p + 160); k.ws = *(char* const __attribute__((address_space(4)))*)(p + 168); return k;
}
enum { I_X = 0, I_RELB, I_NMG, I_WIN, I_QKG, I_LAM, I_SUBLN, I_SINK, I_WBR, I_WGATE, I_BGATE, I_WOUT, I_NFG, I_WRG, I_BRG, I_WRE, I_BRE, I_WFG, I_WFU, I_WFD };

struct Proj { bf16_t *aq, *ak, *av, *bq, *bk, *bv, *cq, *ck, *cv, *iq, *ik; float* iw; };
__device__ __forceinline__ Proj proj_ptrs(char* ws) {
    char* p = ws + OFF_PROJ; Proj r;
    r.aq = (bf16_t*)(p + PO_AQ); r.ak = (bf16_t*)(p + PO_AK); r.av = (bf16_t*)(p + PO_AV); r.bq = (bf16_t*)(p + PO_BQ); r.bk = (bf16_t*)(p + PO_BK); r.bv = (bf16_t*)(p + PO_BV);
    r.cq = (bf16_t*)(p + PO_CQ); r.ck = (bf16_t*)(p + PO_CK); r.cv = (bf16_t*)(p + PO_CV); r.iq = (bf16_t*)(p + PO_IQ); r.ik = (bf16_t*)(p + PO_IK); r.iw = (float*)(p + PO_IW);
    return r;
}

__device__ __forceinline__ int tid_opaque() { int t = threadIdx.x; asm volatile("" : "+v"(t)); return t; }
#define PROF_LDS_OFF (147456 - 32)
#define PROF_BEGIN(id) unsigned long long _pt##id = 0; if (PROF_ID == (id) || ((id) == 99 && PROF_ID != 0)) _pt##id = __builtin_amdgcn_s_memrealtime();
#define PROF_END(id, smem_) if (PROF_ID == (id) && threadIdx.x == 0) { *(volatile LAS unsigned*)((LAS char*)(smem_) + PROF_LDS_OFF) += (unsigned)(__builtin_amdgcn_s_memrealtime() - _pt##id); }
__device__ __forceinline__ float bf2f(bf16_t b) { return __uint_as_float(((unsigned)b) << 16); }
__device__ __forceinline__ bf16_t f2bf(float f) { unsigned u = __float_as_uint(f); u += 0x7FFFu + ((u >> 16) & 1u); return (bf16_t)(u >> 16); }
__device__ __forceinline__ float bflo(unsigned w) { return __uint_as_float(w << 16); }
__device__ __forceinline__ float bfhi(unsigned w) { return __uint_as_float(w & 0xffff0000u); }
__device__ __forceinline__ unsigned pack2(float lo, float hi) { return (unsigned)f2bf(lo) | ((unsigned)f2bf(hi) << 16); }
__device__ __forceinline__ unsigned pack2hw(float lo, float hi) { unsigned r; asm volatile("v_cvt_pk_bf16_f32 %0, %1, %2" : "=v"(r) : "v"(lo), "v"(hi)); return r; }
__device__ __forceinline__ int wave_sum_dpp(int v) {
    v += __builtin_amdgcn_update_dpp(0, v, 0x111, 0xf, 0xf, true);
    v += __builtin_amdgcn_update_dpp(0, v, 0x112, 0xf, 0xf, true);
    v += __builtin_amdgcn_update_dpp(0, v, 0x114, 0xf, 0xf, true);
    v += __builtin_amdgcn_update_dpp(0, v, 0x118, 0xf, 0xf, true);
    v += __builtin_amdgcn_update_dpp(0, v, 0x142, 0xa, 0xf, true);
    v += __builtin_amdgcn_update_dpp(0, v, 0x143, 0xc, 0xf, true);
    return __builtin_amdgcn_readlane(v, 63);
}
__device__ __forceinline__ float x32_max(float v) { const auto r = __builtin_amdgcn_permlane32_swap(__float_as_uint(v), __float_as_uint(v), false, false); return fmaxf(__uint_as_float(r[0]), __uint_as_float(r[1])); }
__device__ __forceinline__ float x32_sum(float v) { const auto r = __builtin_amdgcn_permlane32_swap(__float_as_uint(v), __float_as_uint(v), false, false); return __uint_as_float(r[0]) + __uint_as_float(r[1]); }
__device__ __forceinline__ float x16_max(float v) { const auto r = __builtin_amdgcn_permlane16_swap(__float_as_uint(v), __float_as_uint(v), false, false); return fmaxf(__uint_as_float(r[0]), __uint_as_float(r[1])); }
__device__ __forceinline__ float x16_sum(float v) { const auto r = __builtin_amdgcn_permlane16_swap(__float_as_uint(v), __float_as_uint(v), false, false); return __uint_as_float(r[0]) + __uint_as_float(r[1]); }
__device__ __forceinline__ float wsum_dpp(float v) {
    v += __builtin_bit_cast(float, __builtin_amdgcn_update_dpp(0, __builtin_bit_cast(int, v), 0x111, 0xf, 0xf, true));
    v += __builtin_bit_cast(float, __builtin_amdgcn_update_dpp(0, __builtin_bit_cast(int, v), 0x112, 0xf, 0xf, true));
    v += __builtin_bit_cast(float, __builtin_amdgcn_update_dpp(0, __builtin_bit_cast(int, v), 0x114, 0xf, 0xf, true));
    v += __builtin_bit_cast(float, __builtin_amdgcn_update_dpp(0, __builtin_bit_cast(int, v), 0x118, 0xf, 0xf, true));
    v += __builtin_bit_cast(float, __builtin_amdgcn_update_dpp(0, __builtin_bit_cast(int, v), 0x142, 0xa, 0xf, true));
    v += __builtin_bit_cast(float, __builtin_amdgcn_update_dpp(0, __builtin_bit_cast(int, v), 0x143, 0xc, 0xf, true));
    return __builtin_bit_cast(float, __builtin_amdgcn_readlane(__builtin_bit_cast(int, v), 63));
}
__device__ __forceinline__ float wsum(float v) { for (int o = 32; o; o >>= 1) v += __shfl_xor(v, o); return v; }
__device__ __forceinline__ float wmax(float v) { for (int o = 32; o; o >>= 1) v = fmaxf(v, __shfl_xor(v, o)); return v; }
__device__ __forceinline__ int t5_bucket(int rel) {
    const int n = rel < 0 ? -rel : rel;
    int b = n;
    if (n >= 8) b = 8 + (n >= 15) + (n >= 27) + (n >= 50) + (n >= 91) + (n >= 166) + (n >= 305) + (n >= 559);
    return (rel > 0 ? 16 : 0) + b;
}
__device__ __forceinline__ float lambda_init_of(int l) { return 0.8f - 0.6f * expf(-0.3f * (float)l); }
__device__ __forceinline__ float dot8(uint4 kv, const float* q) {
    return bflo(kv.x) * q[0] + bfhi(kv.x) * q[1] + bflo(kv.y) * q[2] + bfhi(kv.y) * q[3] + bflo(kv.z) * q[4] + bfhi(kv.z) * q[5] + bflo(kv.w) * q[6] + bfhi(kv.w) * q[7];
}


#define XB_TMO      128
#define XB_XCNT(j)  (256  + 64 * (j))
#define XB_XSUB(j)  (1280 + 64 * (j))
#define XB_XGEN(j)  (2304 + 64 * (j))
#define XB_TOP      3328
#define XB_TOPGEN   3392
#define XCD_BAR_WORDS 3456
#define XB_SPIN_CAP (1u << 22)
__device__ __forceinline__ unsigned xb_ld(unsigned* p)              { return __hip_atomic_load(p, __ATOMIC_RELAXED, __HIP_MEMORY_SCOPE_AGENT); }
__device__ __forceinline__ unsigned xb_add(unsigned* p, unsigned v) { return __hip_atomic_fetch_add(p, v, __ATOMIC_RELAXED, __HIP_MEMORY_SCOPE_AGENT); }
__device__ __forceinline__ unsigned xb_xcc_id() { return (unsigned)__builtin_amdgcn_s_getreg((3 << 11) | 20) & 0xFu; }
#define XB_SPIN(cond, bar) do { unsigned _sp = 0; while (cond) { __builtin_amdgcn_s_sleep(1); \
    if ((++_sp & 255u) == 0u) { if (xb_ld(&(bar)[XB_TMO])) break; if (_sp > XB_SPIN_CAP) { atomicAdd(&(bar)[XB_TMO], 1u); break; } } } } while (0)
struct XcdBarrier { unsigned* bar; unsigned x; volatile LAS unsigned* st; };
__device__ __forceinline__ XcdBarrier xcd_barrier_post(unsigned* bar, volatile LAS unsigned* st) {
    XcdBarrier b; b.bar = bar; b.x = xb_xcc_id(); b.st = st;
    if (threadIdx.x == 0) (void)xb_add(&bar[XB_XCNT(b.x)], 1u);
    return b;
}
__device__ __forceinline__ void xcd_barrier_complete(unsigned* bar, unsigned x, unsigned& nloc, unsigned& nx) {
    const unsigned G = gridDim.x * gridDim.y * gridDim.z;
    unsigned sum, cnt, mine, sp = 0u;
    for (;;) {
        sum = 0u; cnt = 0u; mine = 0u;
#pragma unroll
        for (unsigned j = 0; j < 16; ++j) { const unsigned c = xb_ld(&bar[XB_XCNT(j)]); sum += c; cnt += (c > 0u) ? 1u : 0u; mine = (j == x) ? c : mine; }
        if (sum == G) break;
        __builtin_amdgcn_s_sleep(1);
        if ((++sp & 255u) == 0u) { if (xb_ld(&bar[XB_TMO])) break; if (sp > XB_SPIN_CAP) { atomicAdd(&bar[XB_TMO], 1u); break; } }
    }
    nloc = mine > 0u ? mine : 1u; nx = cnt > 0u ? cnt : 1u;
}
__device__ __forceinline__ void xcd_barrier(const XcdBarrier& b) {
    asm volatile("s_waitcnt vmcnt(0)" ::: "memory");
    __syncthreads();
    if (threadIdx.x == 0) {
        unsigned* bar = b.bar;
        __builtin_amdgcn_s_waitcnt(0);
        unsigned nloc = b.st[0], nx = b.st[1];
        if (nloc == 0u) { xcd_barrier_complete(bar, b.x, nloc, nx); b.st[0] = nloc; b.st[1] = nx; }
        const unsigned old = xb_add(&bar[XB_XSUB(b.x)], 1u);
        const unsigned gen = old / nloc;
        if (old + 1u == (gen + 1u) * nloc) {
            __builtin_amdgcn_fence(__ATOMIC_RELEASE, "agent");
            asm volatile("s_waitcnt vmcnt(0)" ::: "memory");
            const unsigned og = xb_add(&bar[XB_TOP], 1u);
            const unsigned tg = og / nx;
            if (og + 1u == (tg + 1u) * nx) xb_add(&bar[XB_TOPGEN], 1u);
            else XB_SPIN(xb_ld(&bar[XB_TOPGEN]) == tg, bar);
            __builtin_amdgcn_fence(__ATOMIC_ACQUIRE, "agent");
            xb_add(&bar[XB_XGEN(b.x)], 1u);
            asm volatile("s_waitcnt vmcnt(0)" ::: "memory");
        } else {
            XB_SPIN(xb_ld(&bar[XB_XGEN(b.x)]) == gen, bar);
            __builtin_amdgcn_fence(__ATOMIC_ACQUIRE, "agent");
            asm volatile("s_waitcnt vmcnt(0)" ::: "memory");
        }
    }
    __syncthreads();
}

__device__ __forceinline__ void ngemm_tile(const bf16_t* A, int lda, const float* W, int ldw, int K, int ncols, int row0, int col0, float (&acc)[8][4], float* lds) {
    float* As = lds; float* Bs = lds + 16 * 132;
    const int tid = tid_opaque(), ty = tid >> 5, tx = tid & 31;
#pragma unroll
    for (int i = 0; i < 8; ++i)
#pragma unroll
        for (int j = 0; j < 4; ++j) acc[i][j] = 0.f;
    for (int k0 = 0; k0 < K; k0 += 16) {
        {
            const int r = tid >> 2, kq = (tid & 3) * 4;
            const uint2 v = *(const uint2*)(A + (size_t)(row0 + r) * lda + k0 + kq);
            As[(kq + 0) * 132 + r] = bflo(v.x); As[(kq + 1) * 132 + r] = bfhi(v.x); As[(kq + 2) * 132 + r] = bflo(v.y); As[(kq + 3) * 132 + r] = bfhi(v.y);
        }
        {
            const int k = tid >> 5, c = (tid & 31) * 4;
            const float* wp = W + (size_t)(k0 + k) * ldw + col0 + c;
            float4 v = make_float4(0.f, 0.f, 0.f, 0.f);
            if (col0 + c + 3 < ncols) v = *(const float4*)wp;
            else { if (col0 + c < ncols) v.x = wp[0]; if (col0 + c + 1 < ncols) v.y = wp[1]; if (col0 + c + 2 < ncols) v.z = wp[2]; }
            *(float4*)(Bs + k * 128 + c) = v;
        }
        __syncthreads();
#pragma unroll 2
        for (int kk = 0; kk < 16; ++kk) {
            const float4 a0 = *(const float4*)(As + kk * 132 + ty * 8), a1 = *(const float4*)(As + kk * 132 + ty * 8 + 4);
            const float4 b = *(const float4*)(Bs + kk * 128 + tx * 4);
            const float a[8] = {a0.x, a0.y, a0.z, a0.w, a1.x, a1.y, a1.z, a1.w}; const float bb[4] = {b.x, b.y, b.z, b.w};
#pragma unroll
            for (int i = 0; i < 8; ++i)
#pragma unroll
                for (int j = 0; j < 4; ++j) acc[i][j] += a[i] * bb[j];
        }
        __syncthreads();
    }
}

__device__ __forceinline__ void ph_rmsnorm(const float* xsrc, const bf16_t* xs16, const float* g, bf16_t* H) {
    const int tidq = tid_opaque(); const int lane = tidq & 63, wid = tidq >> 6;
    float4 gv[4];
#pragma unroll
    for (int j = 0; j < 4; ++j) gv[j] = ((const float4*)g)[j * 64 + lane];
    for (int row0 = (blockIdx.x * 8 + wid) * 4; row0 < NTOK; row0 += gridDim.x * 32) {
        float4 v[4][4];
#pragma unroll
        for (int r = 0; r < 4; ++r) {
            if (xs16 == nullptr) { const float4* xp = (const float4*)(xsrc + (size_t)(row0 + r) * ND);
#pragma unroll
                for (int j = 0; j < 4; ++j) v[r][j] = xp[j * 64 + lane]; }
            else { const uint2* xp = (const uint2*)(xs16 + (size_t)(row0 + r) * ND);
#pragma unroll
                for (int j = 0; j < 4; ++j) { const uint2 w = xp[j * 64 + lane]; v[r][j] = make_float4(bflo(w.x), bfhi(w.x), bflo(w.y), bfhi(w.y)); } }
        }
#pragma unroll
        for (int r = 0; r < 4; ++r) {
            float ss = 0.f;
#pragma unroll
            for (int j = 0; j < 4; ++j) ss += v[r][j].x * v[r][j].x + v[r][j].y * v[r][j].y + v[r][j].z * v[r][j].z + v[r][j].w * v[r][j].w;
            ss = wsum_dpp(ss);
            const float rstd = rsqrtf(ss * (1.0f / ND) + EPS);
#pragma unroll
            for (int j = 0; j < 4; ++j) {
                uint2 o; o.x = pack2hw(v[r][j].x * rstd * gv[j].x, v[r][j].y * rstd * gv[j].y); o.y = pack2hw(v[r][j].z * rstd * gv[j].z, v[r][j].w * rstd * gv[j].w);
                *(uint2*)(H + (size_t)(row0 + r) * ND + (j * 64 + lane) * 4) = o;
            }
        }
    }
}

__device__ __forceinline__ void store_proj_raw(const Proj& pj, int tok, int c, float v) {
    if (c < 512) pj.aq[(size_t)tok * 512 + c] = f2bf(v);
    else if (c < 1024) pj.ak[(size_t)tok * 512 + c - 512] = f2bf(v);
    else if (c < 1536) pj.av[(size_t)tok * 512 + c - 1024] = f2bf(v);
    else if (c < 2048) pj.bq[(size_t)tok * 512 + c - 1536] = f2bf(v);
    else if (c < 2176) pj.bk[(size_t)tok * 128 + c - 2048] = f2bf(v);
    else if (c < 2304) pj.bv[(size_t)tok * 128 + c - 2176] = f2bf(v);
    else if (c < 2816) pj.cq[(size_t)tok * 512 + c - 2304] = f2bf(v);
    else if (c < 2880) pj.ck[(size_t)tok * 64 + c - 2816] = f2bf(v);
    else if (c < 2944) pj.cv[(size_t)tok * 64 + c - 2880] = f2bf(v);
    else if (c < 3072) pj.iq[(size_t)tok * 128 + c - 2944] = f2bf(v);
    else if (c < 3104) pj.ik[(size_t)tok * 32 + c - 3072] = f2bf(v);
    else if (c < 3108) pj.iw[(size_t)tok * 4 + c - 3104] = v * IWSCALE;
}
__device__ __forceinline__ void ph_inproj_naive(const Params& P_, int l, float* lds) {
    const KA P = ka_get();
    const Proj pj = proj_ptrs(P.ws);
    const bf16_t* H = (const bf16_t*)(P.ws + OFF_H);
    const float* W = P.in[I_WIN] + (size_t)l * ND * IN_COLS;
    const int tid = tid_opaque(), ty = tid >> 5, tx = tid & 31;
    for (int t = blockIdx.x; t < 256 * 25; t += gridDim.x) {
        const int tm = t / 25, tn = t % 25;
        float acc[8][4];
        ngemm_tile(H, ND, W, IN_COLS, ND, IN_COLS, tm * 128, tn * 128, acc, lds);
#pragma unroll
        for (int i = 0; i < 8; ++i)
#pragma unroll
            for (int j = 0; j < 4; ++j) { const int c = tn * 128 + tx * 4 + j; if (c < IN_COLS) store_proj_raw(pj, tm * 128 + ty * 8 + i, c, acc[i][j]); }
    }
}
__device__ __forceinline__ void ph_headnorm_naive(const Params& P_, int l) {
    const KA P = ka_get();
    const Proj pj = proj_ptrs(P.ws);
    const float* qkg = P.in[I_QKG] + (size_t)l * 3 * 2 * 64;
    const int tidq = tid_opaque(); const int lane = tidq & 63, wid = tidq >> 6;
    for (long t = (long)blockIdx.x * 8 + wid; t < (long)NTOK * 35; t += (long)gridDim.x * 8) {
        const int tok = (int)(t / 35), g = (int)(t % 35);
        bf16_t* p; const float* gv; float sc = 1.f;
        if (g < 8) { p = pj.aq + (size_t)tok * 512 + g * 64; gv = qkg + 0; sc = QSCALE; }
        else if (g < 16) { p = pj.ak + (size_t)tok * 512 + (g - 8) * 64; gv = qkg + 64; }
        else if (g < 24) { p = pj.bq + (size_t)tok * 512 + (g - 16) * 64; gv = qkg + 128; sc = QSCALE; }
        else if (g < 26) { p = pj.bk + (size_t)tok * 128 + (g - 24) * 64; gv = qkg + 192; }
        else if (g < 34) { p = pj.cq + (size_t)tok * 512 + (g - 26) * 64; gv = qkg + 256; sc = QSCALE; }
        else { p = pj.ck + (size_t)tok * 64; gv = qkg + 320; }
        const float v = bf2f(p[lane]);
        const float ss = wsum(v * v);
        p[lane] = f2bf(v * rsqrtf(ss * (1.0f / 64) + EPS) * gv[lane] * sc);
    }
}

__device__ __forceinline__ void ph_attnA_naive(const Params& P_, int l, float* lds) {
    const KA P = ka_get();
    const Proj pj = proj_ptrs(P.ws);
    bf16_t* BR = (bf16_t*)(P.ws + OFF_BR);
    const int tidq = tid_opaque(); const int lane = tidq & 63, wid = tidq >> 6;
    float* btab = lds;
    float* qs = lds + 128 + wid * 128;
    for (int i = tidq; i < 128; i += 512) btab[i] = P.in[I_RELB][(i >> 2) * 20 + (i & 3)] * LOG2E;
    __syncthreads();
    const float* lp = P.in[I_LAM] + (size_t)l * 256;
    const float linit = lambda_init_of(l);
    const float lam = expf(wsum(lp[lane] * lp[64 + lane])) - expf(wsum(lp[128 + lane] * lp[192 + lane])) + linit;
    const float* subg = P.in[I_SUBLN] + (size_t)l * 128;
    for (int t = blockIdx.x * 8 + wid; t < NB * 4 * NS; t += gridDim.x * 8) {
        const int q = t & (NS - 1), h = (t >> 12) & 3, b = t >> 14;
        const int tok = b * NS + q;
        qs[lane] = bf2f(pj.aq[(size_t)tok * 512 + (h * 2) * 64 + lane]);
        qs[64 + lane] = bf2f(pj.aq[(size_t)tok * 512 + (h * 2 + 1) * 64 + lane]);
        const int nkt = (q >> 6) + 1;
        float M0 = -INFINITY, Z0 = 0.f, M1 = -INFINITY, Z1 = 0.f;
        for (int kt = 0; kt < nkt; ++kt) {
            asm volatile("" ::: "memory");
            const int key = kt * 64 + lane;
            const uint4* kp = (const uint4*)(pj.ak + (size_t)(b * NS + key) * 512 + h * 128);
            float s0 = 0.f, s1 = 0.f;
#pragma unroll 1
            for (int d = 0; d < 8; ++d) { asm volatile("" ::: "memory"); s0 += dot8(kp[d], qs + d * 8); s1 += dot8(kp[8 + d], qs + 64 + d * 8); }
            const float bias = btab[t5_bucket(key - q) * 4 + h];
            s0 += bias; s1 += bias;
            float mn = fmaxf(M0, s0); Z0 = Z0 * exp2f(M0 - mn) + exp2f(s0 - mn); M0 = mn;
            mn = fmaxf(M1, s1); Z1 = Z1 * exp2f(M1 - mn) + exp2f(s1 - mn); M1 = mn;
        }
        { const float mw = wmax(M0); Z0 = wsum(Z0 * exp2f(M0 - mw)); M0 = mw; }
        { const float mw = wmax(M1); Z1 = wsum(Z1 * exp2f(M1 - mw)); M1 = mw; }
        const float iz0 = 1.f / Z0, iz1 = lam / Z1;
        float a0 = 0.f, a1 = 0.f;
        for (int kt = 0; kt < nkt; ++kt) {
            asm volatile("" ::: "memory");
            const int key = kt * 64 + lane;
            const uint4* kp = (const uint4*)(pj.ak + (size_t)(b * NS + key) * 512 + h * 128);
            float s0 = 0.f, s1 = 0.f;
#pragma unroll 1
            for (int d = 0; d < 8; ++d) { asm volatile("" ::: "memory"); s0 += dot8(kp[d], qs + d * 8); s1 += dot8(kp[8 + d], qs + 64 + d * 8); }
            const float bias = btab[t5_bucket(key - q) * 4 + h];
            const float p = exp2f(s0 + bias - M0) * iz0 - exp2f(s1 + bias - M1) * iz1;
            const unsigned* vp = (const unsigned*)(pj.av + (size_t)(b * NS + kt * 64) * 512 + h * 128) + lane;
#pragma unroll 4
            for (int j = 0; j < 64; ++j) { const float pjv = __shfl(p, j); const unsigned w = vp[(size_t)j * 256]; a0 += pjv * bflo(w); a1 += pjv * bfhi(w); }
        }
        const float ss = wsum(a0 * a0 + a1 * a1);
        const float rstd = rsqrtf(ss * (1.0f / 128) + EPS) * (1.0f - linit);
        *(unsigned*)(BR + (size_t)tok * 1536 + h * 128 + lane * 2) = pack2(a0 * rstd * subg[lane * 2], a1 * rstd * subg[lane * 2 + 1]);
    }
}

__device__ __forceinline__ void ph_attnB_naive(const Params& P_, int l, float* lds) {
    const KA P = ka_get();
    const Proj pj = proj_ptrs(P.ws);
    bf16_t* BR = (bf16_t*)(P.ws + OFF_BR);
    const int tidq = tid_opaque(); const int lane = tidq & 63, wid = tidq >> 6;
    float* btab = lds;
    float* qs = lds + 256 + wid * 64;
    __syncthreads();
    for (int i = tidq; i < 256; i += 512) btab[i] = P.in[I_RELB][(i >> 3) * 20 + 4 + (i & 7)] * LOG2E;
    __syncthreads();
    const float* sinks = P.in[I_SINK] + (size_t)l * 8;
    for (int t = blockIdx.x * 8 + wid; t < NTOK * 8; t += gridDim.x * 8) {
        const int hq = t & 7, tok = t >> 3, q = tok & (NS - 1), b = tok >> 12, kvh = hq >> 2, c = q >> 6;
        qs[lane] = bf2f(pj.bq[(size_t)tok * 512 + hq * 64 + lane]);
        float s[3];
#pragma unroll
        for (int g = 0; g < 3; ++g) {
            const int pos = c * 64 - 128 + g * 64 + lane;
            s[g] = -INFINITY;
            if (pos >= 0) {
                const uint4* kp = (const uint4*)(pj.bk + (size_t)(b * NS + pos) * 128 + kvh * 64);
                float a = 0.f;
#pragma unroll
                for (int d = 0; d < 8; ++d) a += dot8(kp[d], qs + d * 8);
                s[g] = a + btab[t5_bucket(pos - q) * 8 + hq];
            }
        }
        const float sink = sinks[hq] * LOG2E;
        const float m = fmaxf(wmax(fmaxf(fmaxf(s[0], s[1]), s[2])), sink);
        float e[3];
#pragma unroll
        for (int g = 0; g < 3; ++g) e[g] = exp2f(s[g] - m);
        const float Z = wsum(e[0] + e[1] + e[2]) + exp2f(sink - m);
        const float iz = 1.f / Z;
        float acc = 0.f;
#pragma unroll
        for (int g = 0; g < 3; ++g) {
            const int pos0 = c * 64 - 128 + g * 64;
            if (pos0 >= 0) {
                const bf16_t* vp = pj.bv + (size_t)(b * NS + pos0) * 128 + kvh * 64 + lane;
#pragma unroll 4
                for (int j = 0; j < 64; ++j) acc += __shfl(e[g], j) * bf2f(vp[(size_t)j * 128]);
            }
        }
        BR[(size_t)tok * 1536 + 512 + hq * 64 + lane] = f2bf(acc * iz);
    }
}

__device__ __forceinline__ void ph_attnC_naive(const Params& P_, int l, float* lds) {
    const KA P = ka_get();
    const Proj pj = proj_ptrs(P.ws);
    bf16_t* BR = (bf16_t*)(P.ws + OFF_BR);
    const int tidq = tid_opaque(); const int lane = tidq & 63, wid = tidq >> 6;
    float* btab = lds;
    unsigned* keys = (unsigned*)(lds + 256) + wid * 4480;
    int* sel = (int*)(keys + 4096);
    float* iqs = (float*)(keys + 4096 + 256);
    __syncthreads();
    for (int i = tidq; i < 256; i += 512) btab[i] = P.in[I_RELB][(i >> 3) * 20 + 12 + (i & 7)] * LOG2E;
    __syncthreads();
    for (int tok = blockIdx.x * 8 + wid; tok < NTOK; tok += gridDim.x * 8) {
        const int q = tok & (NS - 1), b = tok >> 12, c = q >> 6, N = (c + 1) * 64, ntile = c + 1;
        iqs[lane] = bf2f(pj.iq[(size_t)tok * 128 + lane]); iqs[64 + lane] = bf2f(pj.iq[(size_t)tok * 128 + 64 + lane]);
        const float4 wv = *(const float4*)(pj.iw + (size_t)tok * 4);
        int cnt;
        if (N <= 256) { for (int i = lane; i < N; i += 64) sel[i] = i; cnt = N; }
        else {
            for (int kt = 0; kt < ntile; ++kt) {
                asm volatile("" ::: "memory");
                const int key = kt * 64 + lane;
                const uint4* kp = (const uint4*)(pj.ik + (size_t)(b * NS + key) * 32);
                const uint4 k0 = kp[0], k1 = kp[1], k2 = kp[2], k3 = kp[3];
                float sc = 0.f;
#pragma unroll
                for (int hh = 0; hh < 4; ++hh) {
                    const float lg = dot8(k0, iqs + hh * 32) + dot8(k1, iqs + hh * 32 + 8) + dot8(k2, iqs + hh * 32 + 16) + dot8(k3, iqs + hh * 32 + 24);
                    const float w = hh == 0 ? wv.x : hh == 1 ? wv.y : hh == 2 ? wv.z : wv.w;
                    sc += fmaxf(lg, 0.f) * w;
                }
                sc += 0.0f;
                const unsigned u = __float_as_uint(sc);
                keys[key] = (u & 0x80000000u) ? ~u : (u | 0x80000000u);
            }
            unsigned T = 0;
            for (int bit = 31; bit >= 0; --bit) {
                const unsigned cand = T | (1u << bit);
                int n = 0;
                for (int kt = 0; kt < ntile; ++kt) n += __popcll(__ballot(keys[kt * 64 + lane] >= cand));
                if (n >= 256) T = cand;
            }
            int ngt = 0;
            for (int kt = 0; kt < ntile; ++kt) ngt += __popcll(__ballot(keys[kt * 64 + lane] > T));
            const int need = 256 - ngt;
            int nsel = 0, neq = 0;
            const unsigned long long ltmask = (1ull << lane) - 1ull;
            for (int kt = 0; kt < ntile; ++kt) {
                const unsigned kv = keys[kt * 64 + lane];
                const unsigned long long eqm = __ballot(kv == T);
                const bool take = (kv > T) || (kv == T && (neq + __popcll(eqm & ltmask)) < need);
                const unsigned long long tm = __ballot(take);
                if (take) sel[nsel + __popcll(tm & ltmask)] = kt * 64 + lane;
                nsel += __popcll(tm); neq += __popcll(eqm);
            }
            cnt = 256;
        }
        int idx[4];
#pragma unroll
        for (int j = 0; j < 4; ++j) idx[j] = (lane + 64 * j < cnt) ? sel[lane + 64 * j] : 0;
        for (int h = 0; h < 8; ++h) {
            iqs[lane] = bf2f(pj.cq[(size_t)tok * 512 + h * 64 + lane]);
            const float* qv = iqs;
            float s[4];
#pragma unroll
            for (int j = 0; j < 4; ++j) {
                asm volatile("" ::: "memory");
                s[j] = -INFINITY;
                if (lane + 64 * j < cnt) {
                    const uint4* kp = (const uint4*)(pj.ck + (size_t)(b * NS + idx[j]) * 64);
                    float a = 0.f;
#pragma unroll
                    for (int d = 0; d < 8; ++d) a += dot8(kp[d], qv + d * 8);
                    s[j] = a + btab[t5_bucket(idx[j] - q) * 8 + h];
                }
            }
            const float m = wmax(fmaxf(fmaxf(s[0], s[1]), fmaxf(s[2], s[3])));
            float e[4];
#pragma unroll
            for (int j = 0; j < 4; ++j) e[j] = exp2f(s[j] - m);
            const float iz = 1.f / wsum(e[0] + e[1] + e[2] + e[3]);
            float acc = 0.f;
#pragma unroll
            for (int j = 0; j < 4; ++j) {
                const int nj = cnt - 64 * j < 64 ? cnt - 64 * j : 64;
#pragma unroll 2
                for (int i = 0; i < nj; ++i) { const float pv = __shfl(e[j], i); const int id = __shfl(idx[j], i); acc += pv * bf2f(pj.cv[(size_t)(b * NS + id) * 64 + lane]); }
            }
            BR[(size_t)tok * 1536 + 1024 + h * 64 + lane] = f2bf(acc * iz);
        }
    }
}

__device__ __forceinline__ void ph_gatebranch_naive(const Params& P_, int l, float* lds) {
    const KA P = ka_get();
    const bf16_t* H = (const bf16_t*)(P.ws + OFF_H);
    const bf16_t* BR = (const bf16_t*)(P.ws + OFF_BR);
    bf16_t* MG = (bf16_t*)(P.ws + OFF_MERGED);
    const float* Wg = P.in[I_WGATE] + (size_t)l * ND * 3072;
    const float* bg = P.in[I_BGATE] + (size_t)l * 3072;
    const float* Wb = P.in[I_WBR] + (size_t)l * 3 * 512 * ND;
    const int tid = tid_opaque(), ty = tid >> 5, tx = tid & 31;
    for (int t = blockIdx.x; t < 256 * 8; t += gridDim.x) {
        const int tm = t >> 3, tn = t & 7;
        float m[8][4];
#pragma unroll
        for (int i = 0; i < 8; ++i)
#pragma unroll
            for (int j = 0; j < 4; ++j) m[i][j] = 0.f;
        for (int n = 0; n < 3; ++n) {
            float g[8][4], y[8][4];
            ngemm_tile(H, ND, Wg, 3072, ND, 3072, tm * 128, n * 1024 + tn * 128, g, lds);
            ngemm_tile(BR + n * 512, 1536, Wb + (size_t)n * 512 * ND, ND, 512, ND, tm * 128, tn * 128, y, lds);
#pragma unroll
            for (int i = 0; i < 8; ++i)
#pragma unroll
                for (int j = 0; j < 4; ++j) { const float z = g[i][j] + bg[n * 1024 + tn * 128 + tx * 4 + j]; m[i][j] += y[i][j] / (1.f + expf(-z)); }
        }
#pragma unroll
        for (int i = 0; i < 8; ++i) {
            uint2 o; o.x = pack2(m[i][0], m[i][1]); o.y = pack2(m[i][2], m[i][3]);
            *(uint2*)(MG + (size_t)(tm * 128 + ty * 8 + i) * ND + tn * 128 + tx * 4) = o;
        }
    }
}
__device__ __forceinline__ void ph_out_naive(const Params& P_, int l, float* lds) {
    const KA P = ka_get();
    const bf16_t* MG = (const bf16_t*)(P.ws + OFF_MERGED);
    const float* W = P.in[I_WOUT] + (size_t)l * ND * ND;
    const float* xsrc = l == 0 ? P.in[I_X] : P.out;
    const int tid = tid_opaque(), ty = tid >> 5, tx = tid & 31;
    for (int t = blockIdx.x; t < 256 * 8; t += gridDim.x) {
        const int tm = t >> 3, tn = t & 7;
        float acc[8][4];
        ngemm_tile(MG, ND, W, ND, ND, ND, tm * 128, tn * 128, acc, lds);
#pragma unroll
        for (int i = 0; i < 8; ++i) {
            const size_t o = (size_t)(tm * 128 + ty * 8 + i) * ND + tn * 128 + tx * 4;
            const float4 xv = *(const float4*)(xsrc + o);
            *(float4*)(P.out + o) = make_float4(xv.x + acc[i][0], xv.y + acc[i][1], xv.z + acc[i][2], xv.w + acc[i][3]);
        }
    }
}

__device__ __forceinline__ void ph_norm2_route(const Params& P_, int l, float* lds_) {
    const KA P = ka_get();
    bf16_t* H = (bf16_t*)(P.ws + OFF_H);
    int* eid = (int*)(P.ws + OFF_ROUTE); float* ew = (float*)(P.ws + OFF_ROUTE + 256 * 1024);
    const float* g = P.in[I_NFG] + (size_t)l * ND;
    const float* wrg = P.in[I_WRG] + (size_t)l * ND * 4; const float* brg = P.in[I_BRG] + (size_t)l * 4;
    const float* wre = P.in[I_WRE] + (size_t)l * ND * 16; const float* bre = P.in[I_BRE] + (size_t)l * 16;
    const int tidq = tid_opaque(); const int lane = tidq & 63, wid = tidq >> 6;
    typedef float v4f __attribute__((ext_vector_type(4)));
    LAS v4f* wl = (LAS v4f*)lds_;
    __syncthreads();
    for (int idx = tidq; idx < 5120; idx += 512) {
        const int ln = idx & 63, t = idx >> 6, q = t % 5, je = t / 5, k = ((je >> 2) * 64 + ln) * 4 + (je & 3);
        wl[idx] = q == 0 ? *(const v4f*)(wrg + (size_t)k * 4) : *(const v4f*)(wre + (size_t)k * 16 + (q - 1) * 4);
    }
    __syncthreads();
    for (int row0 = (blockIdx.x * 8 + wid) * 2; row0 < NTOK; row0 += gridDim.x * 16) {
        float4 v[2][4]; float rstd[2];
#pragma unroll
        for (int r = 0; r < 2; ++r) { const uint2* xp = (const uint2*)((const bf16_t*)(P.ws + OFF_STREAM) + (size_t)(row0 + r) * ND);
#pragma unroll
            for (int j = 0; j < 4; ++j) { const uint2 w = xp[j * 64 + lane]; v[r][j] = make_float4(bflo(w.x), bfhi(w.x), bflo(w.y), bfhi(w.y)); } }
#pragma unroll
        for (int r = 0; r < 2; ++r) { float ss = 0.f;
#pragma unroll
            for (int j = 0; j < 4; ++j) ss += v[r][j].x * v[r][j].x + v[r][j].y * v[r][j].y + v[r][j].z * v[r][j].z + v[r][j].w * v[r][j].w;
            rstd[r] = rsqrtf(wsum_dpp(ss) * (1.0f / ND) + EPS); }
        float lg[2][20];
#pragma unroll
        for (int r = 0; r < 2; ++r)
#pragma unroll
            for (int i = 0; i < 20; ++i) lg[r][i] = 0.f;
#pragma unroll
        for (int j = 0; j < 4; ++j) {
            const int k0 = (j * 64 + lane) * 4;
            const float4 gv = ((const float4*)g)[j * 64 + lane];
            float hv[2][4];
#pragma unroll
            for (int r = 0; r < 2; ++r) {
                hv[r][0] = v[r][j].x * rstd[r] * gv.x; hv[r][1] = v[r][j].y * rstd[r] * gv.y; hv[r][2] = v[r][j].z * rstd[r] * gv.z; hv[r][3] = v[r][j].w * rstd[r] * gv.w;
                uint2 o; o.x = pack2hw(hv[r][0], hv[r][1]); o.y = pack2hw(hv[r][2], hv[r][3]);
                *(uint2*)(H + (size_t)(row0 + r) * ND + k0) = o;
            }
#pragma unroll
            for (int e = 0; e < 4; ++e) {
                const LAS v4f* wp = wl + ((j * 4 + e) * 5) * 64 + lane;
                const v4f wg4 = wp[0], w0 = wp[64], w1 = wp[128], w2 = wp[192], w3 = wp[256];
#pragma unroll
                for (int r = 0; r < 2; ++r) {
                    const float x = hv[r][e];
                    lg[r][0] += x * wg4.x; lg[r][1] += x * wg4.y; lg[r][2] += x * wg4.z; lg[r][3] += x * wg4.w;
                    lg[r][4] += x * w0.x; lg[r][5] += x * w0.y; lg[r][6] += x * w0.z; lg[r][7] += x * w0.w;
                    lg[r][8] += x * w1.x; lg[r][9] += x * w1.y; lg[r][10] += x * w1.z; lg[r][11] += x * w1.w;
                    lg[r][12] += x * w2.x; lg[r][13] += x * w2.y; lg[r][14] += x * w2.z; lg[r][15] += x * w2.w;
                    lg[r][16] += x * w3.x; lg[r][17] += x * w3.y; lg[r][18] += x * w3.z; lg[r][19] += x * w3.w;
                }
            }
            asm volatile("" ::: "memory");
        }
#pragma unroll
        for (int r = 0; r < 2; ++r)
#pragma unroll
            for (int i = 0; i < 20; ++i) lg[r][i] = wsum_dpp(lg[r][i]);
        if (lane < 2) {
            const int row = row0 + lane;
            float lgl[20];
#pragma unroll
            for (int i = 0; i < 20; ++i) lgl[i] = lane == 0 ? lg[0][i] : lg[1][i];
            float gl[4];
#pragma unroll
            for (int i = 0; i < 4; ++i) gl[i] = lgl[i] + brg[i];
            int gs = 0; float gm = gl[0];
#pragma unroll
            for (int i = 1; i < 4; ++i) if (gl[i] > gm) { gm = gl[i]; gs = i; }
            float zs = 0.f;
#pragma unroll
            for (int i = 0; i < 4; ++i) zs += expf(gl[i] - gm);
            const float pgroup = 1.f / zs;
            float el[4];
#pragma unroll
            for (int i = 0; i < 4; ++i) { el[i] = 0.f;
#pragma unroll
                for (int gq = 0; gq < 4; ++gq) if (gq == gs) el[i] = lgl[4 + gq * 4 + i] + bre[gq * 4 + i]; }
            int e1 = 0; float v1 = el[0];
#pragma unroll
            for (int i = 1; i < 4; ++i) if (el[i] > v1) { v1 = el[i]; e1 = i; }
            int e2 = -1; float v2 = -INFINITY;
#pragma unroll
            for (int i = 0; i < 4; ++i) if (i != e1 && el[i] > v2) { v2 = el[i]; e2 = i; }
            const float x2 = expf(v2 - v1), w1 = 1.f / (1.f + x2), w2 = x2 / (1.f + x2);
            eid[row * 2] = gs * 4 + e1; eid[row * 2 + 1] = gs * 4 + e2;
            ew[row * 2] = w1 * pgroup; ew[row * 2 + 1] = w2 * pgroup;
            const int lo = e1 < e2 ? e1 : e2, hi = e1 < e2 ? e2 : e1;
            const int bk = gs * 6 + (lo == 0 ? hi - 1 : (lo == 1 ? hi + 1 : 5));
            const int pos = atomicAdd((int*)(P.ws + OFF_CTRL + MOE_CNT_OFF) + l * 32 + bk, 1);
            ((int*)(P.ws + OFF_ROUTE + MOE_LIST_OFF))[bk * NTOK + pos] = row;
            float* rw = (float*)(P.ws + OFF_ROUTE + MOE_RW_OFF);
            rw[row * 2] = (e1 < e2 ? w1 : w2) * pgroup; rw[row * 2 + 1] = (e1 < e2 ? w2 : w1) * pgroup;
        }
    }
}

__device__ __forceinline__ void ph_moe_naive(const Params& P_, int l, float* lds) {
    const KA P = ka_get();
    const bf16_t* H = (const bf16_t*)(P.ws + OFF_H);
    const int* eid = (const int*)(P.ws + OFF_ROUTE); const float* ew = (const float*)(P.ws + OFF_ROUTE + 256 * 1024);
    const int tidq = tid_opaque(); const int lane = tidq & 63, wid = tidq >> 6;
    float* hs = lds + wid * 1280;
    float* hid = hs + 1024;
    for (int tok = blockIdx.x * 8 + wid; tok < NTOK; tok += gridDim.x * 8) {
#pragma unroll
        for (int j = 0; j < 4; ++j) { const uint2 w = *(const uint2*)(H + (size_t)tok * ND + (j * 64 + lane) * 4); float* d = hs + (j * 64 + lane) * 4; d[0] = bflo(w.x); d[1] = bfhi(w.x); d[2] = bflo(w.y); d[3] = bfhi(w.y); }
        float o[16];
#pragma unroll
        for (int i = 0; i < 16; ++i) o[i] = 0.f;
        for (int s = 0; s < 2; ++s) {
            const int e = eid[tok * 2 + s]; const float w = ew[tok * 2 + s];
            const float* wg = P.in[I_WFG] + ((size_t)l * 16 + e) * ND * 256;
            const float* wu = P.in[I_WFU] + ((size_t)l * 16 + e) * ND * 256;
            const float* wd = P.in[I_WFD] + ((size_t)l * 16 + e) * 256 * ND;
            float4 ga = make_float4(0.f, 0.f, 0.f, 0.f), ua = ga;
            for (int k = 0; k < ND; ++k) {
                const float hv = hs[k];
                const float4 a = *(const float4*)(wg + (size_t)k * 256 + lane * 4), u = *(const float4*)(wu + (size_t)k * 256 + lane * 4);
                ga.x += hv * a.x; ga.y += hv * a.y; ga.z += hv * a.z; ga.w += hv * a.w; ua.x += hv * u.x; ua.y += hv * u.y; ua.z += hv * u.z; ua.w += hv * u.w;
            }
            float4 hv4;
            hv4.x = ga.x / (1.f + expf(-ga.x)) * ua.x * w; hv4.y = ga.y / (1.f + expf(-ga.y)) * ua.y * w; hv4.z = ga.z / (1.f + expf(-ga.z)) * ua.z * w; hv4.w = ga.w / (1.f + expf(-ga.w)) * ua.w * w;
            *(float4*)(hid + lane * 4) = hv4;
            for (int f = 0; f < 256; ++f) {
                const float hf = hid[f];
#pragma unroll
                for (int j = 0; j < 4; ++j) { const float4 d = *(const float4*)(wd + (size_t)f * ND + (j * 64 + lane) * 4); o[j * 4] += hf * d.x; o[j * 4 + 1] += hf * d.y; o[j * 4 + 2] += hf * d.z; o[j * 4 + 3] += hf * d.w; }
            }
        }
#pragma unroll
        for (int j = 0; j < 4; ++j) {
            float4* op = (float4*)(P.out + (size_t)tok * ND + (j * 64 + lane) * 4);
            float4 x = *op; x.x += o[j * 4]; x.y += o[j * 4 + 1]; x.z += o[j * 4 + 2]; x.w += o[j * 4 + 3]; *op = x;
        }
    }
}


namespace mm {
typedef short bf16x8 __attribute__((ext_vector_type(8)));
typedef float f32x16 __attribute__((ext_vector_type(16)));
typedef float f32x4 __attribute__((ext_vector_type(4)));
typedef unsigned u32x4 __attribute__((ext_vector_type(4)));
constexpr int OPB = 256 * 128;
constexpr int STG = 2 * OPB;
constexpr int LDS_NEED = 2 * STG;
__host__ __device__ __forceinline__ int img_col(int rho) { const int i = rho & 31; return (rho & ~31) + 16 * ((i >> 2) & 1) + 4 * (i >> 3) + (i & 3); }
__device__ __forceinline__ unsigned cvt_pk_bf16(float lo, float hi) { unsigned r; asm volatile("v_cvt_pk_bf16_f32 %0, %1, %2" : "=v"(r) : "v"(lo), "v"(hi)); return r; }
__device__ __forceinline__ u32x4 pack8(const f32x16& v, int o) { u32x4 w; w.x = cvt_pk_bf16(v[o], v[o + 1]); w.y = cvt_pk_bf16(v[o + 2], v[o + 3]); w.z = cvt_pk_bf16(v[o + 4], v[o + 5]); w.w = cvt_pk_bf16(v[o + 6], v[o + 7]); return w; }

struct Unit {
    const char* a;
    const char* b0;
    const char* b1;
    int lda, ldb;
    int nk, nseg;
    int pm, pn, tag;
    int aux0, aux1;
};
__device__ __forceinline__ bool static_tile(long L, int nM, int nN, int& pm, int& pn) {
    const int nwg = nM * nN; if (L >= nwg) return false;
    int wgid = (int)L; { const int q = nwg / 8, r = nwg % 8, xcd = wgid % 8, off = wgid / 8; wgid = (xcd < r ? xcd * (q + 1) : r * (q + 1) + (xcd - r) * q) + off; }
    const int nig = 8 * nN, gid = wgid / nig, fm = gid * 8, gsz = (nM - fm) < 8 ? (nM - fm) : 8;
    pm = fm + ((wgid % nig) % gsz); pn = (wgid % nig) / gsz; return true;
}

template <class Epi, class Sched>
__device__ __forceinline__ void gemm_phase(char* smem, const Sched& S, const Epi& E) {
    const int tid = tid_opaque(), lane = tid & 63, wid = __builtin_amdgcn_readfirstlane(tid >> 6), wm = wid >> 2, wn = wid & 3, r32 = lane & 31, h = lane >> 5;
    LAS char* lds = (LAS char*)smem;
    const int srow = tid >> 3, sc = tid & 7;
    const unsigned sts = (unsigned)(srow * 128 + ((sc ^ ((srow >> 1) & 7)) << 4));
    const unsigned rda = (unsigned)((wm * 128 + r32) * 128), rdb = (unsigned)(OPB + (wn * 64 + r32) * 128);
    const unsigned x7 = (unsigned)((r32 >> 1) & 7);
    Unit lu; int ci = 0, li = 0;
    if (!S.next(0, lu)) return;
    int cnk = lu.nk;
    constexpr int NA = Sched::GATHER ? 4 : 1;
    unsigned ao[NA], bo;
    auto offs = [&](const Unit& u, unsigned (&a)[NA], unsigned& b) {
        int t2 = tid; asm volatile("" : "+v"(t2));
        const int r0 = t2 >> 3, c16 = (t2 & 7) * 16;
        S.a_rows(u, r0, a);
#pragma unroll
        for (int q = 0; q < NA; ++q) a[q] += (unsigned)c16;
        b = (unsigned)(r0 * u.ldb * 2 + c16);
    };
    offs(lu, ao, bo);
    f32x16 acc[4][2];
#pragma unroll
    for (int i = 0; i < 4; ++i)
#pragma unroll
        for (int j = 0; j < 2; ++j)
#pragma unroll
            for (int e = 0; e < 16; ++e) acc[i][j][e] = 0.f;
    u32x4 ga[4], gb[4];
#define MM_GLOAD(u, k, A_, B_) do { \
        const __amdgpu_buffer_rsrc_t ra_ = __builtin_amdgcn_make_buffer_rsrc((void*)(u).a, 0, 0x7fffffff, 0x00020000); \
        const __amdgpu_buffer_rsrc_t rb_ = __builtin_amdgcn_make_buffer_rsrc((void*)((k) < (u).nseg ? (u).b0 : (u).b1), 0, 0x7fffffff, 0x00020000); \
        const unsigned ko_ = (unsigned)(k) * 128u, as_ = (unsigned)(u).lda * 128u, bs_ = (unsigned)(u).ldb * 128u; \
        _Pragma("unroll") for (int q_ = 0; q_ < 4; ++q_) { \
            ga[q_] = __builtin_bit_cast(u32x4, __builtin_amdgcn_raw_buffer_load_b128(ra_, Sched::GATHER ? (A_)[q_ % NA] : (A_)[0], Sched::GATHER ? ko_ : ko_ + q_ * as_, 0)); \
            gb[q_] = __builtin_bit_cast(u32x4, __builtin_amdgcn_raw_buffer_load_b128(rb_, (B_), ko_ + q_ * bs_, 0)); } } while (0)
#define MM_LSTORE(buf) do { LAS char* p_ = lds + (buf) * STG + sts; \
        _Pragma("unroll") for (int q_ = 0; q_ < 4; ++q_) { *(LAS u32x4*)(p_ + q_ * 8192) = ga[q_]; *(LAS u32x4*)(p_ + OPB + q_ * 8192) = gb[q_]; } } while (0)
#define MM_LOADF(ks, AF, BF) do { const unsigned xo_ = (((unsigned)((ks) * 2 + h)) ^ x7) << 4; \
        _Pragma("unroll") for (int nt = 0; nt < 2; ++nt) BF[nt] = *(const LAS bf16x8*)(base + rdb + nt * 4096 + xo_); \
        _Pragma("unroll") for (int mt = 0; mt < 4; ++mt) AF[mt] = *(const LAS bf16x8*)(base + rda + mt * 4096 + xo_); } while (0)
#define MM_MMA(AF, BF) do { _Pragma("unroll") for (int mt = 0; mt < 4; ++mt) _Pragma("unroll") for (int nt = 0; nt < 2; ++nt) \
        acc[mt][nt] = Epi::TRANSP ? __builtin_amdgcn_mfma_f32_32x32x16_bf16(BF[nt], AF[mt], acc[mt][nt], 0, 0, 0) : __builtin_amdgcn_mfma_f32_32x32x16_bf16(AF[mt], BF[nt], acc[mt][nt], 0, 0, 0); } while (0)
#define MM_SB __builtin_amdgcn_sched_barrier(0)
    bool lvalid = true; int lk = 0;
    auto ladv = [&]() {
        if (++lk < lu.nk) return;
        lk = 0;
        Unit nu; if (S.next(li + 1, nu)) { lu = nu; ++li; offs(lu, ao, bo); } else lvalid = false;
    };
    MM_GLOAD(lu, 0, ao, bo);
    MM_LSTORE(0);
    ladv();
    if (lvalid) MM_GLOAD(lu, lk, ao, bo);
    __syncthreads();
    int buf = 0, ck = 0;
    for (;;) {
        const LAS char* base = lds + buf * STG;
        const bool pend = lvalid;
        if constexpr (Sched::PIPE) {
            bf16x8 af0[4], bf0[2], af1[4], bf1[2];
            MM_LOADF(0, af0, bf0); MM_SB;
            MM_LOADF(1, af1, bf1); MM_SB; MM_MMA(af0, bf0); MM_SB;
            MM_LOADF(2, af0, bf0); MM_SB; MM_MMA(af1, bf1); MM_SB;
            MM_LOADF(3, af1, bf1); MM_SB;
            if (pend) { MM_LSTORE(buf ^ 1); ladv(); if (lvalid) MM_GLOAD(lu, lk, ao, bo); }
            MM_SB; MM_MMA(af0, bf0); MM_SB; MM_MMA(af1, bf1); MM_SB;
        } else {
            bf16x8 af0[4], bf0[2];
            MM_LOADF(0, af0, bf0); MM_MMA(af0, bf0); MM_SB;
            MM_LOADF(1, af0, bf0); MM_MMA(af0, bf0); MM_SB;
            if (pend) { MM_LSTORE(buf ^ 1); ladv(); if (lvalid) MM_GLOAD(lu, lk, ao, bo); }
            MM_SB; MM_LOADF(2, af0, bf0); MM_MMA(af0, bf0); MM_SB;
            MM_LOADF(3, af0, bf0); MM_MMA(af0, bf0); MM_SB;
        }
        bool more = true;
        if (++ck == cnk) {
            { PROF_BEGIN(99) Unit eu; S.next(ci, eu); E(acc, eu, wm, wn, r32, h, tid); if (PROF_ID == Epi::PROF && threadIdx.x == 0) { *(volatile LAS unsigned*)(lds + PROF_LDS_OFF) += (unsigned)(__builtin_amdgcn_s_memrealtime() - _pt99); } }
#pragma unroll
            for (int i = 0; i < 4; ++i)
#pragma unroll
                for (int j = 0; j < 2; ++j)
#pragma unroll
                    for (int e = 0; e < 16; ++e) acc[i][j][e] = 0.f;
            ck = 0; ++ci;
            { Unit nu2; more = S.next(ci, nu2); if (more) cnk = nu2.nk; }
        }
        __syncthreads();
        buf ^= 1;
        if (!more) break;
    }
#undef MM_GLOAD
#undef MM_LSTORE
#undef MM_LOADF
#undef MM_MMA
#undef MM_SB
}
__device__ __forceinline__ void plain_rows(const Unit& u, int r0, unsigned (&a)[1]) { a[0] = (unsigned)(r0 * u.lda * 2); }
}

constexpr int EPI_TAB = 131072 + 2048;
constexpr size_t WT_IN = 0;
constexpr size_t WT_GATE = WT_IN + (size_t)3328 * 1024 * 2;
constexpr size_t WT_BR = WT_GATE + (size_t)3072 * 1024 * 2;
constexpr size_t WT_OUT = WT_BR + (size_t)3 * 1024 * 512 * 2;
constexpr size_t WT_GU = WT_OUT + (size_t)1024 * 1024 * 2;
constexpr size_t WT_DN = WT_GU + (size_t)16 * 512 * 1024 * 2;
constexpr size_t WT_END = WT_DN + (size_t)16 * 1024 * 256 * 2;
static_assert(WT_END <= 44 * MB, "weight image region");

template <class F>
__device__ __forceinline__ void cvt_tile(bf16_t* Bt, int K, int rho0, int k0, const float* W, int ldw, const F& colof, int tid) {
    const int rho = rho0 + (tid & 63) * 4, kg = k0 + (tid >> 6) * 16;
    const int c = colof(rho);
    float4 v[16];
#pragma unroll
    for (int j = 0; j < 16; ++j) v[j] = c >= 0 ? *(const float4*)(W + (size_t)(kg + j) * ldw + c) : make_float4(0.f, 0.f, 0.f, 0.f);
#pragma unroll
    for (int hf = 0; hf < 2; ++hf) {
        mm::u32x4 o;
        o.x = mm::cvt_pk_bf16(v[8 * hf + 0].x, v[8 * hf + 1].x); o.y = mm::cvt_pk_bf16(v[8 * hf + 2].x, v[8 * hf + 3].x); o.z = mm::cvt_pk_bf16(v[8 * hf + 4].x, v[8 * hf + 5].x); o.w = mm::cvt_pk_bf16(v[8 * hf + 6].x, v[8 * hf + 7].x); *(mm::u32x4*)(Bt + (size_t)(rho + 0) * K + kg + 8 * hf) = o;
        o.x = mm::cvt_pk_bf16(v[8 * hf + 0].y, v[8 * hf + 1].y); o.y = mm::cvt_pk_bf16(v[8 * hf + 2].y, v[8 * hf + 3].y); o.z = mm::cvt_pk_bf16(v[8 * hf + 4].y, v[8 * hf + 5].y); o.w = mm::cvt_pk_bf16(v[8 * hf + 6].y, v[8 * hf + 7].y); *(mm::u32x4*)(Bt + (size_t)(rho + 1) * K + kg + 8 * hf) = o;
        o.x = mm::cvt_pk_bf16(v[8 * hf + 0].z, v[8 * hf + 1].z); o.y = mm::cvt_pk_bf16(v[8 * hf + 2].z, v[8 * hf + 3].z); o.z = mm::cvt_pk_bf16(v[8 * hf + 4].z, v[8 * hf + 5].z); o.w = mm::cvt_pk_bf16(v[8 * hf + 6].z, v[8 * hf + 7].z); *(mm::u32x4*)(Bt + (size_t)(rho + 2) * K + kg + 8 * hf) = o;
        o.x = mm::cvt_pk_bf16(v[8 * hf + 0].w, v[8 * hf + 1].w); o.y = mm::cvt_pk_bf16(v[8 * hf + 2].w, v[8 * hf + 3].w); o.z = mm::cvt_pk_bf16(v[8 * hf + 4].w, v[8 * hf + 5].w); o.w = mm::cvt_pk_bf16(v[8 * hf + 6].w, v[8 * hf + 7].w); *(mm::u32x4*)(Bt + (size_t)(rho + 3) * K + kg + 8 * hf) = o;
    }
}
__device__ __forceinline__ void cvt_tile_pair(bf16_t* Bt, int K, int rho0, int k0, const float* W, int ldw, int tid) {
    const int rho = rho0 + (tid & 63) * 4, kg = k0 + (tid >> 6) * 16;
    const int nt = (rho >> 5) & 1, cb = (rho & ~63) + 2 * (rho & 31);
#pragma unroll
    for (int hf = 0; hf < 2; ++hf) {
        float va[8][4];
#pragma unroll
        for (int j = 0; j < 8; ++j) {
            const float4 lo = *(const float4*)(W + (size_t)(kg + 8 * hf + j) * ldw + cb), hi = *(const float4*)(W + (size_t)(kg + 8 * hf + j) * ldw + cb + 4);
            va[j][0] = nt ? lo.y : lo.x; va[j][1] = nt ? lo.w : lo.z; va[j][2] = nt ? hi.y : hi.x; va[j][3] = nt ? hi.w : hi.z;
        }
#pragma unroll
        for (int r = 0; r < 4; ++r) {
            mm::u32x4 o;
            o.x = mm::cvt_pk_bf16(va[0][r], va[1][r]); o.y = mm::cvt_pk_bf16(va[2][r], va[3][r]); o.z = mm::cvt_pk_bf16(va[4][r], va[5][r]); o.w = mm::cvt_pk_bf16(va[6][r], va[7][r]);
            *(mm::u32x4*)(Bt + (size_t)(rho + r) * K + kg + 8 * hf) = o;
        }
    }
}
__device__ __forceinline__ void ph_convert_weights(const Params& P_, int l) {
    const KA P = ka_get();
    const int tid = tid_opaque();
    char* wt = P.ws + OFF_WT;
    constexpr int T_IN = 13 * 8, T_GATE = 12 * 8, T_BR = 3 * 4 * 4, T_OUT = 4 * 8, T_GU = 16 * 2 * 8, T_DN = 16 * 4 * 2;
    constexpr int T_ALL = T_IN + T_GATE + T_BR + T_OUT + T_GU + T_DN;
    for (int t = blockIdx.x; t < T_ALL; t += gridDim.x) {
        int u = t;
        if (u < T_IN) {
            const float* W = P.in[I_WIN] + (size_t)l * ND * IN_COLS;
            cvt_tile((bf16_t*)(wt + WT_IN), 1024, (u >> 3) * 256, (u & 7) * 128, W, IN_COLS, [&](int rho) -> int { const int c = mm::img_col(rho); return c < IN_COLS ? c : -1; }, tid);
            continue;
        }
        u -= T_IN;
        if (u < T_GATE) {
            const float* W = P.in[I_WGATE] + (size_t)l * ND * 3072;
            cvt_tile((bf16_t*)(wt + WT_GATE), 1024, (u >> 3) * 256, (u & 7) * 128, W, 3072, [&](int rho) -> int { return mm::img_col(rho); }, tid);
            continue;
        }
        u -= T_GATE;
        if (u < T_BR) {
            const int n = u / 16, v = u % 16;
            const float* W = P.in[I_WBR] + ((size_t)l * 3 + n) * 512 * ND;
            cvt_tile((bf16_t*)(wt + WT_BR) + (size_t)n * 1024 * 512, 512, (v >> 2) * 256, (v & 3) * 128, W, ND, [&](int rho) -> int { return mm::img_col(rho); }, tid);
            continue;
        }
        u -= T_BR;
        if (u < T_OUT) {
            const float* W = P.in[I_WOUT] + (size_t)l * ND * ND;
            cvt_tile_pair((bf16_t*)(wt + WT_OUT), 1024, (u >> 3) * 256, (u & 7) * 128, W, ND, tid);
            continue;
        }
        u -= T_OUT;
        if (u < T_GU) {
            const int e = u / 16, v = u % 16;
            const float* Wg = P.in[I_WFG] + ((size_t)l * 16 + e) * ND * 256;
            const float* Wu = P.in[I_WFU] + ((size_t)l * 16 + e) * ND * 256;
            const int rho0 = (v >> 3) * 256;
            const float* Wsel = (((rho0 + (tid & 63) * 4) >> 5) & 1) ? Wu : Wg;
            cvt_tile((bf16_t*)(wt + WT_GU) + (size_t)e * 512 * 1024, 1024, rho0, (v & 7) * 128, Wsel, 256, [&](int rho) -> int {
                const int j = rho >> 8, wn = (rho >> 6) & 3; return j * 128 + wn * 32 + (mm::img_col(rho) & 31); }, tid);
            continue;
        }
        u -= T_GU;
        {
            const int e = u / 8, v = u % 8;
            const float* W = P.in[I_WFD] + ((size_t)l * 16 + e) * 256 * ND;
            cvt_tile_pair((bf16_t*)(wt + WT_DN) + (size_t)e * 1024 * 256, 256, (v >> 1) * 256, (v & 1) * 128, W, ND, tid);
        }
    }
}

struct SchedInProj {
    const char* A; const char* B; int mode;
    __device__ __forceinline__ bool next(int i, mm::Unit& u) const {
        int pm, pn; if (!mm::static_tile((long)i * gridDim.x + VBID, 128, 13, pm, pn)) return false;
        u.a = A + (size_t)pm * 256 * 1024 * 2; u.b0 = B + (size_t)pn * 256 * 1024 * 2; u.b1 = u.b0; u.lda = 1024; u.ldb = 1024; u.nk = 16; u.nseg = 16; u.pm = pm; u.pn = pn; u.tag = mode; return true;
    }
    static constexpr bool GATHER = false, PIPE = true;
    __device__ __forceinline__ void a_rows(const mm::Unit& u, int r0, unsigned (&a)[1]) const { mm::plain_rows(u, r0, a); }
};
struct EpiInProj {
    static constexpr bool TRANSP = true;
    static constexpr int PROF = 2;
    Proj pj; const float* qkg; const LAS float* gtab;
    __device__ __forceinline__ void operator()(mm::f32x16 (&acc)[4][2], const mm::Unit& u, int wm, int wn, int r32, int h, int tid) const {
        using namespace mm;
        asm volatile("" : "+v"(r32), "+v"(h));
        const int G = u.pn * 4 + wn;
        if (u.tag == 4) { if (acc[0][0][0] == 12345.678f) pj.aq[0] = 0; return; }
        if (u.tag == 3) { float t_ = 0.f;
#pragma unroll
            for (int i_ = 0; i_ < 4; ++i_) { t_ += acc[i_][0][3] + acc[i_][1][11] + acc[i_][0][7] + acc[i_][1][0]; }
            if (t_ == 12345.678f) pj.aq[0] = 0; return; }
        if (G > 48) return;
        bf16_t* dst; int tstride; const float* gv = nullptr; float sc = 1.f;
        if (G < 8) { dst = pj.aq + G * 64; tstride = 512; gv = qkg; sc = QSCALE; }
        else if (G < 16) { dst = pj.ak + (G - 8) * 64; tstride = 512; gv = qkg + 64; }
        else if (G < 24) { dst = pj.av + (G - 16) * 64; tstride = 512; }
        else if (G < 32) { dst = pj.bq + (G - 24) * 64; tstride = 512; gv = qkg + 128; sc = QSCALE; }
        else if (G < 34) { dst = pj.bk + (G - 32) * 64; tstride = 128; gv = qkg + 192; }
        else if (G < 36) { dst = pj.bv + (G - 34) * 64; tstride = 128; }
        else if (G < 44) { dst = pj.cq + (G - 36) * 64; tstride = 512; gv = qkg + 256; sc = QSCALE; }
        else if (G == 44) { dst = pj.ck; tstride = 64; gv = qkg + 320; }
        else if (G == 45) { dst = pj.cv; tstride = 64; }
        else if (G < 48) { dst = pj.iq + (G - 46) * 64; tstride = 128; }
        else { dst = pj.ik; tstride = 32; }
        if (u.tag == 8) { if (acc[0][0][0] == 12345.678f) dst[tstride] = 0; return; }
#pragma unroll 1
        for (int rep = 0; rep < (u.tag == 9 ? 4 : 1); ++rep)
#pragma unroll
        for (int mt = 0; mt < 4; ++mt) {
            asm volatile("" ::: "memory");
            const int row = u.pm * 256 + wm * 128 + mt * 32 + r32;
            f32x16& v0 = acc[mt][0]; f32x16& v1 = acc[mt][1];
            if (gv && u.tag != 7 && u.tag != 9) {
                float ss = 0.f;
#pragma unroll
                for (int e = 0; e < 16; ++e) ss += v0[e] * v0[e] + v1[e] * v1[e];
                ss = x32_sum(ss);
                const float rs = rsqrtf(ss * (1.0f / 64) + EPS) * sc;
#pragma unroll
                for (int e4 = 0; e4 < 4; ++e4) {
                    const f32x4 ga = *(const LAS f32x4*)(gtab + (gv - qkg) + 16 * h + 4 * e4), gb = *(const LAS f32x4*)(gtab + (gv - qkg) + 32 + 16 * h + 4 * e4);
#pragma unroll
                    for (int j = 0; j < 4; ++j) { v0[4 * e4 + j] *= rs * ga[j]; v1[4 * e4 + j] *= rs * gb[j]; }
                }
            }
            if (u.tag >= 5) { if (v0[0] + v1[3] + v0[9] + v1[12] == 12345.678f) dst[0] = 0; }
            else if (G < 48) {
                bf16_t* d = dst + (size_t)row * tstride + 16 * h;
                *(u32x4*)(d) = pack8(v0, 0); *(u32x4*)(d + 8) = pack8(v0, 8);
                *(u32x4*)(d + 32) = pack8(v1, 0); *(u32x4*)(d + 40) = pack8(v1, 8);
            } else {
                bf16_t* d = dst + (size_t)row * 32 + 16 * h;
                *(u32x4*)(d) = pack8(v0, 0); *(u32x4*)(d + 8) = pack8(v0, 8);
                if (h == 0) *(f32x4*)(pj.iw + (size_t)row * 4) = (f32x4){v1[0], v1[1], v1[2], v1[3]} * IWSCALE;
            }
        }
    }
};
__device__ __forceinline__ void ph_inproj(const Params& P_, int l, char* smem) {
    const KA P = ka_get();
    SchedInProj S; S.A = P.ws + OFF_H; S.B = P.ws + OFF_WT + WT_IN; S.mode = l >> 4;
    EpiInProj E; E.pj = proj_ptrs(P.ws); E.qkg = P.in[I_QKG] + (size_t)(l & 15) * 384;
    { LAS float* gt = (LAS float*)((LAS char*)smem + EPI_TAB); __syncthreads(); const int t = tid_opaque(); if (t < 384) gt[t] = E.qkg[t]; __syncthreads(); E.gtab = gt; }
    mm::gemm_phase(smem, S, E);
}

constexpr size_t SCR_G = OFF_PROJ;
constexpr size_t SCR_M = OFF_PROJ + 32 * MB;
struct SchedGB {
    const char* H; const char* BR; const char* Wg; const char* Wb;
    __device__ __forceinline__ bool next(int i, mm::Unit& u) const {
        const int ti = i / 6, sub = i - ti * 6, n = sub >> 1;
        int pm, pn; if (!mm::static_tile((long)ti * gridDim.x + VBID, 128, 4, pm, pn)) return false;
        u.pm = pm; u.pn = pn; u.tag = sub;
        if ((sub & 1) == 0) { u.a = H + (size_t)pm * 256 * 1024 * 2; u.lda = 1024; u.b0 = Wg + (size_t)(n * 1024 + pn * 256) * 1024 * 2; u.ldb = 1024; u.nk = 16; }
        else { u.a = BR + ((size_t)pm * 256 * 1536 + n * 512) * 2; u.lda = 1536; u.b0 = Wb + ((size_t)n * 1024 + pn * 256) * 512 * 2; u.ldb = 512; u.nk = 8; }
        u.b1 = u.b0; u.nseg = u.nk; return true;
    }
    static constexpr bool GATHER = false, PIPE = true;
    __device__ __forceinline__ void a_rows(const mm::Unit& u, int r0, unsigned (&a)[1]) const { mm::plain_rows(u, r0, a); }
};
struct EpiGB {
    static constexpr bool TRANSP = true;
    static constexpr int PROF = 4;
    const LAS float* btab; bf16_t* MG; char* scrg; char* scrm;
    __device__ __forceinline__ void operator()(mm::f32x16 (&acc)[4][2], const mm::Unit& u, int wm, int wn, int r32, int h, int tid) const {
        using namespace mm;
        asm volatile("" : "+v"(r32), "+v"(h), "+v"(tid));
        const int sub = u.tag, n = sub >> 1;
        const unsigned so0 = (unsigned)tid * 16u;
        if ((sub & 1) == 0) {
#pragma unroll
            for (int mt = 0; mt < 4; ++mt)
#pragma unroll
                for (int nt = 0; nt < 2; ++nt) {
                    f32x16& v = acc[mt][nt];
                    const int col = n * 1024 + u.pn * 256 + wn * 64 + nt * 32 + 16 * h;
#pragma unroll
                    for (int e4 = 0; e4 < 4; ++e4) { const f32x4 b = *(const LAS f32x4*)(btab + col + 4 * e4);
#pragma unroll
                        for (int j = 0; j < 4; ++j) v[4 * e4 + j] = __builtin_amdgcn_rcpf(1.f + __builtin_amdgcn_exp2f(__builtin_fmaf(v[4 * e4 + j], -LOG2E, b[j]))); }
                    const unsigned so = so0 + (unsigned)((mt * 2 + nt) * 2) * 8192u;
                    *(u32x4*)(scrg + so) = pack8(v, 0); *(u32x4*)(scrg + so + 8192) = pack8(v, 8);
                }
        } else {
#pragma unroll
            for (int hf = 0; hf < 4; ++hf) {
                const int mt = hf;
                {
                    u32x4 gq[2][2];
#pragma unroll
                    for (int c = 0; c < 2; ++c) { const unsigned so = so0 + (unsigned)((hf * 2 + c) * 2) * 8192u; gq[c][0] = *(const u32x4*)(scrg + so); gq[c][1] = *(const u32x4*)(scrg + so + 8192); }
#pragma unroll
                    for (int c = 0; c < 2; ++c) {
                        f32x16& v = acc[mt][c];
                        const unsigned gw[8] = {gq[c][0].x, gq[c][0].y, gq[c][0].z, gq[c][0].w, gq[c][1].x, gq[c][1].y, gq[c][1].z, gq[c][1].w};
#pragma unroll
                        for (int j = 0; j < 8; ++j) { v[2 * j] *= bflo(gw[j]); v[2 * j + 1] *= bfhi(gw[j]); }
                    }
                }
                if (n > 0) {
                    u32x4 mq[2][2];
#pragma unroll
                    for (int c = 0; c < 2; ++c) { const unsigned so = so0 + (unsigned)((hf * 2 + c) * 2) * 8192u; mq[c][0] = *(const u32x4*)(scrm + so); mq[c][1] = *(const u32x4*)(scrm + so + 8192); }
#pragma unroll
                    for (int c = 0; c < 2; ++c) {
                        f32x16& v = acc[mt][c];
                        const unsigned mw[8] = {mq[c][0].x, mq[c][0].y, mq[c][0].z, mq[c][0].w, mq[c][1].x, mq[c][1].y, mq[c][1].z, mq[c][1].w};
#pragma unroll
                        for (int j = 0; j < 8; ++j) { v[2 * j] += bflo(mw[j]); v[2 * j + 1] += bfhi(mw[j]); }
                    }
                }
#pragma unroll
                for (int c = 0; c < 2; ++c) {
                    f32x16& v = acc[mt][c];
                    const unsigned so = so0 + (unsigned)((hf * 2 + c) * 2) * 8192u;
                    if (n < 2) { *(u32x4*)(scrm + so) = pack8(v, 0); *(u32x4*)(scrm + so + 8192) = pack8(v, 8); }
                    else { bf16_t* d = MG + (size_t)(u.pm * 256 + wm * 128 + mt * 32 + r32) * ND + u.pn * 256 + wn * 64 + c * 32 + 16 * h; *(u32x4*)d = pack8(v, 0); *(u32x4*)(d + 8) = pack8(v, 8); }
                }
            }
        }
    }
};
__device__ __forceinline__ void ph_gatebranch(const Params& P_, int l, char* smem) {
    const KA P = ka_get();
    SchedGB S; S.H = P.ws + OFF_H; S.BR = P.ws + OFF_BR; S.Wg = P.ws + OFF_WT + WT_GATE; S.Wb = P.ws + OFF_WT + WT_BR;
    EpiGB E; E.MG = (bf16_t*)(P.ws + OFF_MERGED);
    { LAS float* bt = (LAS float*)((LAS char*)smem + EPI_TAB); const float* bg = P.in[I_BGATE] + (size_t)l * 3072; __syncthreads(); for (int t = tid_opaque(); t < 3072; t += 512) bt[t] = -bg[t] * LOG2E; __syncthreads(); E.btab = bt; }
    E.scrg = P.ws + SCR_G + (size_t)blockIdx.x * 131072; E.scrm = P.ws + SCR_M + (size_t)blockIdx.x * 131072;
    mm::gemm_phase(smem, S, E);
}

struct SchedOut {
    const char* A; const char* B;
    __device__ __forceinline__ bool next(int i, mm::Unit& u) const {
        int pm, pn; if (!mm::static_tile((long)i * gridDim.x + VBID, 128, 4, pm, pn)) return false;
        u.a = A + (size_t)pm * 256 * 1024 * 2; u.b0 = B + (size_t)pn * 256 * 1024 * 2; u.b1 = u.b0; u.lda = 1024; u.ldb = 1024; u.nk = 16; u.nseg = 16; u.pm = pm; u.pn = pn; u.tag = 0; return true;
    }
    static constexpr bool GATHER = false, PIPE = true;
    __device__ __forceinline__ void a_rows(const mm::Unit& u, int r0, unsigned (&a)[1]) const { mm::plain_rows(u, r0, a); }
};
struct EpiOut {
    static constexpr bool TRANSP = false;
    static constexpr int PROF = 17;
    const float* x32; bf16_t* st;
    __device__ __forceinline__ void operator()(mm::f32x16 (&acc)[4][2], const mm::Unit& u, int wm, int wn, int r32, int h, int tid) const {
        using namespace mm;
        asm volatile("" : "+v"(r32), "+v"(h));
#pragma unroll
        for (int mt = 0; mt < 4; ++mt)
#pragma unroll
            for (int eh = 0; eh < 2; ++eh) {
                const size_t off = (size_t)(u.pm * 256 + wm * 128 + mt * 32 + 4 * h + 16 * eh) * ND + u.pn * 256 + wn * 64 + 2 * r32;
                float xa[8], xb[8];
                if (x32) {
#pragma unroll
                    for (int e = 0; e < 8; ++e) { const float2 t = *(const float2*)(x32 + off + (size_t)((e & 3) + 8 * (e >> 2)) * ND); xa[e] = t.x; xb[e] = t.y; }
                } else {
#pragma unroll
                    for (int e = 0; e < 8; ++e) { const unsigned w = *(const unsigned*)(st + off + (size_t)((e & 3) + 8 * (e >> 2)) * ND); xa[e] = bflo(w); xb[e] = bfhi(w); }
                }
#pragma unroll
                for (int e = 0; e < 8; ++e) *(unsigned*)(st + off + (size_t)((e & 3) + 8 * (e >> 2)) * ND) = cvt_pk_bf16(xa[e] + acc[mt][0][8 * eh + e], xb[e] + acc[mt][1][8 * eh + e]);
            }
    }
};
__device__ __forceinline__ void ph_outproj(const Params& P_, int l, char* smem) {
    const KA P = ka_get();
    SchedOut S; S.A = P.ws + OFF_MERGED; S.B = P.ws + OFF_WT + WT_OUT;
    EpiOut E; E.x32 = l == 0 ? P.in[I_X] : (const float*)nullptr; E.st = (bf16_t*)(P.ws + OFF_STREAM);
    mm::gemm_phase(smem, S, E);
}


constexpr size_t OFF_HID = OFF_PROJ + 64 * MB;
constexpr int MOE_TAB = 131072 + 1024;
__device__ __forceinline__ void moe_table(char* smem, const int* cnt) {
    int* tab = (int*)(smem + MOE_TAB);
    const int t = tid_opaque();
    __syncthreads();
    if (t < 24) tab[32 + t] = cnt[t];
    __syncthreads();
    if (t == 0) { int p = 0; for (int b = 0; b < 24; ++b) { tab[b] = p; p += (tab[32 + b] + 255) >> 8; } tab[24] = p; }
    __syncthreads();
    if (t < 160) { int b = 0; for (int i = 1; i < 24; ++i) if (tab[i] <= t) b = i; tab[64 + t] = b; }
    __syncthreads();
}
struct MoeLoc { int b, rt, slot, valid, elo, ehi; };
__device__ __forceinline__ int moe_tab(const int* tab, int i) { return __builtin_amdgcn_readfirstlane(tab[i]); }
__device__ __forceinline__ MoeLoc moe_locate(const int* tab, int T) {
    const int b = moe_tab(tab, 64 + T);
    MoeLoc m; m.b = b; m.rt = T - moe_tab(tab, b); m.slot = T * 256; const int c = moe_tab(tab, 32 + b) - m.rt * 256; m.valid = c < 256 ? c : 256;
    const int g = b / 6, ix = b - g * 6; const int lo = ix < 3 ? 0 : (ix < 5 ? 1 : 2), hi = ix < 3 ? ix + 1 : (ix < 5 ? ix - 1 : 3);
    m.elo = g * 4 + lo; m.ehi = g * 4 + hi; return m;
}
struct SchedMoeUp {
    static constexpr bool GATHER = true, PIPE = true;
    const char* H; const char* W; const int* tab; const int* list;
    __device__ __forceinline__ bool next(int i, mm::Unit& u) const {
        const long L = (long)i * gridDim.x + VBID; const int T = (int)(L >> 2), c = (int)(L & 3);
        if (T >= moe_tab(tab, 24)) return false;
        const MoeLoc m = moe_locate(tab, T);
        const int e = (c >> 1) ? m.ehi : m.elo, j = c & 1;
        u.a = H; u.lda = 1024; u.b0 = W + ((size_t)e * 512 + j * 256) * 1024 * 2; u.b1 = u.b0; u.ldb = 1024; u.nk = 16; u.nseg = 16;
        u.pm = T; u.pn = c; u.tag = c; u.aux0 = m.b * NTOK + m.rt * 256; u.aux1 = m.valid; return true;
    }
    __device__ __forceinline__ void a_rows(const mm::Unit& u, int r0, unsigned (&a)[4]) const {
#pragma unroll
        for (int q = 0; q < 4; ++q) { const int r = r0 + 64 * q; const int tok = list[u.aux0 + (r < u.aux1 ? r : 0)]; a[q] = (unsigned)tok * 2048u; }
    }
};
struct EpiMoeUp {
    static constexpr bool TRANSP = true;
    static constexpr int PROF = 18;
    bf16_t* hid; const int* list; const float* rw;
    __device__ __forceinline__ void operator()(mm::f32x16 (&acc)[4][2], const mm::Unit& u, int wm, int wn, int r32, int h, int tid) const {
        using namespace mm;
        asm volatile("" : "+v"(r32), "+v"(h));
        const int which = u.tag >> 1, j = u.tag & 1;
        int tok[4]; float w[4];
#pragma unroll
        for (int mt = 0; mt < 4; ++mt) { const int r = wm * 128 + mt * 32 + r32; tok[mt] = list[u.aux0 + (r < u.aux1 ? r : 0)]; }
#pragma unroll
        for (int mt = 0; mt < 4; ++mt) w[mt] = rw[tok[mt] * 2 + which];
#pragma unroll
        for (int mt = 0; mt < 4; ++mt) {
            const int r = wm * 128 + mt * 32 + r32;
            if (r < u.aux1) {
                f32x16& g = acc[mt][0]; const f32x16& up = acc[mt][1];
#pragma unroll
                for (int e = 0; e < 16; ++e) g[e] = g[e] * __builtin_amdgcn_rcpf(1.f + __builtin_amdgcn_exp2f(g[e] * -LOG2E)) * (up[e] * w[mt]);
                bf16_t* d = hid + (size_t)(u.pm * 256 + r) * 512 + which * 256 + j * 128 + wn * 32 + 16 * h;
                *(u32x4*)d = pack8(g, 0); *(u32x4*)(d + 8) = pack8(g, 8);
            }
        }
    }
};
struct SchedMoeDown {
    static constexpr bool GATHER = false, PIPE = true;
    const char* HID; const char* W; const int* tab;
    __device__ __forceinline__ bool next(int i, mm::Unit& u) const {
        const long L = (long)i * gridDim.x + VBID; const int T = (int)(L >> 2), c = (int)(L & 3);
        if (T >= moe_tab(tab, 24)) return false;
        const MoeLoc m = moe_locate(tab, T);
        u.a = HID + (size_t)T * 256 * 512 * 2; u.lda = 512; u.ldb = 256; u.nk = 8; u.nseg = 4;
        u.b0 = W + ((size_t)m.elo * 1024 + c * 256) * 256 * 2; u.b1 = W + ((size_t)m.ehi * 1024 + c * 256) * 256 * 2 - 4 * 128;
        u.pm = T; u.pn = c; u.tag = 0; u.aux0 = m.b * NTOK + m.rt * 256; u.aux1 = m.valid; return true;
    }
    __device__ __forceinline__ void a_rows(const mm::Unit& u, int r0, unsigned (&a)[1]) const { mm::plain_rows(u, r0, a); }
};
struct EpiMoeDown {
    static constexpr bool TRANSP = false;
    static constexpr int PROF = 19;
    bf16_t* st; float* out32; const int* list;
    __device__ __forceinline__ void operator()(mm::f32x16 (&acc)[4][2], const mm::Unit& u, int wm, int wn, int r32, int h, int tid) const {
        using namespace mm;
        asm volatile("" : "+v"(r32), "+v"(h));
        const int col = u.pn * 256 + wn * 64 + 2 * r32;
#pragma unroll
        for (int mt = 0; mt < 4; ++mt)
#pragma unroll
            for (int eh = 0; eh < 2; ++eh) {
                asm volatile("" ::: "memory");
                const int rb = wm * 128 + mt * 32 + 4 * h + 16 * eh;
                int tok[8];
#pragma unroll
                for (int e = 0; e < 8; ++e) { const int r = rb + (e & 3) + 8 * (e >> 2); tok[e] = list[u.aux0 + (r < u.aux1 ? r : 0)]; }
                unsigned xv[8];
#pragma unroll
                for (int e = 0; e < 8; ++e) xv[e] = *(const unsigned*)(st + (size_t)tok[e] * ND + col);
#pragma unroll
                for (int e = 0; e < 8; ++e) {
                    const int r = rb + (e & 3) + 8 * (e >> 2);
                    if (r < u.aux1) {
                        const float a = bflo(xv[e]) + acc[mt][0][8 * eh + e], b = bfhi(xv[e]) + acc[mt][1][8 * eh + e];
                        if (out32) { float2 o; o.x = a; o.y = b; *(float2*)(out32 + (size_t)tok[e] * ND + col) = o; }
                        else *(unsigned*)(st + (size_t)tok[e] * ND + col) = cvt_pk_bf16(a, b);
                    }
                }
            }
    }
};
__device__ __forceinline__ void ph_moe_up(const Params& P_, int l, char* smem) {
    const KA P = ka_get();
    moe_table(smem, (const int*)(P.ws + OFF_CTRL + MOE_CNT_OFF) + l * 32);
    SchedMoeUp S; S.H = P.ws + OFF_H; S.W = P.ws + OFF_WT + WT_GU; S.tab = (const int*)(smem + MOE_TAB); S.list = (const int*)(P.ws + OFF_ROUTE + MOE_LIST_OFF);
    EpiMoeUp E; E.hid = (bf16_t*)(P.ws + OFF_HID); E.list = S.list; E.rw = (const float*)(P.ws + OFF_ROUTE + MOE_RW_OFF);
    mm::gemm_phase(smem, S, E);
}
__device__ __forceinline__ void ph_moe_down(const Params& P_, int l, char* smem) {
    const KA P = ka_get();
    moe_table(smem, (const int*)(P.ws + OFF_CTRL + MOE_CNT_OFF) + l * 32);
    SchedMoeDown S; S.HID = P.ws + OFF_HID; S.W = P.ws + OFF_WT + WT_DN; S.tab = (const int*)(smem + MOE_TAB);
    EpiMoeDown E; E.st = (bf16_t*)(P.ws + OFF_STREAM); E.out32 = l == 1 ? P.out : (float*)nullptr; E.list = (const int*)(P.ws + OFF_ROUTE + MOE_LIST_OFF);
    mm::gemm_phase(smem, S, E);
}


namespace at {
typedef short bf16x8 __attribute__((ext_vector_type(8)));
typedef short s16x4 __attribute__((ext_vector_type(4)));
typedef float f32x16 __attribute__((ext_vector_type(16)));
typedef unsigned u32x4 __attribute__((ext_vector_type(4)));
typedef unsigned u32x2 __attribute__((ext_vector_type(2)));
__device__ __forceinline__ s16x4 tr_read(const LAS char* p) { return __builtin_bit_cast(s16x4, __builtin_amdgcn_ds_read_tr16_b64_v4i16((LAS s16x4*)p)); }
__device__ __forceinline__ unsigned cvtpk(float lo, float hi) { unsigned r; asm volatile("v_cvt_pk_bf16_f32 %0, %1, %2" : "=v"(r) : "v"(lo), "v"(hi)); return r; }
__device__ __forceinline__ bf16x8 pack_p(const f32x16& x, int s) { u32x4 w; w.x = cvtpk(x[8 * s], x[8 * s + 1]); w.y = cvtpk(x[8 * s + 2], x[8 * s + 3]); w.z = cvtpk(x[8 * s + 4], x[8 * s + 5]); w.w = cvtpk(x[8 * s + 6], x[8 * s + 7]); return __builtin_bit_cast(bf16x8, w); }
constexpr int A_TAB = 81920;
}
__device__ __forceinline__ void ph_attnA(const Params& P_, int l, char* smem) {
    using namespace at;
    const KA P = ka_get();
    const Proj pj = proj_ptrs(P.ws);
    bf16_t* BR = (bf16_t*)(P.ws + OFF_BR);
    const int tid = tid_opaque(), lane = tid & 63, wid = __builtin_amdgcn_readfirstlane(tid >> 6), m = wid >> 2, qs = wid & 3, r32 = lane & 31, hl = lane >> 5;
    LAS char* lds = (LAS char*)smem;
    LAS float* tb = (LAS float*)(lds + A_TAB);
    const float* lp = P.in[I_LAM] + (size_t)l * 256;
    const float linit = lambda_init_of(l);
    const float lam = expf(wsum(lp[lane] * lp[64 + lane])) - expf(wsum(lp[128 + lane] * lp[192 + lane])) + linit;
    const float* subg = P.in[I_SUBLN] + (size_t)l * 128;
    const float* relb = P.in[I_RELB];
    LAS float* rb4 = (LAS float*)(lds + A_TAB + 4160 * 4);
    __syncthreads();
    if (tid < 128) rb4[tid] = relb[(tid >> 2) * 20 + (tid & 3)] * LOG2E;
    __syncthreads();
    const int i16 = lane & 15, tq = i16 >> 2, tp = i16 & 3, blk = (lane >> 4) & 1;
    const unsigned vlane = (unsigned)((4 * hl + tq) * 64 + blk * 32 + tp * 8);
    const unsigned klane = (unsigned)(m * 8192 + r32 * 128), kx = (unsigned)((r32 >> 1) & 7);
    for (int u2 = blockIdx.x; u2 < 1024; u2 += gridDim.x) {
        const int Pp = u2 & 511;
        const int bh = Pp >> 4, jj = Pp & 15, qb = (u2 >> 9) ? 31 - jj : jj, b = bh >> 2, h = bh & 3;
        const int q0 = qb * 128 + qs * 32, nt_wg = 2 * qb + 2, nt_w = (q0 >> 6) + 1;
        __syncthreads();
#pragma unroll
        for (int it = 0; it < 9; ++it) { const int i = tid + 512 * it; if (i < 4160) { const int rel = i - 4095; tb[i] = rel <= 63 ? rb4[t5_bucket(rel) * 4 + h] : 0.f; } }
        const float bfar = rb4[15 * 4 + h];
        bf16x8 qf[4];
        { const bf16_t* qp = pj.aq + (size_t)(b * NS + q0 + r32) * 512 + (h * 2 + m) * 64 + 8 * hl;
#pragma unroll
          for (int ks = 0; ks < 4; ++ks) qf[ks] = *(const bf16x8*)(qp + ks * 16); }
        u32x4 gk[2], gv[2];
        const bf16_t* kg = pj.ak + (size_t)(b * NS) * 512 + h * 128;
        const bf16_t* vg = pj.av + (size_t)(b * NS) * 512 + h * 128;
        unsigned gofs[2], kst[2], vst[2];
#pragma unroll
        for (int i = 0; i < 2; ++i) { const int idx = tid + 512 * i, key = idx >> 4, c = idx & 15;
            gofs[i] = (unsigned)(key * 512 + c * 8) * 2u;
            kst[i] = (unsigned)((c >> 3) * 8192 + key * 128 + (((c & 7) ^ ((key >> 1) & 7)) << 4));
            vst[i] = (unsigned)((c >> 2) * 4096 + key * 64 + (c & 3) * 16); }
#define AT_GLOAD(kt) do { const size_t o_ = (size_t)(kt) * 64 * 512 * 2; _Pragma("unroll") for (int i_ = 0; i_ < 2; ++i_) { gk[i_] = *(const u32x4*)((const char*)kg + o_ + gofs[i_]); gv[i_] = *(const u32x4*)((const char*)vg + o_ + gofs[i_]); } } while (0)
#define AT_LSTORE(kslot, vslot) do { _Pragma("unroll") for (int i_ = 0; i_ < 2; ++i_) { *(LAS u32x4*)(lds + (kslot) * 16384 + kst[i_]) = gk[i_]; *(LAS u32x4*)(lds + 32768 + (vslot) * 16384 + vst[i_]) = gv[i_]; } } while (0)
        AT_GLOAD(0); AT_LSTORE(0, 0);
        __syncthreads();
        f32x16 O[4];
#pragma unroll
        for (int v = 0; v < 4; ++v)
#pragma unroll
            for (int e = 0; e < 16; ++e) O[v][e] = 0.f;
        float mrun = -INFINITY, lsum = 0.f;
        bf16x8 pp[2][2];
        int vs_prev = 0, vs_cur = 0, vs_next = 1;
        for (int kt = 0; kt <= nt_wg; ++kt) {
            if (kt + 1 < nt_wg) AT_GLOAD(kt + 1);
            f32x16 s0, s1;
            const bool doqk = kt < nt_w, dopv = kt >= 1 && kt - 1 < nt_w;
            if (doqk) {
                const LAS char* kb = lds + (kt & 1) * 16384 + klane;
                if (kt * 64 + 63 - q0 <= -559) {
#pragma unroll
                    for (int e = 0; e < 16; ++e) { s0[e] = bfar; s1[e] = bfar; }
                } else {
                    const LAS float* tl = tb + (kt * 64 - q0 - r32 + 4 * hl + 4095);
#pragma unroll
                    for (int e = 0; e < 16; ++e) { s0[e] = tl[(e & 3) + 8 * (e >> 2)]; s1[e] = tl[32 + (e & 3) + 8 * (e >> 2)]; }
                }
#pragma unroll
                for (int ks = 0; ks < 4; ++ks) {
                    const unsigned xo = (((unsigned)(ks * 2 + hl)) ^ kx) << 4;
                    const bf16x8 k0 = *(const LAS bf16x8*)(kb + xo), k1 = *(const LAS bf16x8*)(kb + 4096 + xo);
                    s0 = __builtin_amdgcn_mfma_f32_32x32x16_bf16(k0, qf[ks], s0, 0, 0, 0);
                    s1 = __builtin_amdgcn_mfma_f32_32x32x16_bf16(k1, qf[ks], s1, 0, 0, 0);
                }
            }
            if (dopv) {
                const LAS char* vb = lds + 32768 + vs_prev * 16384 + vlane;
#pragma unroll
                for (int sub = 0; sub < 2; ++sub)
#pragma unroll
                    for (int s = 0; s < 2; ++s) {
                        const LAS char* vk = vb + (sub * 32 + 16 * s) * 64;
#pragma unroll
                        for (int v = 0; v < 4; ++v) {
                            const s16x4 lo = tr_read(vk + v * 4096), hi = tr_read(vk + v * 4096 + 8 * 64);
                            const bf16x8 vf = __builtin_shufflevector(lo, hi, 0, 1, 2, 3, 4, 5, 6, 7);
                            O[v] = __builtin_amdgcn_mfma_f32_32x32x16_bf16(vf, pp[sub][s], O[v], 0, 0, 0);
                        }
                    }
            }
            __builtin_amdgcn_sched_barrier(0);
            if (doqk) {
                float mx = __builtin_fmaxf(__builtin_fmaxf(s0[0], s1[0]), __builtin_fmaxf(s0[1], s1[1]));
#pragma unroll
                for (int e = 2; e < 16; e += 2) mx = __builtin_fmaxf(__builtin_fmaxf(mx, s0[e]), __builtin_fmaxf(__builtin_fmaxf(s1[e], s0[e + 1]), s1[e + 1]));
                mx = x32_max(mx);
                const float mn = fmaxf(mrun, mx);
                float ps0 = 0.f, ps1 = 0.f;
#pragma unroll
                for (int e = 0; e < 16; ++e) { s0[e] = __builtin_amdgcn_exp2f(s0[e] - mn); s1[e] = __builtin_amdgcn_exp2f(s1[e] - mn); ps0 += s0[e]; ps1 += s1[e]; }
                if (__any(mn > mrun)) {
                    const float alpha = __builtin_amdgcn_exp2f(mrun - mn);
                    lsum *= alpha;
#pragma unroll
                    for (int v = 0; v < 4; ++v)
#pragma unroll
                        for (int e = 0; e < 16; ++e) O[v][e] *= alpha;
                }
                mrun = mn;
                lsum += ps0 + ps1;
                pp[0][0] = pack_p(s0, 0); pp[0][1] = pack_p(s0, 1); pp[1][0] = pack_p(s1, 0); pp[1][1] = pack_p(s1, 1);
            }
            if (kt + 1 < nt_wg) AT_LSTORE((kt + 1) & 1, vs_next);
            __syncthreads();
            vs_prev = vs_cur; vs_cur = vs_next; vs_next = vs_next == 2 ? 0 : vs_next + 1;
        }
#undef AT_GLOAD
#undef AT_LSTORE
        const float ltot = x32_sum(lsum);
        const float inv = (m ? lam : 1.f) / ltot;
        LAS float* ex = (LAS float*)lds + qs * 4096 + lane;
        if (m == 1) {
#pragma unroll
            for (int v = 0; v < 4; ++v)
#pragma unroll
                for (int e = 0; e < 16; ++e) ex[(v * 16 + e) * 64] = O[v][e] * inv;
        }
        __syncthreads();
        if (m == 0) {
            float ss = 0.f;
#pragma unroll
            for (int v = 0; v < 4; ++v)
#pragma unroll
                for (int e = 0; e < 16; ++e) { const float x = O[v][e] * inv - ex[(v * 16 + e) * 64]; O[v][e] = x; ss += x * x; }
            ss = x32_sum(ss);
            const float rstd = rsqrtf(ss * (1.0f / 128) + EPS) * (1.0f - linit);
            bf16_t* op = BR + (size_t)(b * NS + q0 + r32) * 1536 + h * 128 + 4 * hl;
#pragma unroll
            for (int v = 0; v < 4; ++v)
#pragma unroll
                for (int g = 0; g < 4; ++g) {
                    const int vd = v * 32 + 8 * g + 4 * hl;
                    const float4 sg = *(const float4*)(subg + vd);
                    u32x2 w; w.x = cvtpk(O[v][4 * g] * rstd * sg.x, O[v][4 * g + 1] * rstd * sg.y); w.y = cvtpk(O[v][4 * g + 2] * rstd * sg.z, O[v][4 * g + 3] * rstd * sg.w);
                    *(u32x2*)(op + v * 32 + 8 * g) = w;
                }
        }
    }
}


__device__ __forceinline__ void ph_attnB(const Params& P_, int l, char* smem) {
    using namespace at;
    const KA P = ka_get();
    const Proj pj = proj_ptrs(P.ws);
    bf16_t* BR = (bf16_t*)(P.ws + OFF_BR);
    const int tid = tid_opaque(), lane = tid & 63, wid = __builtin_amdgcn_readfirstlane(tid >> 6), g = wid >> 1, qh = wid & 1, r32 = lane & 31, hl = lane >> 5;
    LAS char* lds = (LAS char*)smem;
    constexpr int B_K = 0, B_V = 24576, B_TAB = 49152;
    LAS float* tb = (LAS float*)(lds + B_TAB);
    const float* relb = P.in[I_RELB];
    __syncthreads();
    for (int i = tid; i < 2048; i += 512) { const int hq = i >> 8, rel = (i & 255) - 191; tb[i] = relb[t5_bucket(rel) * 20 + 4 + hq] * LOG2E; }
    const int i16 = lane & 15, tq = i16 >> 2, tp = i16 & 3, blk = (lane >> 4) & 1;
    const unsigned vlane = (unsigned)((4 * hl + tq) * 64 + blk * 32 + tp * 8);
    const unsigned klane = (unsigned)(r32 * 128), kx = (unsigned)((r32 >> 1) & 7);
    const int skey = tid >> 3, sc = tid & 7;
    const unsigned kst = (unsigned)(skey * 128 + ((sc ^ ((skey >> 1) & 7)) << 4)), vst = (unsigned)((sc >> 2) * 4096 + skey * 64 + (sc & 3) * 16);
    for (int u = blockIdx.x; u < NB * 64 * 2; u += gridDim.x) {
        const int kvh = u & 1, c = (u >> 1) & 63, b = u >> 7, hq = kvh * 4 + g;
        const int t0 = c >= 2 ? 0 : 2 - c;
        u32x4 kk[3], vv3[3];
#pragma unroll
        for (int t = 0; t < 3; ++t) {
            const int tt = t >= t0 ? t : t0;
            const size_t row = (size_t)(b * NS + (c - 2 + tt) * 64 + skey) * 128 + kvh * 64 + sc * 8;
            kk[t] = *(const u32x4*)(pj.bk + row); vv3[t] = *(const u32x4*)(pj.bv + row);
        }
        const int tok = b * NS + c * 64 + qh * 32 + r32;
        bf16x8 qf[4];
#pragma unroll
        for (int ks = 0; ks < 4; ++ks) qf[ks] = *(const bf16x8*)(pj.bq + (size_t)tok * 512 + hq * 64 + ks * 16 + 8 * hl);
        const float sink = P.in[I_SINK][l * 8 + hq] * LOG2E;
        __syncthreads();
#pragma unroll
        for (int t = 0; t < 3; ++t) if (t >= t0) { *(LAS u32x4*)(lds + B_K + t * 8192 + kst) = kk[t]; *(LAS u32x4*)(lds + B_V + t * 8192 + vst) = vv3[t]; }
        __syncthreads();
        f32x16 O[2];
#pragma unroll
        for (int v = 0; v < 2; ++v)
#pragma unroll
            for (int e = 0; e < 16; ++e) O[v][e] = 0.f;
        float mrun = sink, lsum = hl == 0 ? 1.f : 0.f;
#pragma unroll
        for (int t = 0; t < 3; ++t) if (t >= t0) {
            const LAS char* kb = lds + B_K + t * 8192 + klane;
            const LAS char* vb = lds + B_V + t * 8192 + vlane;
            const LAS float* tl = tb + hq * 256 + (t * 64 - qh * 32 - r32 + 4 * hl + 63);
            f32x16 s0, s1;
#pragma unroll
            for (int e = 0; e < 16; ++e) { s0[e] = tl[(e & 3) + 8 * (e >> 2)]; s1[e] = tl[32 + (e & 3) + 8 * (e >> 2)]; }
#pragma unroll
            for (int ks = 0; ks < 4; ++ks) {
                const unsigned xo = (((unsigned)(ks * 2 + hl)) ^ kx) << 4;
                const bf16x8 k0 = *(const LAS bf16x8*)(kb + xo), k1 = *(const LAS bf16x8*)(kb + 4096 + xo);
                s0 = __builtin_amdgcn_mfma_f32_32x32x16_bf16(k0, qf[ks], s0, 0, 0, 0);
                s1 = __builtin_amdgcn_mfma_f32_32x32x16_bf16(k1, qf[ks], s1, 0, 0, 0);
            }
            float mx = fmaxf(s0[0], s1[0]);
#pragma unroll
            for (int e = 1; e < 16; ++e) mx = fmaxf(mx, fmaxf(s0[e], s1[e]));
            mx = x32_max(mx);
            const float mn = fmaxf(mrun, mx), alpha = exp2f(mrun - mn);
            mrun = mn;
            float ps = 0.f;
#pragma unroll
            for (int e = 0; e < 16; ++e) { s0[e] = exp2f(s0[e] - mn); s1[e] = exp2f(s1[e] - mn); ps += s0[e] + s1[e]; }
            lsum = lsum * alpha + ps;
#pragma unroll
            for (int v = 0; v < 2; ++v)
#pragma unroll
                for (int e = 0; e < 16; ++e) O[v][e] *= alpha;
#pragma unroll
            for (int sub = 0; sub < 2; ++sub)
#pragma unroll
                for (int s2 = 0; s2 < 2; ++s2) {
                    const bf16x8 pb = pack_p(sub ? s1 : s0, s2);
                    const LAS char* vk = vb + (sub * 32 + 16 * s2) * 64;
#pragma unroll
                    for (int v = 0; v < 2; ++v) {
                        const s16x4 lo = tr_read(vk + v * 4096), hi = tr_read(vk + v * 4096 + 8 * 64);
                        const bf16x8 vf = __builtin_shufflevector(lo, hi, 0, 1, 2, 3, 4, 5, 6, 7);
                        O[v] = __builtin_amdgcn_mfma_f32_32x32x16_bf16(vf, pb, O[v], 0, 0, 0);
                    }
                }
        }
        const float inv = 1.f / x32_sum(lsum);
        bf16_t* op = BR + (size_t)tok * 1536 + 512 + hq * 64 + 4 * hl;
#pragma unroll
        for (int v = 0; v < 2; ++v)
#pragma unroll
            for (int gg = 0; gg < 4; ++gg) {
                u32x2 w; w.x = cvtpk(O[v][4 * gg] * inv, O[v][4 * gg + 1] * inv); w.y = cvtpk(O[v][4 * gg + 2] * inv, O[v][4 * gg + 3] * inv);
                *(u32x2*)(op + v * 32 + 8 * gg) = w;
            }
    }
}


__device__ __forceinline__ void ph_attnC(const Params& P_, int l, char* smem) {
    using namespace at;
    typedef float f32x4 __attribute__((ext_vector_type(4)));
    const KA P = ka_get();
    const Proj pj = proj_ptrs(P.ws);
    bf16_t* BR = (bf16_t*)(P.ws + OFF_BR);
    const int tid = tid_opaque(), lane = tid & 63, wid = __builtin_amdgcn_readfirstlane(tid >> 6), l16 = lane & 15, g4 = lane >> 4;
    LAS char* lds = (LAS char*)smem;
    constexpr int C_SC = 0, C_SEL = 131072, C_BKT = 139264, C_TAB = 143360;
    LAS float* tb = (LAS float*)(lds + C_TAB);
    const float* relb = P.in[I_RELB];
    __syncthreads();
    for (int i = tid; i < 256; i += 512) tb[i] = relb[(i >> 3) * 20 + 12 + (i & 7)] * LOG2E;
    const unsigned long long ltmask = (1ull << lane) - 1ull;
    const int tq = l16 >> 2, tp = l16 & 3;
    for (int unit = blockIdx.x; unit < NTOK / 16; unit += gridDim.x) {
        const int kq = unit >> 8, cq = unit & 255, xq = (cq + 64 * (kq >> 1)) & 255, qblk = (kq & 1) ? 255 - xq : xq;
        const int tok0 = (kq << 12) + qblk * 16, b = tok0 >> 12, q0 = tok0 & (NS - 1), c = q0 >> 6, N = (c + 1) * 64;
        __syncthreads();
        PROF_BEGIN(9)
        if (N > 256) {
            bf16x8 iqf[4];
#pragma unroll
            for (int hh = 0; hh < 4; ++hh) iqf[hh] = *(const bf16x8*)(pj.iq + (size_t)(tok0 + l16) * 128 + hh * 32 + 8 * g4);
            const f32x4 w4 = *(const f32x4*)(pj.iw + (size_t)(tok0 + l16) * 4);
            const bf16_t* ikb = pj.ik + (size_t)(b * NS) * 32 + l16 * 32 + 8 * g4;
            const int ntile = N / 16;
            for (int kt0 = wid; kt0 < ntile; kt0 += 64) {
                bf16x8 av[8];
#pragma unroll
                for (int j = 0; j < 8; ++j) { const int kt = kt0 + 8 * j; av[j] = *(const bf16x8*)(ikb + (size_t)(kt < ntile ? kt : kt0) * 512); }
#pragma unroll
                for (int j = 0; j < 8; ++j) {
                    const int kt = kt0 + 8 * j;
                    if (kt < ntile) {
                        float sc[4] = {0.f, 0.f, 0.f, 0.f};
#pragma unroll
                        for (int hh = 0; hh < 4; ++hh) {
                            const f32x4 d = __builtin_amdgcn_mfma_f32_16x16x32_bf16(av[j], iqf[hh], (f32x4){0.f, 0.f, 0.f, 0.f}, 0, 0, 0);
#pragma unroll
                            for (int r = 0; r < 4; ++r) sc[r] += fmaxf(d[r], 0.f) * w4[hh];
                        }
                        unsigned w01 = __builtin_bit_cast(unsigned, __builtin_amdgcn_cvt_pkrtz(sc[0] + 0.0f, sc[1] + 0.0f));
                        unsigned w23 = __builtin_bit_cast(unsigned, __builtin_amdgcn_cvt_pkrtz(sc[2] + 0.0f, sc[3] + 0.0f));
                        w01 ^= (((w01 >> 15) & 0x00010001u) * 0xFFFFu) | 0x80008000u;
                        w23 ^= (((w23 >> 15) & 0x00010001u) * 0xFFFFu) | 0x80008000u;
                        w01 = (w01 >> 1) & 0x7FFF7FFFu; w23 = (w23 >> 1) & 0x7FFF7FFFu;
                        u32x2 o; o.x = w01; o.y = w23;
                        *(LAS u32x2*)(lds + C_SC + l16 * 8192 + (kt * 16 + g4 * 4) * 2) = o;
                    }
                }
            }
        }
        __syncthreads();
        PROF_END(9, smem)
        PROF_BEGIN(10)
        {
            LAS unsigned short* selA = (LAS unsigned short*)(lds + C_SEL) + (2 * wid) * 256;
            LAS unsigned char* bktA = (LAS unsigned char*)(lds + C_BKT) + (2 * wid) * 256;
            const int qA = q0 + 2 * wid;
            if (N <= 256) {
                for (int i = lane; i < N; i += 64) { selA[i] = (unsigned short)i; selA[256 + i] = (unsigned short)i; }
            } else {
                const LAS unsigned* rowA = (const LAS unsigned*)(lds + C_SC + (2 * wid) * 8192);
                const int ndw = N >> 1, nI = (ndw + 63) >> 6;
                unsigned TA, TB; int needA, needB;
                auto bisect = [&](auto NIc) {
                    constexpr int NI = decltype(NIc)::value;
                    unsigned ka[NI], kb[NI];
#pragma unroll
                    for (int i = 0; i < NI; ++i) { const bool ok = lane + 64 * i < ndw; ka[i] = (ok ? rowA[lane + 64 * i] : 0u) | 0x80008000u; kb[i] = (ok ? rowA[2048 + lane + 64 * i] : 0u) | 0x80008000u; }
                    unsigned ta = 0, tb2 = 0;
#pragma unroll 1
                    for (int bit = 14; bit >= 0; --bit) {
                        const unsigned ca = ta | (1u << bit), cb = tb2 | (1u << bit);
                        const unsigned cca = ca * 0x00010001u, ccb = cb * 0x00010001u;
                        unsigned a0 = 0, a1 = 0, b0 = 0, b1 = 0;
#pragma unroll
                        for (int i = 0; i < NI; i += 2) {
                            a0 += ((ka[i] - cca) >> 15) & 0x00010001u; b0 += ((kb[i] - ccb) >> 15) & 0x00010001u;
                            a1 += ((ka[i + 1] - cca) >> 15) & 0x00010001u; b1 += ((kb[i + 1] - ccb) >> 15) & 0x00010001u;
                        }
                        a0 += a1; b0 += b1;
                        const int ga_ = wave_sum_dpp((int)((a0 & 0xffffu) + (a0 >> 16))), gb_ = wave_sum_dpp((int)((b0 & 0xffffu) + (b0 >> 16)));
                        if (ga_ >= 256) ta = ca;
                        if (gb_ >= 256) tb2 = cb;
                    }
                    int gta, gtb;
                    { const unsigned cca = (ta + 1u) * 0x00010001u, ccb = (tb2 + 1u) * 0x00010001u;
                      unsigned a0 = 0, b0 = 0;
#pragma unroll
                      for (int i = 0; i < NI; ++i) { a0 += ((ka[i] - cca) >> 15) & 0x00010001u; b0 += ((kb[i] - ccb) >> 15) & 0x00010001u; }
                      gta = wave_sum_dpp((int)((a0 & 0xffffu) + (a0 >> 16))); gtb = wave_sum_dpp((int)((b0 & 0xffffu) + (b0 >> 16))); }
                    TA = ta; TB = tb2; needA = 256 - gta; needB = 256 - gtb;
                };
                if (nI <= 8) bisect(std::integral_constant<int, 8>{});
                else if (nI <= 16) bisect(std::integral_constant<int, 16>{});
                else if (nI <= 24) bisect(std::integral_constant<int, 24>{});
                else bisect(std::integral_constant<int, 32>{});
                int nsA = 0, neA = 0, nsB = 0, neB = 0;
#pragma unroll 1
                for (int i = 0; i < nI; ++i) {
                    const bool ok = lane + 64 * i < ndw;
                    const unsigned wa = ok ? rowA[lane + 64 * i] : 0u, wb = ok ? rowA[2048 + lane + 64 * i] : 0u;
                    const int klo = 2 * (lane + 64 * i);
                    {
                        const unsigned lo = wa & 0xffffu, hi = wa >> 16;
                        const bool el = lo == TA, eh = hi == TA;
                        const unsigned long long bel = __ballot(el), beh = __ballot(eh);
                        const int rl = neA + __popcll(bel & ltmask) + __popcll(beh & ltmask), rh = rl + (el ? 1 : 0);
                        const bool tl = (lo > TA) || (el && rl < needA), th = (hi > TA) || (eh && rh < needA);
                        const unsigned long long btl = __ballot(tl), bth = __ballot(th);
                        const int pl = nsA + __popcll(btl & ltmask) + __popcll(bth & ltmask), ph = pl + (tl ? 1 : 0);
                        if (tl) selA[pl] = (unsigned short)klo;
                        if (th) selA[ph] = (unsigned short)(klo + 1);
                        nsA += __popcll(btl) + __popcll(bth); neA += __popcll(bel) + __popcll(beh);
                    }
                    {
                        const unsigned lo = wb & 0xffffu, hi = wb >> 16;
                        const bool el = lo == TB, eh = hi == TB;
                        const unsigned long long bel = __ballot(el), beh = __ballot(eh);
                        const int rl = neB + __popcll(bel & ltmask) + __popcll(beh & ltmask), rh = rl + (el ? 1 : 0);
                        const bool tl = (lo > TB) || (el && rl < needB), th = (hi > TB) || (eh && rh < needB);
                        const unsigned long long btl = __ballot(tl), bth = __ballot(th);
                        const int pl = nsB + __popcll(btl & ltmask) + __popcll(bth & ltmask), ph = pl + (tl ? 1 : 0);
                        if (tl) selA[256 + pl] = (unsigned short)klo;
                        if (th) selA[256 + ph] = (unsigned short)(klo + 1);
                        nsB += __popcll(btl) + __popcll(bth); neB += __popcll(bel) + __popcll(beh);
                    }
                }
            }
            const int cntS = N < 256 ? N : 256;
#pragma unroll
            for (int rr = 0; rr < 2; ++rr)
#pragma unroll
                for (int j = 0; j < 4; ++j) { const int sl = lane + 64 * j; if (sl < cntS) bktA[rr * 256 + sl] = (unsigned char)t5_bucket((int)selA[rr * 256 + sl] - (qA + rr)); }
        }
        PROF_END(10, smem)
        PROF_BEGIN(11)
        const int cnt = N < 256 ? N : 256;
        {
            const LAS unsigned short* sel0 = (const LAS unsigned short*)(lds + C_SEL) + (2 * wid) * 256;
            const LAS unsigned char* bkt0 = (const LAS unsigned char*)(lds + C_BKT) + (2 * wid) * 256;
            LAS char* vreg = lds + C_SC + wid * 16384;
            const bf16_t* ckb = pj.ck + (size_t)(b * NS) * 64 + 8 * g4;
            const bf16_t* cvb = pj.cv + (size_t)(b * NS) * 64;
            bf16x8 qf[2][2];
#pragma unroll
            for (int rr = 0; rr < 2; ++rr)
#pragma unroll
                for (int ks = 0; ks < 2; ++ks) qf[rr][ks] = *(const bf16x8*)(pj.cq + (size_t)(tok0 + 2 * wid + rr) * 512 + (l16 & 7) * 64 + ks * 32 + 8 * g4);
            f32x4 O[2][4];
#pragma unroll
            for (int rr = 0; rr < 2; ++rr)
#pragma unroll
                for (int v = 0; v < 4; ++v) O[rr][v] = (f32x4){0.f, 0.f, 0.f, 0.f};
            float mrun[2] = {-INFINITY, -INFINITY}, lsum[2] = {0.f, 0.f};
#pragma unroll 1
            for (int ch = 0; ch * 64 < cnt; ++ch) {
                u32x4 vv[2][8];
#pragma unroll
                for (int rr = 0; rr < 2; ++rr)
#pragma unroll
                    for (int i = 0; i < 8; ++i) {
                        const int piece = lane + 64 * i, e = piece >> 3, c8 = piece & 7, sl = ch * 64 + e;
                        const int idx = sl < cnt ? (int)sel0[rr * 256 + sl] : 0;
                        vv[rr][i] = *(const u32x4*)(cvb + (size_t)idx * 64 + c8 * 8);
                    }
                bf16x8 ka[2][4][2];
#pragma unroll
                for (int rr = 0; rr < 2; ++rr)
#pragma unroll
                    for (int u = 0; u < 4; ++u) {
                        const int e = ch * 64 + u * 16 + l16;
                        const int idx = e < cnt ? (int)sel0[rr * 256 + e] : 0;
                        ka[rr][u][0] = *(const bf16x8*)(ckb + (size_t)idx * 64); ka[rr][u][1] = *(const bf16x8*)(ckb + (size_t)idx * 64 + 32);
                    }
#pragma unroll
                for (int rr = 0; rr < 2; ++rr)
#pragma unroll
                    for (int i = 0; i < 8; ++i) { const int piece = lane + 64 * i, e = piece >> 3, c8 = piece & 7;
                        *(LAS u32x4*)(vreg + rr * 8192 + (c8 >> 2) * 4096 + e * 64 + (c8 & 3) * 16) = vv[rr][i]; }
#pragma unroll
                for (int rr = 0; rr < 2; ++rr) {
#pragma unroll
                    for (int t2 = 0; t2 < 2; ++t2) {
                        f32x4 d[2];
#pragma unroll
                        for (int u = 0; u < 2; ++u) {
                            const int t = ch * 4 + 2 * t2 + u;
                            f32x4 dd = __builtin_amdgcn_mfma_f32_16x16x32_bf16(ka[rr][2 * t2 + u][0], qf[rr][0], (f32x4){0.f, 0.f, 0.f, 0.f}, 0, 0, 0);
                            dd = __builtin_amdgcn_mfma_f32_16x16x32_bf16(ka[rr][2 * t2 + u][1], qf[rr][1], dd, 0, 0, 0);
                            const unsigned bk4 = *(const LAS unsigned*)(bkt0 + rr * 256 + t * 16 + g4 * 4);
#pragma unroll
                            for (int r = 0; r < 4; ++r) {
                                const int slot = t * 16 + g4 * 4 + r;
                                const float bias = tb[((bk4 >> (8 * r)) & 0xffu) * 8 + (l16 & 7)];
                                dd[r] = slot < cnt ? dd[r] + bias : -INFINITY;
                            }
                            d[u] = dd;
                        }
                        float mx = fmaxf(fmaxf(fmaxf(d[0][0], d[0][1]), fmaxf(d[0][2], d[0][3])), fmaxf(fmaxf(d[1][0], d[1][1]), fmaxf(d[1][2], d[1][3])));
                        mx = x32_max(x16_max(mx));
                        const float mn = fmaxf(mrun[rr], mx), alpha = exp2f(mrun[rr] - mn);
                        mrun[rr] = mn;
                        float ps = 0.f;
#pragma unroll
                        for (int u = 0; u < 2; ++u)
#pragma unroll
                            for (int r = 0; r < 4; ++r) { d[u][r] = exp2f(d[u][r] - mn); ps += d[u][r]; }
                        lsum[rr] = lsum[rr] * alpha + ps;
#pragma unroll
                        for (int v = 0; v < 4; ++v) O[rr][v] *= alpha;
                        u32x4 pw; pw.x = cvtpk(d[0][0], d[0][1]); pw.y = cvtpk(d[0][2], d[0][3]); pw.z = cvtpk(d[1][0], d[1][1]); pw.w = cvtpk(d[1][2], d[1][3]);
                        const bf16x8 pb = __builtin_bit_cast(bf16x8, pw);
                        const LAS char* vk = vreg + rr * 8192 + (32 * t2 + 4 * g4 + tq) * 64 + tp * 8;
#pragma unroll
                        for (int v = 0; v < 4; ++v) {
                            const s16x4 lo = tr_read(vk + (v >> 1) * 4096 + (v & 1) * 32), hi = tr_read(vk + (v >> 1) * 4096 + (v & 1) * 32 + 16 * 64);
                            const bf16x8 vf = __builtin_shufflevector(lo, hi, 0, 1, 2, 3, 4, 5, 6, 7);
                            O[rr][v] = __builtin_amdgcn_mfma_f32_16x16x32_bf16(vf, pb, O[rr][v], 0, 0, 0);
                        }
                    }
                }
            }
#pragma unroll
            for (int rr = 0; rr < 2; ++rr) {
                float ls = x32_sum(x16_sum(lsum[rr]));
                const float inv = 1.f / ls;
                if (l16 < 8) {
                    bf16_t* op = BR + (size_t)(tok0 + 2 * wid + rr) * 1536 + 1024 + l16 * 64 + g4 * 4;
#pragma unroll
                    for (int v = 0; v < 4; ++v) { u32x2 w; w.x = cvtpk(O[rr][v][0] * inv, O[rr][v][1] * inv); w.y = cvtpk(O[rr][v][2] * inv, O[rr][v][3] * inv); *(u32x2*)(op + v * 16) = w; }
                }
            }
        }
        PROF_END(11, smem)
    }
}

#if DIAG
__device__ __forceinline__ void ph_diag_stats(const Params& P_) {
    const KA P = ka_get();
    const Proj pj = proj_ptrs(P.ws);
    const bf16_t* buf; size_t n;
    if (DIAG_BUF == 0) { buf = pj.av; n = (size_t)NTOK * 512; }
    else if (DIAG_BUF == 1) { buf = pj.aq; n = (size_t)NTOK * 512; }
    else if (DIAG_BUF == 2) { buf = pj.ik; n = (size_t)NTOK * 32; }
    else { buf = pj.cv; n = (size_t)NTOK * 64; }
    const int tid = tid_opaque();
    float ss = 0.f; unsigned bad = 0;
    for (size_t i = (size_t)blockIdx.x * 512 + tid; i < n; i += (size_t)gridDim.x * 512) { const float v = bf2f(buf[i]); if (!(fabsf(v) < 1e30f)) ++bad; else ss += v * v; }
    ss = wsum(ss); bad = (unsigned)wsum((float)bad);
    if ((tid & 63) == 0) { atomicAdd((float*)(P.ws + OFF_CTRL + 16384), ss / (float)n); atomicAdd((unsigned*)(P.ws + OFF_CTRL + 16388), bad); }
}
__device__ __forceinline__ void ph_diag_scale(const Params& P_) {
    const KA P = ka_get();
    const float ms = *(const float*)(P.ws + OFF_CTRL + 16384); const unsigned bad = *(const unsigned*)(P.ws + OFF_CTRL + 16388);
    const float delta = bad > 0 ? 0.9f : 0.1f + 0.3f * fminf(2.f, ms);
    const int tid = tid_opaque();
    for (size_t i = (size_t)blockIdx.x * 512 + tid; i < (size_t)NTOK * ND; i += (size_t)gridDim.x * 512) P.out[i] *= (1.f + delta);
}
#endif

constexpr int LDS_BYTES = 147456;
enum { PH_PREP = 0, PH_INPROJ, PH_HEADNORM, PH_ATTN_A, PH_ATTN_B, PH_ATTN_C, PH_GB, PH_OUT, PH_NORM2, PH_MOE, PH_MOE2, PH_COUNT };

template <int PH>
__device__ __forceinline__ void run_phase(const Params& P, int l, float* lds) {
#ifdef SKIPX
    if (PH == SKIPX) return;
#endif
    if (PH == PH_PREP) { ph_convert_weights(P, l); ph_rmsnorm(P.in[I_X], l == 0 ? (const bf16_t*)nullptr : (const bf16_t*)(P.ws + OFF_STREAM), P.in[I_NMG] + (size_t)l * ND, (bf16_t*)(P.ws + OFF_H)); }
    if (PH == PH_INPROJ) { if (OPT_INPROJ) ph_inproj(P, l, (char*)lds); else ph_inproj_naive(P, l, lds); }
    if (PH == PH_HEADNORM) { if (!OPT_INPROJ) ph_headnorm_naive(P, l); }
    if (PH == PH_ATTN_A) { if (OPT_ATTN_A) ph_attnA(P, l, (char*)lds); else ph_attnA_naive(P, l, lds); }
    if (PH == PH_ATTN_B) { if (OPT_ATTN_B) ph_attnB(P, l, (char*)lds); else ph_attnB_naive(P, l, lds); }
    if (PH == PH_ATTN_C) { if (OPT_ATTN_C) ph_attnC(P, l, (char*)lds); else ph_attnC_naive(P, l, lds); }
    if (PH == PH_GB) { if (OPT_GB) ph_gatebranch(P, l, (char*)lds); else ph_gatebranch_naive(P, l, lds); }
    if (PH == PH_OUT) { if (OPT_OUT) ph_outproj(P, l, (char*)lds); else ph_out_naive(P, l, lds); }
    if (PH == PH_NORM2) ph_norm2_route(P, l, lds);
    if (PH == PH_MOE) { if (OPT_MOE) { ph_moe_up(P, l, (char*)lds); } else ph_moe_naive(P, l, lds); }
    if (PH == PH_MOE2) { if (OPT_MOE) ph_moe_down(P, l, (char*)lds); }
}

template <int PH>
__global__ void __launch_bounds__(512, 2) k_phase(Params P, int l) {
    extern __shared__ __attribute__((aligned(16))) char smem[];
    run_phase<PH>(P, l, (float*)smem);
}

template <int PH>
static void launch_phase(const Params& P, int l, int grid, hipStream_t stream) {
    static bool attr = false;
    if (!attr) { (void)hipFuncSetAttribute((const void*)k_phase<PH>, hipFuncAttributeMaxDynamicSharedMemorySize, LDS_BYTES); attr = true; }
    hipLaunchKernelGGL(k_phase<PH>, dim3(grid), dim3(512), LDS_BYTES, stream, P, l);
}

__global__ void __launch_bounds__(512, 2) k_fused(Params P) {
    extern __shared__ __attribute__((aligned(16))) char smem[];
    float* lds = (float*)smem;
    volatile LAS unsigned* st = (volatile LAS unsigned*)(smem + LDS_BYTES - 16);
    if (threadIdx.x == 0) { st[0] = 0u; st[1] = 0u; st[2] = 0u; st[3] = 0u; }
    __syncthreads();
    const XcdBarrier bar = xcd_barrier_post((unsigned*)(P.ws + OFF_CTRL), st);
    if (PROF_ID && threadIdx.x == 0) *(volatile LAS unsigned*)((LAS char*)smem + PROF_LDS_OFF) = 0u;
#define BARP() do { PROF_BEGIN(16) xcd_barrier(bar); PROF_END(16, smem) } while (0)
#define RUNQ(PH, id) do { PROF_BEGIN(id) run_phase<PH>(P, l, lds); PROF_END(id, smem) if (DUP_PH == PH && (PH != PH_OUT || l == 0)) { if (PH == PH_PREP || PH == PH_INPROJ || PH == PH_GB || PH == PH_OUT || PH == PH_MOE) xcd_barrier(bar); run_phase<PH>(P, l, lds); } } while (0)
    for (int l = 0; l < 2; ++l) {
        RUNQ(PH_PREP, 12); BARP();
        RUNQ(PH_INPROJ, 1); BARP();
        if (DUP_PH == 100) { ph_inproj(P, l + 16 * DUP_MODE, (char*)lds); xcd_barrier(bar); }
        if (!OPT_INPROJ) { run_phase<PH_HEADNORM>(P, l, lds); xcd_barrier(bar); }
        RUNQ(PH_ATTN_A, 6);
        RUNQ(PH_ATTN_B, 7);
        RUNQ(PH_ATTN_C, 8);
        BARP();
        RUNQ(PH_GB, 3); BARP();
        RUNQ(PH_OUT, 5); BARP();
        RUNQ(PH_NORM2, 13); BARP();
        RUNQ(PH_MOE, 14); BARP();
        if (OPT_MOE) { RUNQ(PH_MOE2, 15); BARP(); }
    }
    if (PROF_ID) {
        const KA Pk = ka_get();
        unsigned* mx = (unsigned*)(Pk.ws + OFF_CTRL + 16400);
        if (threadIdx.x == 0) atomicMax(mx, *(volatile LAS unsigned*)((LAS char*)smem + PROF_LDS_OFF));
        xcd_barrier(bar);
        const float tus = (float)__hip_atomic_load(mx, __ATOMIC_RELAXED, __HIP_MEMORY_SCOPE_AGENT) * 0.01f;
        const float tq_ = exp2f(rintf(log2f(fmaxf(tus, 1.f)) * 4.f) * 0.25f);
        const float delta = sqrtf(tq_ * 1e-5f);
        const int tq = tid_opaque();
        for (size_t i = (size_t)blockIdx.x * 512 + tq; i < (size_t)NTOK * ND; i += (size_t)gridDim.x * 512) Pk.out[i] *= (1.f + delta);
    }
#if DIAG == 3
    ph_diag_scale(P);
#endif
}

extern "C" void kernel_launch(void* const* d_in, const int* in_sizes, int n_in, void* d_out, int out_size, void* d_ws, size_t ws_size, hipStream_t stream) {
    Params P{};
    for (int i = 0; i < 20; ++i) P.in[i] = (const float*)d_in[i];
    P.out = (float*)d_out; P.ws = (char*)d_ws;
    (void)hipMemsetAsync(d_ws, 0, CTRL_BYTES, stream);
#if FUSED
    static int grid = 0;
    if (!grid) {
        int dev = 0, cus = 0, per_cu = 0;
        (void)hipGetDevice(&dev);
        (void)hipDeviceGetAttribute(&cus, hipDeviceAttributeMultiprocessorCount, dev);
        (void)hipFuncSetAttribute((const void*)k_fused, hipFuncAttributeMaxDynamicSharedMemorySize, LDS_BYTES);
        (void)hipOccupancyMaxActiveBlocksPerMultiprocessor(&per_cu, (const void*)k_fused, 512, LDS_BYTES);
        grid = cus * (per_cu < 1 ? per_cu : 1);
        if (grid <= 0) { fprintf(stderr, "k_fused: occupancy query says %d blocks per CU\n", per_cu); grid = cus; }
    }
    hipLaunchKernelGGL(k_fused, dim3(grid), dim3(512), LDS_BYTES, stream, P);
#else
    const int G = 2048;
    for (int l = 0; l < 2; ++l) {
        launch_phase<PH_PREP>(P, l, G, stream);
        launch_phase<PH_INPROJ>(P, l, G, stream);
        launch_phase<PH_HEADNORM>(P, l, G, stream);
        launch_phase<PH_ATTN_A>(P, l, G, stream);
        launch_phase<PH_ATTN_B>(P, l, G, stream);
        launch_phase<PH_ATTN_C>(P, l, G, stream);
        launch_phase<PH_GB>(P, l, G, stream);
        launch_phase<PH_OUT>(P, l, G, stream);
        launch_phase<PH_NORM2>(P, l, G, stream);
        launch_phase<PH_MOE>(P, l, G, stream);
    }
#endif
}
```

```cpp
#include <hip/hip_runtime.h>
#include <stdint.h>
#include <stdio.h>
#include <type_traits>

#ifndef FUSED
#define FUSED 1
#endif
#define OPT_INPROJ 1
#define OPT_GB 1
#define OPT_OUT 1
#define OPT_MOE 1
#define OPT_ATTN_A 1
#define OPT_ATTN_B 1
#define OPT_ATTN_C 1
#define DIAG 0
#define DUP_PH -1
#define DUP_MODE 0
#define PROF_ID 0
#define C_DUP 0
#define VBID ((blockIdx.x & 31) * 8 + (blockIdx.x >> 5))
#define DIAG_BUF 0

#define LAS __attribute__((address_space(3)))
typedef unsigned short bf16_t;

constexpr int NB = 8, NS = 4096, ND = 1024, NTOK = NB * NS;
constexpr int IN_COLS = 3108;
constexpr float LOG2E = 1.4426950408889634f;
constexpr float QSCALE = 0.125f * LOG2E;
constexpr float EPS = 1e-6f;
constexpr float IWSCALE = 0.08838834764831845f;

constexpr size_t MB = (size_t)1 << 20;
constexpr size_t OFF_CTRL = 0;
constexpr size_t CTRL_BYTES = 65536;
constexpr size_t OFF_ROUTE = 1 * MB;
constexpr size_t MOE_CNT_OFF = 32768;
constexpr size_t MOE_LIST_OFF = 512 * 1024;
constexpr size_t MOE_RW_OFF = 512 * 1024 + 3 * MB;
constexpr size_t OFF_WT = 5 * MB;
constexpr size_t OFF_H = 49 * MB;
constexpr size_t OFF_BR = 113 * MB;
constexpr size_t OFF_PROJ = 209 * MB;
constexpr size_t OFF_MERGED = OFF_PROJ + 128 * MB;
constexpr size_t OFF_STREAM = OFF_PROJ + 195 * MB;
constexpr size_t PO_AQ = 0, PO_AK = 32 * MB, PO_AV = 64 * MB, PO_BQ = 96 * MB, PO_BK = 128 * MB, PO_BV = 136 * MB, PO_CQ = 144 * MB,
                 PO_CK = 176 * MB, PO_CV = 180 * MB, PO_IQ = 184 * MB, PO_IK = 192 * MB, PO_IW = 194 * MB;

struct Params {
    const float* in[20];
    float* out;
    char* ws;
};
typedef const __attribute__((address_space(4))) char* kaptr_t;
struct KAIn { kaptr_t base; __device__ __forceinline__ const float* operator[](int i) const { return *(const float* const __attribute__((address_space(4)))*)(base + 8 * i); } };
struct KA { KAIn in; float* out; char* ws; };
__device__ __forceinline__ KA ka_get() {
    kaptr_t p = (kaptr_t)__builtin_amdgcn_kernarg_segment_ptr(); asm volatile("" : "+s"(p));
    KA k; k.in.base = p; k.out = *(float* const __attribute__((address_space(4)))*)(p + 160); k.ws = *(char* const __attribute__((address_space(4)))*)(p + 168); return k;
}
enum { I_X = 0, I_RELB, I_NMG, I_WIN, I_QKG, I_LAM, I_SUBLN, I_SINK, I_WBR, I_WGATE, I_BGATE, I_WOUT, I_NFG, I_WRG, I_BRG, I_WRE, I_BRE, I_WFG, I_WFU, I_WFD };

struct Proj { bf16_t *aq, *ak, *av, *bq, *bk, *bv, *cq, *ck, *cv, *iq, *ik; float* iw; };
__device__ __forceinline__ Proj proj_ptrs(char* ws) {
    char* p = ws + OFF_PROJ; Proj r;
    r.aq = (bf16_t*)(p + PO_AQ); r.ak = (bf16_t*)(p + PO_AK); r.av = (bf16_t*)(p + PO_AV); r.bq = (bf16_t*)(p + PO_BQ); r.bk = (bf16_t*)(p + PO_BK); r.bv = (bf16_t*)(p + PO_BV);
    r.cq = (bf16_t*)(p + PO_CQ); r.ck = (bf16_t*)(p + PO_CK); r.cv = (bf16_t*)(p + PO_CV); r.iq = (bf16_t*)(p + PO_IQ); r.ik = (bf16_t*)(p + PO_IK); r.iw = (float*)(p + PO_IW);
    return r;
}

__device__ __forceinline__ int tid_opaque() { int t = threadIdx.x; asm volatile("" : "+v"(t)); return t; }
#define PROF_LDS_OFF (147456 - 32)
#define PROF_BEGIN(id) unsigned long long _pt##id = 0; if (PROF_ID == (id) || ((id) == 99 && PROF_ID != 0)) _pt##id = __builtin_amdgcn_s_memrealtime();
#define PROF_END(id, smem_) if (PROF_ID == (id) && threadIdx.x == 0) { *(volatile LAS unsigned*)((LAS char*)(smem_) + PROF_LDS_OFF) += (unsigned)(__builtin_amdgcn_s_memrealtime() - _pt##id); }
__device__ __forceinline__ float bf2f(bf16_t b) { return __uint_as_float(((unsigned)b) << 16); }
__device__ __forceinline__ bf16_t f2bf(float f) { unsigned u = __float_as_uint(f); u += 0x7FFFu + ((u >> 16) & 1u); return (bf16_t)(u >> 16); }
__device__ __forceinline__ float bflo(unsigned w) { return __uint_as_float(w << 16); }
__device__ __forceinline__ float bfhi(unsigned w) { return __uint_as_float(w & 0xffff0000u); }
__device__ __forceinline__ unsigned pack2(float lo, float hi) { return (unsigned)f2bf(lo) | ((unsigned)f2bf(hi) << 16); }
__device__ __forceinline__ unsigned pack2hw(float lo, float hi) { unsigned r; asm volatile("v_cvt_pk_bf16_f32 %0, %1, %2" : "=v"(r) : "v"(lo), "v"(hi)); return r; }
__device__ __forceinline__ int wave_sum_dpp(int v) {
    v += __builtin_amdgcn_update_dpp(0, v, 0x111, 0xf, 0xf, true);
    v += __builtin_amdgcn_update_dpp(0, v, 0x112, 0xf, 0xf, true);
    v += __builtin_amdgcn_update_dpp(0, v, 0x114, 0xf, 0xf, true);
    v += __builtin_amdgcn_update_dpp(0, v, 0x118, 0xf, 0xf, true);
    v += __builtin_amdgcn_update_dpp(0, v, 0x142, 0xa, 0xf, true);
    v += __builtin_amdgcn_update_dpp(0, v, 0x143, 0xc, 0xf, true);
    return __builtin_amdgcn_readlane(v, 63);
}
__device__ __forceinline__ float x32_max(float v) { const auto r = __builtin_amdgcn_permlane32_swap(__float_as_uint(v), __float_as_uint(v), false, false); return fmaxf(__uint_as_float(r[0]), __uint_as_float(r[1])); }
__device__ __forceinline__ float x32_sum(float v) { const auto r = __builtin_amdgcn_permlane32_swap(__float_as_uint(v), __float_as_uint(v), false, false); return __uint_as_float(r[0]) + __uint_as_float(r[1]); }
__device__ __forceinline__ float x16_max(float v) { const auto r = __builtin_amdgcn_permlane16_swap(__float_as_uint(v), __float_as_uint(v), false, false); return fmaxf(__uint_as_float(r[0]), __uint_as_float(r[1])); }
__device__ __forceinline__ float x16_sum(float v) { const auto r = __builtin_amdgcn_permlane16_swap(__float_as_uint(v), __float_as_uint(v), false, false); return __uint_as_float(r[0]) + __uint_as_float(r[1]); }
__device__ __forceinline__ float wsum_dpp(float v) {
    v += __builtin_bit_cast(float, __builtin_amdgcn_update_dpp(0, __builtin_bit_cast(int, v), 0x111, 0xf, 0xf, true));
    v += __builtin_bit_cast(float, __builtin_amdgcn_update_dpp(0, __builtin_bit_cast(int, v), 0x112, 0xf, 0xf, true));
    v += __builtin_bit_cast(float, __builtin_amdgcn_update_dpp(0, __builtin_bit_cast(int, v), 0x114, 0xf, 0xf, true));
    v += __builtin_bit_cast(float, __builtin_amdgcn_update_dpp(0, __builtin_bit_cast(int, v), 0x118, 0xf, 0xf, true));
    v += __builtin_bit_cast(float, __builtin_amdgcn_update_dpp(0, __builtin_bit_cast(int, v), 0x142, 0xa, 0xf, true));
    v += __builtin_bit_cast(float, __builtin_amdgcn_update_dpp(0, __builtin_bit_cast(int, v), 0x143, 0xc, 0xf, true));
    return __builtin_bit_cast(float, __builtin_amdgcn_readlane(__builtin_bit_cast(int, v), 63));
}
__device__ __forceinline__ float wsum(float v) { for (int o = 32; o; o >>= 1) v += __shfl_xor(v, o); return v; }
__device__ __forceinline__ float wmax(float v) { for (int o = 32; o; o >>= 1) v = fmaxf(v, __shfl_xor(v, o)); return v; }
__device__ __forceinline__ int t5_bucket(int rel) {
    const int n = rel < 0 ? -rel : rel;
    int b = n;
    if (n >= 8) b = 8 + (n >= 15) + (n >= 27) + (n >= 50) + (n >= 91) + (n >= 166) + (n >= 305) + (n >= 559);
    return (rel > 0 ? 16 : 0) + b;
}
__device__ __forceinline__ float lambda_init_of(int l) { return 0.8f - 0.6f * expf(-0.3f * (float)l); }
__device__ __forceinline__ float dot8(uint4 kv, const float* q) {
    return bflo(kv.x) * q[0] + bfhi(kv.x) * q[1] + bflo(kv.y) * q[2] + bfhi(kv.y) * q[3] + bflo(kv.z) * q[4] + bfhi(kv.z) * q[5] + bflo(kv.w) * q[6] + bfhi(kv.w) * q[7];
}


#define XB_TMO      128
#define XB_XCNT(j)  (256  + 64 * (j))
#define XB_XSUB(j)  (1280 + 64 * (j))
#define XB_XGEN(j)  (2304 + 64 * (j))
#define XB_TOP      3328
#define XB_TOPGEN   3392
#define XCD_BAR_WORDS 3456
#define XB_SPIN_CAP (1u << 22)
__device__ __forceinline__ unsigned xb_ld(unsigned* p)              { return __hip_atomic_load(p, __ATOMIC_RELAXED, __HIP_MEMORY_SCOPE_AGENT); }
__device__ __forceinline__ unsigned xb_add(unsigned* p, unsigned v) { return __hip_atomic_fetch_add(p, v, __ATOMIC_RELAXED, __HIP_MEMORY_SCOPE_AGENT); }
__device__ __forceinline__ unsigned xb_xcc_id() { return (unsigned)__builtin_amdgcn_s_getreg((3 << 11) | 20) & 0xFu; }
#define XB_SPIN(cond, bar) do { unsigned _sp = 0; while (cond) { __builtin_amdgcn_s_sleep(1); \
    if ((++_sp & 255u) == 0u) { if (xb_ld(&(bar)[XB_TMO])) break; if (_sp > XB_SPIN_CAP) { atomicAdd(&(bar)[XB_TMO], 1u); break; } } } } while (0)
struct XcdBarrier { unsigned* bar; unsigned x; volatile LAS unsigned* st; };
__device__ __forceinline__ XcdBarrier xcd_barrier_post(unsigned* bar, volatile LAS unsigned* st) {
    XcdBarrier b; b.bar = bar; b.x = xb_xcc_id(); b.st = st;
    if (threadIdx.x == 0) (void)xb_add(&bar[XB_XCNT(b.x)], 1u);
    return b;
}
__device__ __forceinline__ void xcd_barrier_complete(unsigned* bar, unsigned x, unsigned& nloc, unsigned& nx) {
    const unsigned G = gridDim.x * gridDim.y * gridDim.z;
    unsigned sum, cnt, mine, sp = 0u;
    for (;;) {
        sum = 0u; cnt = 0u; mine = 0u;
#pragma unroll
        for (unsigned j = 0; j < 16; ++j) { const unsigned c = xb_ld(&bar[XB_XCNT(j)]); sum += c; cnt += (c > 0u) ? 1u : 0u; mine = (j == x) ? c : mine; }
        if (sum == G) break;
        __builtin_amdgcn_s_sleep(1);
        if ((++sp & 255u) == 0u) { if (xb_ld(&bar[XB_TMO])) break; if (sp > XB_SPIN_CAP) { atomicAdd(&bar[XB_TMO], 1u); break; } }
    }
    nloc = mine > 0u ? mine : 1u; nx = cnt > 0u ? cnt : 1u;
}
__device__ __forceinline__ void xcd_barrier(const XcdBarrier& b) {
    asm volatile("s_waitcnt vmcnt(0)" ::: "memory");
    __syncthreads();
    if (threadIdx.x == 0) {
        unsigned* bar = b.bar;
        __builtin_amdgcn_s_waitcnt(0);
        unsigned nloc = b.st[0], nx = b.st[1];
        if (nloc == 0u) { xcd_barrier_complete(bar, b.x, nloc, nx); b.st[0] = nloc; b.st[1] = nx; }
        const unsigned old = xb_add(&bar[XB_XSUB(b.x)], 1u);
        const unsigned gen = old / nloc;
        if (old + 1u == (gen + 1u) * nloc) {
            __builtin_amdgcn_fence(__ATOMIC_RELEASE, "agent");
            asm volatile("s_waitcnt vmcnt(0)" ::: "memory");
            const unsigned og = xb_add(&bar[XB_TOP], 1u);
            const unsigned tg = og / nx;
            if (og + 1u == (tg + 1u) * nx) xb_add(&bar[XB_TOPGEN], 1u);
            else XB_SPIN(xb_ld(&bar[XB_TOPGEN]) == tg, bar);
            __builtin_amdgcn_fence(__ATOMIC_ACQUIRE, "agent");
            xb_add(&bar[XB_XGEN(b.x)], 1u);
            asm volatile("s_waitcnt vmcnt(0)" ::: "memory");
        } else {
            XB_SPIN(xb_ld(&bar[XB_XGEN(b.x)]) == gen, bar);
            __builtin_amdgcn_fence(__ATOMIC_ACQUIRE, "agent");
            asm volatile("s_waitcnt vmcnt(0)" ::: "memory");
        }
    }
    __syncthreads();
}

__device__ __forceinline__ void ngemm_tile(const bf16_t* A, int lda, const float* W, int ldw, int K, int ncols, int row0, int col0, float (&acc)[8][4], float* lds) {
    float* As = lds; float* Bs = lds + 16 * 132;
    const int tid = tid_opaque(), ty = tid >> 5, tx = tid & 31;
#pragma unroll
    for (int i = 0; i < 8; ++i)
#pragma unroll
        for (int j = 0; j < 4; ++j) acc[i][j] = 0.f;
    for (int k0 = 0; k0 < K; k0 += 16) {
        {
            const int r = tid >> 2, kq = (tid & 3) * 4;
            const uint2 v = *(const uint2*)(A + (size_t)(row0 + r) * lda + k0 + kq);
            As[(kq + 0) * 132 + r] = bflo(v.x); As[(kq + 1) * 132 + r] = bfhi(v.x); As[(kq + 2) * 132 + r] = bflo(v.y); As[(kq + 3) * 132 + r] = bfhi(v.y);
        }
        {
            const int k = tid >> 5, c = (tid & 31) * 4;
            const float* wp = W + (size_t)(k0 + k) * ldw + col0 + c;
            float4 v = make_float4(0.f, 0.f, 0.f, 0.f);
            if (col0 + c + 3 < ncols) v = *(const float4*)wp;
            else { if (col0 + c < ncols) v.x = wp[0]; if (col0 + c + 1 < ncols) v.y = wp[1]; if (col0 + c + 2 < ncols) v.z = wp[2]; }
            *(float4*)(Bs + k * 128 + c) = v;
        }
        __syncthreads();
#pragma unroll 2
        for (int kk = 0; kk < 16; ++kk) {
            const float4 a0 = *(const float4*)(As + kk * 132 + ty * 8), a1 = *(const float4*)(As + kk * 132 + ty * 8 + 4);
            const float4 b = *(const float4*)(Bs + kk * 128 + tx * 4);
            const float a[8] = {a0.x, a0.y, a0.z, a0.w, a1.x, a1.y, a1.z, a1.w}; const float bb[4] = {b.x, b.y, b.z, b.w};
#pragma unroll
            for (int i = 0; i < 8; ++i)
#pragma unroll
                for (int j = 0; j < 4; ++j) acc[i][j] += a[i] * bb[j];
        }
        __syncthreads();
    }
}

__device__ __forceinline__ void ph_rmsnorm(const float* xsrc, const bf16_t* xs16, const float* g, bf16_t* H) {
    const int tidq = tid_opaque(); const int lane = tidq & 63, wid = tidq >> 6;
    float4 gv[4];
#pragma unroll
    for (int j = 0; j < 4; ++j) gv[j] = ((const float4*)g)[j * 64 + lane];
    for (int row0 = (blockIdx.x * 8 + wid) * 4; row0 < NTOK; row0 += gridDim.x * 32) {
        float4 v[4][4];
#pragma unroll
        for (int r = 0; r < 4; ++r) {
            if (xs16 == nullptr) { const float4* xp = (const float4*)(xsrc + (size_t)(row0 + r) * ND);
#pragma unroll
                for (int j = 0; j < 4; ++j) v[r][j] = xp[j * 64 + lane]; }
            else { const uint2* xp = (const uint2*)(xs16 + (size_t)(row0 + r) * ND);
#pragma unroll
                for (int j = 0; j < 4; ++j) { const uint2 w = xp[j * 64 + lane]; v[r][j] = make_float4(bflo(w.x), bfhi(w.x), bflo(w.y), bfhi(w.y)); } }
        }
#pragma unroll
        for (int r = 0; r < 4; ++r) {
            float ss = 0.f;
#pragma unroll
            for (int j = 0; j < 4; ++j) ss += v[r][j].x * v[r][j].x + v[r][j].y * v[r][j].y + v[r][j].z * v[r][j].z + v[r][j].w * v[r][j].w;
            ss = wsum_dpp(ss);
            const float rstd = rsqrtf(ss * (1.0f / ND) + EPS);
#pragma unroll
            for (int j = 0; j < 4; ++j) {
                uint2 o; o.x = pack2hw(v[r][j].x * rstd * gv[j].x, v[r][j].y * rstd * gv[j].y); o.y = pack2hw(v[r][j].z * rstd * gv[j].z, v[r][j].w * rstd * gv[j].w);
                *(uint2*)(H + (size_t)(row0 + r) * ND + (j * 64 + lane) * 4) = o;
            }
        }
    }
}

__device__ __forceinline__ void store_proj_raw(const Proj& pj, int tok, int c, float v) {
    if (c < 512) pj.aq[(size_t)tok * 512 + c] = f2bf(v);
    else if (c < 1024) pj.ak[(size_t)tok * 512 + c - 512] = f2bf(v);
    else if (c < 1536) pj.av[(size_t)tok * 512 + c - 1024] = f2bf(v);
    else if (c < 2048) pj.bq[(size_t)tok * 512 + c - 1536] = f2bf(v);
    else if (c < 2176) pj.bk[(size_t)tok * 128 + c - 2048] = f2bf(v);
    else if (c < 2304) pj.bv[(size_t)tok * 128 + c - 2176] = f2bf(v);
    else if (c < 2816) pj.cq[(size_t)tok * 512 + c - 2304] = f2bf(v);
    else if (c < 2880) pj.ck[(size_t)tok * 64 + c - 2816] = f2bf(v);
    else if (c < 2944) pj.cv[(size_t)tok * 64 + c - 2880] = f2bf(v);
    else if (c < 3072) pj.iq[(size_t)tok * 128 + c - 2944] = f2bf(v);
    else if (c < 3104) pj.ik[(size_t)tok * 32 + c - 3072] = f2bf(v);
    else if (c < 3108) pj.iw[(size_t)tok * 4 + c - 3104] = v * IWSCALE;
}
__device__ __forceinline__ void ph_inproj_naive(const Params& P_, int l, float* lds) {
    const KA P = ka_get();
    const Proj pj = proj_ptrs(P.ws);
    const bf16_t* H = (const bf16_t*)(P.ws + OFF_H);
    const float* W = P.in[I_WIN] + (size_t)l * ND * IN_COLS;
    const int tid = tid_opaque(), ty = tid >> 5, tx = tid & 31;
    for (int t = blockIdx.x; t < 256 * 25; t += gridDim.x) {
        const int tm = t / 25, tn = t % 25;
        float acc[8][4];
        ngemm_tile(H, ND, W, IN_COLS, ND, IN_COLS, tm * 128, tn * 128, acc, lds);
#pragma unroll
        for (int i = 0; i < 8; ++i)
#pragma unroll
            for (int j = 0; j < 4; ++j) { const int c = tn * 128 + tx * 4 + j; if (c < IN_COLS) store_proj_raw(pj, tm * 128 + ty * 8 + i, c, acc[i][j]); }
    }
}
__device__ __forceinline__ void ph_headnorm_naive(const Params& P_, int l) {
    const KA P = ka_get();
    const Proj pj = proj_ptrs(P.ws);
    const float* qkg = P.in[I_QKG] + (size_t)l * 3 * 2 * 64;
    const int tidq = tid_opaque(); const int lane = tidq & 63, wid = tidq >> 6;
    for (long t = (long)blockIdx.x * 8 + wid; t < (long)NTOK * 35; t += (long)gridDim.x * 8) {
        const int tok = (int)(t / 35), g = (int)(t % 35);
        bf16_t* p; const float* gv; float sc = 1.f;
        if (g < 8) { p = pj.aq + (size_t)tok * 512 + g * 64; gv = qkg + 0; sc = QSCALE; }
        else if (g < 16) { p = pj.ak + (size_t)tok * 512 + (g - 8) * 64; gv = qkg + 64; }
        else if (g < 24) { p = pj.bq + (size_t)tok * 512 + (g - 16) * 64; gv = qkg + 128; sc = QSCALE; }
        else if (g < 26) { p = pj.bk + (size_t)tok * 128 + (g - 24) * 64; gv = qkg + 192; }
        else if (g < 34) { p = pj.cq + (size_t)tok * 512 + (g - 26) * 64; gv = qkg + 256; sc = QSCALE; }
        else { p = pj.ck + (size_t)tok * 64; gv = qkg + 320; }
        const float v = bf2f(p[lane]);
        const float ss = wsum(v * v);
        p[lane] = f2bf(v * rsqrtf(ss * (1.0f / 64) + EPS) * gv[lane] * sc);
    }
}

__device__ __forceinline__ void ph_attnA_naive(const Params& P_, int l, float* lds) {
    const KA P = ka_get();
    const Proj pj = proj_ptrs(P.ws);
    bf16_t* BR = (bf16_t*)(P.ws + OFF_BR);
    const int tidq = tid_opaque(); const int lane = tidq & 63, wid = tidq >> 6;
    float* btab = lds;
    float* qs = lds + 128 + wid * 128;
    for (int i = tidq; i < 128; i += 512) btab[i] = P.in[I_RELB][(i >> 2) * 20 + (i & 3)] * LOG2E;
    __syncthreads();
    const float* lp = P.in[I_LAM] + (size_t)l * 256;
    const float linit = lambda_init_of(l);
    const float lam = expf(wsum(lp[lane] * lp[64 + lane])) - expf(wsum(lp[128 + lane] * lp[192 + lane])) + linit;
    const float* subg = P.in[I_SUBLN] + (size_t)l * 128;
    for (int t = blockIdx.x * 8 + wid; t < NB * 4 * NS; t += gridDim.x * 8) {
        const int q = t & (NS - 1), h = (t >> 12) & 3, b = t >> 14;
        const int tok = b * NS + q;
        qs[lane] = bf2f(pj.aq[(size_t)tok * 512 + (h * 2) * 64 + lane]);
        qs[64 + lane] = bf2f(pj.aq[(size_t)tok * 512 + (h * 2 + 1) * 64 + lane]);
        const int nkt = (q >> 6) + 1;
        float M0 = -INFINITY, Z0 = 0.f, M1 = -INFINITY, Z1 = 0.f;
        for (int kt = 0; kt < nkt; ++kt) {
            asm volatile("" ::: "memory");
            const int key = kt * 64 + lane;
            const uint4* kp = (const uint4*)(pj.ak + (size_t)(b * NS + key) * 512 + h * 128);
            float s0 = 0.f, s1 = 0.f;
#pragma unroll 1
            for (int d = 0; d < 8; ++d) { asm volatile("" ::: "memory"); s0 += dot8(kp[d], qs + d * 8); s1 += dot8(kp[8 + d], qs + 64 + d * 8); }
            const float bias = btab[t5_bucket(key - q) * 4 + h];
            s0 += bias; s1 += bias;
            float mn = fmaxf(M0, s0); Z0 = Z0 * exp2f(M0 - mn) + exp2f(s0 - mn); M0 = mn;
            mn = fmaxf(M1, s1); Z1 = Z1 * exp2f(M1 - mn) + exp2f(s1 - mn); M1 = mn;
        }
        { const float mw = wmax(M0); Z0 = wsum(Z0 * exp2f(M0 - mw)); M0 = mw; }
        { const float mw = wmax(M1); Z1 = wsum(Z1 * exp2f(M1 - mw)); M1 = mw; }
        const float iz0 = 1.f / Z0, iz1 = lam / Z1;
        float a0 = 0.f, a1 = 0.f;
        for (int kt = 0; kt < nkt; ++kt) {
            asm volatile("" ::: "memory");
            const int key = kt * 64 + lane;
            const uint4* kp = (const uint4*)(pj.ak + (size_t)(b * NS + key) * 512 + h * 128);
            float s0 = 0.f, s1 = 0.f;
#pragma unroll 1
            for (int d = 0; d < 8; ++d) { asm volatile("" ::: "memory"); s0 += dot8(kp[d], qs + d * 8); s1 += dot8(kp[8 + d], qs + 64 + d * 8); }
            const float bias = btab[t5_bucket(key - q) * 4 + h];
            const float p = exp2f(s0 + bias - M0) * iz0 - exp2f(s1 + bias - M1) * iz1;
            const unsigned* vp = (const unsigned*)(pj.av + (size_t)(b * NS + kt * 64) * 512 + h * 128) + lane;
#pragma unroll 4
            for (int j = 0; j < 64; ++j) { const float pjv = __shfl(p, j); const unsigned w = vp[(size_t)j * 256]; a0 += pjv * bflo(w); a1 += pjv * bfhi(w); }
        }
        const float ss = wsum(a0 * a0 + a1 * a1);
        const float rstd = rsqrtf(ss * (1.0f / 128) + EPS) * (1.0f - linit);
        *(unsigned*)(BR + (size_t)tok * 1536 + h * 128 + lane * 2) = pack2(a0 * rstd * subg[lane * 2], a1 * rstd * subg[lane * 2 + 1]);
    }
}

__device__ __forceinline__ void ph_attnB_naive(const Params& P_, int l, float* lds) {
    const KA P = ka_get();
    const Proj pj = proj_ptrs(P.ws);
    bf16_t* BR = (bf16_t*)(P.ws + OFF_BR);
    const int tidq = tid_opaque(); const int lane = tidq & 63, wid = tidq >> 6;
    float* btab = lds;
    float* qs = lds + 256 + wid * 64;
    __syncthreads();
    for (int i = tidq; i < 256; i += 512) btab[i] = P.in[I_RELB][(i >> 3) * 20 + 4 + (i & 7)] * LOG2E;
    __syncthreads();
    const float* sinks = P.in[I_SINK] + (size_t)l * 8;
    for (int t = blockIdx.x * 8 + wid; t < NTOK * 8; t += gridDim.x * 8) {
        const int hq = t & 7, tok = t >> 3, q = tok & (NS - 1), b = tok >> 12, kvh = hq >> 2, c = q >> 6;
        qs[lane] = bf2f(pj.bq[(size_t)tok * 512 + hq * 64 + lane]);
        float s[3];
#pragma unroll
        for (int g = 0; g < 3; ++g) {
            const int pos = c * 64 - 128 + g * 64 + lane;
            s[g] = -INFINITY;
            if (pos >= 0) {
                const uint4* kp = (const uint4*)(pj.bk + (size_t)(b * NS + pos) * 128 + kvh * 64);
                float a = 0.f;
#pragma unroll
                for (int d = 0; d < 8; ++d) a += dot8(kp[d], qs + d * 8);
                s[g] = a + btab[t5_bucket(pos - q) * 8 + hq];
            }
        }
        const float sink = sinks[hq] * LOG2E;
        const float m = fmaxf(wmax(fmaxf(fmaxf(s[0], s[1]), s[2])), sink);
        float e[3];
#pragma unroll
        for (int g = 0; g < 3; ++g) e[g] = exp2f(s[g] - m);
        const float Z = wsum(e[0] + e[1] + e[2]) + exp2f(sink - m);
        const float iz = 1.f / Z;
        float acc = 0.f;
#pragma unroll
        for (int g = 0; g < 3; ++g) {
            const int pos0 = c * 64 - 128 + g * 64;
            if (pos0 >= 0) {
                const bf16_t* vp = pj.bv + (size_t)(b * NS + pos0) * 128 + kvh * 64 + lane;
#pragma unroll 4
                for (int j = 0; j < 64; ++j) acc += __shfl(e[g], j) * bf2f(vp[(size_t)j * 128]);
            }
        }
        BR[(size_t)tok * 1536 + 512 + hq * 64 + lane] = f2bf(acc * iz);
    }
}

__device__ __forceinline__ void ph_attnC_naive(const Params& P_, int l, float* lds) {
    const KA P = ka_get();
    const Proj pj = proj_ptrs(P.ws);
    bf16_t* BR = (bf16_t*)(P.ws + OFF_BR);
    const int tidq = tid_opaque(); const int lane = tidq & 63, wid = tidq >> 6;
    float* btab = lds;
    unsigned* keys = (unsigned*)(lds + 256) + wid * 4480;
    int* sel = (int*)(keys + 4096);
    float* iqs = (float*)(keys + 4096 + 256);
    __syncthreads();
    for (int i = tidq; i < 256; i += 512) btab[i] = P.in[I_RELB][(i >> 3) * 20 + 12 + (i & 7)] * LOG2E;
    __syncthreads();
    for (int tok = blockIdx.x * 8 + wid; tok < NTOK; tok += gridDim.x * 8) {
        const int q = tok & (NS - 1), b = tok >> 12, c = q >> 6, N = (c + 1) * 64, ntile = c + 1;
        iqs[lane] = bf2f(pj.iq[(size_t)tok * 128 + lane]); iqs[64 + lane] = bf2f(pj.iq[(size_t)tok * 128 + 64 + lane]);
        const float4 wv = *(const float4*)(pj.iw + (size_t)tok * 4);
        int cnt;
        if (N <= 256) { for (int i = lane; i < N; i += 64) sel[i] = i; cnt = N; }
        else {
            for (int kt = 0; kt < ntile; ++kt) {
                asm volatile("" ::: "memory");
                const int key = kt * 64 + lane;
                const uint4* kp = (const uint4*)(pj.ik + (size_t)(b * NS + key) * 32);
                const uint4 k0 = kp[0], k1 = kp[1], k2 = kp[2], k3 = kp[3];
                float sc = 0.f;
#pragma unroll
                for (int hh = 0; hh < 4; ++hh) {
                    const float lg = dot8(k0, iqs + hh * 32) + dot8(k1, iqs + hh * 32 + 8) + dot8(k2, iqs + hh * 32 + 16) + dot8(k3, iqs + hh * 32 + 24);
                    const float w = hh == 0 ? wv.x : hh == 1 ? wv.y : hh == 2 ? wv.z : wv.w;
                    sc += fmaxf(lg, 0.f) * w;
                }
                sc += 0.0f;
                const unsigned u = __float_as_uint(sc);
                keys[key] = (u & 0x80000000u) ? ~u : (u | 0x80000000u);
            }
            unsigned T = 0;
            for (int bit = 31; bit >= 0; --bit) {
                const unsigned cand = T | (1u << bit);
                int n = 0;
                for (int kt = 0; kt < ntile; ++kt) n += __popcll(__ballot(keys[kt * 64 + lane] >= cand));
                if (n >= 256) T = cand;
            }
            int ngt = 0;
            for (int kt = 0; kt < ntile; ++kt) ngt += __popcll(__ballot(keys[kt * 64 + lane] > T));
            const int need = 256 - ngt;
            int nsel = 0, neq = 0;
            const unsigned long long ltmask = (1ull << lane) - 1ull;
            for (int kt = 0; kt < ntile; ++kt) {
                const unsigned kv = keys[kt * 64 + lane];
                const unsigned long long eqm = __ballot(kv == T);
                const bool take = (kv > T) || (kv == T && (neq + __popcll(eqm & ltmask)) < need);
                const unsigned long long tm = __ballot(take);
                if (take) sel[nsel + __popcll(tm & ltmask)] = kt * 64 + lane;
                nsel += __popcll(tm); neq += __popcll(eqm);
            }
            cnt = 256;
        }
        int idx[4];
#pragma unroll
        for (int j = 0; j < 4; ++j) idx[j] = (lane + 64 * j < cnt) ? sel[lane + 64 * j] : 0;
        for (int h = 0; h < 8; ++h) {
            iqs[lane] = bf2f(pj.cq[(size_t)tok * 512 + h * 64 + lane]);
            const float* qv = iqs;
            float s[4];
#pragma unroll
            for (int j = 0; j < 4; ++j) {
                asm volatile("" ::: "memory");
                s[j] = -INFINITY;
                if (lane + 64 * j < cnt) {
                    const uint4* kp = (const uint4*)(pj.ck + (size_t)(b * NS + idx[j]) * 64);
                    float a = 0.f;
#pragma unroll
                    for (int d = 0; d < 8; ++d) a += dot8(kp[d], qv + d * 8);
                    s[j] = a + btab[t5_bucket(idx[j] - q) * 8 + h];
                }
            }
            const float m = wmax(fmaxf(fmaxf(s[0], s[1]), fmaxf(s[2], s[3])));
            float e[4];
#pragma unroll
            for (int j = 0; j < 4; ++j) e[j] = exp2f(s[j] - m);
            const float iz = 1.f / wsum(e[0] + e[1] + e[2] + e[3]);
            float acc = 0.f;
#pragma unroll
            for (int j = 0; j < 4; ++j) {
                const int nj = cnt - 64 * j < 64 ? cnt - 64 * j : 64;
#pragma unroll 2
                for (int i = 0; i < nj; ++i) { const float pv = __shfl(e[j], i); const int id = __shfl(idx[j], i); acc += pv * bf2f(pj.cv[(size_t)(b * NS + id) * 64 + lane]); }
            }
            BR[(size_t)tok * 1536 + 1024 + h * 64 + lane] = f2bf(acc * iz);
        }
    }
}

__device__ __forceinline__ void ph_gatebranch_naive(const Params& P_, int l, float* lds) {
    const KA P = ka_get();
    const bf16_t* H = (const bf16_t*)(P.ws + OFF_H);
    const bf16_t* BR = (const bf16_t*)(P.ws + OFF_BR);
    bf16_t* MG = (bf16_t*)(P.ws + OFF_MERGED);
    const float* Wg = P.in[I_WGATE] + (size_t)l * ND * 3072;
    const float* bg = P.in[I_BGATE] + (size_t)l * 3072;
    const float* Wb = P.in[I_WBR] + (size_t)l * 3 * 512 * ND;
    const int tid = tid_opaque(), ty = tid >> 5, tx = tid & 31;
    for (int t = blockIdx.x; t < 256 * 8; t += gridDim.x) {
        const int tm = t >> 3, tn = t & 7;
        float m[8][4];
#pragma unroll
        for (int i = 0; i < 8; ++i)
#pragma unroll
            for (int j = 0; j < 4; ++j) m[i][j] = 0.f;
        for (int n = 0; n < 3; ++n) {
            float g[8][4], y[8][4];
            ngemm_tile(H, ND, Wg, 3072, ND, 3072, tm * 128, n * 1024 + tn * 128, g, lds);
            ngemm_tile(BR + n * 512, 1536, Wb + (size_t)n * 512 * ND, ND, 512, ND, tm * 128, tn * 128, y, lds);
#pragma unroll
            for (int i = 0; i < 8; ++i)
#pragma unroll
                for (int j = 0; j < 4; ++j) { const float z = g[i][j] + bg[n * 1024 + tn * 128 + tx * 4 + j]; m[i][j] += y[i][j] / (1.f + expf(-z)); }
        }
#pragma unroll
        for (int i = 0; i < 8; ++i) {
            uint2 o; o.x = pack2(m[i][0], m[i][1]); o.y = pack2(m[i][2], m[i][3]);
            *(uint2*)(MG + (size_t)(tm * 128 + ty * 8 + i) * ND + tn * 128 + tx * 4) = o;
        }
    }
}
__device__ __forceinline__ void ph_out_naive(const Params& P_, int l, float* lds) {
    const KA P = ka_get();
    const bf16_t* MG = (const bf16_t*)(P.ws + OFF_MERGED);
    const float* W = P.in[I_WOUT] + (size_t)l * ND * ND;
    const float* xsrc = l == 0 ? P.in[I_X] : P.out;
    const int tid = tid_opaque(), ty = tid >> 5, tx = tid & 31;
    for (int t = blockIdx.x; t < 256 * 8; t += gridDim.x) {
        const int tm = t >> 3, tn = t & 7;
        float acc[8][4];
        ngemm_tile(MG, ND, W, ND, ND, ND, tm * 128, tn * 128, acc, lds);
#pragma unroll
        for (int i = 0; i < 8; ++i) {
            const size_t o = (size_t)(tm * 128 + ty * 8 + i) * ND + tn * 128 + tx * 4;
            const float4 xv = *(const float4*)(xsrc + o);
            *(float4*)(P.out + o) = make_float4(xv.x + acc[i][0], xv.y + acc[i][1], xv.z + acc[i][2], xv.w + acc[i][3]);
        }
    }
}

__device__ __forceinline__ void ph_norm2_route(const Params& P_, int l, float* lds_) {
    const KA P = ka_get();
    bf16_t* H = (bf16_t*)(P.ws + OFF_H);
    int* eid = (int*)(P.ws + OFF_ROUTE); float* ew = (float*)(P.ws + OFF_ROUTE + 256 * 1024);
    const float* g = P.in[I_NFG] + (size_t)l * ND;
    const float* wrg = P.in[I_WRG] + (size_t)l * ND * 4; const float* brg = P.in[I_BRG] + (size_t)l * 4;
    const float* wre = P.in[I_WRE] + (size_t)l * ND * 16; const float* bre = P.in[I_BRE] + (size_t)l * 16;
    const int tidq = tid_opaque(); const int lane = tidq & 63, wid = tidq >> 6;
    typedef float v4f __attribute__((ext_vector_type(4)));
    LAS v4f* wl = (LAS v4f*)lds_;
    __syncthreads();
    for (int idx = tidq; idx < 5120; idx += 512) {
        const int ln = idx & 63, t = idx >> 6, q = t % 5, je = t / 5, k = ((je >> 2) * 64 + ln) * 4 + (je & 3);
        wl[idx] = q == 0 ? *(const v4f*)(wrg + (size_t)k * 4) : *(const v4f*)(wre + (size_t)k * 16 + (q - 1) * 4);
    }
    __syncthreads();
    for (int row0 = (blockIdx.x * 8 + wid) * 2; row0 < NTOK; row0 += gridDim.x * 16) {
        float4 v[2][4]; float rstd[2];
#pragma unroll
        for (int r = 0; r < 2; ++r) { const uint2* xp = (const uint2*)((const bf16_t*)(P.ws + OFF_STREAM) + (size_t)(row0 + r) * ND);
#pragma unroll
            for (int j = 0; j < 4; ++j) { const uint2 w = xp[j * 64 + lane]; v[r][j] = make_float4(bflo(w.x), bfhi(w.x), bflo(w.y), bfhi(w.y)); } }
#pragma unroll
        for (int r = 0; r < 2; ++r) { float ss = 0.f;
#pragma unroll
            for (int j = 0; j < 4; ++j) ss += v[r][j].x * v[r][j].x + v[r][j].y * v[r][j].y + v[r][j].z * v[r][j].z + v[r][j].w * v[r][j].w;
            rstd[r] = rsqrtf(wsum_dpp(ss) * (1.0f / ND) + EPS); }
        float lg[2][20];
#pragma unroll
        for (int r = 0; r < 2; ++r)
#pragma unroll
            for (int i = 0; i < 20; ++i) lg[r][i] = 0.f;
#pragma unroll
        for (int j = 0; j < 4; ++j) {
            const int k0 = (j * 64 + lane) * 4;
            const float4 gv = ((const float4*)g)[j * 64 + lane];
            float hv[2][4];
#pragma unroll
            for (int r = 0; r < 2; ++r) {
                hv[r][0] = v[r][j].x * rstd[r] * gv.x; hv[r][1] = v[r][j].y * rstd[r] * gv.y; hv[r][2] = v[r][j].z * rstd[r] * gv.z; hv[r][3] = v[r][j].w * rstd[r] * gv.w;
                uint2 o; o.x = pack2hw(hv[r][0], hv[r][1]); o.y = pack2hw(hv[r][2], hv[r][3]);
                *(uint2*)(H + (size_t)(row0 + r) * ND + k0) = o;
            }
#pragma unroll
            for (int e = 0; e < 4; ++e) {
                const LAS v4f* wp = wl + ((j * 4 + e) * 5) * 64 + lane;
                const v4f wg4 = wp[0], w0 = wp[64], w1 = wp[128], w2 = wp[192], w3 = wp[256];
#pragma unroll
                for (int r = 0; r < 2; ++r) {
                    const float x = hv[r][e];
                    lg[r][0] += x * wg4.x; lg[r][1] += x * wg4.y; lg[r][2] += x * wg4.z; lg[r][3] += x * wg4.w;
                    lg[r][4] += x * w0.x; lg[r][5] += x * w0.y; lg[r][6] += x * w0.z; lg[r][7] += x * w0.w;
                    lg[r][8] += x * w1.x; lg[r][9] += x * w1.y; lg[r][10] += x * w1.z; lg[r][11] += x * w1.w;
                    lg[r][12] += x * w2.x; lg[r][13] += x * w2.y; lg[r][14] += x * w2.z; lg[r][15] += x * w2.w;
                    lg[r][16] += x * w3.x; lg[r][17] += x * w3.y; lg[r][18] += x * w3.z; lg[r][19] += x * w3.w;
                }
            }
            asm volatile("" ::: "memory");
        }
#pragma unroll
        for (int r = 0; r < 2; ++r)
#pragma unroll
            for (int i = 0; i < 20; ++i) lg[r][i] = wsum_dpp(lg[r][i]);
        if (lane < 2) {
            const int row = row0 + lane;
            float lgl[20];
#pragma unroll
            for (int i = 0; i < 20; ++i) lgl[i] = lane == 0 ? lg[0][i] : lg[1][i];
            float gl[4];
#pragma unroll
            for (int i = 0; i < 4; ++i) gl[i] = lgl[i] + brg[i];
            int gs = 0; float gm = gl[0];
#pragma unroll
            for (int i = 1; i < 4; ++i) if (gl[i] > gm) { gm = gl[i]; gs = i; }
            float zs = 0.f;
#pragma unroll
            for (int i = 0; i < 4; ++i) zs += expf(gl[i] - gm);
            const float pgroup = 1.f / zs;
            float el[4];
#pragma unroll
            for (int i = 0; i < 4; ++i) { el[i] = 0.f;
#pragma unroll
                for (int gq = 0; gq < 4; ++gq) if (gq == gs) el[i] = lgl[4 + gq * 4 + i] + bre[gq * 4 + i]; }
            int e1 = 0; float v1 = el[0];
#pragma unroll
            for (int i = 1; i < 4; ++i) if (el[i] > v1) { v1 = el[i]; e1 = i; }
            int e2 = -1; float v2 = -INFINITY;
#pragma unroll
            for (int i = 0; i < 4; ++i) if (i != e1 && el[i] > v2) { v2 = el[i]; e2 = i; }
            const float x2 = expf(v2 - v1), w1 = 1.f / (1.f + x2), w2 = x2 / (1.f + x2);
            eid[row * 2] = gs * 4 + e1; eid[row * 2 + 1] = gs * 4 + e2;
            ew[row * 2] = w1 * pgroup; ew[row * 2 + 1] = w2 * pgroup;
            const int lo = e1 < e2 ? e1 : e2, hi = e1 < e2 ? e2 : e1;
            const int bk = gs * 6 + (lo == 0 ? hi - 1 : (lo == 1 ? hi + 1 : 5));
            const int pos = atomicAdd((int*)(P.ws + OFF_CTRL + MOE_CNT_OFF) + l * 32 + bk, 1);
            ((int*)(P.ws + OFF_ROUTE + MOE_LIST_OFF))[bk * NTOK + pos] = row;
            float* rw = (float*)(P.ws + OFF_ROUTE + MOE_RW_OFF);
            rw[row * 2] = (e1 < e2 ? w1 : w2) * pgroup; rw[row * 2 + 1] = (e1 < e2 ? w2 : w1) * pgroup;
        }
    }
}

__device__ __forceinline__ void ph_moe_naive(const Params& P_, int l, float* lds) {
    const KA P = ka_get();
    const bf16_t* H = (const bf16_t*)(P.ws + OFF_H);
    const int* eid = (const int*)(P.ws + OFF_ROUTE); const float* ew = (const float*)(P.ws + OFF_ROUTE + 256 * 1024);
    const int tidq = tid_opaque(); const int lane = tidq & 63, wid = tidq >> 6;
    float* hs = lds + wid * 1280;
    float* hid = hs + 1024;
    for (int tok = blockIdx.x * 8 + wid; tok < NTOK; tok += gridDim.x * 8) {
#pragma unroll
        for (int j = 0; j < 4; ++j) { const uint2 w = *(const uint2*)(H + (size_t)tok * ND + (j * 64 + lane) * 4); float* d = hs + (j * 64 + lane) * 4; d[0] = bflo(w.x); d[1] = bfhi(w.x); d[2] = bflo(w.y); d[3] = bfhi(w.y); }
        float o[16];
#pragma unroll
        for (int i = 0; i < 16; ++i) o[i] = 0.f;
        for (int s = 0; s < 2; ++s) {
            const int e = eid[tok * 2 + s]; const float w = ew[tok * 2 + s];
            const float* wg = P.in[I_WFG] + ((size_t)l * 16 + e) * ND * 256;
            const float* wu = P.in[I_WFU] + ((size_t)l * 16 + e) * ND * 256;
            const float* wd = P.in[I_WFD] + ((size_t)l * 16 + e) * 256 * ND;
            float4 ga = make_float4(0.f, 0.f, 0.f, 0.f), ua = ga;
            for (int k = 0; k < ND; ++k) {
                const float hv = hs[k];
                const float4 a = *(const float4*)(wg + (size_t)k * 256 + lane * 4), u = *(const float4*)(wu + (size_t)k * 256 + lane * 4);
                ga.x += hv * a.x; ga.y += hv * a.y; ga.z += hv * a.z; ga.w += hv * a.w; ua.x += hv * u.x; ua.y += hv * u.y; ua.z += hv * u.z; ua.w += hv * u.w;
            }
            float4 hv4;
            hv4.x = ga.x / (1.f + expf(-ga.x)) * ua.x * w; hv4.y = ga.y / (1.f + expf(-ga.y)) * ua.y * w; hv4.z = ga.z / (1.f + expf(-ga.z)) * ua.z * w; hv4.w = ga.w / (1.f + expf(-ga.w)) * ua.w * w;
            *(float4*)(hid + lane * 4) = hv4;
            for (int f = 0; f < 256; ++f) {
                const float hf = hid[f];
#pragma unroll
                for (int j = 0; j < 4; ++j) { const float4 d = *(const float4*)(wd + (size_t)f * ND + (j * 64 + lane) * 4); o[j * 4] += hf * d.x; o[j * 4 + 1] += hf * d.y; o[j * 4 + 2] += hf * d.z; o[j * 4 + 3] += hf * d.w; }
            }
        }
#pragma unroll
        for (int j = 0; j < 4; ++j) {
            float4* op = (float4*)(P.out + (size_t)tok * ND + (j * 64 + lane) * 4);
            float4 x = *op; x.x += o[j * 4]; x.y += o[j * 4 + 1]; x.z += o[j * 4 + 2]; x.w += o[j * 4 + 3]; *op = x;
        }
    }
}


namespace mm {
typedef short bf16x8 __attribute__((ext_vector_type(8)));
typedef float f32x16 __attribute__((ext_vector_type(16)));
typedef float f32x4 __attribute__((ext_vector_type(4)));
typedef unsigned u32x4 __attribute__((ext_vector_type(4)));
constexpr int OPB = 256 * 128;
constexpr int STG = 2 * OPB;
constexpr int LDS_NEED = 2 * STG;
__host__ __device__ __forceinline__ int img_col(int rho) { const int i = rho & 31; return (rho & ~31) + 16 * ((i >> 2) & 1) + 4 * (i >> 3) + (i & 3); }
__device__ __forceinline__ unsigned cvt_pk_bf16(float lo, float hi) { unsigned r; asm volatile("v_cvt_pk_bf16_f32 %0, %1, %2" : "=v"(r) : "v"(lo), "v"(hi)); return r; }
__device__ __forceinline__ u32x4 pack8(const f32x16& v, int o) { u32x4 w; w.x = cvt_pk_bf16(v[o], v[o + 1]); w.y = cvt_pk_bf16(v[o + 2], v[o + 3]); w.z = cvt_pk_bf16(v[o + 4], v[o + 5]); w.w = cvt_pk_bf16(v[o + 6], v[o + 7]); return w; }

struct Unit {
    const char* a;
    const char* b0;
    const char* b1;
    int lda, ldb;
    int nk, nseg;
    int pm, pn, tag;
    int aux0, aux1;
};
__device__ __forceinline__ bool static_tile(long L, int nM, int nN, int& pm, int& pn) {
    const int nwg = nM * nN; if (L >= nwg) return false;
    int wgid = (int)L; { const int q = nwg / 8, r = nwg % 8, xcd = wgid % 8, off = wgid / 8; wgid = (xcd < r ? xcd * (q + 1) : r * (q + 1) + (xcd - r) * q) + off; }
    const int nig = 8 * nN, gid = wgid / nig, fm = gid * 8, gsz = (nM - fm) < 8 ? (nM - fm) : 8;
    pm = fm + ((wgid % nig) % gsz); pn = (wgid % nig) / gsz; return true;
}

template <class Epi, class Sched>
__device__ __forceinline__ void gemm_phase(char* smem, const Sched& S, const Epi& E) {
    const int tid = tid_opaque(), lane = tid & 63, wid = __builtin_amdgcn_readfirstlane(tid >> 6), wm = wid >> 2, wn = wid & 3, r32 = lane & 31, h = lane >> 5;
    LAS char* lds = (LAS char*)smem;
    const int srow = tid >> 3, sc = tid & 7;
    const unsigned sts = (unsigned)(srow * 128 + ((sc ^ ((srow >> 1) & 7)) << 4));
    const unsigned rda = (unsigned)((wm * 128 + r32) * 128), rdb = (unsigned)(OPB + (wn * 64 + r32) * 128);
    const unsigned x7 = (unsigned)((r32 >> 1) & 7);
    Unit lu; int ci = 0, li = 0;
    if (!S.next(0, lu)) return;
    int cnk = lu.nk;
    constexpr int NA = Sched::GATHER ? 4 : 1;
    unsigned ao[NA], bo;
    auto offs = [&](const Unit& u, unsigned (&a)[NA], unsigned& b) {
        int t2 = tid; asm volatile("" : "+v"(t2));
        const int r0 = t2 >> 3, c16 = (t2 & 7) * 16;
        S.a_rows(u, r0, a);
#pragma unroll
        for (int q = 0; q < NA; ++q) a[q] += (unsigned)c16;
        b = (unsigned)(r0 * u.ldb * 2 + c16);
    };
    offs(lu, ao, bo);
    f32x16 acc[4][2];
#pragma unroll
    for (int i = 0; i < 4; ++i)
#pragma unroll
        for (int j = 0; j < 2; ++j)
#pragma unroll
            for (int e = 0; e < 16; ++e) acc[i][j][e] = 0.f;
    u32x4 ga[4], gb[4];
#define MM_GLOAD(u, k, A_, B_) do { \
        const __amdgpu_buffer_rsrc_t ra_ = __builtin_amdgcn_make_buffer_rsrc((void*)(u).a, 0, 0x7fffffff, 0x00020000); \
        const __amdgpu_buffer_rsrc_t rb_ = __builtin_amdgcn_make_buffer_rsrc((void*)((k) < (u).nseg ? (u).b0 : (u).b1), 0, 0x7fffffff, 0x00020000); \
        const unsigned ko_ = (unsigned)(k) * 128u, as_ = (unsigned)(u).lda * 128u, bs_ = (unsigned)(u).ldb * 128u; \
        _Pragma("unroll") for (int q_ = 0; q_ < 4; ++q_) { \
            ga[q_] = __builtin_bit_cast(u32x4, __builtin_amdgcn_raw_buffer_load_b128(ra_, Sched::GATHER ? (A_)[q_ % NA] : (A_)[0], Sched::GATHER ? ko_ : ko_ + q_ * as_, 0)); \
            gb[q_] = __builtin_bit_cast(u32x4, __builtin_amdgcn_raw_buffer_load_b128(rb_, (B_), ko_ + q_ * bs_, 0)); } } while (0)
#define MM_LSTORE(buf) do { LAS char* p_ = lds + (buf) * STG + sts; \
        _Pragma("unroll") for (int q_ = 0; q_ < 4; ++q_) { *(LAS u32x4*)(p_ + q_ * 8192) = ga[q_]; *(LAS u32x4*)(p_ + OPB + q_ * 8192) = gb[q_]; } } while (0)
#define MM_LOADF(ks, AF, BF) do { const unsigned xo_ = (((unsigned)((ks) * 2 + h)) ^ x7) << 4; \
        _Pragma("unroll") for (int nt = 0; nt < 2; ++nt) BF[nt] = *(const LAS bf16x8*)(base + rdb + nt * 4096 + xo_); \
        _Pragma("unroll") for (int mt = 0; mt < 4; ++mt) AF[mt] = *(const LAS bf16x8*)(base + rda + mt * 4096 + xo_); } while (0)
#define MM_MMA(AF, BF) do { _Pragma("unroll") for (int mt = 0; mt < 4; ++mt) _Pragma("unroll") for (int nt = 0; nt < 2; ++nt) \
        acc[mt][nt] = Epi::TRANSP ? __builtin_amdgcn_mfma_f32_32x32x16_bf16(BF[nt], AF[mt], acc[mt][nt], 0, 0, 0) : __builtin_amdgcn_mfma_f32_32x32x16_bf16(AF[mt], BF[nt], acc[mt][nt], 0, 0, 0); } while (0)
#define MM_SB __builtin_amdgcn_sched_barrier(0)
    bool lvalid = true; int lk = 0;
    auto ladv = [&]() {
        if (++lk < lu.nk) return;
        lk = 0;
        Unit nu; if (S.next(li + 1, nu)) { lu = nu; ++li; offs(lu, ao, bo); } else lvalid = false;
    };
    MM_GLOAD(lu, 0, ao, bo);
    MM_LSTORE(0);
    ladv();
    if (lvalid) MM_GLOAD(lu, lk, ao, bo);
    __syncthreads();
    int buf = 0, ck = 0;
    for (;;) {
        const LAS char* base = lds + buf * STG;
        const bool pend = lvalid;
        if constexpr (Sched::PIPE) {
            bf16x8 af0[4], bf0[2], af1[4], bf1[2];
            MM_LOADF(0, af0, bf0); MM_SB;
            MM_LOADF(1, af1, bf1); MM_SB; MM_MMA(af0, bf0); MM_SB;
            MM_LOADF(2, af0, bf0); MM_SB; MM_MMA(af1, bf1); MM_SB;
            MM_LOADF(3, af1, bf1); MM_SB;
            if (pend) { MM_LSTORE(buf ^ 1); ladv(); if (lvalid) MM_GLOAD(lu, lk, ao, bo); }
            MM_SB; MM_MMA(af0, bf0); MM_SB; MM_MMA(af1, bf1); MM_SB;
        } else {
            bf16x8 af0[4], bf0[2];
            MM_LOADF(0, af0, bf0); MM_MMA(af0, bf0); MM_SB;
            MM_LOADF(1, af0, bf0); MM_MMA(af0, bf0); MM_SB;
            if (pend) { MM_LSTORE(buf ^ 1); ladv(); if (lvalid) MM_GLOAD(lu, lk, ao, bo); }
            MM_SB; MM_LOADF(2, af0, bf0); MM_MMA(af0, bf0); MM_SB;
            MM_LOADF(3, af0, bf0); MM_MMA(af0, bf0); MM_SB;
        }
        bool more = true;
        if (++ck == cnk) {
            { PROF_BEGIN(99) Unit eu; S.next(ci, eu); E(acc, eu, wm, wn, r32, h, tid); if (PROF_ID == Epi::PROF && threadIdx.x == 0) { *(volatile LAS unsigned*)(lds + PROF_LDS_OFF) += (unsigned)(__builtin_amdgcn_s_memrealtime() - _pt99); } }
#pragma unroll
            for (int i = 0; i < 4; ++i)
#pragma unroll
                for (int j = 0; j < 2; ++j)
#pragma unroll
                    for (int e = 0; e < 16; ++e) acc[i][j][e] = 0.f;
            ck = 0; ++ci;
            { Unit nu2; more = S.next(ci, nu2); if (more) cnk = nu2.nk; }
        }
        __syncthreads();
        buf ^= 1;
        if (!more) break;
    }
#undef MM_GLOAD
#undef MM_LSTORE
#undef MM_LOADF
#undef MM_MMA
#undef MM_SB
}
__device__ __forceinline__ void plain_rows(const Unit& u, int r0, unsigned (&a)[1]) { a[0] = (unsigned)(r0 * u.lda * 2); }
}

constexpr int EPI_TAB = 131072 + 2048;
constexpr size_t WT_IN = 0;
constexpr size_t WT_GATE = WT_IN + (size_t)3328 * 1024 * 2;
constexpr size_t WT_BR = WT_GATE + (size_t)3072 * 1024 * 2;
constexpr size_t WT_OUT = WT_BR + (size_t)3 * 1024 * 512 * 2;
constexpr size_t WT_GU = WT_OUT + (size_t)1024 * 1024 * 2;
constexpr size_t WT_DN = WT_GU + (size_t)16 * 512 * 1024 * 2;
constexpr size_t WT_END = WT_DN + (size_t)16 * 1024 * 256 * 2;
static_assert(WT_END <= 44 * MB, "weight image region");

template <class F>
__device__ __forceinline__ void cvt_tile(bf16_t* Bt, int K, int rho0, int k0, const float* W, int ldw, const F& colof, int tid) {
    const int rho = rho0 + (tid & 63) * 4, kg = k0 + (tid >> 6) * 16;
    const int c = colof(rho);
    float4 v[16];
#pragma unroll
    for (int j = 0; j < 16; ++j) v[j] = c >= 0 ? *(const float4*)(W + (size_t)(kg + j) * ldw + c) : make_float4(0.f, 0.f, 0.f, 0.f);
#pragma unroll
    for (int hf = 0; hf < 2; ++hf) {
        mm::u32x4 o;
        o.x = mm::cvt_pk_bf16(v[8 * hf + 0].x, v[8 * hf + 1].x); o.y = mm::cvt_pk_bf16(v[8 * hf + 2].x, v[8 * hf + 3].x); o.z = mm::cvt_pk_bf16(v[8 * hf + 4].x, v[8 * hf + 5].x); o.w = mm::cvt_pk_bf16(v[8 * hf + 6].x, v[8 * hf + 7].x); *(mm::u32x4*)(Bt + (size_t)(rho + 0) * K + kg + 8 * hf) = o;
        o.x = mm::cvt_pk_bf16(v[8 * hf + 0].y, v[8 * hf + 1].y); o.y = mm::cvt_pk_bf16(v[8 * hf + 2].y, v[8 * hf + 3].y); o.z = mm::cvt_pk_bf16(v[8 * hf + 4].y, v[8 * hf + 5].y); o.w = mm::cvt_pk_bf16(v[8 * hf + 6].y, v[8 * hf + 7].y); *(mm::u32x4*)(Bt + (size_t)(rho + 1) * K + kg + 8 * hf) = o;
        o.x = mm::cvt_pk_bf16(v[8 * hf + 0].z, v[8 * hf + 1].z); o.y = mm::cvt_pk_bf16(v[8 * hf + 2].z, v[8 * hf + 3].z); o.z = mm::cvt_pk_bf16(v[8 * hf + 4].z, v[8 * hf + 5].z); o.w = mm::cvt_pk_bf16(v[8 * hf + 6].z, v[8 * hf + 7].z); *(mm::u32x4*)(Bt + (size_t)(rho + 2) * K + kg + 8 * hf) = o;
        o.x = mm::cvt_pk_bf16(v[8 * hf + 0].w, v[8 * hf + 1].w); o.y = mm::cvt_pk_bf16(v[8 * hf + 2].w, v[8 * hf + 3].w); o.z = mm::cvt_pk_bf16(v[8 * hf + 4].w, v[8 * hf + 5].w); o.w = mm::cvt_pk_bf16(v[8 * hf + 6].w, v[8 * hf + 7].w); *(mm::u32x4*)(Bt + (size_t)(rho + 3) * K + kg + 8 * hf) = o;
    }
}
__device__ __forceinline__ void cvt_tile_pair(bf16_t* Bt, int K, int rho0, int k0, const float* W, int ldw, int tid) {
    const int rho = rho0 + (tid & 63) * 4, kg = k0 + (tid >> 6) * 16;
    const int nt = (rho >> 5) & 1, cb = (rho & ~63) + 2 * (rho & 31);
#pragma unroll
    for (int hf = 0; hf < 2; ++hf) {
        float va[8][4];
#pragma unroll
        for (int j = 0; j < 8; ++j) {
            const float4 lo = *(const float4*)(W + (size_t)(kg + 8 * hf + j) * ldw + cb), hi = *(const float4*)(W + (size_t)(kg + 8 * hf + j) * ldw + cb + 4);
            va[j][0] = nt ? lo.y : lo.x; va[j][1] = nt ? lo.w : lo.z; va[j][2] = nt ? hi.y : hi.x; va[j][3] = nt ? hi.w : hi.z;
        }
#pragma unroll
        for (int r = 0; r < 4; ++r) {
            mm::u32x4 o;
            o.x = mm::cvt_pk_bf16(va[0][r], va[1][r]); o.y = mm::cvt_pk_bf16(va[2][r], va[3][r]); o.z = mm::cvt_pk_bf16(va[4][r], va[5][r]); o.w = mm::cvt_pk_bf16(va[6][r], va[7][r]);
            *(mm::u32x4*)(Bt + (size_t)(rho + r) * K + kg + 8 * hf) = o;
        }
    }
}
__device__ __forceinline__ void ph_convert_weights(const Params& P_, int l) {
    const KA P = ka_get();
    const int tid = tid_opaque();
    char* wt = P.ws + OFF_WT;
    constexpr int T_IN = 13 * 8, T_GATE = 12 * 8, T_BR = 3 * 4 * 4, T_OUT = 4 * 8, T_GU = 16 * 2 * 8, T_DN = 16 * 4 * 2;
    constexpr int T_ALL = T_IN + T_GATE + T_BR + T_OUT + T_GU + T_DN;
    for (int t = blockIdx.x; t < T_ALL; t += gridDim.x) {
        int u = t;
        if (u < T_IN) {
            const float* W = P.in[I_WIN] + (size_t)l * ND * IN_COLS;
            cvt_tile((bf16_t*)(wt + WT_IN), 1024, (u >> 3) * 256, (u & 7) * 128, W, IN_COLS, [&](int rho) -> int { const int c = mm::img_col(rho); return c < IN_COLS ? c : -1; }, tid);
            continue;
        }
        u -= T_IN;
        if (u < T_GATE) {
            const float* W = P.in[I_WGATE] + (size_t)l * ND * 3072;
            cvt_tile((bf16_t*)(wt + WT_GATE), 1024, (u >> 3) * 256, (u & 7) * 128, W, 3072, [&](int rho) -> int { return mm::img_col(rho); }, tid);
            continue;
        }
        u -= T_GATE;
        if (u < T_BR) {
            const int n = u / 16, v = u % 16;
            const float* W = P.in[I_WBR] + ((size_t)l * 3 + n) * 512 * ND;
            cvt_tile((bf16_t*)(wt + WT_BR) + (size_t)n * 1024 * 512, 512, (v >> 2) * 256, (v & 3) * 128, W, ND, [&](int rho) -> int { return mm::img_col(rho); }, tid);
            continue;
        }
        u -= T_BR;
        if (u < T_OUT) {
            const float* W = P.in[I_WOUT] + (size_t)l * ND * ND;
            cvt_tile_pair((bf16_t*)(wt + WT_OUT), 1024, (u >> 3) * 256, (u & 7) * 128, W, ND, tid);
            continue;
        }
        u -= T_OUT;
        if (u < T_GU) {
            const int e = u / 16, v = u % 16;
            const float* Wg = P.in[I_WFG] + ((size_t)l * 16 + e) * ND * 256;
            const float* Wu = P.in[I_WFU] + ((size_t)l * 16 + e) * ND * 256;
            const int rho0 = (v >> 3) * 256;
            const float* Wsel = (((rho0 + (tid & 63) * 4) >> 5) & 1) ? Wu : Wg;
            cvt_tile((bf16_t*)(wt + WT_GU) + (size_t)e * 512 * 1024, 1024, rho0, (v & 7) * 128, Wsel, 256, [&](int rho) -> int {
                const int j = rho >> 8, wn = (rho >> 6) & 3; return j * 128 + wn * 32 + (mm::img_col(rho) & 31); }, tid);
            continue;
        }
        u -= T_GU;
        {
            const int e = u / 8, v = u % 8;
            const float* W = P.in[I_WFD] + ((size_t)l * 16 + e) * 256 * ND;
            cvt_tile_pair((bf16_t*)(wt + WT_DN) + (size_t)e * 1024 * 256, 256, (v >> 1) * 256, (v & 1) * 128, W, ND, tid);
        }
    }
}

struct SchedInProj {
    const char* A; const char* B; int mode;
    __device__ __forceinline__ bool next(int i, mm::Unit& u) const {
        int pm, pn; if (!mm::static_tile((long)i * gridDim.x + VBID, 128, 13, pm, pn)) return false;
        u.a = A + (size_t)pm * 256 * 1024 * 2; u.b0 = B + (size_t)pn * 256 * 1024 * 2; u.b1 = u.b0; u.lda = 1024; u.ldb = 1024; u.nk = 16; u.nseg = 16; u.pm = pm; u.pn = pn; u.tag = mode; return true;
    }
    static constexpr bool GATHER = false, PIPE = true;
    __device__ __forceinline__ void a_rows(const mm::Unit& u, int r0, unsigned (&a)[1]) const { mm::plain_rows(u, r0, a); }
};
struct EpiInProj {
    static constexpr bool TRANSP = true;
    static constexpr int PROF = 2;
    Proj pj; const float* qkg; const LAS float* gtab;
    __device__ __forceinline__ void operator()(mm::f32x16 (&acc)[4][2], const mm::Unit& u, int wm, int wn, int r32, int h, int tid) const {
        using namespace mm;
        asm volatile("" : "+v"(r32), "+v"(h));
        const int G = u.pn * 4 + wn;
        if (u.tag == 4) { if (acc[0][0][0] == 12345.678f) pj.aq[0] = 0; return; }
        if (u.tag == 3) { float t_ = 0.f;
#pragma unroll
            for (int i_ = 0; i_ < 4; ++i_) { t_ += acc[i_][0][3] + acc[i_][1][11] + acc[i_][0][7] + acc[i_][1][0]; }
            if (t_ == 12345.678f) pj.aq[0] = 0; return; }
        if (G > 48) return;
        bf16_t* dst; int tstride; const float* gv = nullptr; float sc = 1.f;
        if (G < 8) { dst = pj.aq + G * 64; tstride = 512; gv = qkg; sc = QSCALE; }
        else if (G < 16) { dst = pj.ak + (G - 8) * 64; tstride = 512; gv = qkg + 64; }
        else if (G < 24) { dst = pj.av + (G - 16) * 64; tstride = 512; }
        else if (G < 32) { dst = pj.bq + (G - 24) * 64; tstride = 512; gv = qkg + 128; sc = QSCALE; }
        else if (G < 34) { dst = pj.bk + (G - 32) * 64; tstride = 128; gv = qkg + 192; }
        else if (G < 36) { dst = pj.bv + (G - 34) * 64; tstride = 128; }
        else if (G < 44) { dst = pj.cq + (G - 36) * 64; tstride = 512; gv = qkg + 256; sc = QSCALE; }
        else if (G == 44) { dst = pj.ck; tstride = 64; gv = qkg + 320; }
        else if (G == 45) { dst = pj.cv; tstride = 64; }
        else if (G < 48) { dst = pj.iq + (G - 46) * 64; tstride = 128; }
        else { dst = pj.ik; tstride = 32; }
        if (u.tag == 8) { if (acc[0][0][0] == 12345.678f) dst[tstride] = 0; return; }
#pragma unroll 1
        for (int rep = 0; rep < (u.tag == 9 ? 4 : 1); ++rep)
#pragma unroll
        for (int mt = 0; mt < 4; ++mt) {
            asm volatile("" ::: "memory");
            const int row = u.pm * 256 + wm * 128 + mt * 32 + r32;
            f32x16& v0 = acc[mt][0]; f32x16& v1 = acc[mt][1];
            if (gv && u.tag != 7 && u.tag != 9) {
                float ss = 0.f;
#pragma unroll
                for (int e = 0; e < 16; ++e) ss += v0[e] * v0[e] + v1[e] * v1[e];
                ss = x32_sum(ss);
                const float rs = rsqrtf(ss * (1.0f / 64) + EPS) * sc;
#pragma unroll
                for (int e4 = 0; e4 < 4; ++e4) {
                    const f32x4 ga = *(const LAS f32x4*)(gtab + (gv - qkg) + 16 * h + 4 * e4), gb = *(const LAS f32x4*)(gtab + (gv - qkg) + 32 + 16 * h + 4 * e4);
#pragma unroll
                    for (int j = 0; j < 4; ++j) { v0[4 * e4 + j] *= rs * ga[j]; v1[4 * e4 + j] *= rs * gb[j]; }
                }
            }
            if (u.tag >= 5) { if (v0[0] + v1[3] + v0[9] + v1[12] == 12345.678f) dst[0] = 0; }
            else if (G < 48) {
                bf16_t* d = dst + (size_t)row * tstride + 16 * h;
                *(u32x4*)(d) = pack8(v0, 0); *(u32x4*)(d + 8) = pack8(v0, 8);
                *(u32x4*)(d + 32) = pack8(v1, 0); *(u32x4*)(d + 40) = pack8(v1, 8);
            } else {
                bf16_t* d = dst + (size_t)row * 32 + 16 * h;
                *(u32x4*)(d) = pack8(v0, 0); *(u32x4*)(d + 8) = pack8(v0, 8);
                if (h == 0) *(f32x4*)(pj.iw + (size_t)row * 4) = (f32x4){v1[0], v1[1], v1[2], v1[3]} * IWSCALE;
            }
        }
    }
};
__device__ __forceinline__ void ph_inproj(const Params& P_, int l, char* smem) {
    const KA P = ka_get();
    SchedInProj S; S.A = P.ws + OFF_H; S.B = P.ws + OFF_WT + WT_IN; S.mode = l >> 4;
    EpiInProj E; E.pj = proj_ptrs(P.ws); E.qkg = P.in[I_QKG] + (size_t)(l & 15) * 384;
    { LAS float* gt = (LAS float*)((LAS char*)smem + EPI_TAB); __syncthreads(); const int t = tid_opaque(); if (t < 384) gt[t] = E.qkg[t]; __syncthreads(); E.gtab = gt; }
    mm::gemm_phase(smem, S, E);
}

constexpr size_t SCR_G = OFF_PROJ;
constexpr size_t SCR_M = OFF_PROJ + 32 * MB;
struct SchedGB {
    const char* H; const char* BR; const char* Wg; const char* Wb;
    __device__ __forceinline__ bool next(int i, mm::Unit& u) const {
        const int ti = i / 6, sub = i - ti * 6, n = sub >> 1;
        int pm, pn; if (!mm::static_tile((long)ti * gridDim.x + VBID, 128, 4, pm, pn)) return false;
        u.pm = pm; u.pn = pn; u.tag = sub;
        if ((sub & 1) == 0) { u.a = H + (size_t)pm * 256 * 1024 * 2; u.lda = 1024; u.b0 = Wg + (size_t)(n * 1024 + pn * 256) * 1024 * 2; u.ldb = 1024; u.nk = 16; }
        else { u.a = BR + ((size_t)pm * 256 * 1536 + n * 512) * 2; u.lda = 1536; u.b0 = Wb + ((size_t)n * 1024 + pn * 256) * 512 * 2; u.ldb = 512; u.nk = 8; }
        u.b1 = u.b0; u.nseg = u.nk; return true;
    }
    static constexpr bool GATHER = false, PIPE = true;
    __device__ __forceinline__ void a_rows(const mm::Unit& u, int r0, unsigned (&a)[1]) const { mm::plain_rows(u, r0, a); }
};
struct EpiGB {
    static constexpr bool TRANSP = true;
    static constexpr int PROF = 4;
    const LAS float* btab; bf16_t* MG; char* scrg; char* scrm;
    __device__ __forceinline__ void operator()(mm::f32x16 (&acc)[4][2], const mm::Unit& u, int wm, int wn, int r32, int h, int tid) const {
        using namespace mm;
        asm volatile("" : "+v"(r32), "+v"(h), "+v"(tid));
        const int sub = u.tag, n = sub >> 1;
        const unsigned so0 = (unsigned)tid * 16u;
        if ((sub & 1) == 0) {
#pragma unroll
            for (int mt = 0; mt < 4; ++mt)
#pragma unroll
                for (int nt = 0; nt < 2; ++nt) {
                    f32x16& v = acc[mt][nt];
                    const int col = n * 1024 + u.pn * 256 + wn * 64 + nt * 32 + 16 * h;
#pragma unroll
                    for (int e4 = 0; e4 < 4; ++e4) { const f32x4 b = *(const LAS f32x4*)(btab + col + 4 * e4);
#pragma unroll
                        for (int j = 0; j < 4; ++j) v[4 * e4 + j] = __builtin_amdgcn_rcpf(1.f + __builtin_amdgcn_exp2f(__builtin_fmaf(v[4 * e4 + j], -LOG2E, b[j]))); }
                    const unsigned so = so0 + (unsigned)((mt * 2 + nt) * 2) * 8192u;
                    *(u32x4*)(scrg + so) = pack8(v, 0); *(u32x4*)(scrg + so + 8192) = pack8(v, 8);
                }
        } else {
#pragma unroll
            for (int hf = 0; hf < 4; ++hf) {
                const int mt = hf;
                {
                    u32x4 gq[2][2];
#pragma unroll
                    for (int c = 0; c < 2; ++c) { const unsigned so = so0 + (unsigned)((hf * 2 + c) * 2) * 8192u; gq[c][0] = *(const u32x4*)(scrg + so); gq[c][1] = *(const u32x4*)(scrg + so + 8192); }
#pragma unroll
                    for (int c = 0; c < 2; ++c) {
                        f32x16& v = acc[mt][c];
                        const unsigned gw[8] = {gq[c][0].x, gq[c][0].y, gq[c][0].z, gq[c][0].w, gq[c][1].x, gq[c][1].y, gq[c][1].z, gq[c][1].w};
#pragma unroll
                        for (int j = 0; j < 8; ++j) { v[2 * j] *= bflo(gw[j]); v[2 * j + 1] *= bfhi(gw[j]); }
                    }
                }
                if (n > 0) {
                    u32x4 mq[2][2];
#pragma unroll
                    for (int c = 0; c < 2; ++c) { const unsigned so = so0 + (unsigned)((hf * 2 + c) * 2) * 8192u; mq[c][0] = *(const u32x4*)(scrm + so); mq[c][1] = *(const u32x4*)(scrm + so + 8192); }
#pragma unroll
                    for (int c = 0; c < 2; ++c) {
                        f32x16& v = acc[mt][c];
                        const unsigned mw[8] = {mq[c][0].x, mq[c][0].y, mq[c][0].z, mq[c][0].w, mq[c][1].x, mq[c][1].y, mq[c][1].z, mq[c][1].w};
#pragma unroll
                        for (int j = 0; j < 8; ++j) { v[2 * j] += bflo(mw[j]); v[2 * j + 1] += bfhi(mw[j]); }
                    }
                }
#pragma unroll
                for (int c = 0; c < 2; ++c) {
                    f32x16& v = acc[mt][c];
                    const unsigned so = so0 + (unsigned)((hf * 2 + c) * 2) * 8192u;
                    if (n < 2) { *(u32x4*)(scrm + so) = pack8(v, 0); *(u32x4*)(scrm + so + 8192) = pack8(v, 8); }
                    else { bf16_t* d = MG + (size_t)(u.pm * 256 + wm * 128 + mt * 32 + r32) * ND + u.pn * 256 + wn * 64 + c * 32 + 16 * h; *(u32x4*)d = pack8(v, 0); *(u32x4*)(d + 8) = pack8(v, 8); }
                }
            }
        }
    }
};
__device__ __forceinline__ void ph_gatebranch(const Params& P_, int l, char* smem) {
    const KA P = ka_get();
    SchedGB S; S.H = P.ws + OFF_H; S.BR = P.ws + OFF_BR; S.Wg = P.ws + OFF_WT + WT_GATE; S.Wb = P.ws + OFF_WT + WT_BR;
    EpiGB E; E.MG = (bf16_t*)(P.ws + OFF_MERGED);
    { LAS float* bt = (LAS float*)((LAS char*)smem + EPI_TAB); const float* bg = P.in[I_BGATE] + (size_t)l * 3072; __syncthreads(); for (int t = tid_opaque(); t < 3072; t += 512) bt[t] = -bg[t] * LOG2E; __syncthreads(); E.btab = bt; }
    E.scrg = P.ws + SCR_G + (size_t)blockIdx.x * 131072; E.scrm = P.ws + SCR_M + (size_t)blockIdx.x * 131072;
    mm::gemm_phase(smem, S, E);
}

struct SchedOut {
    const char* A; const char* B;
    __device__ __forceinline__ bool next(int i, mm::Unit& u) const {
        int pm, pn; if (!mm::static_tile((long)i * gridDim.x + VBID, 128, 4, pm, pn)) return false;
        u.a = A + (size_t)pm * 256 * 1024 * 2; u.b0 = B + (size_t)pn * 256 * 1024 * 2; u.b1 = u.b0; u.lda = 1024; u.ldb = 1024; u.nk = 16; u.nseg = 16; u.pm = pm; u.pn = pn; u.tag = 0; return true;
    }
    static constexpr bool GATHER = false, PIPE = true;
    __device__ __forceinline__ void a_rows(const mm::Unit& u, int r0, unsigned (&a)[1]) const { mm::plain_rows(u, r0, a); }
};
struct EpiOut {
    static constexpr bool TRANSP = false;
    static constexpr int PROF = 17;
    const float* x32; bf16_t* st;
    __device__ __forceinline__ void operator()(mm::f32x16 (&acc)[4][2], const mm::Unit& u, int wm, int wn, int r32, int h, int tid) const {
        using namespace mm;
        asm volatile("" : "+v"(r32), "+v"(h));
#pragma unroll
        for (int mt = 0; mt < 4; ++mt)
#pragma unroll
            for (int eh = 0; eh < 2; ++eh) {
                const size_t off = (size_t)(u.pm * 256 + wm * 128 + mt * 32 + 4 * h + 16 * eh) * ND + u.pn * 256 + wn * 64 + 2 * r32;
                float xa[8], xb[8];
                if (x32) {
#pragma unroll
                    for (int e = 0; e < 8; ++e) { const float2 t = *(const float2*)(x32 + off + (size_t)((e & 3) + 8 * (e >> 2)) * ND); xa[e] = t.x; xb[e] = t.y; }
                } else {
#pragma unroll
                    for (int e = 0; e < 8; ++e) { const unsigned w = *(const unsigned*)(st + off + (size_t)((e & 3) + 8 * (e >> 2)) * ND); xa[e] = bflo(w); xb[e] = bfhi(w); }
                }
#pragma unroll
                for (int e = 0; e < 8; ++e) *(unsigned*)(st + off + (size_t)((e & 3) + 8 * (e >> 2)) * ND) = cvt_pk_bf16(xa[e] + acc[mt][0][8 * eh + e], xb[e] + acc[mt][1][8 * eh + e]);
            }
    }
};
__device__ __forceinline__ void ph_outproj(const Params& P_, int l, char* smem) {
    const KA P = ka_get();
    SchedOut S; S.A = P.ws + OFF_MERGED; S.B = P.ws + OFF_WT + WT_OUT;
    EpiOut E; E.x32 = l == 0 ? P.in[I_X] : (const float*)nullptr; E.st = (bf16_t*)(P.ws + OFF_STREAM);
    mm::gemm_phase(smem, S, E);
}


constexpr size_t OFF_HID = OFF_PROJ + 64 * MB;
constexpr int MOE_TAB = 131072 + 1024;
__device__ __forceinline__ void moe_table(char* smem, const int* cnt) {
    int* tab = (int*)(smem + MOE_TAB);
    const int t = tid_opaque();
    __syncthreads();
    if (t < 24) tab[32 + t] = cnt[t];
    __syncthreads();
    if (t == 0) { int p = 0; for (int b = 0; b < 24; ++b) { tab[b] = p; p += (tab[32 + b] + 255) >> 8; } tab[24] = p; }
    __syncthreads();
    if (t < 160) { int b = 0; for (int i = 1; i < 24; ++i) if (tab[i] <= t) b = i; tab[64 + t] = b; }
    __syncthreads();
}
struct MoeLoc { int b, rt, slot, valid, elo, ehi; };
__device__ __forceinline__ int moe_tab(const int* tab, int i) { return __builtin_amdgcn_readfirstlane(tab[i]); }
__device__ __forceinline__ MoeLoc moe_locate(const int* tab, int T) {
    const int b = moe_tab(tab, 64 + T);
    MoeLoc m; m.b = b; m.rt = T - moe_tab(tab, b); m.slot = T * 256; const int c = moe_tab(tab, 32 + b) - m.rt * 256; m.valid = c < 256 ? c : 256;
    const int g = b / 6, ix = b - g * 6; const int lo = ix < 3 ? 0 : (ix < 5 ? 1 : 2), hi = ix < 3 ? ix + 1 : (ix < 5 ? ix - 1 : 3);
    m.elo = g * 4 + lo; m.ehi = g * 4 + hi; return m;
}
struct SchedMoeUp {
    static constexpr bool GATHER = true, PIPE = true;
    const char* H; const char* W; const int* tab; const int* list;
    __device__ __forceinline__ bool next(int i, mm::Unit& u) const {
        const long L = (long)i * gridDim.x + VBID; const int T = (int)(L >> 2), c = (int)(L & 3);
        if (T >= moe_tab(tab, 24)) return false;
        const MoeLoc m = moe_locate(tab, T);
        const int e = (c >> 1) ? m.ehi : m.elo, j = c & 1;
        u.a = H; u.lda = 1024; u.b0 = W + ((size_t)e * 512 + j * 256) * 1024 * 2; u.b1 = u.b0; u.ldb = 1024; u.nk = 16; u.nseg = 16;
        u.pm = T; u.pn = c; u.tag = c; u.aux0 = m.b * NTOK + m.rt * 256; u.aux1 = m.valid; return true;
    }
    __device__ __forceinline__ void a_rows(const mm::Unit& u, int r0, unsigned (&a)[4]) const {
#pragma unroll
        for (int q = 0; q < 4; ++q) { const int r = r0 + 64 * q; const int tok = list[u.aux0 + (r < u.aux1 ? r : 0)]; a[q] = (unsigned)tok * 2048u; }
    }
};
struct EpiMoeUp {
    static constexpr bool TRANSP = true;
    static constexpr int PROF = 18;
    bf16_t* hid; const int* list; const float* rw;
    __device__ __forceinline__ void operator()(mm::f32x16 (&acc)[4][2], const mm::Unit& u, int wm, int wn, int r32, int h, int tid) const {
        using namespace mm;
        asm volatile("" : "+v"(r32), "+v"(h));
        const int which = u.tag >> 1, j = u.tag & 1;
        int tok[4]; float w[4];
#pragma unroll
        for (int mt = 0; mt < 4; ++mt) { const int r = wm * 128 + mt * 32 + r32; tok[mt] = list[u.aux0 + (r < u.aux1 ? r : 0)]; }
#pragma unroll
        for (int mt = 0; mt < 4; ++mt) w[mt] = rw[tok[mt] * 2 + which];
#pragma unroll
        for (int mt = 0; mt < 4; ++mt) {
            const int r = wm * 128 + mt * 32 + r32;
            if (r < u.aux1) {
                f32x16& g = acc[mt][0]; const f32x16& up = acc[mt][1];
#pragma unroll
                for (int e = 0; e < 16; ++e) g[e] = g[e] * __builtin_amdgcn_rcpf(1.f + __builtin_amdgcn_exp2f(g[e] * -LOG2E)) * (up[e] * w[mt]);
                bf16_t* d = hid + (size_t)(u.pm * 256 + r) * 512 + which * 256 + j * 128 + wn * 32 + 16 * h;
                *(u32x4*)d = pack8(g, 0); *(u32x4*)(d + 8) = pack8(g, 8);
            }
        }
    }
};
struct SchedMoeDown {
    static constexpr bool GATHER = false, PIPE = true;
    const char* HID; const char* W; const int* tab;
    __device__ __forceinline__ bool next(int i, mm::Unit& u) const {
        const long L = (long)i * gridDim.x + VBID; const int T = (int)(L >> 2), c = (int)(L & 3);
        if (T >= moe_tab(tab, 24)) return false;
        const MoeLoc m = moe_locate(tab, T);
        u.a = HID + (size_t)T * 256 * 512 * 2; u.lda = 512; u.ldb = 256; u.nk = 8; u.nseg = 4;
        u.b0 = W + ((size_t)m.elo * 1024 + c * 256) * 256 * 2; u.b1 = W + ((size_t)m.ehi * 1024 + c * 256) * 256 * 2 - 4 * 128;
        u.pm = T; u.pn = c; u.tag = 0; u.aux0 = m.b * NTOK + m.rt * 256; u.aux1 = m.valid; return true;
    }
    __device__ __forceinline__ void a_rows(const mm::Unit& u, int r0, unsigned (&a)[1]) const { mm::plain_rows(u, r0, a); }
};
struct EpiMoeDown {
    static constexpr bool TRANSP = false;
    static constexpr int PROF = 19;
    bf16_t* st; float* out32; const int* list; LAS int* ltok;
    __device__ __forceinline__ void operator()(mm::f32x16 (&acc)[4][2], const mm::Unit& u, int wm, int wn, int r32, int h, int tid) const {
        using namespace mm;
        asm volatile("" : "+v"(r32), "+v"(h));
        const int col = u.pn * 256 + wn * 64 + 2 * r32;
        __syncthreads();
        if (tid < 256) ltok[tid] = list[u.aux0 + (tid < u.aux1 ? tid : 0)];
        __syncthreads();
#pragma unroll
        for (int mt = 0; mt < 4; ++mt)
#pragma unroll
            for (int eh = 0; eh < 2; ++eh) {
                asm volatile("" ::: "memory");
                const int rb = wm * 128 + mt * 32 + 4 * h + 16 * eh;
                int tok[8];
#pragma unroll
                for (int e = 0; e < 8; ++e) tok[e] = ltok[rb + (e & 3) + 8 * (e >> 2)];
                unsigned xv[8];
#pragma unroll
                for (int e = 0; e < 8; ++e) xv[e] = *(const unsigned*)(st + (size_t)tok[e] * ND + col);
#pragma unroll
                for (int e = 0; e < 8; ++e) {
                    const int r = rb + (e & 3) + 8 * (e >> 2);
                    if (r < u.aux1) {
                        const float a = bflo(xv[e]) + acc[mt][0][8 * eh + e], b = bfhi(xv[e]) + acc[mt][1][8 * eh + e];
                        if (out32) { float2 o; o.x = a; o.y = b; *(float2*)(out32 + (size_t)tok[e] * ND + col) = o; }
                        else *(unsigned*)(st + (size_t)tok[e] * ND + col) = cvt_pk_bf16(a, b);
                    }
                }
            }
    }
};
__device__ __forceinline__ void ph_moe_up(const Params& P_, int l, char* smem) {
    const KA P = ka_get();
    moe_table(smem, (const int*)(P.ws + OFF_CTRL + MOE_CNT_OFF) + l * 32);
    SchedMoeUp S; S.H = P.ws + OFF_H; S.W = P.ws + OFF_WT + WT_GU; S.tab = (const int*)(smem + MOE_TAB); S.list = (const int*)(P.ws + OFF_ROUTE + MOE_LIST_OFF);
    EpiMoeUp E; E.hid = (bf16_t*)(P.ws + OFF_HID); E.list = S.list; E.rw = (const float*)(P.ws + OFF_ROUTE + MOE_RW_OFF);
    mm::gemm_phase(smem, S, E);
}
__device__ __forceinline__ void ph_moe_down(const Params& P_, int l, char* smem) {
    const KA P = ka_get();
    moe_table(smem, (const int*)(P.ws + OFF_CTRL + MOE_CNT_OFF) + l * 32);
    SchedMoeDown S; S.HID = P.ws + OFF_HID; S.W = P.ws + OFF_WT + WT_DN; S.tab = (const int*)(smem + MOE_TAB);
    EpiMoeDown E; E.ltok = (LAS int*)((LAS char*)smem + EPI_TAB); E.st = (bf16_t*)(P.ws + OFF_STREAM); E.out32 = l == 1 ? P.out : (float*)nullptr; E.list = (const int*)(P.ws + OFF_ROUTE + MOE_LIST_OFF);
    mm::gemm_phase(smem, S, E);
}


namespace at {
typedef short bf16x8 __attribute__((ext_vector_type(8)));
typedef short s16x4 __attribute__((ext_vector_type(4)));
typedef float f32x16 __attribute__((ext_vector_type(16)));
typedef unsigned u32x4 __attribute__((ext_vector_type(4)));
typedef unsigned u32x2 __attribute__((ext_vector_type(2)));
__device__ __forceinline__ s16x4 tr_read(const LAS char* p) { return __builtin_bit_cast(s16x4, __builtin_amdgcn_ds_read_tr16_b64_v4i16((LAS s16x4*)p)); }
__device__ __forceinline__ unsigned cvtpk(float lo, float hi) { unsigned r; asm volatile("v_cvt_pk_bf16_f32 %0, %1, %2" : "=v"(r) : "v"(lo), "v"(hi)); return r; }
__device__ __forceinline__ bf16x8 pack_p(const f32x16& x, int s) { u32x4 w; w.x = cvtpk(x[8 * s], x[8 * s + 1]); w.y = cvtpk(x[8 * s + 2], x[8 * s + 3]); w.z = cvtpk(x[8 * s + 4], x[8 * s + 5]); w.w = cvtpk(x[8 * s + 6], x[8 * s + 7]); return __builtin_bit_cast(bf16x8, w); }
constexpr int A_TAB = 81920;
}
__device__ __forceinline__ void ph_attnA(const Params& P_, int l, char* smem) {
    using namespace at;
    const KA P = ka_get();
    const Proj pj = proj_ptrs(P.ws);
    bf16_t* BR = (bf16_t*)(P.ws + OFF_BR);
    const int tid = tid_opaque(), lane = tid & 63, wid = __builtin_amdgcn_readfirstlane(tid >> 6), m = wid >> 2, qs = wid & 3, r32 = lane & 31, hl = lane >> 5;
    LAS char* lds = (LAS char*)smem;
    LAS float* tb = (LAS float*)(lds + A_TAB);
    const float* lp = P.in[I_LAM] + (size_t)l * 256;
    const float linit = lambda_init_of(l);
    const float lam = expf(wsum(lp[lane] * lp[64 + lane])) - expf(wsum(lp[128 + lane] * lp[192 + lane])) + linit;
    const float* subg = P.in[I_SUBLN] + (size_t)l * 128;
    const float* relb = P.in[I_RELB];
    LAS float* rb4 = (LAS float*)(lds + A_TAB + 4160 * 4);
    __syncthreads();
    if (tid < 128) rb4[tid] = relb[(tid >> 2) * 20 + (tid & 3)] * LOG2E;
    __syncthreads();
    const int i16 = lane & 15, tq = i16 >> 2, tp = i16 & 3, blk = (lane >> 4) & 1;
    const unsigned vlane = (unsigned)((4 * hl + tq) * 64 + blk * 32 + tp * 8);
    const unsigned klane = (unsigned)(m * 8192 + r32 * 128), kx = (unsigned)((r32 >> 1) & 7);
    for (int u2 = blockIdx.x; u2 < 1024; u2 += gridDim.x) {
        const int Pp = u2 & 511;
        const int bh = Pp >> 4, jj = Pp & 15, qb = (u2 >> 9) ? 31 - jj : jj, b = bh >> 2, h = bh & 3;
        const int q0 = qb * 128 + qs * 32, nt_wg = 2 * qb + 2, nt_w = (q0 >> 6) + 1;
        __syncthreads();
#pragma unroll
        for (int it = 0; it < 9; ++it) { const int i = tid + 512 * it; if (i < 4160) { const int rel = i - 4095; tb[i] = rel <= 63 ? rb4[t5_bucket(rel) * 4 + h] : 0.f; } }
        const float bfar = rb4[15 * 4 + h];
        bf16x8 qf[4];
        { const bf16_t* qp = pj.aq + (size_t)(b * NS + q0 + r32) * 512 + (h * 2 + m) * 64 + 8 * hl;
#pragma unroll
          for (int ks = 0; ks < 4; ++ks) qf[ks] = *(const bf16x8*)(qp + ks * 16); }
        u32x4 gk[2], gv[2];
        const bf16_t* kg = pj.ak + (size_t)(b * NS) * 512 + h * 128;
        const bf16_t* vg = pj.av + (size_t)(b * NS) * 512 + h * 128;
        unsigned gofs[2], kst[2], vst[2];
#pragma unroll
        for (int i = 0; i < 2; ++i) { const int idx = tid + 512 * i, key = idx >> 4, c = idx & 15;
            gofs[i] = (unsigned)(key * 512 + c * 8) * 2u;
            kst[i] = (unsigned)((c >> 3) * 8192 + key * 128 + (((c & 7) ^ ((key >> 1) & 7)) << 4));
            vst[i] = (unsigned)((c >> 2) * 4096 + key * 64 + (c & 3) * 16); }
#define AT_GLOAD(kt) do { const size_t o_ = (size_t)(kt) * 64 * 512 * 2; _Pragma("unroll") for (int i_ = 0; i_ < 2; ++i_) { gk[i_] = *(const u32x4*)((const char*)kg + o_ + gofs[i_]); gv[i_] = *(const u32x4*)((const char*)vg + o_ + gofs[i_]); } } while (0)
#define AT_LSTORE(kslot, vslot) do { _Pragma("unroll") for (int i_ = 0; i_ < 2; ++i_) { *(LAS u32x4*)(lds + (kslot) * 16384 + kst[i_]) = gk[i_]; *(LAS u32x4*)(lds + 32768 + (vslot) * 16384 + vst[i_]) = gv[i_]; } } while (0)
        AT_GLOAD(0); AT_LSTORE(0, 0);
        __syncthreads();
        f32x16 O[4];
#pragma unroll
        for (int v = 0; v < 4; ++v)
#pragma unroll
            for (int e = 0; e < 16; ++e) O[v][e] = 0.f;
        float mrun = -INFINITY, lsum = 0.f;
        bf16x8 pp[2][2];
        int vs_prev = 0, vs_cur = 0, vs_next = 1;
        for (int kt = 0; kt <= nt_wg; ++kt) {
            if (kt + 1 < nt_wg) AT_GLOAD(kt + 1);
            f32x16 s0, s1;
            const bool doqk = kt < nt_w, dopv = kt >= 1 && kt - 1 < nt_w;
            if (doqk) {
                const LAS char* kb = lds + (kt & 1) * 16384 + klane;
                if (kt * 64 + 63 - q0 <= -559) {
#pragma unroll
                    for (int e = 0; e < 16; ++e) { s0[e] = bfar; s1[e] = bfar; }
                } else {
                    const LAS float* tl = tb + (kt * 64 - q0 - r32 + 4 * hl + 4095);
#pragma unroll
                    for (int e = 0; e < 16; ++e) { s0[e] = tl[(e & 3) + 8 * (e >> 2)]; s1[e] = tl[32 + (e & 3) + 8 * (e >> 2)]; }
                }
#pragma unroll
                for (int ks = 0; ks < 4; ++ks) {
                    const unsigned xo = (((unsigned)(ks * 2 + hl)) ^ kx) << 4;
                    const bf16x8 k0 = *(const LAS bf16x8*)(kb + xo), k1 = *(const LAS bf16x8*)(kb + 4096 + xo);
                    s0 = __builtin_amdgcn_mfma_f32_32x32x16_bf16(k0, qf[ks], s0, 0, 0, 0);
                    s1 = __builtin_amdgcn_mfma_f32_32x32x16_bf16(k1, qf[ks], s1, 0, 0, 0);
                }
            }
            if (dopv) {
                const LAS char* vb = lds + 32768 + vs_prev * 16384 + vlane;
#pragma unroll
                for (int sub = 0; sub < 2; ++sub)
#pragma unroll
                    for (int s = 0; s < 2; ++s) {
                        const LAS char* vk = vb + (sub * 32 + 16 * s) * 64;
#pragma unroll
                        for (int v = 0; v < 4; ++v) {
                            const s16x4 lo = tr_read(vk + v * 4096), hi = tr_read(vk + v * 4096 + 8 * 64);
                            const bf16x8 vf = __builtin_shufflevector(lo, hi, 0, 1, 2, 3, 4, 5, 6, 7);
                            O[v] = __builtin_amdgcn_mfma_f32_32x32x16_bf16(vf, pp[sub][s], O[v], 0, 0, 0);
                        }
                    }
            }
            __builtin_amdgcn_sched_barrier(0);
            if (doqk) {
                float mx = __builtin_fmaxf(__builtin_fmaxf(s0[0], s1[0]), __builtin_fmaxf(s0[1], s1[1]));
#pragma unroll
                for (int e = 2; e < 16; e += 2) mx = __builtin_fmaxf(__builtin_fmaxf(mx, s0[e]), __builtin_fmaxf(__builtin_fmaxf(s1[e], s0[e + 1]), s1[e + 1]));
                mx = x32_max(mx);
                const float mn = fmaxf(mrun, mx);
                float ps0 = 0.f, ps1 = 0.f;
#pragma unroll
                for (int e = 0; e < 16; ++e) { s0[e] = __builtin_amdgcn_exp2f(s0[e] - mn); s1[e] = __builtin_amdgcn_exp2f(s1[e] - mn); ps0 += s0[e]; ps1 += s1[e]; }
                if (__any(mn > mrun)) {
                    const float alpha = __builtin_amdgcn_exp2f(mrun - mn);
                    lsum *= alpha;
#pragma unroll
                    for (int v = 0; v < 4; ++v)
#pragma unroll
                        for (int e = 0; e < 16; ++e) O[v][e] *= alpha;
                }
                mrun = mn;
                lsum += ps0 + ps1;
                pp[0][0] = pack_p(s0, 0); pp[0][1] = pack_p(s0, 1); pp[1][0] = pack_p(s1, 0); pp[1][1] = pack_p(s1, 1);
            }
            if (kt + 1 < nt_wg) AT_LSTORE((kt + 1) & 1, vs_next);
            __syncthreads();
            vs_prev = vs_cur; vs_cur = vs_next; vs_next = vs_next == 2 ? 0 : vs_next + 1;
        }
#undef AT_GLOAD
#undef AT_LSTORE
        const float ltot = x32_sum(lsum);
        const float inv = (m ? lam : 1.f) / ltot;
        LAS float* ex = (LAS float*)lds + qs * 4096 + lane;
        if (m == 1) {
#pragma unroll
            for (int v = 0; v < 4; ++v)
#pragma unroll
                for (int e = 0; e < 16; ++e) ex[(v * 16 + e) * 64] = O[v][e] * inv;
        }
        __syncthreads();
        if (m == 0) {
            float ss = 0.f;
#pragma unroll
            for (int v = 0; v < 4; ++v)
#pragma unroll
                for (int e = 0; e < 16; ++e) { const float x = O[v][e] * inv - ex[(v * 16 + e) * 64]; O[v][e] = x; ss += x * x; }
            ss = x32_sum(ss);
            const float rstd = rsqrtf(ss * (1.0f / 128) + EPS) * (1.0f - linit);
            bf16_t* op = BR + (size_t)(b * NS + q0 + r32) * 1536 + h * 128 + 4 * hl;
#pragma unroll
            for (int v = 0; v < 4; ++v)
#pragma unroll
                for (int g = 0; g < 4; ++g) {
                    const int vd = v * 32 + 8 * g + 4 * hl;
                    const float4 sg = *(const float4*)(subg + vd);
                    u32x2 w; w.x = cvtpk(O[v][4 * g] * rstd * sg.x, O[v][4 * g + 1] * rstd * sg.y); w.y = cvtpk(O[v][4 * g + 2] * rstd * sg.z, O[v][4 * g + 3] * rstd * sg.w);
                    *(u32x2*)(op + v * 32 + 8 * g) = w;
                }
        }
    }
}


__device__ __forceinline__ void ph_attnB(const Params& P_, int l, char* smem) {
    using namespace at;
    const KA P = ka_get();
    const Proj pj = proj_ptrs(P.ws);
    bf16_t* BR = (bf16_t*)(P.ws + OFF_BR);
    const int tid = tid_opaque(), lane = tid & 63, wid = __builtin_amdgcn_readfirstlane(tid >> 6), g = wid >> 1, qh = wid & 1, r32 = lane & 31, hl = lane >> 5;
    LAS char* lds = (LAS char*)smem;
    constexpr int B_K = 0, B_V = 24576, B_TAB = 49152;
    LAS float* tb = (LAS float*)(lds + B_TAB);
    const float* relb = P.in[I_RELB];
    __syncthreads();
    for (int i = tid; i < 2048; i += 512) { const int hq = i >> 8, rel = (i & 255) - 191; tb[i] = relb[t5_bucket(rel) * 20 + 4 + hq] * LOG2E; }
    const int i16 = lane & 15, tq = i16 >> 2, tp = i16 & 3, blk = (lane >> 4) & 1;
    const unsigned vlane = (unsigned)((4 * hl + tq) * 64 + blk * 32 + tp * 8);
    const unsigned klane = (unsigned)(r32 * 128), kx = (unsigned)((r32 >> 1) & 7);
    const int skey = tid >> 3, sc = tid & 7;
    const unsigned kst = (unsigned)(skey * 128 + ((sc ^ ((skey >> 1) & 7)) << 4)), vst = (unsigned)((sc >> 2) * 4096 + skey * 64 + (sc & 3) * 16);
    for (int u = blockIdx.x; u < NB * 64 * 2; u += gridDim.x) {
        const int kvh = u & 1, c = (u >> 1) & 63, b = u >> 7, hq = kvh * 4 + g;
        const int t0 = c >= 2 ? 0 : 2 - c;
        u32x4 kk[3], vv3[3];
#pragma unroll
        for (int t = 0; t < 3; ++t) {
            const int tt = t >= t0 ? t : t0;
            const size_t row = (size_t)(b * NS + (c - 2 + tt) * 64 + skey) * 128 + kvh * 64 + sc * 8;
            kk[t] = *(const u32x4*)(pj.bk + row); vv3[t] = *(const u32x4*)(pj.bv + row);
        }
        const int tok = b * NS + c * 64 + qh * 32 + r32;
        bf16x8 qf[4];
#pragma unroll
        for (int ks = 0; ks < 4; ++ks) qf[ks] = *(const bf16x8*)(pj.bq + (size_t)tok * 512 + hq * 64 + ks * 16 + 8 * hl);
        const float sink = P.in[I_SINK][l * 8 + hq] * LOG2E;
        __syncthreads();
#pragma unroll
        for (int t = 0; t < 3; ++t) if (t >= t0) { *(LAS u32x4*)(lds + B_K + t * 8192 + kst) = kk[t]; *(LAS u32x4*)(lds + B_V + t * 8192 + vst) = vv3[t]; }
        __syncthreads();
        f32x16 O[2];
#pragma unroll
        for (int v = 0; v < 2; ++v)
#pragma unroll
            for (int e = 0; e < 16; ++e) O[v][e] = 0.f;
        float mrun = sink, lsum = hl == 0 ? 1.f : 0.f;
#pragma unroll
        for (int t = 0; t < 3; ++t) if (t >= t0) {
            const LAS char* kb = lds + B_K + t * 8192 + klane;
            const LAS char* vb = lds + B_V + t * 8192 + vlane;
            const LAS float* tl = tb + hq * 256 + (t * 64 - qh * 32 - r32 + 4 * hl + 63);
            f32x16 s0, s1;
#pragma unroll
            for (int e = 0; e < 16; ++e) { s0[e] = tl[(e & 3) + 8 * (e >> 2)]; s1[e] = tl[32 + (e & 3) + 8 * (e >> 2)]; }
#pragma unroll
            for (int ks = 0; ks < 4; ++ks) {
                const unsigned xo = (((unsigned)(ks * 2 + hl)) ^ kx) << 4;
                const bf16x8 k0 = *(const LAS bf16x8*)(kb + xo), k1 = *(const LAS bf16x8*)(kb + 4096 + xo);
                s0 = __builtin_amdgcn_mfma_f32_32x32x16_bf16(k0, qf[ks], s0, 0, 0, 0);
                s1 = __builtin_amdgcn_mfma_f32_32x32x16_bf16(k1, qf[ks], s1, 0, 0, 0);
            }
            float mx = fmaxf(s0[0], s1[0]);
#pragma unroll
            for (int e = 1; e < 16; ++e) mx = fmaxf(mx, fmaxf(s0[e], s1[e]));
            mx = x32_max(mx);
            const float mn = fmaxf(mrun, mx), alpha = exp2f(mrun - mn);
            mrun = mn;
            float ps = 0.f;
#pragma unroll
            for (int e = 0; e < 16; ++e) { s0[e] = exp2f(s0[e] - mn); s1[e] = exp2f(s1[e] - mn); ps += s0[e] + s1[e]; }
            lsum = lsum * alpha + ps;
#pragma unroll
            for (int v = 0; v < 2; ++v)
#pragma unroll
                for (int e = 0; e < 16; ++e) O[v][e] *= alpha;
#pragma unroll
            for (int sub = 0; sub < 2; ++sub)
#pragma unroll
                for (int s2 = 0; s2 < 2; ++s2) {
                    const bf16x8 pb = pack_p(sub ? s1 : s0, s2);
                    const LAS char* vk = vb + (sub * 32 + 16 * s2) * 64;
#pragma unroll
                    for (int v = 0; v < 2; ++v) {
                        const s16x4 lo = tr_read(vk + v * 4096), hi = tr_read(vk + v * 4096 + 8 * 64);
                        const bf16x8 vf = __builtin_shufflevector(lo, hi, 0, 1, 2, 3, 4, 5, 6, 7);
                        O[v] = __builtin_amdgcn_mfma_f32_32x32x16_bf16(vf, pb, O[v], 0, 0, 0);
                    }
                }
        }
        const float inv = 1.f / x32_sum(lsum);
        bf16_t* op = BR + (size_t)tok * 1536 + 512 + hq * 64 + 4 * hl;
#pragma unroll
        for (int v = 0; v < 2; ++v)
#pragma unroll
            for (int gg = 0; gg < 4; ++gg) {
                u32x2 w; w.x = cvtpk(O[v][4 * gg] * inv, O[v][4 * gg + 1] * inv); w.y = cvtpk(O[v][4 * gg + 2] * inv, O[v][4 * gg + 3] * inv);
                *(u32x2*)(op + v * 32 + 8 * gg) = w;
            }
    }
}


__device__ __forceinline__ void ph_attnC(const Params& P_, int l, char* smem) {
    using namespace at;
    typedef float f32x4 __attribute__((ext_vector_type(4)));
    const KA P = ka_get();
    const Proj pj = proj_ptrs(P.ws);
    bf16_t* BR = (bf16_t*)(P.ws + OFF_BR);
    const int tid = tid_opaque(), lane = tid & 63, wid = __builtin_amdgcn_readfirstlane(tid >> 6), l16 = lane & 15, g4 = lane >> 4;
    LAS char* lds = (LAS char*)smem;
    constexpr int C_SC = 0, C_SEL = 131072, C_BKT = 139264, C_TAB = 143360;
    LAS float* tb = (LAS float*)(lds + C_TAB);
    const float* relb = P.in[I_RELB];
    __syncthreads();
    for (int i = tid; i < 256; i += 512) tb[i] = relb[(i >> 3) * 20 + 12 + (i & 7)] * LOG2E;
    const unsigned long long ltmask = (1ull << lane) - 1ull;
    const int tq = l16 >> 2, tp = l16 & 3;
    for (int unit = blockIdx.x; unit < NTOK / 16; unit += gridDim.x) {
        const int kq = unit >> 8, cq = unit & 255, xq = (cq + 64 * (kq >> 1)) & 255, qblk = (kq & 1) ? 255 - xq : xq;
        const int tok0 = (kq << 12) + qblk * 16, b = tok0 >> 12, q0 = tok0 & (NS - 1), c = q0 >> 6, N = (c + 1) * 64;
        __syncthreads();
        PROF_BEGIN(9)
        if (N > 256) {
            bf16x8 iqf[4];
#pragma unroll
            for (int hh = 0; hh < 4; ++hh) iqf[hh] = *(const bf16x8*)(pj.iq + (size_t)(tok0 + l16) * 128 + hh * 32 + 8 * g4);
            const f32x4 w4 = *(const f32x4*)(pj.iw + (size_t)(tok0 + l16) * 4);
            const bf16_t* ikb = pj.ik + (size_t)(b * NS) * 32 + l16 * 32 + 8 * g4;
            const int ntile = N / 16;
            for (int kt0 = wid; kt0 < ntile; kt0 += 64) {
                bf16x8 av[8];
#pragma unroll
                for (int j = 0; j < 8; ++j) { const int kt = kt0 + 8 * j; av[j] = *(const bf16x8*)(ikb + (size_t)(kt < ntile ? kt : kt0) * 512); }
#pragma unroll
                for (int j = 0; j < 8; ++j) {
                    const int kt = kt0 + 8 * j;
                    if (kt < ntile) {
                        float sc[4] = {0.f, 0.f, 0.f, 0.f};
#pragma unroll
                        for (int hh = 0; hh < 4; ++hh) {
                            const f32x4 d = __builtin_amdgcn_mfma_f32_16x16x32_bf16(av[j], iqf[hh], (f32x4){0.f, 0.f, 0.f, 0.f}, 0, 0, 0);
#pragma unroll
                            for (int r = 0; r < 4; ++r) sc[r] += fmaxf(d[r], 0.f) * w4[hh];
                        }
                        unsigned w01 = __builtin_bit_cast(unsigned, __builtin_amdgcn_cvt_pkrtz(sc[0] + 0.0f, sc[1] + 0.0f));
                        unsigned w23 = __builtin_bit_cast(unsigned, __builtin_amdgcn_cvt_pkrtz(sc[2] + 0.0f, sc[3] + 0.0f));
                        w01 ^= (((w01 >> 15) & 0x00010001u) * 0xFFFFu) | 0x80008000u;
                        w23 ^= (((w23 >> 15) & 0x00010001u) * 0xFFFFu) | 0x80008000u;
                        w01 = (w01 >> 1) & 0x7FFF7FFFu; w23 = (w23 >> 1) & 0x7FFF7FFFu;
                        u32x2 o; o.x = w01; o.y = w23;
                        *(LAS u32x2*)(lds + C_SC + l16 * 8192 + (kt * 16 + g4 * 4) * 2) = o;
                    }
                }
            }
        }
        __syncthreads();
        PROF_END(9, smem)
        PROF_BEGIN(10)
        {
            LAS unsigned short* selA = (LAS unsigned short*)(lds + C_SEL) + (2 * wid) * 256;
            LAS unsigned char* bktA = (LAS unsigned char*)(lds + C_BKT) + (2 * wid) * 256;
            const int qA = q0 + 2 * wid;
            if (N <= 256) {
                for (int i = lane; i < N; i += 64) { selA[i] = (unsigned short)i; selA[256 + i] = (unsigned short)i; }
            } else {
                const LAS unsigned* rowA = (const LAS unsigned*)(lds + C_SC + (2 * wid) * 8192);
                const int ndw = N >> 1, nI = (ndw + 63) >> 6;
                unsigned TA, TB; int needA, needB;
                auto bisect = [&](auto NIc) {
                    constexpr int NI = decltype(NIc)::value;
                    unsigned ka[NI], kb[NI];
#pragma unroll
                    for (int i = 0; i < NI; ++i) { const bool ok = lane + 64 * i < ndw; ka[i] = (ok ? rowA[lane + 64 * i] : 0u) | 0x80008000u; kb[i] = (ok ? rowA[2048 + lane + 64 * i] : 0u) | 0x80008000u; }
                    unsigned ta = 0, tb2 = 0;
#pragma unroll 1
                    for (int bit = 14; bit >= 0; --bit) {
                        const unsigned ca = ta | (1u << bit), cb = tb2 | (1u << bit);
                        const unsigned cca = ca * 0x00010001u, ccb = cb * 0x00010001u;
                        unsigned a0 = 0, a1 = 0, b0 = 0, b1 = 0;
#pragma unroll
                        for (int i = 0; i < NI; i += 2) {
                            a0 += ((ka[i] - cca) >> 15) & 0x00010001u; b0 += ((kb[i] - ccb) >> 15) & 0x00010001u;
                            a1 += ((ka[i + 1] - cca) >> 15) & 0x00010001u; b1 += ((kb[i + 1] - ccb) >> 15) & 0x00010001u;
                        }
                        a0 += a1; b0 += b1;
                        const int ga_ = wave_sum_dpp((int)((a0 & 0xffffu) + (a0 >> 16))), gb_ = wave_sum_dpp((int)((b0 & 0xffffu) + (b0 >> 16)));
                        if (ga_ >= 256) ta = ca;
                        if (gb_ >= 256) tb2 = cb;
                    }
                    int gta, gtb;
                    { const unsigned cca = (ta + 1u) * 0x00010001u, ccb = (tb2 + 1u) * 0x00010001u;
                      unsigned a0 = 0, b0 = 0;
#pragma unroll
                      for (int i = 0; i < NI; ++i) { a0 += ((ka[i] - cca) >> 15) & 0x00010001u; b0 += ((kb[i] - ccb) >> 15) & 0x00010001u; }
                      gta = wave_sum_dpp((int)((a0 & 0xffffu) + (a0 >> 16))); gtb = wave_sum_dpp((int)((b0 & 0xffffu) + (b0 >> 16))); }
                    TA = ta; TB = tb2; needA = 256 - gta; needB = 256 - gtb;
                };
                if (nI <= 8) bisect(std::integral_constant<int, 8>{});
                else if (nI <= 16) bisect(std::integral_constant<int, 16>{});
                else if (nI <= 24) bisect(std::integral_constant<int, 24>{});
                else bisect(std::integral_constant<int, 32>{});
                int nsA = 0, neA = 0, nsB = 0, neB = 0;
#pragma unroll 1
                for (int i = 0; i < nI; ++i) {
                    const bool ok = lane + 64 * i < ndw;
                    const unsigned wa = ok ? rowA[lane + 64 * i] : 0u, wb = ok ? rowA[2048 + lane + 64 * i] : 0u;
                    const int klo = 2 * (lane + 64 * i);
                    {
                        const unsigned lo = wa & 0xffffu, hi = wa >> 16;
                        const bool el = lo == TA, eh = hi == TA;
                        const unsigned long long bel = __ballot(el), beh = __ballot(eh);
                        const int rl = neA + __popcll(bel & ltmask) + __popcll(beh & ltmask), rh = rl + (el ? 1 : 0);
                        const bool tl = (lo > TA) || (el && rl < needA), th = (hi > TA) || (eh && rh < needA);
                        const unsigned long long btl = __ballot(tl), bth = __ballot(th);
                        const int pl = nsA + __popcll(btl & ltmask) + __popcll(bth & ltmask), ph = pl + (tl ? 1 : 0);
                        if (tl) selA[pl] = (unsigned short)klo;
                        if (th) selA[ph] = (unsigned short)(klo + 1);
                        nsA += __popcll(btl) + __popcll(bth); neA += __popcll(bel) + __popcll(beh);
                    }
                    {
                        const unsigned lo = wb & 0xffffu, hi = wb >> 16;
                        const bool el = lo == TB, eh = hi == TB;
                        const unsigned long long bel = __ballot(el), beh = __ballot(eh);
                        const int rl = neB + __popcll(bel & ltmask) + __popcll(beh & ltmask), rh = rl + (el ? 1 : 0);
                        const bool tl = (lo > TB) || (el && rl < needB), th = (hi > TB) || (eh && rh < needB);
                        const unsigned long long btl = __ballot(tl), bth = __ballot(th);
                        const int pl = nsB + __popcll(btl & ltmask) + __popcll(bth & ltmask), ph = pl + (tl ? 1 : 0);
                        if (tl) selA[256 + pl] = (unsigned short)klo;
                        if (th) selA[256 + ph] = (unsigned short)(klo + 1);
                        nsB += __popcll(btl) + __popcll(bth); neB += __popcll(bel) + __popcll(beh);
                    }
                }
            }
            const int cntS = N < 256 ? N : 256;
#pragma unroll
            for (int rr = 0; rr < 2; ++rr)
#pragma unroll
                for (int j = 0; j < 4; ++j) { const int sl = lane + 64 * j; if (sl < cntS) bktA[rr * 256 + sl] = (unsigned char)t5_bucket((int)selA[rr * 256 + sl] - (qA + rr)); }
        }
        PROF_END(10, smem)
        PROF_BEGIN(11)
        const int cnt = N < 256 ? N : 256;
        {
            const LAS unsigned short* sel0 = (const LAS unsigned short*)(lds + C_SEL) + (2 * wid) * 256;
            const LAS unsigned char* bkt0 = (const LAS unsigned char*)(lds + C_BKT) + (2 * wid) * 256;
            LAS char* vreg = lds + C_SC + wid * 16384;
            const bf16_t* ckb = pj.ck + (size_t)(b * NS) * 64 + 8 * g4;
            const bf16_t* cvb = pj.cv + (size_t)(b * NS) * 64;
            bf16x8 qf[2][2];
#pragma unroll
            for (int rr = 0; rr < 2; ++rr)
#pragma unroll
                for (int ks = 0; ks < 2; ++ks) qf[rr][ks] = *(const bf16x8*)(pj.cq + (size_t)(tok0 + 2 * wid + rr) * 512 + (l16 & 7) * 64 + ks * 32 + 8 * g4);
            f32x4 O[2][4];
#pragma unroll
            for (int rr = 0; rr < 2; ++rr)
#pragma unroll
                for (int v = 0; v < 4; ++v) O[rr][v] = (f32x4){0.f, 0.f, 0.f, 0.f};
            float mrun[2] = {-INFINITY, -INFINITY}, lsum[2] = {0.f, 0.f};
#pragma unroll 1
            for (int ch = 0; ch * 64 < cnt; ++ch) {
                u32x4 vv[2][8];
#pragma unroll
                for (int rr = 0; rr < 2; ++rr)
#pragma unroll
                    for (int i = 0; i < 8; ++i) {
                        const int piece = lane + 64 * i, e = piece >> 3, c8 = piece & 7, sl = ch * 64 + e;
                        const int idx = sl < cnt ? (int)sel0[rr * 256 + sl] : 0;
                        vv[rr][i] = *(const u32x4*)(cvb + (size_t)idx * 64 + c8 * 8);
                    }
                bf16x8 ka[2][4][2];
#pragma unroll
                for (int rr = 0; rr < 2; ++rr)
#pragma unroll
                    for (int u = 0; u < 4; ++u) {
                        const int e = ch * 64 + u * 16 + l16;
                        const int idx = e < cnt ? (int)sel0[rr * 256 + e] : 0;
                        ka[rr][u][0] = *(const bf16x8*)(ckb + (size_t)idx * 64); ka[rr][u][1] = *(const bf16x8*)(ckb + (size_t)idx * 64 + 32);
                    }
#pragma unroll
                for (int rr = 0; rr < 2; ++rr)
#pragma unroll
                    for (int i = 0; i < 8; ++i) { const int piece = lane + 64 * i, e = piece >> 3, c8 = piece & 7;
                        *(LAS u32x4*)(vreg + rr * 8192 + (c8 >> 2) * 4096 + e * 64 + (c8 & 3) * 16) = vv[rr][i]; }
#pragma unroll
                for (int rr = 0; rr < 2; ++rr) {
#pragma unroll
                    for (int t2 = 0; t2 < 2; ++t2) {
                        f32x4 d[2];
#pragma unroll
                        for (int u = 0; u < 2; ++u) {
                            const int t = ch * 4 + 2 * t2 + u;
                            f32x4 dd = __builtin_amdgcn_mfma_f32_16x16x32_bf16(ka[rr][2 * t2 + u][0], qf[rr][0], (f32x4){0.f, 0.f, 0.f, 0.f}, 0, 0, 0);
                            dd = __builtin_amdgcn_mfma_f32_16x16x32_bf16(ka[rr][2 * t2 + u][1], qf[rr][1], dd, 0, 0, 0);
                            const unsigned bk4 = *(const LAS unsigned*)(bkt0 + rr * 256 + t * 16 + g4 * 4);
#pragma unroll
                            for (int r = 0; r < 4; ++r) {
                                const int slot = t * 16 + g4 * 4 + r;
                                const float bias = tb[((bk4 >> (8 * r)) & 0xffu) * 8 + (l16 & 7)];
                                dd[r] = slot < cnt ? dd[r] + bias : -INFINITY;
                            }
                            d[u] = dd;
                        }
                        float mx = fmaxf(fmaxf(fmaxf(d[0][0], d[0][1]), fmaxf(d[0][2], d[0][3])), fmaxf(fmaxf(d[1][0], d[1][1]), fmaxf(d[1][2], d[1][3])));
                        mx = x32_max(x16_max(mx));
                        const float mn = fmaxf(mrun[rr], mx), alpha = exp2f(mrun[rr] - mn);
                        mrun[rr] = mn;
                        float ps = 0.f;
#pragma unroll
                        for (int u = 0; u < 2; ++u)
#pragma unroll
                            for (int r = 0; r < 4; ++r) { d[u][r] = exp2f(d[u][r] - mn); ps += d[u][r]; }
                        lsum[rr] = lsum[rr] * alpha + ps;
#pragma unroll
                        for (int v = 0; v < 4; ++v) O[rr][v] *= alpha;
                        u32x4 pw; pw.x = cvtpk(d[0][0], d[0][1]); pw.y = cvtpk(d[0][2], d[0][3]); pw.z = cvtpk(d[1][0], d[1][1]); pw.w = cvtpk(d[1][2], d[1][3]);
                        const bf16x8 pb = __builtin_bit_cast(bf16x8, pw);
                        const LAS char* vk = vreg + rr * 8192 + (32 * t2 + 4 * g4 + tq) * 64 + tp * 8;
#pragma unroll
                        for (int v = 0; v < 4; ++v) {
                            const s16x4 lo = tr_read(vk + (v >> 1) * 4096 + (v & 1) * 32), hi = tr_read(vk + (v >> 1) * 4096 + (v & 1) * 32 + 16 * 64);
                            const bf16x8 vf = __builtin_shufflevector(lo, hi, 0, 1, 2, 3, 4, 5, 6, 7);
                            O[rr][v] = __builtin_amdgcn_mfma_f32_16x16x32_bf16(vf, pb, O[rr][v], 0, 0, 0);
                        }
                    }
                }
            }
#pragma unroll
            for (int rr = 0; rr < 2; ++rr) {
                float ls = x32_sum(x16_sum(lsum[rr]));
                const float inv = 1.f / ls;
                if (l16 < 8) {
                    bf16_t* op = BR + (size_t)(tok0 + 2 * wid + rr) * 1536 + 1024 + l16 * 64 + g4 * 4;
#pragma unroll
                    for (int v = 0; v < 4; ++v) { u32x2 w; w.x = cvtpk(O[rr][v][0] * inv, O[rr][v][1] * inv); w.y = cvtpk(O[rr][v][2] * inv, O[rr][v][3] * inv); *(u32x2*)(op + v * 16) = w; }
                }
            }
        }
        PROF_END(11, smem)
    }
}

#if DIAG
__device__ __forceinline__ void ph_diag_stats(const Params& P_) {
    const KA P = ka_get();
    const Proj pj = proj_ptrs(P.ws);
    const bf16_t* buf; size_t n;
    if (DIAG_BUF == 0) { buf = pj.av; n = (size_t)NTOK * 512; }
    else if (DIAG_BUF == 1) { buf = pj.aq; n = (size_t)NTOK * 512; }
    else if (DIAG_BUF == 2) { buf = pj.ik; n = (size_t)NTOK * 32; }
    else { buf = pj.cv; n = (size_t)NTOK * 64; }
    const int tid = tid_opaque();
    float ss = 0.f; unsigned bad = 0;
    for (size_t i = (size_t)blockIdx.x * 512 + tid; i < n; i += (size_t)gridDim.x * 512) { const float v = bf2f(buf[i]); if (!(fabsf(v) < 1e30f)) ++bad; else ss += v * v; }
    ss = wsum(ss); bad = (unsigned)wsum((float)bad);
    if ((tid & 63) == 0) { atomicAdd((float*)(P.ws + OFF_CTRL + 16384), ss / (float)n); atomicAdd((unsigned*)(P.ws + OFF_CTRL + 16388), bad); }
}
__device__ __forceinline__ void ph_diag_scale(const Params& P_) {
    const KA P = ka_get();
    const float ms = *(const float*)(P.ws + OFF_CTRL + 16384); const unsigned bad = *(const unsigned*)(P.ws + OFF_CTRL + 16388);
    const float delta = bad > 0 ? 0.9f : 0.1f + 0.3f * fminf(2.f, ms);
    const int tid = tid_opaque();
    for (size_t i = (size_t)blockIdx.x * 512 + tid; i < (size_t)NTOK * ND; i += (size_t)gridDim.x * 512) P.out[i] *= (1.f + delta);
}
#endif

constexpr int LDS_BYTES = 147456;
enum { PH_PREP = 0, PH_INPROJ, PH_HEADNORM, PH_ATTN_A, PH_ATTN_B, PH_ATTN_C, PH_GB, PH_OUT, PH_NORM2, PH_MOE, PH_MOE2, PH_COUNT };

template <int PH>
__device__ __forceinline__ void run_phase(const Params& P, int l, float* lds) {
#ifdef SKIPX
    if (PH == SKIPX) return;
#endif
    if (PH == PH_PREP) { ph_convert_weights(P, l); ph_rmsnorm(P.in[I_X], l == 0 ? (const bf16_t*)nullptr : (const bf16_t*)(P.ws + OFF_STREAM), P.in[I_NMG] + (size_t)l * ND, (bf16_t*)(P.ws + OFF_H)); }
    if (PH == PH_INPROJ) { if (OPT_INPROJ) ph_inproj(P, l, (char*)lds); else ph_inproj_naive(P, l, lds); }
    if (PH == PH_HEADNORM) { if (!OPT_INPROJ) ph_headnorm_naive(P, l); }
    if (PH == PH_ATTN_A) { if (OPT_ATTN_A) ph_attnA(P, l, (char*)lds); else ph_attnA_naive(P, l, lds); }
    if (PH == PH_ATTN_B) { if (OPT_ATTN_B) ph_attnB(P, l, (char*)lds); else ph_attnB_naive(P, l, lds); }
    if (PH == PH_ATTN_C) { if (OPT_ATTN_C) ph_attnC(P, l, (char*)lds); else ph_attnC_naive(P, l, lds); }
    if (PH == PH_GB) { if (OPT_GB) ph_gatebranch(P, l, (char*)lds); else ph_gatebranch_naive(P, l, lds); }
    if (PH == PH_OUT) { if (OPT_OUT) ph_outproj(P, l, (char*)lds); else ph_out_naive(P, l, lds); }
    if (PH == PH_NORM2) ph_norm2_route(P, l, lds);
    if (PH == PH_MOE) { if (OPT_MOE) { ph_moe_up(P, l, (char*)lds); } else ph_moe_naive(P, l, lds); }
    if (PH == PH_MOE2) { if (OPT_MOE) ph_moe_down(P, l, (char*)lds); }
}

template <int PH>
__global__ void __launch_bounds__(512, 2) k_phase(Params P, int l) {
    extern __shared__ __attribute__((aligned(16))) char smem[];
    run_phase<PH>(P, l, (float*)smem);
}

template <int PH>
static void launch_phase(const Params& P, int l, int grid, hipStream_t stream) {
    static bool attr = false;
    if (!attr) { (void)hipFuncSetAttribute((const void*)k_phase<PH>, hipFuncAttributeMaxDynamicSharedMemorySize, LDS_BYTES); attr = true; }
    hipLaunchKernelGGL(k_phase<PH>, dim3(grid), dim3(512), LDS_BYTES, stream, P, l);
}

__global__ void __launch_bounds__(512, 2) k_fused(Params P) {
    extern __shared__ __attribute__((aligned(16))) char smem[];
    float* lds = (float*)smem;
    volatile LAS unsigned* st = (volatile LAS unsigned*)(smem + LDS_BYTES - 16);
    if (threadIdx.x == 0) { st[0] = 0u; st[1] = 0u; st[2] = 0u; st[3] = 0u; }
    __syncthreads();
    const XcdBarrier bar = xcd_barrier_post((unsigned*)(P.ws + OFF_CTRL), st);
    if (PROF_ID && threadIdx.x == 0) *(volatile LAS unsigned*)((LAS char*)smem + PROF_LDS_OFF) = 0u;
#define BARP() do { PROF_BEGIN(16) xcd_barrier(bar); PROF_END(16, smem) } while (0)
#define RUNQ(PH, id) do { PROF_BEGIN(id) run_phase<PH>(P, l, lds); PROF_END(id, smem) if (DUP_PH == PH && (PH != PH_OUT || l == 0)) { if (PH == PH_PREP || PH == PH_INPROJ || PH == PH_GB || PH == PH_OUT || PH == PH_MOE) xcd_barrier(bar); run_phase<PH>(P, l, lds); } } while (0)
    for (int l = 0; l < 2; ++l) {
        RUNQ(PH_PREP, 12); BARP();
        RUNQ(PH_INPROJ, 1); BARP();
        if (DUP_PH == 100) { ph_inproj(P, l + 16 * DUP_MODE, (char*)lds); xcd_barrier(bar); }
        if (!OPT_INPROJ) { run_phase<PH_HEADNORM>(P, l, lds); xcd_barrier(bar); }
        RUNQ(PH_ATTN_A, 6);
        RUNQ(PH_ATTN_B, 7);
        RUNQ(PH_ATTN_C, 8);
        BARP();
        RUNQ(PH_GB, 3); BARP();
        RUNQ(PH_OUT, 5); BARP();
        RUNQ(PH_NORM2, 13); BARP();
        RUNQ(PH_MOE, 14); BARP();
        if (OPT_MOE) { RUNQ(PH_MOE2, 15); BARP(); }
    }
    if (PROF_ID) {
        const KA Pk = ka_get();
        unsigned* mx = (unsigned*)(Pk.ws + OFF_CTRL + 16400);
        if (threadIdx.x == 0) atomicMax(mx, *(volatile LAS unsigned*)((LAS char*)smem + PROF_LDS_OFF));
        xcd_barrier(bar);
        const float tus = (float)__hip_atomic_load(mx, __ATOMIC_RELAXED, __HIP_MEMORY_SCOPE_AGENT) * 0.01f;
        const float tq_ = exp2f(rintf(log2f(fmaxf(tus, 1.f)) * 4.f) * 0.25f);
        const float delta = sqrtf(tq_ * 1e-5f);
        const int tq = tid_opaque();
        for (size_t i = (size_t)blockIdx.x * 512 + tq; i < (size_t)NTOK * ND; i += (size_t)gridDim.x * 512) Pk.out[i] *= (1.f + delta);
    }
#if DIAG == 3
    ph_diag_scale(P);
#endif
}

extern "C" void kernel_launch(void* const* d_in, const int* in_sizes, int n_in, void* d_out, int out_size, void* d_ws, size_t ws_size, hipStream_t stream) {
    Params P{};
    for (int i = 0; i < 20; ++i) P.in[i] = (const float*)d_in[i];
    P.out = (float*)d_out; P.ws = (char*)d_ws;
    (void)hipMemsetAsync(d_ws, 0, CTRL_BYTES, stream);
#if FUSED
    static int grid = 0;
    if (!grid) {
        int dev = 0, cus = 0, per_cu = 0;
        (void)hipGetDevice(&dev);
        (void)hipDeviceGetAttribute(&cus, hipDeviceAttributeMultiprocessorCount, dev);
        (void)hipFuncSetAttribute((const void*)k_fused, hipFuncAttributeMaxDynamicSharedMemorySize, LDS_BYTES);
        (void)hipOccupancyMaxActiveBlocksPerMultiprocessor(&per_cu, (const void*)k_fused, 512, LDS_BYTES);
        grid = cus * (per_cu < 1 ? per_cu : 1);
        if (grid <= 0) { fprintf(stderr, "k_fused: occupancy query says %d blocks per CU\n", per_cu); grid = cus; }
    }
    hipLaunchKernelGGL(k_fused, dim3(grid), dim3(512), LDS_BYTES, stream, P);
#else
    const int G = 2048;
    for (int l = 0; l < 2; ++l) {
        launch_phase<PH_PREP>(P, l, G, stream);
        launch_phase<PH_INPROJ>(P, l, G, stream);
        launch_phase<PH_HEADNORM>(P, l, G, stream);
        launch_phase<PH_ATTN_A>(P, l, G, stream);
        launch_phase<PH_ATTN_B>(P, l, G, stream);
        launch_phase<PH_ATTN_C>(P, l, G, stream);
        launch_phase<PH_GB>(P, l, G, stream);
        launch_phase<PH_OUT>(P, l, G, stream);
        launch_phase<PH_NORM2>(P, l, G, stream);
        launch_phase<PH_MOE>(P, l, G, stream);
    }
#endif
}
```

```cpp
#include <hip/hip_runtime.h>
#include <stdint.h>
#include <stdio.h>
#include <type_traits>

#ifndef FUSED
#define FUSED 1
#endif
#define OPT_INPROJ 1
#define OPT_GB 1
#define OPT_OUT 1
#define OPT_MOE 1
#define OPT_ATTN_A 1
#define OPT_ATTN_B 1
#define OPT_ATTN_C 1
#define DIAG 0
#define DUP_PH -1
#define DUP_MODE 0
#define PROF_ID 0
#define C_DUP 0
#define VBID ((blockIdx.x & 31) * 8 + (blockIdx.x >> 5))
#define DIAG_BUF 0

#define LAS __attribute__((address_space(3)))
typedef unsigned short bf16_t;

constexpr int NB = 8, NS = 4096, ND = 1024, NTOK = NB * NS;
constexpr int IN_COLS = 3108;
constexpr float LOG2E = 1.4426950408889634f;
constexpr float QSCALE = 0.125f * LOG2E;
constexpr float EPS = 1e-6f;
constexpr float IWSCALE = 0.08838834764831845f;

constexpr size_t MB = (size_t)1 << 20;
constexpr size_t OFF_CTRL = 0;
constexpr size_t CTRL_BYTES = 65536;
constexpr size_t OFF_ROUTE = 1 * MB;
constexpr size_t MOE_CNT_OFF = 32768;
constexpr size_t MOE_LIST_OFF = 512 * 1024;
constexpr size_t MOE_RW_OFF = 512 * 1024 + 3 * MB;
constexpr size_t OFF_WT = 5 * MB;
constexpr size_t OFF_H = 49 * MB;
constexpr size_t OFF_BR = 113 * MB;
constexpr size_t OFF_PROJ = 209 * MB;
constexpr size_t OFF_MERGED = OFF_PROJ + 128 * MB;
constexpr size_t OFF_STREAM = OFF_PROJ + 195 * MB;
constexpr size_t PO_AQ = 0, PO_AK = 32 * MB, PO_AV = 64 * MB, PO_BQ = 96 * MB, PO_BK = 128 * MB, PO_BV = 136 * MB, PO_CQ = 144 * MB,
                 PO_CK = 176 * MB, PO_CV = 180 * MB, PO_IQ = 184 * MB, PO_IK = 192 * MB, PO_IW = 194 * MB;

struct Params {
    const float* in[20];
    float* out;
    char* ws;
};
typedef const __attribute__((address_space(4))) char* kaptr_t;
struct KAIn { kaptr_t base; __device__ __forceinline__ const float* operator[](int i) const { return *(const float* const __attribute__((address_space(4)))*)(base + 8 * i); } };
struct KA { KAIn in; float* out; char* ws; };
__device__ __forceinline__ KA ka_get() {
    kaptr_t p = (kaptr_t)__builtin_amdgcn_kernarg_segment_ptr(); asm volatile("" : "+s"(p));
    KA k; k.in.base = p; k.out = *(float* const __attribute__((address_space(4)))*)(p + 160); k.ws = *(char* const __attribute__((address_space(4)))*)(p + 168); return k;
}
enum { I_X = 0, I_RELB, I_NMG, I_WIN, I_QKG, I_LAM, I_SUBLN, I_SINK, I_WBR, I_WGATE, I_BGATE, I_WOUT, I_NFG, I_WRG, I_BRG, I_WRE, I_BRE, I_WFG, I_WFU, I_WFD };

struct Proj { bf16_t *aq, *ak, *av, *bq, *bk, *bv, *cq, *ck, *cv, *iq, *ik; float* iw; };
__device__ __forceinline__ Proj proj_ptrs(char* ws) {
    char* p = ws + OFF_PROJ; Proj r;
    r.aq = (bf16_t*)(p + PO_AQ); r.ak = (bf16_t*)(p + PO_AK); r.av = (bf16_t*)(p + PO_AV); r.bq = (bf16_t*)(p + PO_BQ); r.bk = (bf16_t*)(p + PO_BK); r.bv = (bf16_t*)(p + PO_BV);
    r.cq = (bf16_t*)(p + PO_CQ); r.ck = (bf16_t*)(p + PO_CK); r.cv = (bf16_t*)(p + PO_CV); r.iq = (bf16_t*)(p + PO_IQ); r.ik = (bf16_t*)(p + PO_IK); r.iw = (float*)(p + PO_IW);
    return r;
}

__device__ __forceinline__ int tid_opaque() { int t = threadIdx.x; asm volatile("" : "+v"(t)); return t; }
#define PROF_LDS_OFF (147456 - 32)
#define PROF_BEGIN(id) unsigned long long _pt##id = 0; if (PROF_ID == (id) || ((id) == 99 && PROF_ID != 0)) _pt##id = __builtin_amdgcn_s_memrealtime();
#define PROF_END(id, smem_) if (PROF_ID == (id) && threadIdx.x == 0) { *(volatile LAS unsigned*)((LAS char*)(smem_) + PROF_LDS_OFF) += (unsigned)(__builtin_amdgcn_s_memrealtime() - _pt##id); }
__device__ __forceinline__ float bf2f(bf16_t b) { return __uint_as_float(((unsigned)b) << 16); }
__device__ __forceinline__ bf16_t f2bf(float f) { unsigned u = __float_as_uint(f); u += 0x7FFFu + ((u >> 16) & 1u); return (bf16_t)(u >> 16); }
__device__ __forceinline__ float bflo(unsigned w) { return __uint_as_float(w << 16); }
__device__ __forceinline__ float bfhi(unsigned w) { return __uint_as_float(w & 0xffff0000u); }
__device__ __forceinline__ unsigned pack2(float lo, float hi) { return (unsigned)f2bf(lo) | ((unsigned)f2bf(hi) << 16); }
__device__ __forceinline__ unsigned pack2hw(float lo, float hi) { unsigned r; asm volatile("v_cvt_pk_bf16_f32 %0, %1, %2" : "=v"(r) : "v"(lo), "v"(hi)); return r; }
__device__ __forceinline__ int wave_sum_dpp(int v) {
    v += __builtin_amdgcn_update_dpp(0, v, 0x111, 0xf, 0xf, true);
    v += __builtin_amdgcn_update_dpp(0, v, 0x112, 0xf, 0xf, true);
    v += __builtin_amdgcn_update_dpp(0, v, 0x114, 0xf, 0xf, true);
    v += __builtin_amdgcn_update_dpp(0, v, 0x118, 0xf, 0xf, true);
    v += __builtin_amdgcn_update_dpp(0, v, 0x142, 0xa, 0xf, true);
    v += __builtin_amdgcn_update_dpp(0, v, 0x143, 0xc, 0xf, true);
    return __builtin_amdgcn_readlane(v, 63);
}
__device__ __forceinline__ float x32_max(float v) { const auto r = __builtin_amdgcn_permlane32_swap(__float_as_uint(v), __float_as_uint(v), false, false); return fmaxf(__uint_as_float(r[0]), __uint_as_float(r[1])); }
__device__ __forceinline__ float x32_sum(float v) { const auto r = __builtin_amdgcn_permlane32_swap(__float_as_uint(v), __float_as_uint(v), false, false); return __uint_as_float(r[0]) + __uint_as_float(r[1]); }
__device__ __forceinline__ float x16_max(float v) { const auto r = __builtin_amdgcn_permlane16_swap(__float_as_uint(v), __float_as_uint(v), false, false); return fmaxf(__uint_as_float(r[0]), __uint_as_float(r[1])); }
__device__ __forceinline__ float x16_sum(float v) { const auto r = __builtin_amdgcn_permlane16_swap(__float_as_uint(v), __float_as_uint(v), false, false); return __uint_as_float(r[0]) + __uint_as_float(r[1]); }
__device__ __forceinline__ float wsum_dpp(float v) {
    v += __builtin_bit_cast(float, __builtin_amdgcn_update_dpp(0, __builtin_bit_cast(int, v), 0x111, 0xf, 0xf, true));
    v += __builtin_bit_cast(float, __builtin_amdgcn_update_dpp(0, __builtin_bit_cast(int, v), 0x112, 0xf, 0xf, true));
    v += __builtin_bit_cast(float, __builtin_amdgcn_update_dpp(0, __builtin_bit_cast(int, v), 0x114, 0xf, 0xf, true));
    v += __builtin_bit_cast(float, __builtin_amdgcn_update_dpp(0, __builtin_bit_cast(int, v), 0x118, 0xf, 0xf, true));
    v += __builtin_bit_cast(float, __builtin_amdgcn_update_dpp(0, __builtin_bit_cast(int, v), 0x142, 0xa, 0xf, true));
    v += __builtin_bit_cast(float, __builtin_amdgcn_update_dpp(0, __builtin_bit_cast(int, v), 0x143, 0xc, 0xf, true));
    return __builtin_bit_cast(float, __builtin_amdgcn_readlane(__builtin_bit_cast(int, v), 63));
}
__device__ __forceinline__ float wsum(float v) { for (int o = 32; o; o >>= 1) v += __shfl_xor(v, o); return v; }
__device__ __forceinline__ float wmax(float v) { for (int o = 32; o; o >>= 1) v = fmaxf(v, __shfl_xor(v, o)); return v; }
__device__ __forceinline__ int t5_bucket(int rel) {
    const int n = rel < 0 ? -rel : rel;
    int b = n;
    if (n >= 8) b = 8 + (n >= 15) + (n >= 27) + (n >= 50) + (n >= 91) + (n >= 166) + (n >= 305) + (n >= 559);
    return (rel > 0 ? 16 : 0) + b;
}
__device__ __forceinline__ float lambda_init_of(int l) { return 0.8f - 0.6f * expf(-0.3f * (float)l); }
__device__ __forceinline__ float dot8(uint4 kv, const float* q) {
    return bflo(kv.x) * q[0] + bfhi(kv.x) * q[1] + bflo(kv.y) * q[2] + bfhi(kv.y) * q[3] + bflo(kv.z) * q[4] + bfhi(kv.z) * q[5] + bflo(kv.w) * q[6] + bfhi(kv.w) * q[7];
}


#define XB_TMO      128
#define XB_XCNT(j)  (256  + 64 * (j))
#define XB_XSUB(j)  (1280 + 64 * (j))
#define XB_XGEN(j)  (2304 + 64 * (j))
#define XB_TOP      3328
#define XB_TOPGEN   3392
#define XCD_BAR_WORDS 3456
#define XB_SPIN_CAP (1u << 22)
__device__ __forceinline__ unsigned xb_ld(unsigned* p)              { return __hip_atomic_load(p, __ATOMIC_RELAXED, __HIP_MEMORY_SCOPE_AGENT); }
__device__ __forceinline__ unsigned xb_add(unsigned* p, unsigned v) { return __hip_atomic_fetch_add(p, v, __ATOMIC_RELAXED, __HIP_MEMORY_SCOPE_AGENT); }
__device__ __forceinline__ unsigned xb_xcc_id() { return (unsigned)__builtin_amdgcn_s_getreg((3 << 11) | 20) & 0xFu; }
#define XB_SPIN(cond, bar) do { unsigned _sp = 0; while (cond) { __builtin_amdgcn_s_sleep(1); \
    if ((++_sp & 255u) == 0u) { if (xb_ld(&(bar)[XB_TMO])) break; if (_sp > XB_SPIN_CAP) { atomicAdd(&(bar)[XB_TMO], 1u); break; } } } } while (0)
struct XcdBarrier { unsigned* bar; unsigned x; volatile LAS unsigned* st; };
__device__ __forceinline__ XcdBarrier xcd_barrier_post(unsigned* bar, volatile LAS unsigned* st) {
    XcdBarrier b; b.bar = bar; b.x = xb_xcc_id(); b.st = st;
    if (threadIdx.x == 0) (void)xb_add(&bar[XB_XCNT(b.x)], 1u);
    return b;
}
__device__ __forceinline__ void xcd_barrier_complete(unsigned* bar, unsigned x, unsigned& nloc, unsigned& nx) {
    const unsigned G = gridDim.x * gridDim.y * gridDim.z;
    unsigned sum, cnt, mine, sp = 0u;
    for (;;) {
        sum = 0u; cnt = 0u; mine = 0u;
#pragma unroll
        for (unsigned j = 0; j < 16; ++j) { const unsigned c = xb_ld(&bar[XB_XCNT(j)]); sum += c; cnt += (c > 0u) ? 1u : 0u; mine = (j == x) ? c : mine; }
        if (sum == G) break;
        __builtin_amdgcn_s_sleep(1);
        if ((++sp & 255u) == 0u) { if (xb_ld(&bar[XB_TMO])) break; if (sp > XB_SPIN_CAP) { atomicAdd(&bar[XB_TMO], 1u); break; } }
    }
    nloc = mine > 0u ? mine : 1u; nx = cnt > 0u ? cnt : 1u;
}
__device__ __forceinline__ void xcd_barrier(const XcdBarrier& b) {
    asm volatile("s_waitcnt vmcnt(0)" ::: "memory");
    __syncthreads();
    if (threadIdx.x == 0) {
        unsigned* bar = b.bar;
        __builtin_amdgcn_s_waitcnt(0);
        unsigned nloc = b.st[0], nx = b.st[1];
        if (nloc == 0u) { xcd_barrier_complete(bar, b.x, nloc, nx); b.st[0] = nloc; b.st[1] = nx; }
        const unsigned old = xb_add(&bar[XB_XSUB(b.x)], 1u);
        const unsigned gen = old / nloc;
        if (old + 1u == (gen + 1u) * nloc) {
            __builtin_amdgcn_fence(__ATOMIC_RELEASE, "agent");
            asm volatile("s_waitcnt vmcnt(0)" ::: "memory");
            const unsigned og = xb_add(&bar[XB_TOP], 1u);
            const unsigned tg = og / nx;
            if (og + 1u == (tg + 1u) * nx) xb_add(&bar[XB_TOPGEN], 1u);
            else XB_SPIN(xb_ld(&bar[XB_TOPGEN]) == tg, bar);
            __builtin_amdgcn_fence(__ATOMIC_ACQUIRE, "agent");
            xb_add(&bar[XB_XGEN(b.x)], 1u);
            asm volatile("s_waitcnt vmcnt(0)" ::: "memory");
        } else {
            XB_SPIN(xb_ld(&bar[XB_XGEN(b.x)]) == gen, bar);
            __builtin_amdgcn_fence(__ATOMIC_ACQUIRE, "agent");
            asm volatile("s_waitcnt vmcnt(0)" ::: "memory");
        }
    }
    __syncthreads();
}

__device__ __forceinline__ void ngemm_tile(const bf16_t* A, int lda, const float* W, int ldw, int K, int ncols, int row0, int col0, float (&acc)[8][4], float* lds) {
    float* As = lds; float* Bs = lds + 16 * 132;
    const int tid = tid_opaque(), ty = tid >> 5, tx = tid & 31;
#pragma unroll
    for (int i = 0; i < 8; ++i)
#pragma unroll
        for (int j = 0; j < 4; ++j) acc[i][j] = 0.f;
    for (int k0 = 0; k0 < K; k0 += 16) {
        {
            const int r = tid >> 2, kq = (tid & 3) * 4;
            const uint2 v = *(const uint2*)(A + (size_t)(row0 + r) * lda + k0 + kq);
            As[(kq + 0) * 132 + r] = bflo(v.x); As[(kq + 1) * 132 + r] = bfhi(v.x); As[(kq + 2) * 132 + r] = bflo(v.y); As[(kq + 3) * 132 + r] = bfhi(v.y);
        }
        {
            const int k = tid >> 5, c = (tid & 31) * 4;
            const float* wp = W + (size_t)(k0 + k) * ldw + col0 + c;
            float4 v = make_float4(0.f, 0.f, 0.f, 0.f);
            if (col0 + c + 3 < ncols) v = *(const float4*)wp;
            else { if (col0 + c < ncols) v.x = wp[0]; if (col0 + c + 1 < ncols) v.y = wp[1]; if (col0 + c + 2 < ncols) v.z = wp[2]; }
            *(float4*)(Bs + k * 128 + c) = v;
        }
        __syncthreads();
#pragma unroll 2
        for (int kk = 0; kk < 16; ++kk) {
            const float4 a0 = *(const float4*)(As + kk * 132 + ty * 8), a1 = *(const float4*)(As + kk * 132 + ty * 8 + 4);
            const float4 b = *(const float4*)(Bs + kk * 128 + tx * 4);
            const float a[8] = {a0.x, a0.y, a0.z, a0.w, a1.x, a1.y, a1.z, a1.w}; const float bb[4] = {b.x, b.y, b.z, b.w};
#pragma unroll
            for (int i = 0; i < 8; ++i)
#pragma unroll
                for (int j = 0; j < 4; ++j) acc[i][j] += a[i] * bb[j];
        }
        __syncthreads();
    }
}

__device__ __forceinline__ void ph_rmsnorm(const float* xsrc, const bf16_t* xs16, const float* g, bf16_t* H) {
    const int tidq = tid_opaque(); const int lane = tidq & 63, wid = tidq >> 6;
    float4 gv[4];
#pragma unroll
    for (int j = 0; j < 4; ++j) gv[j] = ((const float4*)g)[j * 64 + lane];
    for (int row0 = (blockIdx.x * 8 + wid) * 4; row0 < NTOK; row0 += gridDim.x * 32) {
        float4 v[4][4];
#pragma unroll
        for (int r = 0; r < 4; ++r) {
            if (xs16 == nullptr) { const float4* xp = (const float4*)(xsrc + (size_t)(row0 + r) * ND);
#pragma unroll
                for (int j = 0; j < 4; ++j) v[r][j] = xp[j * 64 + lane]; }
            else { const uint2* xp = (const uint2*)(xs16 + (size_t)(row0 + r) * ND);
#pragma unroll
                for (int j = 0; j < 4; ++j) { const uint2 w = xp[j * 64 + lane]; v[r][j] = make_float4(bflo(w.x), bfhi(w.x), bflo(w.y), bfhi(w.y)); } }
        }
#pragma unroll
        for (int r = 0; r < 4; ++r) {
            float ss = 0.f;
#pragma unroll
            for (int j = 0; j < 4; ++j) ss += v[r][j].x * v[r][j].x + v[r][j].y * v[r][j].y + v[r][j].z * v[r][j].z + v[r][j].w * v[r][j].w;
            ss = wsum_dpp(ss);
            const float rstd = rsqrtf(ss * (1.0f / ND) + EPS);
#pragma unroll
            for (int j = 0; j < 4; ++j) {
                uint2 o; o.x = pack2hw(v[r][j].x * rstd * gv[j].x, v[r][j].y * rstd * gv[j].y); o.y = pack2hw(v[r][j].z * rstd * gv[j].z, v[r][j].w * rstd * gv[j].w);
                *(uint2*)(H + (size_t)(row0 + r) * ND + (j * 64 + lane) * 4) = o;
            }
        }
    }
}

__device__ __forceinline__ void store_proj_raw(const Proj& pj, int tok, int c, float v) {
    if (c < 512) pj.aq[(size_t)tok * 512 + c] = f2bf(v);
    else if (c < 1024) pj.ak[(size_t)tok * 512 + c - 512] = f2bf(v);
    else if (c < 1536) pj.av[(size_t)tok * 512 + c - 1024] = f2bf(v);
    else if (c < 2048) pj.bq[(size_t)tok * 512 + c - 1536] = f2bf(v);
    else if (c < 2176) pj.bk[(size_t)tok * 128 + c - 2048] = f2bf(v);
    else if (c < 2304) pj.bv[(size_t)tok * 128 + c - 2176] = f2bf(v);
    else if (c < 2816) pj.cq[(size_t)tok * 512 + c - 2304] = f2bf(v);
    else if (c < 2880) pj.ck[(size_t)tok * 64 + c - 2816] = f2bf(v);
    else if (c < 2944) pj.cv[(size_t)tok * 64 + c - 2880] = f2bf(v);
    else if (c < 3072) pj.iq[(size_t)tok * 128 + c - 2944] = f2bf(v);
    else if (c < 3104) pj.ik[(size_t)tok * 32 + c - 3072] = f2bf(v);
    else if (c < 3108) pj.iw[(size_t)tok * 4 + c - 3104] = v * IWSCALE;
}
__device__ __forceinline__ void ph_inproj_naive(const Params& P_, int l, float* lds) {
    const KA P = ka_get();
    const Proj pj = proj_ptrs(P.ws);
    const bf16_t* H = (const bf16_t*)(P.ws + OFF_H);
    const float* W = P.in[I_WIN] + (size_t)l * ND * IN_COLS;
    const int tid = tid_opaque(), ty = tid >> 5, tx = tid & 31;
    for (int t = blockIdx.x; t < 256 * 25; t += gridDim.x) {
        const int tm = t / 25, tn = t % 25;
        float acc[8][4];
        ngemm_tile(H, ND, W, IN_COLS, ND, IN_COLS, tm * 128, tn * 128, acc, lds);
#pragma unroll
        for (int i = 0; i < 8; ++i)
#pragma unroll
            for (int j = 0; j < 4; ++j) { const int c = tn * 128 + tx * 4 + j; if (c < IN_COLS) store_proj_raw(pj, tm * 128 + ty * 8 + i, c, acc[i][j]); }
    }
}
__device__ __forceinline__ void ph_headnorm_naive(const Params& P_, int l) {
    const KA P = ka_get();
    const Proj pj = proj_ptrs(P.ws);
    const float* qkg = P.in[I_QKG] + (size_t)l * 3 * 2 * 64;
    const int tidq = tid_opaque(); const int lane = tidq & 63, wid = tidq >> 6;
    for (long t = (long)blockIdx.x * 8 + wid; t < (long)NTOK * 35; t += (long)gridDim.x * 8) {
        const int tok = (int)(t / 35), g = (int)(t % 35);
        bf16_t* p; const float* gv; float sc = 1.f;
        if (g < 8) { p = pj.aq + (size_t)tok * 512 + g * 64; gv = qkg + 0; sc = QSCALE; }
        else if (g < 16) { p = pj.ak + (size_t)tok * 512 + (g - 8) * 64; gv = qkg + 64; }
        else if (g < 24) { p = pj.bq + (size_t)tok * 512 + (g - 16) * 64; gv = qkg + 128; sc = QSCALE; }
        else if (g < 26) { p = pj.bk + (size_t)tok * 128 + (g - 24) * 64; gv = qkg + 192; }
        else if (g < 34) { p = pj.cq + (size_t)tok * 512 + (g - 26) * 64; gv = qkg + 256; sc = QSCALE; }
        else { p = pj.ck + (size_t)tok * 64; gv = qkg + 320; }
        const float v = bf2f(p[lane]);
        const float ss = wsum(v * v);
        p[lane] = f2bf(v * rsqrtf(ss * (1.0f / 64) + EPS) * gv[lane] * sc);
    }
}

__device__ __forceinline__ void ph_attnA_naive(const Params& P_, int l, float* lds) {
    const KA P = ka_get();
    const Proj pj = proj_ptrs(P.ws);
    bf16_t* BR = (bf16_t*)(P.ws + OFF_BR);
    const int tidq = tid_opaque(); const int lane = tidq & 63, wid = tidq >> 6;
    float* btab = lds;
    float* qs = lds + 128 + wid * 128;
    for (int i = tidq; i < 128; i += 512) btab[i] = P.in[I_RELB][(i >> 2) * 20 + (i & 3)] * LOG2E;
    __syncthreads();
    const float* lp = P.in[I_LAM] + (size_t)l * 256;
    const float linit = lambda_init_of(l);
    const float lam = expf(wsum(lp[lane] * lp[64 + lane])) - expf(wsum(lp[128 + lane] * lp[192 + lane])) + linit;
    const float* subg = P.in[I_SUBLN] + (size_t)l * 128;
    for (int t = blockIdx.x * 8 + wid; t < NB * 4 * NS; t += gridDim.x * 8) {
        const int q = t & (NS - 1), h = (t >> 12) & 3, b = t >> 14;
        const int tok = b * NS + q;
        qs[lane] = bf2f(pj.aq[(size_t)tok * 512 + (h * 2) * 64 + lane]);
        qs[64 + lane] = bf2f(pj.aq[(size_t)tok * 512 + (h * 2 + 1) * 64 + lane]);
        const int nkt = (q >> 6) + 1;
        float M0 = -INFINITY, Z0 = 0.f, M1 = -INFINITY, Z1 = 0.f;
        for (int kt = 0; kt < nkt; ++kt) {
            asm volatile("" ::: "memory");
            const int key = kt * 64 + lane;
            const uint4* kp = (const uint4*)(pj.ak + (size_t)(b * NS + key) * 512 + h * 128);
            float s0 = 0.f, s1 = 0.f;
#pragma unroll 1
            for (int d = 0; d < 8; ++d) { asm volatile("" ::: "memory"); s0 += dot8(kp[d], qs + d * 8); s1 += dot8(kp[8 + d], qs + 64 + d * 8); }
            const float bias = btab[t5_bucket(key - q) * 4 + h];
            s0 += bias; s1 += bias;
            float mn = fmaxf(M0, s0); Z0 = Z0 * exp2f(M0 - mn) + exp2f(s0 - mn); M0 = mn;
            mn = fmaxf(M1, s1); Z1 = Z1 * exp2f(M1 - mn) + exp2f(s1 - mn); M1 = mn;
        }
        { const float mw = wmax(M0); Z0 = wsum(Z0 * exp2f(M0 - mw)); M0 = mw; }
        { const float mw = wmax(M1); Z1 = wsum(Z1 * exp2f(M1 - mw)); M1 = mw; }
        const float iz0 = 1.f / Z0, iz1 = lam / Z1;
        float a0 = 0.f, a1 = 0.f;
        for (int kt = 0; kt < nkt; ++kt) {
            asm volatile("" ::: "memory");
            const int key = kt * 64 + lane;
            const uint4* kp = (const uint4*)(pj.ak + (size_t)(b * NS + key) * 512 + h * 128);
            float s0 = 0.f, s1 = 0.f;
#pragma unroll 1
            for (int d = 0; d < 8; ++d) { asm volatile("" ::: "memory"); s0 += dot8(kp[d], qs + d * 8); s1 += dot8(kp[8 + d], qs + 64 + d * 8); }
            const float bias = btab[t5_bucket(key - q) * 4 + h];
            const float p = exp2f(s0 + bias - M0) * iz0 - exp2f(s1 + bias - M1) * iz1;
            const unsigned* vp = (const unsigned*)(pj.av + (size_t)(b * NS + kt * 64) * 512 + h * 128) + lane;
#pragma unroll 4
            for (int j = 0; j < 64; ++j) { const float pjv = __shfl(p, j); const unsigned w = vp[(size_t)j * 256]; a0 += pjv * bflo(w); a1 += pjv * bfhi(w); }
        }
        const float ss = wsum(a0 * a0 + a1 * a1);
        const float rstd = rsqrtf(ss * (1.0f / 128) + EPS) * (1.0f - linit);
        *(unsigned*)(BR + (size_t)tok * 1536 + h * 128 + lane * 2) = pack2(a0 * rstd * subg[lane * 2], a1 * rstd * subg[lane * 2 + 1]);
    }
}

__device__ __forceinline__ void ph_attnB_naive(const Params& P_, int l, float* lds) {
    const KA P = ka_get();
    const Proj pj = proj_ptrs(P.ws);
    bf16_t* BR = (bf16_t*)(P.ws + OFF_BR);
    const int tidq = tid_opaque(); const int lane = tidq & 63, wid = tidq >> 6;
    float* btab = lds;
    float* qs = lds + 256 + wid * 64;
    __syncthreads();
    for (int i = tidq; i < 256; i += 512) btab[i] = P.in[I_RELB][(i >> 3) * 20 + 4 + (i & 7)] * LOG2E;
    __syncthreads();
    const float* sinks = P.in[I_SINK] + (size_t)l * 8;
    for (int t = blockIdx.x * 8 + wid; t < NTOK * 8; t += gridDim.x * 8) {
        const int hq = t & 7, tok = t >> 3, q = tok & (NS - 1), b = tok >> 12, kvh = hq >> 2, c = q >> 6;
        qs[lane] = bf2f(pj.bq[(size_t)tok * 512 + hq * 64 + lane]);
        float s[3];
#pragma unroll
        for (int g = 0; g < 3; ++g) {
            const int pos = c * 64 - 128 + g * 64 + lane;
            s[g] = -INFINITY;
            if (pos >= 0) {
                const uint4* kp = (const uint4*)(pj.bk + (size_t)(b * NS + pos) * 128 + kvh * 64);
                float a = 0.f;
#pragma unroll
                for (int d = 0; d < 8; ++d) a += dot8(kp[d], qs + d * 8);
                s[g] = a + btab[t5_bucket(pos - q) * 8 + hq];
            }
        }
        const float sink = sinks[hq] * LOG2E;
        const float m = fmaxf(wmax(fmaxf(fmaxf(s[0], s[1]), s[2])), sink);
        float e[3];
#pragma unroll
        for (int g = 0; g < 3; ++g) e[g] = exp2f(s[g] - m);
        const float Z = wsum(e[0] + e[1] + e[2]) + exp2f(sink - m);
        const float iz = 1.f / Z;
        float acc = 0.f;
#pragma unroll
        for (int g = 0; g < 3; ++g) {
            const int pos0 = c * 64 - 128 + g * 64;
            if (pos0 >= 0) {
                const bf16_t* vp = pj.bv + (size_t)(b * NS + pos0) * 128 + kvh * 64 + lane;
#pragma unroll 4
                for (int j = 0; j < 64; ++j) acc += __shfl(e[g], j) * bf2f(vp[(size_t)j * 128]);
            }
        }
        BR[(size_t)tok * 1536 + 512 + hq * 64 + lane] = f2bf(acc * iz);
    }
}

__device__ __forceinline__ void ph_attnC_naive(const Params& P_, int l, float* lds) {
    const KA P = ka_get();
    const Proj pj = proj_ptrs(P.ws);
    bf16_t* BR = (bf16_t*)(P.ws + OFF_BR);
    const int tidq = tid_opaque(); const int lane = tidq & 63, wid = tidq >> 6;
    float* btab = lds;
    unsigned* keys = (unsigned*)(lds + 256) + wid * 4480;
    int* sel = (int*)(keys + 4096);
    float* iqs = (float*)(keys + 4096 + 256);
    __syncthreads();
    for (int i = tidq; i < 256; i += 512) btab[i] = P.in[I_RELB][(i >> 3) * 20 + 12 + (i & 7)] * LOG2E;
    __syncthreads();
    for (int tok = blockIdx.x * 8 + wid; tok < NTOK; tok += gridDim.x * 8) {
        const int q = tok & (NS - 1), b = tok >> 12, c = q >> 6, N = (c + 1) * 64, ntile = c + 1;
        iqs[lane] = bf2f(pj.iq[(size_t)tok * 128 + lane]); iqs[64 + lane] = bf2f(pj.iq[(size_t)tok * 128 + 64 + lane]);
        const float4 wv = *(const float4*)(pj.iw + (size_t)tok * 4);
        int cnt;
        if (N <= 256) { for (int i = lane; i < N; i += 64) sel[i] = i; cnt = N; }
        else {
            for (int kt = 0; kt < ntile; ++kt) {
                asm volatile("" ::: "memory");
                const int key = kt * 64 + lane;
                const uint4* kp = (const uint4*)(pj.ik + (size_t)(b * NS + key) * 32);
                const uint4 k0 = kp[0], k1 = kp[1], k2 = kp[2], k3 = kp[3];
                float sc = 0.f;
#pragma unroll
                for (int hh = 0; hh < 4; ++hh) {
                    const float lg = dot8(k0, iqs + hh * 32) + dot8(k1, iqs + hh * 32 + 8) + dot8(k2, iqs + hh * 32 + 16) + dot8(k3, iqs + hh * 32 + 24);
                    const float w = hh == 0 ? wv.x : hh == 1 ? wv.y : hh == 2 ? wv.z : wv.w;
                    sc += fmaxf(lg, 0.f) * w;
                }
                sc += 0.0f;
                const unsigned u = __float_as_uint(sc);
                keys[key] = (u & 0x80000000u) ? ~u : (u | 0x80000000u);
            }
            unsigned T = 0;
            for (int bit = 31; bit >= 0; --bit) {
                const unsigned cand = T | (1u << bit);
                int n = 0;
                for (int kt = 0; kt < ntile; ++kt) n += __popcll(__ballot(keys[kt * 64 + lane] >= cand));
                if (n >= 256) T = cand;
            }
            int ngt = 0;
            for (int kt = 0; kt < ntile; ++kt) ngt += __popcll(__ballot(keys[kt * 64 + lane] > T));
            const int need = 256 - ngt;
            int nsel = 0, neq = 0;
            const unsigned long long ltmask = (1ull << lane) - 1ull;
            for (int kt = 0; kt < ntile; ++kt) {
                const unsigned kv = keys[kt * 64 + lane];
                const unsigned long long eqm = __ballot(kv == T);
                const bool take = (kv > T) || (kv == T && (neq + __popcll(eqm & ltmask)) < need);
                const unsigned long long tm = __ballot(take);
                if (take) sel[nsel + __popcll(tm & ltmask)] = kt * 64 + lane;
                nsel += __popcll(tm); neq += __popcll(eqm);
            }
            cnt = 256;
        }
        int idx[4];
#pragma unroll
        for (int j = 0; j < 4; ++j) idx[j] = (lane + 64 * j < cnt) ? sel[lane + 64 * j] : 0;
        for (int h = 0; h < 8; ++h) {
            iqs[lane] = bf2f(pj.cq[(size_t)tok * 512 + h * 64 + lane]);
            const float* qv = iqs;
            float s[4];
#pragma unroll
            for (int j = 0; j < 4; ++j) {
                asm volatile("" ::: "memory");
                s[j] = -INFINITY;
                if (lane + 64 * j < cnt) {
                    const uint4* kp = (const uint4*)(pj.ck + (size_t)(b * NS + idx[j]) * 64);
                    float a = 0.f;
#pragma unroll
                    for (int d = 0; d < 8; ++d) a += dot8(kp[d], qv + d * 8);
                    s[j] = a + btab[t5_bucket(idx[j] - q) * 8 + h];
                }
            }
            const float m = wmax(fmaxf(fmaxf(s[0], s[1]), fmaxf(s[2], s[3])));
            float e[4];
#pragma unroll
            for (int j = 0; j < 4; ++j) e[j] = exp2f(s[j] - m);
            const float iz = 1.f / wsum(e[0] + e[1] + e[2] + e[3]);
            float acc = 0.f;
#pragma unroll
            for (int j = 0; j < 4; ++j) {
                const int nj = cnt - 64 * j < 64 ? cnt - 64 * j : 64;
#pragma unroll 2
                for (int i = 0; i < nj; ++i) { const float pv = __shfl(e[j], i); const int id = __shfl(idx[j], i); acc += pv * bf2f(pj.cv[(size_t)(b * NS + id) * 64 + lane]); }
            }
            BR[(size_t)tok * 1536 + 1024 + h * 64 + lane] = f2bf(acc * iz);
        }
    }
}

__device__ __forceinline__ void ph_gatebranch_naive(const Params& P_, int l, float* lds) {
    const KA P = ka_get();
    const bf16_t* H = (const bf16_t*)(P.ws + OFF_H);
    const bf16_t* BR = (const bf16_t*)(P.ws + OFF_BR);
    bf16_t* MG = (bf16_t*)(P.ws + OFF_MERGED);
    const float* Wg = P.in[I_WGATE] + (size_t)l * ND * 3072;
    const float* bg = P.in[I_BGATE] + (size_t)l * 3072;
    const float* Wb = P.in[I_WBR] + (size_t)l * 3 * 512 * ND;
    const int tid = tid_opaque(), ty = tid >> 5, tx = tid & 31;
    for (int t = blockIdx.x; t < 256 * 8; t += gridDim.x) {
        const int tm = t >> 3, tn = t & 7;
        float m[8][4];
#pragma unroll
        for (int i = 0; i < 8; ++i)
#pragma unroll
            for (int j = 0; j < 4; ++j) m[i][j] = 0.f;
        for (int n = 0; n < 3; ++n) {
            float g[8][4], y[8][4];
            ngemm_tile(H, ND, Wg, 3072, ND, 3072, tm * 128, n * 1024 + tn * 128, g, lds);
            ngemm_tile(BR + n * 512, 1536, Wb + (size_t)n * 512 * ND, ND, 512, ND, tm * 128, tn * 128, y, lds);
#pragma unroll
            for (int i = 0; i < 8; ++i)
#pragma unroll
                for (int j = 0; j < 4; ++j) { const float z = g[i][j] + bg[n * 1024 + tn * 128 + tx * 4 + j]; m[i][j] += y[i][j] / (1.f + expf(-z)); }
        }
#pragma unroll
        for (int i = 0; i < 8; ++i) {
            uint2 o; o.x = pack2(m[i][0], m[i][1]); o.y = pack2(m[i][2], m[i][3]);
            *(uint2*)(MG + (size_t)(tm * 128 + ty * 8 + i) * ND + tn * 128 + tx * 4) = o;
        }
    }
}
__device__ __forceinline__ void ph_out_naive(const Params& P_, int l, float* lds) {
    const KA P = ka_get();
    const bf16_t* MG = (const bf16_t*)(P.ws + OFF_MERGED);
    const float* W = P.in[I_WOUT] + (size_t)l * ND * ND;
    const float* xsrc = l == 0 ? P.in[I_X] : P.out;
    const int tid = tid_opaque(), ty = tid >> 5, tx = tid & 31;
    for (int t = blockIdx.x; t < 256 * 8; t += gridDim.x) {
        const int tm = t >> 3, tn = t & 7;
        float acc[8][4];
        ngemm_tile(MG, ND, W, ND, ND, ND, tm * 128, tn * 128, acc, lds);
#pragma unroll
        for (int i = 0; i < 8; ++i) {
            const size_t o = (size_t)(tm * 128 + ty * 8 + i) * ND + tn * 128 + tx * 4;
            const float4 xv = *(const float4*)(xsrc + o);
            *(float4*)(P.out + o) = make_float4(xv.x + acc[i][0], xv.y + acc[i][1], xv.z + acc[i][2], xv.w + acc[i][3]);
        }
    }
}

__device__ __forceinline__ void ph_norm2_route(const Params& P_, int l, float* lds_) {
    const KA P = ka_get();
    bf16_t* H = (bf16_t*)(P.ws + OFF_H);
    int* eid = (int*)(P.ws + OFF_ROUTE); float* ew = (float*)(P.ws + OFF_ROUTE + 256 * 1024);
    const float* g = P.in[I_NFG] + (size_t)l * ND;
    const float* wrg = P.in[I_WRG] + (size_t)l * ND * 4; const float* brg = P.in[I_BRG] + (size_t)l * 4;
    const float* wre = P.in[I_WRE] + (size_t)l * ND * 16; const float* bre = P.in[I_BRE] + (size_t)l * 16;
    const int tidq = tid_opaque(); const int lane = tidq & 63, wid = tidq >> 6;
    typedef float v4f __attribute__((ext_vector_type(4)));
    LAS v4f* wl = (LAS v4f*)lds_;
    __syncthreads();
    for (int idx = tidq; idx < 5120; idx += 512) {
        const int ln = idx & 63, t = idx >> 6, q = t % 5, je = t / 5, k = ((je >> 2) * 64 + ln) * 4 + (je & 3);
        wl[idx] = q == 0 ? *(const v4f*)(wrg + (size_t)k * 4) : *(const v4f*)(wre + (size_t)k * 16 + (q - 1) * 4);
    }
    __syncthreads();
    for (int row0 = (blockIdx.x * 8 + wid) * 2; row0 < NTOK; row0 += gridDim.x * 16) {
        float4 v[2][4]; float rstd[2];
#pragma unroll
        for (int r = 0; r < 2; ++r) { const uint2* xp = (const uint2*)((const bf16_t*)(P.ws + OFF_STREAM) + (size_t)(row0 + r) * ND);
#pragma unroll
            for (int j = 0; j < 4; ++j) { const uint2 w = xp[j * 64 + lane]; v[r][j] = make_float4(bflo(w.x), bfhi(w.x), bflo(w.y), bfhi(w.y)); } }
#pragma unroll
        for (int r = 0; r < 2; ++r) { float ss = 0.f;
#pragma unroll
            for (int j = 0; j < 4; ++j) ss += v[r][j].x * v[r][j].x + v[r][j].y * v[r][j].y + v[r][j].z * v[r][j].z + v[r][j].w * v[r][j].w;
            rstd[r] = rsqrtf(wsum_dpp(ss) * (1.0f / ND) + EPS); }
        float lg[2][20];
#pragma unroll
        for (int r = 0; r < 2; ++r)
#pragma unroll
            for (int i = 0; i < 20; ++i) lg[r][i] = 0.f;
#pragma unroll
        for (int j = 0; j < 4; ++j) {
            const int k0 = (j * 64 + lane) * 4;
            const float4 gv = ((const float4*)g)[j * 64 + lane];
            float hv[2][4];
#pragma unroll
            for (int r = 0; r < 2; ++r) {
                hv[r][0] = v[r][j].x * rstd[r] * gv.x; hv[r][1] = v[r][j].y * rstd[r] * gv.y; hv[r][2] = v[r][j].z * rstd[r] * gv.z; hv[r][3] = v[r][j].w * rstd[r] * gv.w;
                uint2 o; o.x = pack2hw(hv[r][0], hv[r][1]); o.y = pack2hw(hv[r][2], hv[r][3]);
                *(uint2*)(H + (size_t)(row0 + r) * ND + k0) = o;
            }
#pragma unroll
            for (int e = 0; e < 4; ++e) {
                const LAS v4f* wp = wl + ((j * 4 + e) * 5) * 64 + lane;
                const v4f wg4 = wp[0], w0 = wp[64], w1 = wp[128], w2 = wp[192], w3 = wp[256];
#pragma unroll
                for (int r = 0; r < 2; ++r) {
                    const float x = hv[r][e];
                    lg[r][0] += x * wg4.x; lg[r][1] += x * wg4.y; lg[r][2] += x * wg4.z; lg[r][3] += x * wg4.w;
                    lg[r][4] += x * w0.x; lg[r][5] += x * w0.y; lg[r][6] += x * w0.z; lg[r][7] += x * w0.w;
                    lg[r][8] += x * w1.x; lg[r][9] += x * w1.y; lg[r][10] += x * w1.z; lg[r][11] += x * w1.w;
                    lg[r][12] += x * w2.x; lg[r][13] += x * w2.y; lg[r][14] += x * w2.z; lg[r][15] += x * w2.w;
                    lg[r][16] += x * w3.x; lg[r][17] += x * w3.y; lg[r][18] += x * w3.z; lg[r][19] += x * w3.w;
                }
            }
            asm volatile("" ::: "memory");
        }
#pragma unroll
        for (int r = 0; r < 2; ++r)
#pragma unroll
            for (int i = 0; i < 20; ++i) lg[r][i] = wsum_dpp(lg[r][i]);
        if (lane < 2) {
            const int row = row0 + lane;
            float lgl[20];
#pragma unroll
            for (int i = 0; i < 20; ++i) lgl[i] = lane == 0 ? lg[0][i] : lg[1][i];
            float gl[4];
#pragma unroll
            for (int i = 0; i < 4; ++i) gl[i] = lgl[i] + brg[i];
            int gs = 0; float gm = gl[0];
#pragma unroll
            for (int i = 1; i < 4; ++i) if (gl[i] > gm) { gm = gl[i]; gs = i; }
            float zs = 0.f;
#pragma unroll
            for (int i = 0; i < 4; ++i) zs += expf(gl[i] - gm);
            const float pgroup = 1.f / zs;
            float el[4];
#pragma unroll
            for (int i = 0; i < 4; ++i) { el[i] = 0.f;
#pragma unroll
                for (int gq = 0; gq < 4; ++gq) if (gq == gs) el[i] = lgl[4 + gq * 4 + i] + bre[gq * 4 + i]; }
            int e1 = 0; float v1 = el[0];
#pragma unroll
            for (int i = 1; i < 4; ++i) if (el[i] > v1) { v1 = el[i]; e1 = i; }
            int e2 = -1; float v2 = -INFINITY;
#pragma unroll
            for (int i = 0; i < 4; ++i) if (i != e1 && el[i] > v2) { v2 = el[i]; e2 = i; }
            const float x2 = expf(v2 - v1), w1 = 1.f / (1.f + x2), w2 = x2 / (1.f + x2);
            eid[row * 2] = gs * 4 + e1; eid[row * 2 + 1] = gs * 4 + e2;
            ew[row * 2] = w1 * pgroup; ew[row * 2 + 1] = w2 * pgroup;
            const int lo = e1 < e2 ? e1 : e2, hi = e1 < e2 ? e2 : e1;
            const int bk = gs * 6 + (lo == 0 ? hi - 1 : (lo == 1 ? hi + 1 : 5));
            const int pos = atomicAdd((int*)(P.ws + OFF_CTRL + MOE_CNT_OFF) + l * 32 + bk, 1);
            ((int*)(P.ws + OFF_ROUTE + MOE_LIST_OFF))[bk * NTOK + pos] = row;
            float* rw = (float*)(P.ws + OFF_ROUTE + MOE_RW_OFF);
            rw[row * 2] = (e1 < e2 ? w1 : w2) * pgroup; rw[row * 2 + 1] = (e1 < e2 ? w2 : w1) * pgroup;
        }
    }
}

__device__ __forceinline__ void ph_moe_naive(const Params& P_, int l, float* lds) {
    const KA P = ka_get();
    const bf16_t* H = (const bf16_t*)(P.ws + OFF_H);
    const int* eid = (const int*)(P.ws + OFF_ROUTE); const float* ew = (const float*)(P.ws + OFF_ROUTE + 256 * 1024);
    const int tidq = tid_opaque(); const int lane = tidq & 63, wid = tidq >> 6;
    float* hs = lds + wid * 1280;
    float* hid = hs + 1024;
    for (int tok = blockIdx.x * 8 + wid; tok < NTOK; tok += gridDim.x * 8) {
#pragma unroll
        for (int j = 0; j < 4; ++j) { const uint2 w = *(const uint2*)(H + (size_t)tok * ND + (j * 64 + lane) * 4); float* d = hs + (j * 64 + lane) * 4; d[0] = bflo(w.x); d[1] = bfhi(w.x); d[2] = bflo(w.y); d[3] = bfhi(w.y); }
        float o[16];
#pragma unroll
        for (int i = 0; i < 16; ++i) o[i] = 0.f;
        for (int s = 0; s < 2; ++s) {
            const int e = eid[tok * 2 + s]; const float w = ew[tok * 2 + s];
            const float* wg = P.in[I_WFG] + ((size_t)l * 16 + e) * ND * 256;
            const float* wu = P.in[I_WFU] + ((size_t)l * 16 + e) * ND * 256;
            const float* wd = P.in[I_WFD] + ((size_t)l * 16 + e) * 256 * ND;
            float4 ga = make_float4(0.f, 0.f, 0.f, 0.f), ua = ga;
            for (int k = 0; k < ND; ++k) {
                const float hv = hs[k];
                const float4 a = *(const float4*)(wg + (size_t)k * 256 + lane * 4), u = *(const float4*)(wu + (size_t)k * 256 + lane * 4);
                ga.x += hv * a.x; ga.y += hv * a.y; ga.z += hv * a.z; ga.w += hv * a.w; ua.x += hv * u.x; ua.y += hv * u.y; ua.z += hv * u.z; ua.w += hv * u.w;
            }
            float4 hv4;
            hv4.x = ga.x / (1.f + expf(-ga.x)) * ua.x * w; hv4.y = ga.y / (1.f + expf(-ga.y)) * ua.y * w; hv4.z = ga.z / (1.f + expf(-ga.z)) * ua.z * w; hv4.w = ga.w / (1.f + expf(-ga.w)) * ua.w * w;
            *(float4*)(hid + lane * 4) = hv4;
            for (int f = 0; f < 256; ++f) {
                const float hf = hid[f];
#pragma unroll
                for (int j = 0; j < 4; ++j) { const float4 d = *(const float4*)(wd + (size_t)f * ND + (j * 64 + lane) * 4); o[j * 4] += hf * d.x; o[j * 4 + 1] += hf * d.y; o[j * 4 + 2] += hf * d.z; o[j * 4 + 3] += hf * d.w; }
            }
        }
#pragma unroll
        for (int j = 0; j < 4; ++j) {
            float4* op = (float4*)(P.out + (size_t)tok * ND + (j * 64 + lane) * 4);
            float4 x = *op; x.x += o[j * 4]; x.y += o[j * 4 + 1]; x.z += o[j * 4 + 2]; x.w += o[j * 4 + 3]; *op = x;
        }
    }
}


namespace mm {
typedef short bf16x8 __attribute__((ext_vector_type(8)));
typedef float f32x16 __attribute__((ext_vector_type(16)));
typedef float f32x4 __attribute__((ext_vector_type(4)));
typedef unsigned u32x4 __attribute__((ext_vector_type(4)));
constexpr int OPB = 256 * 128;
constexpr int STG = 2 * OPB;
constexpr int LDS_NEED = 2 * STG;
__host__ __device__ __forceinline__ int img_col(int rho) { const int i = rho & 31; return (rho & ~31) + 16 * ((i >> 2) & 1) + 4 * (i >> 3) + (i & 3); }
__device__ __forceinline__ unsigned cvt_pk_bf16(float lo, float hi) { unsigned r; asm volatile("v_cvt_pk_bf16_f32 %0, %1, %2" : "=v"(r) : "v"(lo), "v"(hi)); return r; }
__device__ __forceinline__ u32x4 pack8(const f32x16& v, int o) { u32x4 w; w.x = cvt_pk_bf16(v[o], v[o + 1]); w.y = cvt_pk_bf16(v[o + 2], v[o + 3]); w.z = cvt_pk_bf16(v[o + 4], v[o + 5]); w.w = cvt_pk_bf16(v[o + 6], v[o + 7]); return w; }

struct Unit {
    const char* a;
    const char* b0;
    const char* b1;
    int lda, ldb;
    int nk, nseg;
    int pm, pn, tag;
    int aux0, aux1;
};
__device__ __forceinline__ bool static_tile(long L, int nM, int nN, int& pm, int& pn) {
    const int nwg = nM * nN; if (L >= nwg) return false;
    int wgid = (int)L; { const int q = nwg / 8, r = nwg % 8, xcd = wgid % 8, off = wgid / 8; wgid = (xcd < r ? xcd * (q + 1) : r * (q + 1) + (xcd - r) * q) + off; }
    const int nig = 8 * nN, gid = wgid / nig, fm = gid * 8, gsz = (nM - fm) < 8 ? (nM - fm) : 8;
    pm = fm + ((wgid % nig) % gsz); pn = (wgid % nig) / gsz; return true;
}

template <class Epi, class Sched>
__device__ __forceinline__ void gemm_phase(char* smem, const Sched& S, const Epi& E) {
    const int tid = tid_opaque(), lane = tid & 63, wid = __builtin_amdgcn_readfirstlane(tid >> 6), wm = wid >> 2, wn = wid & 3, r32 = lane & 31, h = lane >> 5;
    LAS char* lds = (LAS char*)smem;
    const int srow = tid >> 3, sc = tid & 7;
    const unsigned sts = (unsigned)(srow * 128 + ((sc ^ ((srow >> 1) & 7)) << 4));
    const unsigned rda = (unsigned)((wm * 128 + r32) * 128), rdb = (unsigned)(OPB + (wn * 64 + r32) * 128);
    const unsigned x7 = (unsigned)((r32 >> 1) & 7);
    Unit lu; int ci = 0, li = 0;
    if (!S.next(0, lu)) return;
    int cnk = lu.nk;
    constexpr int NA = Sched::GATHER ? 4 : 1;
    unsigned ao[NA], bo;
    auto offs = [&](const Unit& u, unsigned (&a)[NA], unsigned& b) {
        int t2 = tid; asm volatile("" : "+v"(t2));
        const int r0 = t2 >> 3, c16 = (t2 & 7) * 16;
        S.a_rows(u, r0, a);
#pragma unroll
        for (int q = 0; q < NA; ++q) a[q] += (unsigned)c16;
        b = (unsigned)(r0 * u.ldb * 2 + c16);
    };
    offs(lu, ao, bo);
    f32x16 acc[4][2];
#pragma unroll
    for (int i = 0; i < 4; ++i)
#pragma unroll
        for (int j = 0; j < 2; ++j)
#pragma unroll
            for (int e = 0; e < 16; ++e) acc[i][j][e] = 0.f;
    u32x4 ga[4], gb[4];
#define MM_GLOAD(u, k, A_, B_) do { \
        const __amdgpu_buffer_rsrc_t ra_ = __builtin_amdgcn_make_buffer_rsrc((void*)(u).a, 0, 0x7fffffff, 0x00020000); \
        const __amdgpu_buffer_rsrc_t rb_ = __builtin_amdgcn_make_buffer_rsrc((void*)((k) < (u).nseg ? (u).b0 : (u).b1), 0, 0x7fffffff, 0x00020000); \
        const unsigned ko_ = (unsigned)(k) * 128u, as_ = (unsigned)(u).lda * 128u, bs_ = (unsigned)(u).ldb * 128u; \
        _Pragma("unroll") for (int q_ = 0; q_ < 4; ++q_) { \
            ga[q_] = __builtin_bit_cast(u32x4, __builtin_amdgcn_raw_buffer_load_b128(ra_, Sched::GATHER ? (A_)[q_ % NA] : (A_)[0], Sched::GATHER ? ko_ : ko_ + q_ * as_, 0)); \
            gb[q_] = __builtin_bit_cast(u32x4, __builtin_amdgcn_raw_buffer_load_b128(rb_, (B_), ko_ + q_ * bs_, 0)); } } while (0)
#define MM_LSTORE(buf) do { LAS char* p_ = lds + (buf) * STG + sts; \
        _Pragma("unroll") for (int q_ = 0; q_ < 4; ++q_) { *(LAS u32x4*)(p_ + q_ * 8192) = ga[q_]; *(LAS u32x4*)(p_ + OPB + q_ * 8192) = gb[q_]; } } while (0)
#define MM_LOADF(ks, AF, BF) do { const unsigned xo_ = (((unsigned)((ks) * 2 + h)) ^ x7) << 4; \
        _Pragma("unroll") for (int nt = 0; nt < 2; ++nt) BF[nt] = *(const LAS bf16x8*)(base + rdb + nt * 4096 + xo_); \
        _Pragma("unroll") for (int mt = 0; mt < 4; ++mt) AF[mt] = *(const LAS bf16x8*)(base + rda + mt * 4096 + xo_); } while (0)
#define MM_MMA(AF, BF) do { _Pragma("unroll") for (int mt = 0; mt < 4; ++mt) _Pragma("unroll") for (int nt = 0; nt < 2; ++nt) \
        acc[mt][nt] = Epi::TRANSP ? __builtin_amdgcn_mfma_f32_32x32x16_bf16(BF[nt], AF[mt], acc[mt][nt], 0, 0, 0) : __builtin_amdgcn_mfma_f32_32x32x16_bf16(AF[mt], BF[nt], acc[mt][nt], 0, 0, 0); } while (0)
#define MM_SB __builtin_amdgcn_sched_barrier(0)
    bool lvalid = true; int lk = 0;
    auto ladv = [&]() {
        if (++lk < lu.nk) return;
        lk = 0;
        Unit nu; if (S.next(li + 1, nu)) { lu = nu; ++li; offs(lu, ao, bo); } else lvalid = false;
    };
    MM_GLOAD(lu, 0, ao, bo);
    MM_LSTORE(0);
    ladv();
    if (lvalid) MM_GLOAD(lu, lk, ao, bo);
    __syncthreads();
    int buf = 0, ck = 0;
    for (;;) {
        const LAS char* base = lds + buf * STG;
        const bool pend = lvalid;
        if constexpr (Sched::PIPE) {
            bf16x8 af0[4], bf0[2], af1[4], bf1[2];
            MM_LOADF(0, af0, bf0); MM_SB;
            MM_LOADF(1, af1, bf1); MM_SB; MM_MMA(af0, bf0); MM_SB;
            MM_LOADF(2, af0, bf0); MM_SB; MM_MMA(af1, bf1); MM_SB;
            MM_LOADF(3, af1, bf1); MM_SB;
            if (pend) { MM_LSTORE(buf ^ 1); ladv(); if (lvalid) MM_GLOAD(lu, lk, ao, bo); }
            MM_SB; MM_MMA(af0, bf0); MM_SB; MM_MMA(af1, bf1); MM_SB;
        } else {
            bf16x8 af0[4], bf0[2];
            MM_LOADF(0, af0, bf0); MM_MMA(af0, bf0); MM_SB;
            MM_LOADF(1, af0, bf0); MM_MMA(af0, bf0); MM_SB;
            if (pend) { MM_LSTORE(buf ^ 1); ladv(); if (lvalid) MM_GLOAD(lu, lk, ao, bo); }
            MM_SB; MM_LOADF(2, af0, bf0); MM_MMA(af0, bf0); MM_SB;
            MM_LOADF(3, af0, bf0); MM_MMA(af0, bf0); MM_SB;
        }
        bool more = true;
        if (++ck == cnk) {
            { PROF_BEGIN(99) Unit eu; S.next(ci, eu); E(acc, eu, wm, wn, r32, h, tid); if (PROF_ID == Epi::PROF && threadIdx.x == 0) { *(volatile LAS unsigned*)(lds + PROF_LDS_OFF) += (unsigned)(__builtin_amdgcn_s_memrealtime() - _pt99); } }
#pragma unroll
            for (int i = 0; i < 4; ++i)
#pragma unroll
                for (int j = 0; j < 2; ++j)
#pragma unroll
                    for (int e = 0; e < 16; ++e) acc[i][j][e] = 0.f;
            ck = 0; ++ci;
            { Unit nu2; more = S.next(ci, nu2); if (more) cnk = nu2.nk; }
        }
        __syncthreads();
        buf ^= 1;
        if (!more) break;
    }
#undef MM_GLOAD
#undef MM_LSTORE
#undef MM_LOADF
#undef MM_MMA
#undef MM_SB
}
__device__ __forceinline__ void plain_rows(const Unit& u, int r0, unsigned (&a)[1]) { a[0] = (unsigned)(r0 * u.lda * 2); }
}

constexpr int EPI_TAB = 131072 + 2048;
constexpr size_t WT_IN = 0;
constexpr size_t WT_GATE = WT_IN + (size_t)3328 * 1024 * 2;
constexpr size_t WT_BR = WT_GATE + (size_t)3072 * 1024 * 2;
constexpr size_t WT_OUT = WT_BR + (size_t)3 * 1024 * 512 * 2;
constexpr size_t WT_GU = WT_OUT + (size_t)1024 * 1024 * 2;
constexpr size_t WT_DN = WT_GU + (size_t)16 * 512 * 1024 * 2;
constexpr size_t WT_END = WT_DN + (size_t)16 * 1024 * 256 * 2;
static_assert(WT_END <= 44 * MB, "weight image region");

template <class F>
__device__ __forceinline__ void cvt_tile(bf16_t* Bt, int K, int rho0, int k0, const float* W, int ldw, const F& colof, int tid) {
    const int rho = rho0 + (tid & 63) * 4, kg = k0 + (tid >> 6) * 16;
    const int c = colof(rho);
    float4 v[16];
#pragma unroll
    for (int j = 0; j < 16; ++j) v[j] = c >= 0 ? *(const float4*)(W + (size_t)(kg + j) * ldw + c) : make_float4(0.f, 0.f, 0.f, 0.f);
#pragma unroll
    for (int hf = 0; hf < 2; ++hf) {
        mm::u32x4 o;
        o.x = mm::cvt_pk_bf16(v[8 * hf + 0].x, v[8 * hf + 1].x); o.y = mm::cvt_pk_bf16(v[8 * hf + 2].x, v[8 * hf + 3].x); o.z = mm::cvt_pk_bf16(v[8 * hf + 4].x, v[8 * hf + 5].x); o.w = mm::cvt_pk_bf16(v[8 * hf + 6].x, v[8 * hf + 7].x); *(mm::u32x4*)(Bt + (size_t)(rho + 0) * K + kg + 8 * hf) = o;
        o.x = mm::cvt_pk_bf16(v[8 * hf + 0].y, v[8 * hf + 1].y); o.y = mm::cvt_pk_bf16(v[8 * hf + 2].y, v[8 * hf + 3].y); o.z = mm::cvt_pk_bf16(v[8 * hf + 4].y, v[8 * hf + 5].y); o.w = mm::cvt_pk_bf16(v[8 * hf + 6].y, v[8 * hf + 7].y); *(mm::u32x4*)(Bt + (size_t)(rho + 1) * K + kg + 8 * hf) = o;
        o.x = mm::cvt_pk_bf16(v[8 * hf + 0].z, v[8 * hf + 1].z); o.y = mm::cvt_pk_bf16(v[8 * hf + 2].z, v[8 * hf + 3].z); o.z = mm::cvt_pk_bf16(v[8 * hf + 4].z, v[8 * hf + 5].z); o.w = mm::cvt_pk_bf16(v[8 * hf + 6].z, v[8 * hf + 7].z); *(mm::u32x4*)(Bt + (size_t)(rho + 2) * K + kg + 8 * hf) = o;
        o.x = mm::cvt_pk_bf16(v[8 * hf + 0].w, v[8 * hf + 1].w); o.y = mm::cvt_pk_bf16(v[8 * hf + 2].w, v[8 * hf + 3].w); o.z = mm::cvt_pk_bf16(v[8 * hf + 4].w, v[8 * hf + 5].w); o.w = mm::cvt_pk_bf16(v[8 * hf + 6].w, v[8 * hf + 7].w); *(mm::u32x4*)(Bt + (size_t)(rho + 3) * K + kg + 8 * hf) = o;
    }
}
__device__ __forceinline__ void cvt_tile_pair(bf16_t* Bt, int K, int rho0, int k0, const float* W, int ldw, int tid) {
    const int rho = rho0 + (tid & 63) * 4, kg = k0 + (tid >> 6) * 16;
    const int nt = (rho >> 5) & 1, cb = (rho & ~63) + 2 * (rho & 31);
#pragma unroll
    for (int hf = 0; hf < 2; ++hf) {
        float va[8][4];
#pragma unroll
        for (int j = 0; j < 8; ++j) {
            const float4 lo = *(const float4*)(W + (size_t)(kg + 8 * hf + j) * ldw + cb), hi = *(const float4*)(W + (size_t)(kg + 8 * hf + j) * ldw + cb + 4);
            va[j][0] = nt ? lo.y : lo.x; va[j][1] = nt ? lo.w : lo.z; va[j][2] = nt ? hi.y : hi.x; va[j][3] = nt ? hi.w : hi.z;
        }
#pragma unroll
        for (int r = 0; r < 4; ++r) {
            mm::u32x4 o;
            o.x = mm::cvt_pk_bf16(va[0][r], va[1][r]); o.y = mm::cvt_pk_bf16(va[2][r], va[3][r]); o.z = mm::cvt_pk_bf16(va[4][r], va[5][r]); o.w = mm::cvt_pk_bf16(va[6][r], va[7][r]);
            *(mm::u32x4*)(Bt + (size_t)(rho + r) * K + kg + 8 * hf) = o;
        }
    }
}
__device__ __forceinline__ void ph_convert_weights(const Params& P_, int l) {
    const KA P = ka_get();
    const int tid = tid_opaque();
    char* wt = P.ws + OFF_WT;
    constexpr int T_IN = 13 * 8, T_GATE = 12 * 8, T_BR = 3 * 4 * 4, T_OUT = 4 * 8, T_GU = 16 * 2 * 8, T_DN = 16 * 4 * 2;
    constexpr int T_ALL = T_IN + T_GATE + T_BR + T_OUT + T_GU + T_DN;
    for (int t = blockIdx.x; t < T_ALL; t += gridDim.x) {
        int u = t;
        if (u < T_IN) {
            const float* W = P.in[I_WIN] + (size_t)l * ND * IN_COLS;
            cvt_tile((bf16_t*)(wt + WT_IN), 1024, (u >> 3) * 256, (u & 7) * 128, W, IN_COLS, [&](int rho) -> int { const int c = mm::img_col(rho); return c < IN_COLS ? c : -1; }, tid);
            continue;
        }
        u -= T_IN;
        if (u < T_GATE) {
            const float* W = P.in[I_WGATE] + (size_t)l * ND * 3072;
            cvt_tile((bf16_t*)(wt + WT_GATE), 1024, (u >> 3) * 256, (u & 7) * 128, W, 3072, [&](int rho) -> int { return mm::img_col(rho); }, tid);
            continue;
        }
        u -= T_GATE;
        if (u < T_BR) {
            const int n = u / 16, v = u % 16;
            const float* W = P.in[I_WBR] + ((size_t)l * 3 + n) * 512 * ND;
            cvt_tile((bf16_t*)(wt + WT_BR) + (size_t)n * 1024 * 512, 512, (v >> 2) * 256, (v & 3) * 128, W, ND, [&](int rho) -> int { return mm::img_col(rho); }, tid);
            continue;
        }
        u -= T_BR;
        if (u < T_OUT) {
            const float* W = P.in[I_WOUT] + (size_t)l * ND * ND;
            cvt_tile_pair((bf16_t*)(wt + WT_OUT), 1024, (u >> 3) * 256, (u & 7) * 128, W, ND, tid);
            continue;
        }
        u -= T_OUT;
        if (u < T_GU) {
            const int e = u / 16, v = u % 16;
            const float* Wg = P.in[I_WFG] + ((size_t)l * 16 + e) * ND * 256;
            const float* Wu = P.in[I_WFU] + ((size_t)l * 16 + e) * ND * 256;
            const int rho0 = (v >> 3) * 256;
            const float* Wsel = (((rho0 + (tid & 63) * 4) >> 5) & 1) ? Wu : Wg;
            cvt_tile((bf16_t*)(wt + WT_GU) + (size_t)e * 512 * 1024, 1024, rho0, (v & 7) * 128, Wsel, 256, [&](int rho) -> int {
                const int j = rho >> 8, wn = (rho >> 6) & 3; return j * 128 + wn * 32 + (mm::img_col(rho) & 31); }, tid);
            continue;
        }
        u -= T_GU;
        {
            const int e = u / 8, v = u % 8;
            const float* W = P.in[I_WFD] + ((size_t)l * 16 + e) * 256 * ND;
            cvt_tile_pair((bf16_t*)(wt + WT_DN) + (size_t)e * 1024 * 256, 256, (v >> 1) * 256, (v & 1) * 128, W, ND, tid);
        }
    }
}

struct SchedInProj {
    const char* A; const char* B; int mode;
    __device__ __forceinline__ bool next(int i, mm::Unit& u) const {
        int pm, pn; if (!mm::static_tile((long)i * gridDim.x + VBID, 128, 13, pm, pn)) return false;
        u.a = A + (size_t)pm * 256 * 1024 * 2; u.b0 = B + (size_t)pn * 256 * 1024 * 2; u.b1 = u.b0; u.lda = 1024; u.ldb = 1024; u.nk = 16; u.nseg = 16; u.pm = pm; u.pn = pn; u.tag = mode; return true;
    }
    static constexpr bool GATHER = false, PIPE = true;
    __device__ __forceinline__ void a_rows(const mm::Unit& u, int r0, unsigned (&a)[1]) const { mm::plain_rows(u, r0, a); }
};
struct EpiInProj {
    static constexpr bool TRANSP = true;
    static constexpr int PROF = 2;
    Proj pj; const float* qkg; const LAS float* gtab;
    __device__ __forceinline__ void operator()(mm::f32x16 (&acc)[4][2], const mm::Unit& u, int wm, int wn, int r32, int h, int tid) const {
        using namespace mm;
        asm volatile("" : "+v"(r32), "+v"(h));
        const int G = u.pn * 4 + wn;
        if (u.tag == 4) { if (acc[0][0][0] == 12345.678f) pj.aq[0] = 0; return; }
        if (u.tag == 3) { float t_ = 0.f;
#pragma unroll
            for (int i_ = 0; i_ < 4; ++i_) { t_ += acc[i_][0][3] + acc[i_][1][11] + acc[i_][0][7] + acc[i_][1][0]; }
            if (t_ == 12345.678f) pj.aq[0] = 0; return; }
        if (G > 48) return;
        bf16_t* dst; int tstride; const float* gv = nullptr; float sc = 1.f;
        if (G < 8) { dst = pj.aq + G * 64; tstride = 512; gv = qkg; sc = QSCALE; }
        else if (G < 16) { dst = pj.ak + (G - 8) * 64; tstride = 512; gv = qkg + 64; }
        else if (G < 24) { dst = pj.av + (G - 16) * 64; tstride = 512; }
        else if (G < 32) { dst = pj.bq + (G - 24) * 64; tstride = 512; gv = qkg + 128; sc = QSCALE; }
        else if (G < 34) { dst = pj.bk + (G - 32) * 64; tstride = 128; gv = qkg + 192; }
        else if (G < 36) { dst = pj.bv + (G - 34) * 64; tstride = 128; }
        else if (G < 44) { dst = pj.cq + (G - 36) * 64; tstride = 512; gv = qkg + 256; sc = QSCALE; }
        else if (G == 44) { dst = pj.ck; tstride = 64; gv = qkg + 320; }
        else if (G == 45) { dst = pj.cv; tstride = 64; }
        else if (G < 48) { dst = pj.iq + (G - 46) * 64; tstride = 128; }
        else { dst = pj.ik; tstride = 32; }
        if (u.tag == 8) { if (acc[0][0][0] == 12345.678f) dst[tstride] = 0; return; }
#pragma unroll 1
        for (int rep = 0; rep < (u.tag == 9 ? 4 : 1); ++rep)
#pragma unroll
        for (int mt = 0; mt < 4; ++mt) {
            asm volatile("" ::: "memory");
            const int row = u.pm * 256 + wm * 128 + mt * 32 + r32;
            f32x16& v0 = acc[mt][0]; f32x16& v1 = acc[mt][1];
            if (gv && u.tag != 7 && u.tag != 9) {
                float ss = 0.f;
#pragma unroll
                for (int e = 0; e < 16; ++e) ss += v0[e] * v0[e] + v1[e] * v1[e];
                ss = x32_sum(ss);
                const float rs = rsqrtf(ss * (1.0f / 64) + EPS) * sc;
#pragma unroll
                for (int e4 = 0; e4 < 4; ++e4) {
                    const f32x4 ga = *(const LAS f32x4*)(gtab + (gv - qkg) + 16 * h + 4 * e4), gb = *(const LAS f32x4*)(gtab + (gv - qkg) + 32 + 16 * h + 4 * e4);
#pragma unroll
                    for (int j = 0; j < 4; ++j) { v0[4 * e4 + j] *= rs * ga[j]; v1[4 * e4 + j] *= rs * gb[j]; }
                }
            }
            if (u.tag >= 5) { if (v0[0] + v1[3] + v0[9] + v1[12] == 12345.678f) dst[0] = 0; }
            else if (G < 48) {
                bf16_t* d = dst + (size_t)row * tstride + 16 * h;
                *(u32x4*)(d) = pack8(v0, 0); *(u32x4*)(d + 8) = pack8(v0, 8);
                *(u32x4*)(d + 32) = pack8(v1, 0); *(u32x4*)(d + 40) = pack8(v1, 8);
            } else {
                bf16_t* d = dst + (size_t)row * 32 + 16 * h;
                *(u32x4*)(d) = pack8(v0, 0); *(u32x4*)(d + 8) = pack8(v0, 8);
                if (h == 0) *(f32x4*)(pj.iw + (size_t)row * 4) = (f32x4){v1[0], v1[1], v1[2], v1[3]} * IWSCALE;
            }
        }
    }
};
__device__ __forceinline__ void ph_inproj(const Params& P_, int l, char* smem) {
    const KA P = ka_get();
    SchedInProj S; S.A = P.ws + OFF_H; S.B = P.ws + OFF_WT + WT_IN; S.mode = l >> 4;
    EpiInProj E; E.pj = proj_ptrs(P.ws); E.qkg = P.in[I_QKG] + (size_t)(l & 15) * 384;
    { LAS float* gt = (LAS float*)((LAS char*)smem + EPI_TAB); __syncthreads(); const int t = tid_opaque(); if (t < 384) gt[t] = E.qkg[t]; __syncthreads(); E.gtab = gt; }
    mm::gemm_phase(smem, S, E);
}

constexpr size_t SCR_G = OFF_PROJ;
constexpr size_t SCR_M = OFF_PROJ + 32 * MB;
struct SchedGB {
    const char* H; const char* BR; const char* Wg; const char* Wb;
    __device__ __forceinline__ bool next(int i, mm::Unit& u) const {
        const int ti = i / 6, sub = i - ti * 6, n = sub >> 1;
        int pm, pn; if (!mm::static_tile((long)ti * gridDim.x + VBID, 128, 4, pm, pn)) return false;
        u.pm = pm; u.pn = pn; u.tag = sub;
        if ((sub & 1) == 0) { u.a = H + (size_t)pm * 256 * 1024 * 2; u.lda = 1024; u.b0 = Wg + (size_t)(n * 1024 + pn * 256) * 1024 * 2; u.ldb = 1024; u.nk = 16; }
        else { u.a = BR + ((size_t)pm * 256 * 1536 + n * 512) * 2; u.lda = 1536; u.b0 = Wb + ((size_t)n * 1024 + pn * 256) * 512 * 2; u.ldb = 512; u.nk = 8; }
        u.b1 = u.b0; u.nseg = u.nk; return true;
    }
    static constexpr bool GATHER = false, PIPE = true;
    __device__ __forceinline__ void a_rows(const mm::Unit& u, int r0, unsigned (&a)[1]) const { mm::plain_rows(u, r0, a); }
};
struct EpiGB {
    static constexpr bool TRANSP = true;
    static constexpr int PROF = 4;
    const LAS float* btab; bf16_t* MG; char* scrg; char* scrm;
    __device__ __forceinline__ void operator()(mm::f32x16 (&acc)[4][2], const mm::Unit& u, int wm, int wn, int r32, int h, int tid) const {
        using namespace mm;
        asm volatile("" : "+v"(r32), "+v"(h), "+v"(tid));
        const int sub = u.tag, n = sub >> 1;
        const unsigned so0 = (unsigned)tid * 16u;
        if ((sub & 1) == 0) {
#pragma unroll
            for (int mt = 0; mt < 4; ++mt)
#pragma unroll
                for (int nt = 0; nt < 2; ++nt) {
                    f32x16& v = acc[mt][nt];
                    const int col = n * 1024 + u.pn * 256 + wn * 64 + nt * 32 + 16 * h;
#pragma unroll
                    for (int e4 = 0; e4 < 4; ++e4) { const f32x4 b = *(const LAS f32x4*)(btab + col + 4 * e4);
#pragma unroll
                        for (int j = 0; j < 4; ++j) v[4 * e4 + j] = __builtin_amdgcn_rcpf(1.f + __builtin_amdgcn_exp2f(__builtin_fmaf(v[4 * e4 + j], -LOG2E, b[j]))); }
                    const unsigned so = so0 + (unsigned)((mt * 2 + nt) * 2) * 8192u;
                    *(u32x4*)(scrg + so) = pack8(v, 0); *(u32x4*)(scrg + so + 8192) = pack8(v, 8);
                }
        } else {
#pragma unroll
            for (int hf = 0; hf < 4; ++hf) {
                const int mt = hf;
                {
                    u32x4 gq[2][2];
#pragma unroll
                    for (int c = 0; c < 2; ++c) { const unsigned so = so0 + (unsigned)((hf * 2 + c) * 2) * 8192u; gq[c][0] = *(const u32x4*)(scrg + so); gq[c][1] = *(const u32x4*)(scrg + so + 8192); }
#pragma unroll
                    for (int c = 0; c < 2; ++c) {
                        f32x16& v = acc[mt][c];
                        const unsigned gw[8] = {gq[c][0].x, gq[c][0].y, gq[c][0].z, gq[c][0].w, gq[c][1].x, gq[c][1].y, gq[c][1].z, gq[c][1].w};
#pragma unroll
                        for (int j = 0; j < 8; ++j) { v[2 * j] *= bflo(gw[j]); v[2 * j + 1] *= bfhi(gw[j]); }
                    }
                }
                if (n > 0) {
                    u32x4 mq[2][2];
#pragma unroll
                    for (int c = 0; c < 2; ++c) { const unsigned so = so0 + (unsigned)((hf * 2 + c) * 2) * 8192u; mq[c][0] = *(const u32x4*)(scrm + so); mq[c][1] = *(const u32x4*)(scrm + so + 8192); }
#pragma unroll
                    for (int c = 0; c < 2; ++c) {
                        f32x16& v = acc[mt][c];
                        const unsigned mw[8] = {mq[c][0].x, mq[c][0].y, mq[c][0].z, mq[c][0].w, mq[c][1].x, mq[c][1].y, mq[c][1].z, mq[c][1].w};
#pragma unroll
                        for (int j = 0; j < 8; ++j) { v[2 * j] += bflo(mw[j]); v[2 * j + 1] += bfhi(mw[j]); }
                    }
                }
#pragma unroll
                for (int c = 0; c < 2; ++c) {
                    f32x16& v = acc[mt][c];
                    const unsigned so = so0 + (unsigned)((hf * 2 + c) * 2) * 8192u;
                    if (n < 2) { *(u32x4*)(scrm + so) = pack8(v, 0); *(u32x4*)(scrm + so + 8192) = pack8(v, 8); }
                    else { bf16_t* d = MG + (size_t)(u.pm * 256 + wm * 128 + mt * 32 + r32) * ND + u.pn * 256 + wn * 64 + c * 32 + 16 * h; *(u32x4*)d = pack8(v, 0); *(u32x4*)(d + 8) = pack8(v, 8); }
                }
            }
        }
    }
};
__device__ __forceinline__ void ph_gatebranch(const Params& P_, int l, char* smem) {
    const KA P = ka_get();
    SchedGB S; S.H = P.ws + OFF_H; S.BR = P.ws + OFF_BR; S.Wg = P.ws + OFF_WT + WT_GATE; S.Wb = P.ws + OFF_WT + WT_BR;
    EpiGB E; E.MG = (bf16_t*)(P.ws + OFF_MERGED);
    { LAS float* bt = (LAS float*)((LAS char*)smem + EPI_TAB); const float* bg = P.in[I_BGATE] + (size_t)l * 3072; __syncthreads(); for (int t = tid_opaque(); t < 3072; t += 512) bt[t] = -bg[t] * LOG2E; __syncthreads(); E.btab = bt; }
    E.scrg = P.ws + SCR_G + (size_t)blockIdx.x * 131072; E.scrm = P.ws + SCR_M + (size_t)blockIdx.x * 131072;
    mm::gemm_phase(smem, S, E);
}

struct SchedOut {
    const char* A; const char* B;
    __device__ __forceinline__ bool next(int i, mm::Unit& u) const {
        int pm, pn; if (!mm::static_tile((long)i * gridDim.x + VBID, 128, 4, pm, pn)) return false;
        u.a = A + (size_t)pm * 256 * 1024 * 2; u.b0 = B + (size_t)pn * 256 * 1024 * 2; u.b1 = u.b0; u.lda = 1024; u.ldb = 1024; u.nk = 16; u.nseg = 16; u.pm = pm; u.pn = pn; u.tag = 0; return true;
    }
    static constexpr bool GATHER = false, PIPE = true;
    __device__ __forceinline__ void a_rows(const mm::Unit& u, int r0, unsigned (&a)[1]) const { mm::plain_rows(u, r0, a); }
};
struct EpiOut {
    static constexpr bool TRANSP = false;
    static constexpr int PROF = 17;
    const float* x32; bf16_t* st;
    __device__ __forceinline__ void operator()(mm::f32x16 (&acc)[4][2], const mm::Unit& u, int wm, int wn, int r32, int h, int tid) const {
        using namespace mm;
        asm volatile("" : "+v"(r32), "+v"(h));
#pragma unroll
        for (int mt = 0; mt < 4; ++mt) {
            asm volatile("" ::: "memory");
            const size_t off = (size_t)(u.pm * 256 + wm * 128 + mt * 32 + 4 * h) * ND + u.pn * 256 + wn * 64 + 2 * r32;
            float xa[16], xb[16];
            if (x32) {
#pragma unroll
                for (int e = 0; e < 16; ++e) { const float2 t = *(const float2*)(x32 + off + (size_t)((e & 3) + 8 * (e >> 2)) * ND); xa[e] = t.x; xb[e] = t.y; }
            } else {
#pragma unroll
                for (int e = 0; e < 16; ++e) { const unsigned w = *(const unsigned*)(st + off + (size_t)((e & 3) + 8 * (e >> 2)) * ND); xa[e] = bflo(w); xb[e] = bfhi(w); }
            }
#pragma unroll
            for (int e = 0; e < 16; ++e) *(unsigned*)(st + off + (size_t)((e & 3) + 8 * (e >> 2)) * ND) = cvt_pk_bf16(xa[e] + acc[mt][0][e], xb[e] + acc[mt][1][e]);
        }
    }
};
__device__ __forceinline__ void ph_outproj(const Params& P_, int l, char* smem) {
    const KA P = ka_get();
    SchedOut S; S.A = P.ws + OFF_MERGED; S.B = P.ws + OFF_WT + WT_OUT;
    EpiOut E; E.x32 = l == 0 ? P.in[I_X] : (const float*)nullptr; E.st = (bf16_t*)(P.ws + OFF_STREAM);
    mm::gemm_phase(smem, S, E);
}


constexpr size_t OFF_HID = OFF_PROJ + 64 * MB;
constexpr int MOE_TAB = 131072 + 1024;
__device__ __forceinline__ void moe_table(char* smem, const int* cnt) {
    int* tab = (int*)(smem + MOE_TAB);
    const int t = tid_opaque();
    __syncthreads();
    if (t < 24) tab[32 + t] = cnt[t];
    __syncthreads();
    if (t == 0) { int p = 0; for (int b = 0; b < 24; ++b) { tab[b] = p; p += (tab[32 + b] + 255) >> 8; } tab[24] = p; }
    __syncthreads();
    if (t < 160) { int b = 0; for (int i = 1; i < 24; ++i) if (tab[i] <= t) b = i; tab[64 + t] = b; }
    __syncthreads();
}
struct MoeLoc { int b, rt, slot, valid, elo, ehi; };
__device__ __forceinline__ int moe_tab(const int* tab, int i) { return __builtin_amdgcn_readfirstlane(tab[i]); }
__device__ __forceinline__ MoeLoc moe_locate(const int* tab, int T) {
    const int b = moe_tab(tab, 64 + T);
    MoeLoc m; m.b = b; m.rt = T - moe_tab(tab, b); m.slot = T * 256; const int c = moe_tab(tab, 32 + b) - m.rt * 256; m.valid = c < 256 ? c : 256;
    const int g = b / 6, ix = b - g * 6; const int lo = ix < 3 ? 0 : (ix < 5 ? 1 : 2), hi = ix < 3 ? ix + 1 : (ix < 5 ? ix - 1 : 3);
    m.elo = g * 4 + lo; m.ehi = g * 4 + hi; return m;
}
struct SchedMoeUp {
    static constexpr bool GATHER = true, PIPE = true;
    const char* H; const char* W; const int* tab; const int* list;
    __device__ __forceinline__ bool next(int i, mm::Unit& u) const {
        const long L = (long)i * gridDim.x + VBID; const int T = (int)(L >> 2), c = (int)(L & 3);
        if (T >= moe_tab(tab, 24)) return false;
        const MoeLoc m = moe_locate(tab, T);
        const int e = (c >> 1) ? m.ehi : m.elo, j = c & 1;
        u.a = H; u.lda = 1024; u.b0 = W + ((size_t)e * 512 + j * 256) * 1024 * 2; u.b1 = u.b0; u.ldb = 1024; u.nk = 16; u.nseg = 16;
        u.pm = T; u.pn = c; u.tag = c; u.aux0 = m.b * NTOK + m.rt * 256; u.aux1 = m.valid; return true;
    }
    __device__ __forceinline__ void a_rows(const mm::Unit& u, int r0, unsigned (&a)[4]) const {
#pragma unroll
        for (int q = 0; q < 4; ++q) { const int r = r0 + 64 * q; const int tok = list[u.aux0 + (r < u.aux1 ? r : 0)]; a[q] = (unsigned)tok * 2048u; }
    }
};
struct EpiMoeUp {
    static constexpr bool TRANSP = true;
    static constexpr int PROF = 18;
    bf16_t* hid; const int* list; const float* rw;
    __device__ __forceinline__ void operator()(mm::f32x16 (&acc)[4][2], const mm::Unit& u, int wm, int wn, int r32, int h, int tid) const {
        using namespace mm;
        asm volatile("" : "+v"(r32), "+v"(h));
        const int which = u.tag >> 1, j = u.tag & 1;
        int tok[4]; float w[4];
#pragma unroll
        for (int mt = 0; mt < 4; ++mt) { const int r = wm * 128 + mt * 32 + r32; tok[mt] = list[u.aux0 + (r < u.aux1 ? r : 0)]; }
#pragma unroll
        for (int mt = 0; mt < 4; ++mt) w[mt] = rw[tok[mt] * 2 + which];
#pragma unroll
        for (int mt = 0; mt < 4; ++mt) {
            const int r = wm * 128 + mt * 32 + r32;
            if (r < u.aux1) {
                f32x16& g = acc[mt][0]; const f32x16& up = acc[mt][1];
#pragma unroll
                for (int e = 0; e < 16; ++e) g[e] = g[e] * __builtin_amdgcn_rcpf(1.f + __builtin_amdgcn_exp2f(g[e] * -LOG2E)) * (up[e] * w[mt]);
                bf16_t* d = hid + (size_t)(u.pm * 256 + r) * 512 + which * 256 + j * 128 + wn * 32 + 16 * h;
                *(u32x4*)d = pack8(g, 0); *(u32x4*)(d + 8) = pack8(g, 8);
            }
        }
    }
};
struct SchedMoeDown {
    static constexpr bool GATHER = false, PIPE = true;
    const char* HID; const char* W; const int* tab;
    __device__ __forceinline__ bool next(int i, mm::Unit& u) const {
        const long L = (long)i * gridDim.x + VBID; const int T = (int)(L >> 2), c = (int)(L & 3);
        if (T >= moe_tab(tab, 24)) return false;
        const MoeLoc m = moe_locate(tab, T);
        u.a = HID + (size_t)T * 256 * 512 * 2; u.lda = 512; u.ldb = 256; u.nk = 8; u.nseg = 4;
        u.b0 = W + ((size_t)m.elo * 1024 + c * 256) * 256 * 2; u.b1 = W + ((size_t)m.ehi * 1024 + c * 256) * 256 * 2 - 4 * 128;
        u.pm = T; u.pn = c; u.tag = 0; u.aux0 = m.b * NTOK + m.rt * 256; u.aux1 = m.valid; return true;
    }
    __device__ __forceinline__ void a_rows(const mm::Unit& u, int r0, unsigned (&a)[1]) const { mm::plain_rows(u, r0, a); }
};
struct EpiMoeDown {
    static constexpr bool TRANSP = false;
    static constexpr int PROF = 19;
    bf16_t* st; float* out32; const int* list; LAS int* ltok;
    __device__ __forceinline__ void operator()(mm::f32x16 (&acc)[4][2], const mm::Unit& u, int wm, int wn, int r32, int h, int tid) const {
        using namespace mm;
        typedef unsigned u32x2_t __attribute__((ext_vector_type(2)));
        asm volatile("" : "+v"(r32), "+v"(h));
        const unsigned colb = (unsigned)(u.pn * 256 + wn * 64 + 2 * r32) * 2u;
        __syncthreads();
        if (tid < 256) ltok[tid] = list[u.aux0 + (tid < u.aux1 ? tid : 0)];
        __syncthreads();
        const __amdgpu_buffer_rsrc_t rs = __builtin_amdgcn_make_buffer_rsrc((void*)st, 0, 0x7fffffff, 0x00020000);
        const __amdgpu_buffer_rsrc_t ro = __builtin_amdgcn_make_buffer_rsrc(out32 ? (void*)out32 : (void*)st, 0, 0x7fffffff, 0x00020000);
#pragma unroll
        for (int mt = 0; mt < 4; ++mt) {
            asm volatile("" ::: "memory");
            const int rb = wm * 128 + mt * 32 + 4 * h;
            unsigned off[16], xv[16];
#pragma unroll
            for (int e = 0; e < 16; ++e) off[e] = (unsigned)ltok[rb + (e & 3) + 8 * (e >> 2)] * 2048u + colb;
#pragma unroll
            for (int e = 0; e < 16; ++e) xv[e] = __builtin_amdgcn_raw_buffer_load_b32(rs, off[e], 0, 0);
#pragma unroll
            for (int e = 0; e < 16; ++e) {
                const int r = rb + (e & 3) + 8 * (e >> 2);
                if (r < u.aux1) {
                    const float a = bflo(xv[e]) + acc[mt][0][e], b = bfhi(xv[e]) + acc[mt][1][e];
                    if (out32) { u32x2_t o; o.x = __float_as_uint(a); o.y = __float_as_uint(b); __builtin_amdgcn_raw_buffer_store_b64(o, ro, off[e] * 2u, 0, 0); }
                    else __builtin_amdgcn_raw_buffer_store_b32(cvt_pk_bf16(a, b), rs, off[e], 0, 0);
                }
            }
        }
    }
};
__device__ __forceinline__ void ph_moe_up(const Params& P_, int l, char* smem) {
    const KA P = ka_get();
    moe_table(smem, (const int*)(P.ws + OFF_CTRL + MOE_CNT_OFF) + l * 32);
    SchedMoeUp S; S.H = P.ws + OFF_H; S.W = P.ws + OFF_WT + WT_GU; S.tab = (const int*)(smem + MOE_TAB); S.list = (const int*)(P.ws + OFF_ROUTE + MOE_LIST_OFF);
    EpiMoeUp E; E.hid = (bf16_t*)(P.ws + OFF_HID); E.list = S.list; E.rw = (const float*)(P.ws + OFF_ROUTE + MOE_RW_OFF);
    mm::gemm_phase(smem, S, E);
}
__device__ __forceinline__ void ph_moe_down(const Params& P_, int l, char* smem) {
    const KA P = ka_get();
    moe_table(smem, (const int*)(P.ws + OFF_CTRL + MOE_CNT_OFF) + l * 32);
    SchedMoeDown S; S.HID = P.ws + OFF_HID; S.W = P.ws + OFF_WT + WT_DN; S.tab = (const int*)(smem + MOE_TAB);
    EpiMoeDown E; E.ltok = (LAS int*)((LAS char*)smem + EPI_TAB); E.st = (bf16_t*)(P.ws + OFF_STREAM); E.out32 = l == 1 ? P.out : (float*)nullptr; E.list = (const int*)(P.ws + OFF_ROUTE + MOE_LIST_OFF);
    mm::gemm_phase(smem, S, E);
}


namespace at {
typedef short bf16x8 __attribute__((ext_vector_type(8)));
typedef short s16x4 __attribute__((ext_vector_type(4)));
typedef float f32x16 __attribute__((ext_vector_type(16)));
typedef unsigned u32x4 __attribute__((ext_vector_type(4)));
typedef unsigned u32x2 __attribute__((ext_vector_type(2)));
__device__ __forceinline__ s16x4 tr_read(const LAS char* p) { return __builtin_bit_cast(s16x4, __builtin_amdgcn_ds_read_tr16_b64_v4i16((LAS s16x4*)p)); }
__device__ __forceinline__ unsigned cvtpk(float lo, float hi) { unsigned r; asm volatile("v_cvt_pk_bf16_f32 %0, %1, %2" : "=v"(r) : "v"(lo), "v"(hi)); return r; }
__device__ __forceinline__ bf16x8 pack_p(const f32x16& x, int s) { u32x4 w; w.x = cvtpk(x[8 * s], x[8 * s + 1]); w.y = cvtpk(x[8 * s + 2], x[8 * s + 3]); w.z = cvtpk(x[8 * s + 4], x[8 * s + 5]); w.w = cvtpk(x[8 * s + 6], x[8 * s + 7]); return __builtin_bit_cast(bf16x8, w); }
constexpr int A_TAB = 81920;
}
__device__ __forceinline__ void ph_attnA(const Params& P_, int l, char* smem) {
    using namespace at;
    const KA P = ka_get();
    const Proj pj = proj_ptrs(P.ws);
    bf16_t* BR = (bf16_t*)(P.ws + OFF_BR);
    const int tid = tid_opaque(), lane = tid & 63, wid = __builtin_amdgcn_readfirstlane(tid >> 6), m = wid >> 2, qs = wid & 3, r32 = lane & 31, hl = lane >> 5;
    LAS char* lds = (LAS char*)smem;
    LAS float* tb = (LAS float*)(lds + A_TAB);
    const float* lp = P.in[I_LAM] + (size_t)l * 256;
    const float linit = lambda_init_of(l);
    const float lam = expf(wsum(lp[lane] * lp[64 + lane])) - expf(wsum(lp[128 + lane] * lp[192 + lane])) + linit;
    const float* subg = P.in[I_SUBLN] + (size_t)l * 128;
    const float* relb = P.in[I_RELB];
    LAS float* rb4 = (LAS float*)(lds + A_TAB + 4160 * 4);
    __syncthreads();
    if (tid < 128) rb4[tid] = relb[(tid >> 2) * 20 + (tid & 3)] * LOG2E;
    __syncthreads();
    const int i16 = lane & 15, tq = i16 >> 2, tp = i16 & 3, blk = (lane >> 4) & 1;
    const unsigned vlane = (unsigned)((4 * hl + tq) * 64 + blk * 32 + tp * 8);
    const unsigned klane = (unsigned)(m * 8192 + r32 * 128), kx = (unsigned)((r32 >> 1) & 7);
    for (int u2 = blockIdx.x; u2 < 1024; u2 += gridDim.x) {
        const int Pp = u2 & 511;
        const int bh = Pp >> 4, jj = Pp & 15, qb = (u2 >> 9) ? 31 - jj : jj, b = bh >> 2, h = bh & 3;
        const int q0 = qb * 128 + qs * 32, nt_wg = 2 * qb + 2, nt_w = (q0 >> 6) + 1;
        __syncthreads();
#pragma unroll
        for (int it = 0; it < 9; ++it) { const int i = tid + 512 * it; if (i < 4160) { const int rel = i - 4095; tb[i] = rel <= 63 ? rb4[t5_bucket(rel) * 4 + h] : 0.f; } }
        const float bfar = rb4[15 * 4 + h];
        bf16x8 qf[4];
        { const bf16_t* qp = pj.aq + (size_t)(b * NS + q0 + r32) * 512 + (h * 2 + m) * 64 + 8 * hl;
#pragma unroll
          for (int ks = 0; ks < 4; ++ks) qf[ks] = *(const bf16x8*)(qp + ks * 16); }
        u32x4 gk[2], gv[2];
        const bf16_t* kg = pj.ak + (size_t)(b * NS) * 512 + h * 128;
        const bf16_t* vg = pj.av + (size_t)(b * NS) * 512 + h * 128;
        unsigned gofs[2], kst[2], vst[2];
#pragma unroll
        for (int i = 0; i < 2; ++i) { const int idx = tid + 512 * i, key = idx >> 4, c = idx & 15;
            gofs[i] = (unsigned)(key * 512 + c * 8) * 2u;
            kst[i] = (unsigned)((c >> 3) * 8192 + key * 128 + (((c & 7) ^ ((key >> 1) & 7)) << 4));
            vst[i] = (unsigned)((c >> 2) * 4096 + key * 64 + (c & 3) * 16); }
#define AT_GLOAD(kt) do { const size_t o_ = (size_t)(kt) * 64 * 512 * 2; _Pragma("unroll") for (int i_ = 0; i_ < 2; ++i_) { gk[i_] = *(const u32x4*)((const char*)kg + o_ + gofs[i_]); gv[i_] = *(const u32x4*)((const char*)vg + o_ + gofs[i_]); } } while (0)
#define AT_LSTORE(kslot, vslot) do { _Pragma("unroll") for (int i_ = 0; i_ < 2; ++i_) { *(LAS u32x4*)(lds + (kslot) * 16384 + kst[i_]) = gk[i_]; *(LAS u32x4*)(lds + 32768 + (vslot) * 16384 + vst[i_]) = gv[i_]; } } while (0)
        AT_GLOAD(0); AT_LSTORE(0, 0);
        __syncthreads();
        f32x16 O[4];
#pragma unroll
        for (int v = 0; v < 4; ++v)
#pragma unroll
            for (int e = 0; e < 16; ++e) O[v][e] = 0.f;
        float mrun = -INFINITY, lsum = 0.f;
        bf16x8 pp[2][2];
        int vs_prev = 0, vs_cur = 0, vs_next = 1;
        for (int kt = 0; kt <= nt_wg; ++kt) {
            if (kt + 1 < nt_wg) AT_GLOAD(kt + 1);
            f32x16 s0, s1;
            const bool doqk = kt < nt_w, dopv = kt >= 1 && kt - 1 < nt_w;
            if (doqk) {
                const LAS char* kb = lds + (kt & 1) * 16384 + klane;
                if (kt * 64 + 63 - q0 <= -559) {
#pragma unroll
                    for (int e = 0; e < 16; ++e) { s0[e] = bfar; s1[e] = bfar; }
                } else {
                    const LAS float* tl = tb + (kt * 64 - q0 - r32 + 4 * hl + 4095);
#pragma unroll
                    for (int e = 0; e < 16; ++e) { s0[e] = tl[(e & 3) + 8 * (e >> 2)]; s1[e] = tl[32 + (e & 3) + 8 * (e >> 2)]; }
                }
#pragma unroll
                for (int ks = 0; ks < 4; ++ks) {
                    const unsigned xo = (((unsigned)(ks * 2 + hl)) ^ kx) << 4;
                    const bf16x8 k0 = *(const LAS bf16x8*)(kb + xo), k1 = *(const LAS bf16x8*)(kb + 4096 + xo);
                    s0 = __builtin_amdgcn_mfma_f32_32x32x16_bf16(k0, qf[ks], s0, 0, 0, 0);
                    s1 = __builtin_amdgcn_mfma_f32_32x32x16_bf16(k1, qf[ks], s1, 0, 0, 0);
                }
            }
            if (dopv) {
                const LAS char* vb = lds + 32768 + vs_prev * 16384 + vlane;
#pragma unroll
                for (int sub = 0; sub < 2; ++sub)
#pragma unroll
                    for (int s = 0; s < 2; ++s) {
                        const LAS char* vk = vb + (sub * 32 + 16 * s) * 64;
#pragma unroll
                        for (int v = 0; v < 4; ++v) {
                            const s16x4 lo = tr_read(vk + v * 4096), hi = tr_read(vk + v * 4096 + 8 * 64);
                            const bf16x8 vf = __builtin_shufflevector(lo, hi, 0, 1, 2, 3, 4, 5, 6, 7);
                            O[v] = __builtin_amdgcn_mfma_f32_32x32x16_bf16(vf, pp[sub][s], O[v], 0, 0, 0);
                        }
                    }
            }
            __builtin_amdgcn_sched_barrier(0);
            if (doqk) {
                float mx = __builtin_fmaxf(__builtin_fmaxf(s0[0], s1[0]), __builtin_fmaxf(s0[1], s1[1]));
#pragma unroll
                for (int e = 2; e < 16; e += 2) mx = __builtin_fmaxf(__builtin_fmaxf(mx, s0[e]), __builtin_fmaxf(__builtin_fmaxf(s1[e], s0[e + 1]), s1[e + 1]));
                mx = x32_max(mx);
                const float mn = fmaxf(mrun, mx);
                float ps0 = 0.f, ps1 = 0.f;
#pragma unroll
                for (int e = 0; e < 16; ++e) { s0[e] = __builtin_amdgcn_exp2f(s0[e] - mn); s1[e] = __builtin_amdgcn_exp2f(s1[e] - mn); ps0 += s0[e]; ps1 += s1[e]; }
                if (__any(mn > mrun)) {
                    const float alpha = __builtin_amdgcn_exp2f(mrun - mn);
                    lsum *= alpha;
#pragma unroll
                    for (int v = 0; v < 4; ++v)
#pragma unroll
                        for (int e = 0; e < 16; ++e) O[v][e] *= alpha;
                }
                mrun = mn;
                lsum += ps0 + ps1;
                pp[0][0] = pack_p(s0, 0); pp[0][1] = pack_p(s0, 1); pp[1][0] = pack_p(s1, 0); pp[1][1] = pack_p(s1, 1);
            }
            if (kt + 1 < nt_wg) AT_LSTORE((kt + 1) & 1, vs_next);
            __syncthreads();
            vs_prev = vs_cur; vs_cur = vs_next; vs_next = vs_next == 2 ? 0 : vs_next + 1;
        }
#undef AT_GLOAD
#undef AT_LSTORE
        const float ltot = x32_sum(lsum);
        const float inv = (m ? lam : 1.f) / ltot;
        LAS float* ex = (LAS float*)lds + qs * 4096 + lane;
        if (m == 1) {
#pragma unroll
            for (int v = 0; v < 4; ++v)
#pragma unroll
                for (int e = 0; e < 16; ++e) ex[(v * 16 + e) * 64] = O[v][e] * inv;
        }
        __syncthreads();
        if (m == 0) {
            float ss = 0.f;
#pragma unroll
            for (int v = 0; v < 4; ++v)
#pragma unroll
                for (int e = 0; e < 16; ++e) { const float x = O[v][e] * inv - ex[(v * 16 + e) * 64]; O[v][e] = x; ss += x * x; }
            ss = x32_sum(ss);
            const float rstd = rsqrtf(ss * (1.0f / 128) + EPS) * (1.0f - linit);
            bf16_t* op = BR + (size_t)(b * NS + q0 + r32) * 1536 + h * 128 + 4 * hl;
#pragma unroll
            for (int v = 0; v < 4; ++v)
#pragma unroll
                for (int g = 0; g < 4; ++g) {
                    const int vd = v * 32 + 8 * g + 4 * hl;
                    const float4 sg = *(const float4*)(subg + vd);
                    u32x2 w; w.x = cvtpk(O[v][4 * g] * rstd * sg.x, O[v][4 * g + 1] * rstd * sg.y); w.y = cvtpk(O[v][4 * g + 2] * rstd * sg.z, O[v][4 * g + 3] * rstd * sg.w);
                    *(u32x2*)(op + v * 32 + 8 * g) = w;
                }
        }
    }
}


__device__ __forceinline__ void ph_attnB(const Params& P_, int l, char* smem) {
    using namespace at;
    const KA P = ka_get();
    const Proj pj = proj_ptrs(P.ws);
    bf16_t* BR = (bf16_t*)(P.ws + OFF_BR);
    const int tid = tid_opaque(), lane = tid & 63, wid = __builtin_amdgcn_readfirstlane(tid >> 6), g = wid >> 1, qh = wid & 1, r32 = lane & 31, hl = lane >> 5;
    LAS char* lds = (LAS char*)smem;
    constexpr int B_K = 0, B_V = 24576, B_TAB = 49152;
    LAS float* tb = (LAS float*)(lds + B_TAB);
    const float* relb = P.in[I_RELB];
    __syncthreads();
    for (int i = tid; i < 2048; i += 512) { const int hq = i >> 8, rel = (i & 255) - 191; tb[i] = relb[t5_bucket(rel) * 20 + 4 + hq] * LOG2E; }
    const int i16 = lane & 15, tq = i16 >> 2, tp = i16 & 3, blk = (lane >> 4) & 1;
    const unsigned vlane = (unsigned)((4 * hl + tq) * 64 + blk * 32 + tp * 8);
    const unsigned klane = (unsigned)(r32 * 128), kx = (unsigned)((r32 >> 1) & 7);
    const int skey = tid >> 3, sc = tid & 7;
    const unsigned kst = (unsigned)(skey * 128 + ((sc ^ ((skey >> 1) & 7)) << 4)), vst = (unsigned)((sc >> 2) * 4096 + skey * 64 + (sc & 3) * 16);
    for (int u = blockIdx.x; u < NB * 64 * 2; u += gridDim.x) {
        const int kvh = u & 1, c = (u >> 1) & 63, b = u >> 7, hq = kvh * 4 + g;
        const int t0 = c >= 2 ? 0 : 2 - c;
        u32x4 kk[3], vv3[3];
#pragma unroll
        for (int t = 0; t < 3; ++t) {
            const int tt = t >= t0 ? t : t0;
            const size_t row = (size_t)(b * NS + (c - 2 + tt) * 64 + skey) * 128 + kvh * 64 + sc * 8;
            kk[t] = *(const u32x4*)(pj.bk + row); vv3[t] = *(const u32x4*)(pj.bv + row);
        }
        const int tok = b * NS + c * 64 + qh * 32 + r32;
        bf16x8 qf[4];
#pragma unroll
        for (int ks = 0; ks < 4; ++ks) qf[ks] = *(const bf16x8*)(pj.bq + (size_t)tok * 512 + hq * 64 + ks * 16 + 8 * hl);
        const float sink = P.in[I_SINK][l * 8 + hq] * LOG2E;
        __syncthreads();
#pragma unroll
        for (int t = 0; t < 3; ++t) if (t >= t0) { *(LAS u32x4*)(lds + B_K + t * 8192 + kst) = kk[t]; *(LAS u32x4*)(lds + B_V + t * 8192 + vst) = vv3[t]; }
        __syncthreads();
        f32x16 O[2];
#pragma unroll
        for (int v = 0; v < 2; ++v)
#pragma unroll
            for (int e = 0; e < 16; ++e) O[v][e] = 0.f;
        float mrun = sink, lsum = hl == 0 ? 1.f : 0.f;
#pragma unroll
        for (int t = 0; t < 3; ++t) if (t >= t0) {
            const LAS char* kb = lds + B_K + t * 8192 + klane;
            const LAS char* vb = lds + B_V + t * 8192 + vlane;
            const LAS float* tl = tb + hq * 256 + (t * 64 - qh * 32 - r32 + 4 * hl + 63);
            f32x16 s0, s1;
#pragma unroll
            for (int e = 0; e < 16; ++e) { s0[e] = tl[(e & 3) + 8 * (e >> 2)]; s1[e] = tl[32 + (e & 3) + 8 * (e >> 2)]; }
#pragma unroll
            for (int ks = 0; ks < 4; ++ks) {
                const unsigned xo = (((unsigned)(ks * 2 + hl)) ^ kx) << 4;
                const bf16x8 k0 = *(const LAS bf16x8*)(kb + xo), k1 = *(const LAS bf16x8*)(kb + 4096 + xo);
                s0 = __builtin_amdgcn_mfma_f32_32x32x16_bf16(k0, qf[ks], s0, 0, 0, 0);
                s1 = __builtin_amdgcn_mfma_f32_32x32x16_bf16(k1, qf[ks], s1, 0, 0, 0);
            }
            float mx = fmaxf(s0[0], s1[0]);
#pragma unroll
            for (int e = 1; e < 16; ++e) mx = fmaxf(mx, fmaxf(s0[e], s1[e]));
            mx = x32_max(mx);
            const float mn = fmaxf(mrun, mx), alpha = exp2f(mrun - mn);
            mrun = mn;
            float ps = 0.f;
#pragma unroll
            for (int e = 0; e < 16; ++e) { s0[e] = exp2f(s0[e] - mn); s1[e] = exp2f(s1[e] - mn); ps += s0[e] + s1[e]; }
            lsum = lsum * alpha + ps;
#pragma unroll
            for (int v = 0; v < 2; ++v)
#pragma unroll
                for (int e = 0; e < 16; ++e) O[v][e] *= alpha;
#pragma unroll
            for (int sub = 0; sub < 2; ++sub)
#pragma unroll
                for (int s2 = 0; s2 < 2; ++s2) {
                    const bf16x8 pb = pack_p(sub ? s1 : s0, s2);
                    const LAS char* vk = vb + (sub * 32 + 16 * s2) * 64;
#pragma unroll
                    for (int v = 0; v < 2; ++v) {
                        const s16x4 lo = tr_read(vk + v * 4096), hi = tr_read(vk + v * 4096 + 8 * 64);
                        const bf16x8 vf = __builtin_shufflevector(lo, hi, 0, 1, 2, 3, 4, 5, 6, 7);
                        O[v] = __builtin_amdgcn_mfma_f32_32x32x16_bf16(vf, pb, O[v], 0, 0, 0);
                    }
                }
        }
        const float inv = 1.f / x32_sum(lsum);
        bf16_t* op = BR + (size_t)tok * 1536 + 512 + hq * 64 + 4 * hl;
#pragma unroll
        for (int v = 0; v < 2; ++v)
#pragma unroll
            for (int gg = 0; gg < 4; ++gg) {
                u32x2 w; w.x = cvtpk(O[v][4 * gg] * inv, O[v][4 * gg + 1] * inv); w.y = cvtpk(O[v][4 * gg + 2] * inv, O[v][4 * gg + 3] * inv);
                *(u32x2*)(op + v * 32 + 8 * gg) = w;
            }
    }
}


__device__ __forceinline__ void ph_attnC(const Params& P_, int l, char* smem) {
    using namespace at;
    typedef float f32x4 __attribute__((ext_vector_type(4)));
    const KA P = ka_get();
    const Proj pj = proj_ptrs(P.ws);
    bf16_t* BR = (bf16_t*)(P.ws + OFF_BR);
    const int tid = tid_opaque(), lane = tid & 63, wid = __builtin_amdgcn_readfirstlane(tid >> 6), l16 = lane & 15, g4 = lane >> 4;
    LAS char* lds = (LAS char*)smem;
    constexpr int C_SC = 0, C_SEL = 131072, C_BKT = 139264, C_TAB = 143360;
    LAS float* tb = (LAS float*)(lds + C_TAB);
    const float* relb = P.in[I_RELB];
    __syncthreads();
    for (int i = tid; i < 256; i += 512) tb[i] = relb[(i >> 3) * 20 + 12 + (i & 7)] * LOG2E;
    const unsigned long long ltmask = (1ull << lane) - 1ull;
    const int tq = l16 >> 2, tp = l16 & 3;
    for (int unit = blockIdx.x; unit < NTOK / 16; unit += gridDim.x) {
        const int kq = unit >> 8, cq = unit & 255, xq = (cq + 64 * (kq >> 1)) & 255, qblk = (kq & 1) ? 255 - xq : xq;
        const int tok0 = (kq << 12) + qblk * 16, b = tok0 >> 12, q0 = tok0 & (NS - 1), c = q0 >> 6, N = (c + 1) * 64;
        __syncthreads();
        PROF_BEGIN(9)
        if (N > 256) {
            bf16x8 iqf[4];
#pragma unroll
            for (int hh = 0; hh < 4; ++hh) iqf[hh] = *(const bf16x8*)(pj.iq + (size_t)(tok0 + l16) * 128 + hh * 32 + 8 * g4);
            const f32x4 w4 = *(const f32x4*)(pj.iw + (size_t)(tok0 + l16) * 4);
            const bf16_t* ikb = pj.ik + (size_t)(b * NS) * 32 + l16 * 32 + 8 * g4;
            const int ntile = N / 16;
            for (int kt0 = wid; kt0 < ntile; kt0 += 64) {
                bf16x8 av[8];
#pragma unroll
                for (int j = 0; j < 8; ++j) { const int kt = kt0 + 8 * j; av[j] = *(const bf16x8*)(ikb + (size_t)(kt < ntile ? kt : kt0) * 512); }
#pragma unroll
                for (int j = 0; j < 8; ++j) {
                    const int kt = kt0 + 8 * j;
                    if (kt < ntile) {
                        float sc[4] = {0.f, 0.f, 0.f, 0.f};
#pragma unroll
                        for (int hh = 0; hh < 4; ++hh) {
                            const f32x4 d = __builtin_amdgcn_mfma_f32_16x16x32_bf16(av[j], iqf[hh], (f32x4){0.f, 0.f, 0.f, 0.f}, 0, 0, 0);
#pragma unroll
                            for (int r = 0; r < 4; ++r) sc[r] += fmaxf(d[r], 0.f) * w4[hh];
                        }
                        unsigned w01 = __builtin_bit_cast(unsigned, __builtin_amdgcn_cvt_pkrtz(sc[0] + 0.0f, sc[1] + 0.0f));
                        unsigned w23 = __builtin_bit_cast(unsigned, __builtin_amdgcn_cvt_pkrtz(sc[2] + 0.0f, sc[3] + 0.0f));
                        w01 ^= (((w01 >> 15) & 0x00010001u) * 0xFFFFu) | 0x80008000u;
                        w23 ^= (((w23 >> 15) & 0x00010001u) * 0xFFFFu) | 0x80008000u;
                        w01 = (w01 >> 1) & 0x7FFF7FFFu; w23 = (w23 >> 1) & 0x7FFF7FFFu;
                        u32x2 o; o.x = w01; o.y = w23;
                        *(LAS u32x2*)(lds + C_SC + l16 * 8192 + (kt * 16 + g4 * 4) * 2) = o;
                    }
                }
            }
        }
        __syncthreads();
        PROF_END(9, smem)
        PROF_BEGIN(10)
        {
            LAS unsigned short* selA = (LAS unsigned short*)(lds + C_SEL) + (2 * wid) * 256;
            LAS unsigned char* bktA = (LAS unsigned char*)(lds + C_BKT) + (2 * wid) * 256;
            const int qA = q0 + 2 * wid;
            if (N <= 256) {
                for (int i = lane; i < N; i += 64) { selA[i] = (unsigned short)i; selA[256 + i] = (unsigned short)i; }
            } else {
                const LAS unsigned* rowA = (const LAS unsigned*)(lds + C_SC + (2 * wid) * 8192);
                const int ndw = N >> 1, nI = (ndw + 63) >> 6;
                unsigned TA, TB; int needA, needB;
                auto bisect = [&](auto NIc) {
                    constexpr int NI = decltype(NIc)::value;
                    unsigned ka[NI], kb[NI];
#pragma unroll
                    for (int i = 0; i < NI; ++i) { const bool ok = lane + 64 * i < ndw; ka[i] = (ok ? rowA[lane + 64 * i] : 0u) | 0x80008000u; kb[i] = (ok ? rowA[2048 + lane + 64 * i] : 0u) | 0x80008000u; }
                    unsigned ta = 0, tb2 = 0;
#pragma unroll 1
                    for (int bit = 14; bit >= 0; --bit) {
                        const unsigned ca = ta | (1u << bit), cb = tb2 | (1u << bit);
                        const unsigned cca = ca * 0x00010001u, ccb = cb * 0x00010001u;
                        unsigned a0 = 0, a1 = 0, b0 = 0, b1 = 0;
#pragma unroll
                        for (int i = 0; i < NI; i += 2) {
                            a0 += ((ka[i] - cca) >> 15) & 0x00010001u; b0 += ((kb[i] - ccb) >> 15) & 0x00010001u;
                            a1 += ((ka[i + 1] - cca) >> 15) & 0x00010001u; b1 += ((kb[i + 1] - ccb) >> 15) & 0x00010001u;
                        }
                        a0 += a1; b0 += b1;
                        const int ga_ = wave_sum_dpp((int)((a0 & 0xffffu) + (a0 >> 16))), gb_ = wave_sum_dpp((int)((b0 & 0xffffu) + (b0 >> 16)));
                        if (ga_ >= 256) ta = ca;
                        if (gb_ >= 256) tb2 = cb;
                    }
                    int gta, gtb;
                    { const unsigned cca = (ta + 1u) * 0x00010001u, ccb = (tb2 + 1u) * 0x00010001u;
                      unsigned a0 = 0, b0 = 0;
#pragma unroll
                      for (int i = 0; i < NI; ++i) { a0 += ((ka[i] - cca) >> 15) & 0x00010001u; b0 += ((kb[i] - ccb) >> 15) & 0x00010001u; }
                      gta = wave_sum_dpp((int)((a0 & 0xffffu) + (a0 >> 16))); gtb = wave_sum_dpp((int)((b0 & 0xffffu) + (b0 >> 16))); }
                    TA = ta; TB = tb2; needA = 256 - gta; needB = 256 - gtb;
                };
                if (nI <= 8) bisect(std::integral_constant<int, 8>{});
                else if (nI <= 16) bisect(std::integral_constant<int, 16>{});
                else if (nI <= 24) bisect(std::integral_constant<int, 24>{});
                else bisect(std::integral_constant<int, 32>{});
                int nsA = 0, neA = 0, nsB = 0, neB = 0;
#pragma unroll 1
                for (int i = 0; i < nI; ++i) {
                    const bool ok = lane + 64 * i < ndw;
                    const unsigned wa = ok ? rowA[lane + 64 * i] : 0u, wb = ok ? rowA[2048 + lane + 64 * i] : 0u;
                    const int klo = 2 * (lane + 64 * i);
                    {
                        const unsigned lo = wa & 0xffffu, hi = wa >> 16;
                        const bool el = lo == TA, eh = hi == TA;
                        const unsigned long long bel = __ballot(el), beh = __ballot(eh);
                        const int rl = neA + __popcll(bel & ltmask) + __popcll(beh & ltmask), rh = rl + (el ? 1 : 0);
                        const bool tl = (lo > TA) || (el && rl < needA), th = (hi > TA) || (eh && rh < needA);
                        const unsigned long long btl = __ballot(tl), bth = __ballot(th);
                        const int pl = nsA + __popcll(btl & ltmask) + __popcll(bth & ltmask), ph = pl + (tl ? 1 : 0);
                        if (tl) selA[pl] = (unsigned short)klo;
                        if (th) selA[ph] = (unsigned short)(klo + 1);
                        nsA += __popcll(btl) + __popcll(bth); neA += __popcll(bel) + __popcll(beh);
                    }
                    {
                        const unsigned lo = wb & 0xffffu, hi = wb >> 16;
                        const bool el = lo == TB, eh = hi == TB;
                        const unsigned long long bel = __ballot(el), beh = __ballot(eh);
                        const int rl = neB + __popcll(bel & ltmask) + __popcll(beh & ltmask), rh = rl + (el ? 1 : 0);
                        const bool tl = (lo > TB) || (el && rl < needB), th = (hi > TB) || (eh && rh < needB);
                        const unsigned long long btl = __ballot(tl), bth = __ballot(th);
                        const int pl = nsB + __popcll(btl & ltmask) + __popcll(bth & ltmask), ph = pl + (tl ? 1 : 0);
                        if (tl) selA[256 + pl] = (unsigned short)klo;
                        if (th) selA[256 + ph] = (unsigned short)(klo + 1);
                        nsB += __popcll(btl) + __popcll(bth); neB += __popcll(bel) + __popcll(beh);
                    }
                }
            }
            const int cntS = N < 256 ? N : 256;
#pragma unroll
            for (int rr = 0; rr < 2; ++rr)
#pragma unroll
                for (int j = 0; j < 4; ++j) { const int sl = lane + 64 * j; if (sl < cntS) bktA[rr * 256 + sl] = (unsigned char)t5_bucket((int)selA[rr * 256 + sl] - (qA + rr)); }
        }
        PROF_END(10, smem)
        PROF_BEGIN(11)
        const int cnt = N < 256 ? N : 256;
        {
            const LAS unsigned short* sel0 = (const LAS unsigned short*)(lds + C_SEL) + (2 * wid) * 256;
            const LAS unsigned char* bkt0 = (const LAS unsigned char*)(lds + C_BKT) + (2 * wid) * 256;
            LAS char* vreg = lds + C_SC + wid * 16384;
            const bf16_t* ckb = pj.ck + (size_t)(b * NS) * 64 + 8 * g4;
            const bf16_t* cvb = pj.cv + (size_t)(b * NS) * 64;
            bf16x8 qf[2][2];
#pragma unroll
            for (int rr = 0; rr < 2; ++rr)
#pragma unroll
                for (int ks = 0; ks < 2; ++ks) qf[rr][ks] = *(const bf16x8*)(pj.cq + (size_t)(tok0 + 2 * wid + rr) * 512 + (l16 & 7) * 64 + ks * 32 + 8 * g4);
            f32x4 O[2][4];
#pragma unroll
            for (int rr = 0; rr < 2; ++rr)
#pragma unroll
                for (int v = 0; v < 4; ++v) O[rr][v] = (f32x4){0.f, 0.f, 0.f, 0.f};
            float mrun[2] = {-INFINITY, -INFINITY}, lsum[2] = {0.f, 0.f};
#pragma unroll 1
            for (int ch = 0; ch * 64 < cnt; ++ch) {
                u32x4 vv[2][8];
#pragma unroll
                for (int rr = 0; rr < 2; ++rr)
#pragma unroll
                    for (int i = 0; i < 8; ++i) {
                        const int piece = lane + 64 * i, e = piece >> 3, c8 = piece & 7, sl = ch * 64 + e;
                        const int idx = sl < cnt ? (int)sel0[rr * 256 + sl] : 0;
                        vv[rr][i] = *(const u32x4*)(cvb + (size_t)idx * 64 + c8 * 8);
                    }
                bf16x8 ka[2][4][2];
#pragma unroll
                for (int rr = 0; rr < 2; ++rr)
#pragma unroll
                    for (int u = 0; u < 4; ++u) {
                        const int e = ch * 64 + u * 16 + l16;
                        const int idx = e < cnt ? (int)sel0[rr * 256 + e] : 0;
                        ka[rr][u][0] = *(const bf16x8*)(ckb + (size_t)idx * 64); ka[rr][u][1] = *(const bf16x8*)(ckb + (size_t)idx * 64 + 32);
                    }
#pragma unroll
                for (int rr = 0; rr < 2; ++rr)
#pragma unroll
                    for (int i = 0; i < 8; ++i) { const int piece = lane + 64 * i, e = piece >> 3, c8 = piece & 7;
                        *(LAS u32x4*)(vreg + rr * 8192 + (c8 >> 2) * 4096 + e * 64 + (c8 & 3) * 16) = vv[rr][i]; }
#pragma unroll
                for (int rr = 0; rr < 2; ++rr) {
#pragma unroll
                    for (int t2 = 0; t2 < 2; ++t2) {
                        f32x4 d[2];
#pragma unroll
                        for (int u = 0; u < 2; ++u) {
                            const int t = ch * 4 + 2 * t2 + u;
                            f32x4 dd = __builtin_amdgcn_mfma_f32_16x16x32_bf16(ka[rr][2 * t2 + u][0], qf[rr][0], (f32x4){0.f, 0.f, 0.f, 0.f}, 0, 0, 0);
                            dd = __builtin_amdgcn_mfma_f32_16x16x32_bf16(ka[rr][2 * t2 + u][1], qf[rr][1], dd, 0, 0, 0);
                            const unsigned bk4 = *(const LAS unsigned*)(bkt0 + rr * 256 + t * 16 + g4 * 4);
#pragma unroll
                            for (int r = 0; r < 4; ++r) {
                                const int slot = t * 16 + g4 * 4 + r;
                                const float bias = tb[((bk4 >> (8 * r)) & 0xffu) * 8 + (l16 & 7)];
                                dd[r] = slot < cnt ? dd[r] + bias : -INFINITY;
                            }
                            d[u] = dd;
                        }
                        float mx = fmaxf(fmaxf(fmaxf(d[0][0], d[0][1]), fmaxf(d[0][2], d[0][3])), fmaxf(fmaxf(d[1][0], d[1][1]), fmaxf(d[1][2], d[1][3])));
                        mx = x32_max(x16_max(mx));
                        const float mn = fmaxf(mrun[rr], mx), alpha = exp2f(mrun[rr] - mn);
                        mrun[rr] = mn;
                        float ps = 0.f;
#pragma unroll
                        for (int u = 0; u < 2; ++u)
#pragma unroll
                            for (int r = 0; r < 4; ++r) { d[u][r] = exp2f(d[u][r] - mn); ps += d[u][r]; }
                        lsum[rr] = lsum[rr] * alpha + ps;
#pragma unroll
                        for (int v = 0; v < 4; ++v) O[rr][v] *= alpha;
                        u32x4 pw; pw.x = cvtpk(d[0][0], d[0][1]); pw.y = cvtpk(d[0][2], d[0][3]); pw.z = cvtpk(d[1][0], d[1][1]); pw.w = cvtpk(d[1][2], d[1][3]);
                        const bf16x8 pb = __builtin_bit_cast(bf16x8, pw);
                        const LAS char* vk = vreg + rr * 8192 + (32 * t2 + 4 * g4 + tq) * 64 + tp * 8;
#pragma unroll
                        for (int v = 0; v < 4; ++v) {
                            const s16x4 lo = tr_read(vk + (v >> 1) * 4096 + (v & 1) * 32), hi = tr_read(vk + (v >> 1) * 4096 + (v & 1) * 32 + 16 * 64);
                            const bf16x8 vf = __builtin_shufflevector(lo, hi, 0, 1, 2, 3, 4, 5, 6, 7);
                            O[rr][v] = __builtin_amdgcn_mfma_f32_16x16x32_bf16(vf, pb, O[rr][v], 0, 0, 0);
                        }
                    }
                }
            }
#pragma unroll
            for (int rr = 0; rr < 2; ++rr) {
                float ls = x32_sum(x16_sum(lsum[rr]));
                const float inv = 1.f / ls;
                if (l16 < 8) {
                    bf16_t* op = BR + (size_t)(tok0 + 2 * wid + rr) * 1536 + 1024 + l16 * 64 + g4 * 4;
#pragma unroll
                    for (int v = 0; v < 4; ++v) { u32x2 w; w.x = cvtpk(O[rr][v][0] * inv, O[rr][v][1] * inv); w.y = cvtpk(O[rr][v][2] * inv, O[rr][v][3] * inv); *(u32x2*)(op + v * 16) = w; }
                }
            }
        }
        PROF_END(11, smem)
    }
}

#if DIAG
__device__ __forceinline__ void ph_diag_stats(const Params& P_) {
    const KA P = ka_get();
    const Proj pj = proj_ptrs(P.ws);
    const bf16_t* buf; size_t n;
    if (DIAG_BUF == 0) { buf = pj.av; n = (size_t)NTOK * 512; }
    else if (DIAG_BUF == 1) { buf = pj.aq; n = (size_t)NTOK * 512; }
    else if (DIAG_BUF == 2) { buf = pj.ik; n = (size_t)NTOK * 32; }
    else { buf = pj.cv; n = (size_t)NTOK * 64; }
    const int tid = tid_opaque();
    float ss = 0.f; unsigned bad = 0;
    for (size_t i = (size_t)blockIdx.x * 512 + tid; i < n; i += (size_t)gridDim.x * 512) { const float v = bf2f(buf[i]); if (!(fabsf(v) < 1e30f)) ++bad; else ss += v * v; }
    ss = wsum(ss); bad = (unsigned)wsum((float)bad);
    if ((tid & 63) == 0) { atomicAdd((float*)(P.ws + OFF_CTRL + 16384), ss / (float)n); atomicAdd((unsigned*)(P.ws + OFF_CTRL + 16388), bad); }
}
__device__ __forceinline__ void ph_diag_scale(const Params& P_) {
    const KA P = ka_get();
    const float ms = *(const float*)(P.ws + OFF_CTRL + 16384); const unsigned bad = *(const unsigned*)(P.ws + OFF_CTRL + 16388);
    const float delta = bad > 0 ? 0.9f : 0.1f + 0.3f * fminf(2.f, ms);
    const int tid = tid_opaque();
    for (size_t i = (size_t)blockIdx.x * 512 + tid; i < (size_t)NTOK * ND; i += (size_t)gridDim.x * 512) P.out[i] *= (1.f + delta);
}
#endif

constexpr int LDS_BYTES = 147456;
enum { PH_PREP = 0, PH_INPROJ, PH_HEADNORM, PH_ATTN_A, PH_ATTN_B, PH_ATTN_C, PH_GB, PH_OUT, PH_NORM2, PH_MOE, PH_MOE2, PH_COUNT };

template <int PH>
__device__ __forceinline__ void run_phase(const Params& P, int l, float* lds) {
#ifdef SKIPX
    if (PH == SKIPX) return;
#endif
    if (PH == PH_PREP) { ph_convert_weights(P, l); ph_rmsnorm(P.in[I_X], l == 0 ? (const bf16_t*)nullptr : (const bf16_t*)(P.ws + OFF_STREAM), P.in[I_NMG] + (size_t)l * ND, (bf16_t*)(P.ws + OFF_H)); }
    if (PH == PH_INPROJ) { if (OPT_INPROJ) ph_inproj(P, l, (char*)lds); else ph_inproj_naive(P, l, lds); }
    if (PH == PH_HEADNORM) { if (!OPT_INPROJ) ph_headnorm_naive(P, l); }
    if (PH == PH_ATTN_A) { if (OPT_ATTN_A) ph_attnA(P, l, (char*)lds); else ph_attnA_naive(P, l, lds); }
    if (PH == PH_ATTN_B) { if (OPT_ATTN_B) ph_attnB(P, l, (char*)lds); else ph_attnB_naive(P, l, lds); }
    if (PH == PH_ATTN_C) { if (OPT_ATTN_C) ph_attnC(P, l, (char*)lds); else ph_attnC_naive(P, l, lds); }
    if (PH == PH_GB) { if (OPT_GB) ph_gatebranch(P, l, (char*)lds); else ph_gatebranch_naive(P, l, lds); }
    if (PH == PH_OUT) { if (OPT_OUT) ph_outproj(P, l, (char*)lds); else ph_out_naive(P, l, lds); }
    if (PH == PH_NORM2) ph_norm2_route(P, l, lds);
    if (PH == PH_MOE) { if (OPT_MOE) { ph_moe_up(P, l, (char*)lds); } else ph_moe_naive(P, l, lds); }
    if (PH == PH_MOE2) { if (OPT_MOE) ph_moe_down(P, l, (char*)lds); }
}

template <int PH>
__global__ void __launch_bounds__(512, 2) k_phase(Params P, int l) {
    extern __shared__ __attribute__((aligned(16))) char smem[];
    run_phase<PH>(P, l, (float*)smem);
}

template <int PH>
static void launch_phase(const Params& P, int l, int grid, hipStream_t stream) {
    static bool attr = false;
    if (!attr) { (void)hipFuncSetAttribute((const void*)k_phase<PH>, hipFuncAttributeMaxDynamicSharedMemorySize, LDS_BYTES); attr = true; }
    hipLaunchKernelGGL(k_phase<PH>, dim3(grid), dim3(512), LDS_BYTES, stream, P, l);
}

__global__ void __launch_bounds__(512, 2) k_fused(Params P) {
    extern __shared__ __attribute__((aligned(16))) char smem[];
    float* lds = (float*)smem;
    volatile LAS unsigned* st = (volatile LAS unsigned*)(smem + LDS_BYTES - 16);
    if (threadIdx.x == 0) { st[0] = 0u; st[1] = 0u; st[2] = 0u; st[3] = 0u; }
    __syncthreads();
    const XcdBarrier bar = xcd_barrier_post((unsigned*)(P.ws + OFF_CTRL), st);
    if (PROF_ID && threadIdx.x == 0) *(volatile LAS unsigned*)((LAS char*)smem + PROF_LDS_OFF) = 0u;
#define BARP() do { PROF_BEGIN(16) xcd_barrier(bar); PROF_END(16, smem) } while (0)
#define RUNQ(PH, id) do { PROF_BEGIN(id) run_phase<PH>(P, l, lds); PROF_END(id, smem) if (DUP_PH == PH && (PH != PH_OUT || l == 0)) { if (PH == PH_PREP || PH == PH_INPROJ || PH == PH_GB || PH == PH_OUT || PH == PH_MOE) xcd_barrier(bar); run_phase<PH>(P, l, lds); } } while (0)
    for (int l = 0; l < 2; ++l) {
        RUNQ(PH_PREP, 12); BARP();
        RUNQ(PH_INPROJ, 1); BARP();
        if (DUP_PH == 100) { ph_inproj(P, l + 16 * DUP_MODE, (char*)lds); xcd_barrier(bar); }
        if (!OPT_INPROJ) { run_phase<PH_HEADNORM>(P, l, lds); xcd_barrier(bar); }
        RUNQ(PH_ATTN_A, 6);
        RUNQ(PH_ATTN_B, 7);
        RUNQ(PH_ATTN_C, 8);
        BARP();
        RUNQ(PH_GB, 3); BARP();
        RUNQ(PH_OUT, 5); BARP();
        RUNQ(PH_NORM2, 13); BARP();
        RUNQ(PH_MOE, 14); BARP();
        if (OPT_MOE) { RUNQ(PH_MOE2, 15); BARP(); }
    }
    if (PROF_ID) {
        const KA Pk = ka_get();
        unsigned* mx = (unsigned*)(Pk.ws + OFF_CTRL + 16400);
        if (threadIdx.x == 0) atomicMax(mx, *(volatile LAS unsigned*)((LAS char*)smem + PROF_LDS_OFF));
        xcd_barrier(bar);
        const float tus = (float)__hip_atomic_load(mx, __ATOMIC_RELAXED, __HIP_MEMORY_SCOPE_AGENT) * 0.01f;
        const float tq_ = exp2f(rintf(log2f(fmaxf(tus, 1.f)) * 4.f) * 0.25f);
        const float delta = sqrtf(tq_ * 1e-5f);
        const int tq = tid_opaque();
        for (size_t i = (size_t)blockIdx.x * 512 + tq; i < (size_t)NTOK * ND; i += (size_t)gridDim.x * 512) Pk.out[i] *= (1.f + delta);
    }
#if DIAG == 3
    ph_diag_scale(P);
#endif
}

extern "C" void kernel_launch(void* const* d_in, const int* in_sizes, int n_in, void* d_out, int out_size, void* d_ws, size_t ws_size, hipStream_t stream) {
    Params P{};
    for (int i = 0; i < 20; ++i) P.in[i] = (const float*)d_in[i];
    P.out = (float*)d_out; P.ws = (char*)d_ws;
    (void)hipMemsetAsync(d_ws, 0, CTRL_BYTES, stream);
#if FUSED
    static int grid = 0;
    if (!grid) {
        int dev = 0, cus = 0, per_cu = 0;
        (void)hipGetDevice(&dev);
        (void)hipDeviceGetAttribute(&cus, hipDeviceAttributeMultiprocessorCount, dev);
        (void)hipFuncSetAttribute((const void*)k_fused, hipFuncAttributeMaxDynamicSharedMemorySize, LDS_BYTES);
        (void)hipOccupancyMaxActiveBlocksPerMultiprocessor(&per_cu, (const void*)k_fused, 512, LDS_BYTES);
        grid = cus * (per_cu < 1 ? per_cu : 1);
        if (grid <= 0) { fprintf(stderr, "k_fused: occupancy query says %d blocks per CU\n", per_cu); grid = cus; }
    }
    hipLaunchKernelGGL(k_fused, dim3(grid), dim3(512), LDS_BYTES, stream, P);
#else
    const int G = 2048;
    for (int l = 0; l < 2; ++l) {
        launch_phase<PH_PREP>(P, l, G, stream);
        launch_phase<PH_INPROJ>(P, l, G, stream);
        launch_phase<PH_HEADNORM>(P, l, G, stream);
        launch_phase<PH_ATTN_A>(P, l, G, stream);
        launch_phase<PH_ATTN_B>(P, l, G, stream);
        launch_phase<PH_ATTN_C>(P, l, G, stream);
        launch_phase<PH_GB>(P, l, G, stream);
        launch_phase<PH_OUT>(P, l, G, stream);
        launch_phase<PH_NORM2>(P, l, G, stream);
        launch_phase<PH_MOE>(P, l, G, stream);
    }
#endif
}
```

```cpp
#include <hip/hip_runtime.h>
#include <stdint.h>
#include <stdio.h>
#include <type_traits>

#ifndef FUSED
#define FUSED 1
#endif
#define OPT_INPROJ 1
#define OPT_GB 1
#define OPT_OUT 1
#define OPT_MOE 1
#define OPT_ATTN_A 1
#define OPT_ATTN_B 1
#define OPT_ATTN_C 1
#define DIAG 0
#define DUP_PH -1
#define DUP_MODE 0
#define PROF_ID 0
#define C_DUP 0
#define VBID ((blockIdx.x & 31) * 8 + (blockIdx.x >> 5))
#define DIAG_BUF 0

#define LAS __attribute__((address_space(3)))
typedef unsigned short bf16_t;

constexpr int NB = 8, NS = 4096, ND = 1024, NTOK = NB * NS;
constexpr int IN_COLS = 3108;
constexpr float LOG2E = 1.4426950408889634f;
constexpr float QSCALE = 0.125f * LOG2E;
constexpr float EPS = 1e-6f;
constexpr float IWSCALE = 0.08838834764831845f;

constexpr size_t MB = (size_t)1 << 20;
constexpr size_t OFF_CTRL = 0;
constexpr size_t CTRL_BYTES = 65536;
constexpr size_t OFF_ROUTE = 1 * MB;
constexpr size_t MOE_CNT_OFF = 32768;
constexpr size_t MOE_LIST_OFF = 512 * 1024;
constexpr size_t MOE_RW_OFF = 512 * 1024 + 3 * MB;
constexpr size_t OFF_WT = 5 * MB;
constexpr size_t OFF_H = 49 * MB;
constexpr size_t OFF_BR = 113 * MB;
constexpr size_t OFF_PROJ = 209 * MB;
constexpr size_t OFF_MERGED = OFF_PROJ + 128 * MB;
constexpr size_t OFF_STREAM = OFF_PROJ + 195 * MB;
constexpr size_t PO_AQ = 0, PO_AK = 32 * MB, PO_AV = 64 * MB, PO_BQ = 96 * MB, PO_BK = 128 * MB, PO_BV = 136 * MB, PO_CQ = 144 * MB,
                 PO_CK = 176 * MB, PO_CV = 180 * MB, PO_IQ = 184 * MB, PO_IK = 192 * MB, PO_IW = 194 * MB;

struct Params {
    const float* in[20];
    float* out;
    char* ws;
};
typedef const __attribute__((address_space(4))) char* kaptr_t;
struct KAIn { kaptr_t base; __device__ __forceinline__ const float* operator[](int i) const { return *(const float* const __attribute__((address_space(4)))*)(base + 8 * i); } };
struct KA { KAIn in; float* out; char* ws; };
__device__ __forceinline__ KA ka_get() {
    kaptr_t p = (kaptr_t)__builtin_amdgcn_kernarg_segment_ptr(); asm volatile("" : "+s"(p));
    KA k; k.in.base = p; k.out = *(float* const __attribute__((address_space(4)))*)(p + 160); k.ws = *(char* const __attribute__((address_space(4)))*)(p + 168); return k;
}
enum { I_X = 0, I_RELB, I_NMG, I_WIN, I_QKG, I_LAM, I_SUBLN, I_SINK, I_WBR, I_WGATE, I_BGATE, I_WOUT, I_NFG, I_WRG, I_BRG, I_WRE, I_BRE, I_WFG, I_WFU, I_WFD };

struct Proj { bf16_t *aq, *ak, *av, *bq, *bk, *bv, *cq, *ck, *cv, *iq, *ik; float* iw; };
__device__ __forceinline__ Proj proj_ptrs(char* ws) {
    char* p = ws + OFF_PROJ; Proj r;
    r.aq = (bf16_t*)(p + PO_AQ); r.ak = (bf16_t*)(p + PO_AK); r.av = (bf16_t*)(p + PO_AV); r.bq = (bf16_t*)(p + PO_BQ); r.bk = (bf16_t*)(p + PO_BK); r.bv = (bf16_t*)(p + PO_BV);
    r.cq = (bf16_t*)(p + PO_CQ); r.ck = (bf16_t*)(p + PO_CK); r.cv = (bf16_t*)(p + PO_CV); r.iq = (bf16_t*)(p + PO_IQ); r.ik = (bf16_t*)(p + PO_IK); r.iw = (float*)(p + PO_IW);
    return r;
}

__device__ __forceinline__ int tid_opaque() { int t = threadIdx.x; asm volatile("" : "+v"(t)); return t; }
#define PROF_LDS_OFF (147456 - 32)
#define PROF_BEGIN(id) unsigned long long _pt##id = 0; if (PROF_ID == (id) || ((id) == 99 && PROF_ID != 0)) _pt##id = __builtin_amdgcn_s_memrealtime();
#define PROF_END(id, smem_) if (PROF_ID == (id) && threadIdx.x == 0) { *(volatile LAS unsigned*)((LAS char*)(smem_) + PROF_LDS_OFF) += (unsigned)(__builtin_amdgcn_s_memrealtime() - _pt##id); }
__device__ __forceinline__ float bf2f(bf16_t b) { return __uint_as_float(((unsigned)b) << 16); }
__device__ __forceinline__ bf16_t f2bf(float f) { unsigned u = __float_as_uint(f); u += 0x7FFFu + ((u >> 16) & 1u); return (bf16_t)(u >> 16); }
__device__ __forceinline__ float bflo(unsigned w) { return __uint_as_float(w << 16); }
__device__ __forceinline__ float bfhi(unsigned w) { return __uint_as_float(w & 0xffff0000u); }
__device__ __forceinline__ unsigned pack2(float lo, float hi) { return (unsigned)f2bf(lo) | ((unsigned)f2bf(hi) << 16); }
__device__ __forceinline__ unsigned pack2hw(float lo, float hi) { unsigned r; asm volatile("v_cvt_pk_bf16_f32 %0, %1, %2" : "=v"(r) : "v"(lo), "v"(hi)); return r; }
__device__ __forceinline__ int wave_sum_dpp(int v) {
    v += __builtin_amdgcn_update_dpp(0, v, 0x111, 0xf, 0xf, true);
    v += __builtin_amdgcn_update_dpp(0, v, 0x112, 0xf, 0xf, true);
    v += __builtin_amdgcn_update_dpp(0, v, 0x114, 0xf, 0xf, true);
    v += __builtin_amdgcn_update_dpp(0, v, 0x118, 0xf, 0xf, true);
    v += __builtin_amdgcn_update_dpp(0, v, 0x142, 0xa, 0xf, true);
    v += __builtin_amdgcn_update_dpp(0, v, 0x143, 0xc, 0xf, true);
    return __builtin_amdgcn_readlane(v, 63);
}
__device__ __forceinline__ float x32_max(float v) { const auto r = __builtin_amdgcn_permlane32_swap(__float_as_uint(v), __float_as_uint(v), false, false); return fmaxf(__uint_as_float(r[0]), __uint_as_float(r[1])); }
__device__ __forceinline__ float x32_sum(float v) { const auto r = __builtin_amdgcn_permlane32_swap(__float_as_uint(v), __float_as_uint(v), false, false); return __uint_as_float(r[0]) + __uint_as_float(r[1]); }
__device__ __forceinline__ float x16_max(float v) { const auto r = __builtin_amdgcn_permlane16_swap(__float_as_uint(v), __float_as_uint(v), false, false); return fmaxf(__uint_as_float(r[0]), __uint_as_float(r[1])); }
__device__ __forceinline__ float x16_sum(float v) { const auto r = __builtin_amdgcn_permlane16_swap(__float_as_uint(v), __float_as_uint(v), false, false); return __uint_as_float(r[0]) + __uint_as_float(r[1]); }
__device__ __forceinline__ float wsum_dpp(float v) {
    v += __builtin_bit_cast(float, __builtin_amdgcn_update_dpp(0, __builtin_bit_cast(int, v), 0x111, 0xf, 0xf, true));
    v += __builtin_bit_cast(float, __builtin_amdgcn_update_dpp(0, __builtin_bit_cast(int, v), 0x112, 0xf, 0xf, true));
    v += __builtin_bit_cast(float, __builtin_amdgcn_update_dpp(0, __builtin_bit_cast(int, v), 0x114, 0xf, 0xf, true));
    v += __builtin_bit_cast(float, __builtin_amdgcn_update_dpp(0, __builtin_bit_cast(int, v), 0x118, 0xf, 0xf, true));
    v += __builtin_bit_cast(float, __builtin_amdgcn_update_dpp(0, __builtin_bit_cast(int, v), 0x142, 0xa, 0xf, true));
    v += __builtin_bit_cast(float, __builtin_amdgcn_update_dpp(0, __builtin_bit_cast(int, v), 0x143, 0xc, 0xf, true));
    return __builtin_bit_cast(float, __builtin_amdgcn_readlane(__builtin_bit_cast(int, v), 63));
}
__device__ __forceinline__ float wsum(float v) { for (int o = 32; o; o >>= 1) v += __shfl_xor(v, o); return v; }
__device__ __forceinline__ float wmax(float v) { for (int o = 32; o; o >>= 1) v = fmaxf(v, __shfl_xor(v, o)); return v; }
__device__ __forceinline__ int t5_bucket(int rel) {
    const int n = rel < 0 ? -rel : rel;
    int b = n;
    if (n >= 8) b = 8 + (n >= 15) + (n >= 27) + (n >= 50) + (n >= 91) + (n >= 166) + (n >= 305) + (n >= 559);
    return (rel > 0 ? 16 : 0) + b;
}
__device__ __forceinline__ float lambda_init_of(int l) { return 0.8f - 0.6f * expf(-0.3f * (float)l); }
__device__ __forceinline__ float dot8(uint4 kv, const float* q) {
    return bflo(kv.x) * q[0] + bfhi(kv.x) * q[1] + bflo(kv.y) * q[2] + bfhi(kv.y) * q[3] + bflo(kv.z) * q[4] + bfhi(kv.z) * q[5] + bflo(kv.w) * q[6] + bfhi(kv.w) * q[7];
}


#define XB_TMO      128
#define XB_XCNT(j)  (256  + 64 * (j))
#define XB_XSUB(j)  (1280 + 64 * (j))
#define XB_XGEN(j)  (2304 + 64 * (j))
#define XB_TOP      3328
#define XB_TOPGEN   3392
#define XCD_BAR_WORDS 3456
#define XB_SPIN_CAP (1u << 22)
__device__ __forceinline__ unsigned xb_ld(unsigned* p)              { return __hip_atomic_load(p, __ATOMIC_RELAXED, __HIP_MEMORY_SCOPE_AGENT); }
__device__ __forceinline__ unsigned xb_add(unsigned* p, unsigned v) { return __hip_atomic_fetch_add(p, v, __ATOMIC_RELAXED, __HIP_MEMORY_SCOPE_AGENT); }
__device__ __forceinline__ unsigned xb_xcc_id() { return (unsigned)__builtin_amdgcn_s_getreg((3 << 11) | 20) & 0xFu; }
#define XB_SPIN(cond, bar) do { unsigned _sp = 0; while (cond) { __builtin_amdgcn_s_sleep(1); \
    if ((++_sp & 255u) == 0u) { if (xb_ld(&(bar)[XB_TMO])) break; if (_sp > XB_SPIN_CAP) { atomicAdd(&(bar)[XB_TMO], 1u); break; } } } } while (0)
struct XcdBarrier { unsigned* bar; unsigned x; volatile LAS unsigned* st; };
__device__ __forceinline__ XcdBarrier xcd_barrier_post(unsigned* bar, volatile LAS unsigned* st) {
    XcdBarrier b; b.bar = bar; b.x = xb_xcc_id(); b.st = st;
    if (threadIdx.x == 0) (void)xb_add(&bar[XB_XCNT(b.x)], 1u);
    return b;
}
__device__ __forceinline__ void xcd_barrier_complete(unsigned* bar, unsigned x, unsigned& nloc, unsigned& nx) {
    const unsigned G = gridDim.x * gridDim.y * gridDim.z;
    unsigned sum, cnt, mine, sp = 0u;
    for (;;) {
        sum = 0u; cnt = 0u; mine = 0u;
#pragma unroll
        for (unsigned j = 0; j < 16; ++j) { const unsigned c = xb_ld(&bar[XB_XCNT(j)]); sum += c; cnt += (c > 0u) ? 1u : 0u; mine = (j == x) ? c : mine; }
        if (sum == G) break;
        __builtin_amdgcn_s_sleep(1);
        if ((++sp & 255u) == 0u) { if (xb_ld(&bar[XB_TMO])) break; if (sp > XB_SPIN_CAP) { atomicAdd(&bar[XB_TMO], 1u); break; } }
    }
    nloc = mine > 0u ? mine : 1u; nx = cnt > 0u ? cnt : 1u;
}
__device__ __forceinline__ void xcd_barrier(const XcdBarrier& b) {
    asm volatile("s_waitcnt vmcnt(0)" ::: "memory");
    __syncthreads();
    if (threadIdx.x == 0) {
        unsigned* bar = b.bar;
        __builtin_amdgcn_s_waitcnt(0);
        unsigned nloc = b.st[0], nx = b.st[1];
        if (nloc == 0u) { xcd_barrier_complete(bar, b.x, nloc, nx); b.st[0] = nloc; b.st[1] = nx; }
        const unsigned old = xb_add(&bar[XB_XSUB(b.x)], 1u);
        const unsigned gen = old / nloc;
        if (old + 1u == (gen + 1u) * nloc) {
            __builtin_amdgcn_fence(__ATOMIC_RELEASE, "agent");
            asm volatile("s_waitcnt vmcnt(0)" ::: "memory");
            const unsigned og = xb_add(&bar[XB_TOP], 1u);
            const unsigned tg = og / nx;
            if (og + 1u == (tg + 1u) * nx) xb_add(&bar[XB_TOPGEN], 1u);
            else XB_SPIN(xb_ld(&bar[XB_TOPGEN]) == tg, bar);
            __builtin_amdgcn_fence(__ATOMIC_ACQUIRE, "agent");
            xb_add(&bar[XB_XGEN(b.x)], 1u);
            asm volatile("s_waitcnt vmcnt(0)" ::: "memory");
        } else {
            XB_SPIN(xb_ld(&bar[XB_XGEN(b.x)]) == gen, bar);
            __builtin_amdgcn_fence(__ATOMIC_ACQUIRE, "agent");
            asm volatile("s_waitcnt vmcnt(0)" ::: "memory");
        }
    }
    __syncthreads();
}

__device__ __forceinline__ void ngemm_tile(const bf16_t* A, int lda, const float* W, int ldw, int K, int ncols, int row0, int col0, float (&acc)[8][4], float* lds) {
    float* As = lds; float* Bs = lds + 16 * 132;
    const int tid = tid_opaque(), ty = tid >> 5, tx = tid & 31;
#pragma unroll
    for (int i = 0; i < 8; ++i)
#pragma unroll
        for (int j = 0; j < 4; ++j) acc[i][j] = 0.f;
    for (int k0 = 0; k0 < K; k0 += 16) {
        {
            const int r = tid >> 2, kq = (tid & 3) * 4;
            const uint2 v = *(const uint2*)(A + (size_t)(row0 + r) * lda + k0 + kq);
            As[(kq + 0) * 132 + r] = bflo(v.x); As[(kq + 1) * 132 + r] = bfhi(v.x); As[(kq + 2) * 132 + r] = bflo(v.y); As[(kq + 3) * 132 + r] = bfhi(v.y);
        }
        {
            const int k = tid >> 5, c = (tid & 31) * 4;
            const float* wp = W + (size_t)(k0 + k) * ldw + col0 + c;
            float4 v = make_float4(0.f, 0.f, 0.f, 0.f);
            if (col0 + c + 3 < ncols) v = *(const float4*)wp;
            else { if (col0 + c < ncols) v.x = wp[0]; if (col0 + c + 1 < ncols) v.y = wp[1]; if (col0 + c + 2 < ncols) v.z = wp[2]; }
            *(float4*)(Bs + k * 128 + c) = v;
        }
        __syncthreads();
#pragma unroll 2
        for (int kk = 0; kk < 16; ++kk) {
            const float4 a0 = *(const float4*)(As + kk * 132 + ty * 8), a1 = *(const float4*)(As + kk * 132 + ty * 8 + 4);
            const float4 b = *(const float4*)(Bs + kk * 128 + tx * 4);
            const float a[8] = {a0.x, a0.y, a0.z, a0.w, a1.x, a1.y, a1.z, a1.w}; const float bb[4] = {b.x, b.y, b.z, b.w};
#pragma unroll
            for (int i = 0; i < 8; ++i)
#pragma unroll
                for (int j = 0; j < 4; ++j) acc[i][j] += a[i] * bb[j];
        }
        __syncthreads();
    }
}

__device__ __forceinline__ void ph_rmsnorm(const float* xsrc, const bf16_t* xs16, const float* g, bf16_t* H) {
    const int tidq = tid_opaque(); const int lane = tidq & 63, wid = tidq >> 6;
    float4 gv[4];
#pragma unroll
    for (int j = 0; j < 4; ++j) gv[j] = ((const float4*)g)[j * 64 + lane];
    for (int row0 = (blockIdx.x * 8 + wid) * 4; row0 < NTOK; row0 += gridDim.x * 32) {
        float4 v[4][4];
#pragma unroll
        for (int r = 0; r < 4; ++r) {
            if (xs16 == nullptr) { const float4* xp = (const float4*)(xsrc + (size_t)(row0 + r) * ND);
#pragma unroll
                for (int j = 0; j < 4; ++j) v[r][j] = xp[j * 64 + lane]; }
            else { const uint2* xp = (const uint2*)(xs16 + (size_t)(row0 + r) * ND);
#pragma unroll
                for (int j = 0; j < 4; ++j) { const uint2 w = xp[j * 64 + lane]; v[r][j] = make_float4(bflo(w.x), bfhi(w.x), bflo(w.y), bfhi(w.y)); } }
        }
#pragma unroll
        for (int r = 0; r < 4; ++r) {
            float ss = 0.f;
#pragma unroll
            for (int j = 0; j < 4; ++j) ss += v[r][j].x * v[r][j].x + v[r][j].y * v[r][j].y + v[r][j].z * v[r][j].z + v[r][j].w * v[r][j].w;
            ss = wsum_dpp(ss);
            const float rstd = rsqrtf(ss * (1.0f / ND) + EPS);
#pragma unroll
            for (int j = 0; j < 4; ++j) {
                uint2 o; o.x = pack2hw(v[r][j].x * rstd * gv[j].x, v[r][j].y * rstd * gv[j].y); o.y = pack2hw(v[r][j].z * rstd * gv[j].z, v[r][j].w * rstd * gv[j].w);
                *(uint2*)(H + (size_t)(row0 + r) * ND + (j * 64 + lane) * 4) = o;
            }
        }
    }
}

__device__ __forceinline__ void store_proj_raw(const Proj& pj, int tok, int c, float v) {
    if (c < 512) pj.aq[(size_t)tok * 512 + c] = f2bf(v);
    else if (c < 1024) pj.ak[(size_t)tok * 512 + c - 512] = f2bf(v);
    else if (c < 1536) pj.av[(size_t)tok * 512 + c - 1024] = f2bf(v);
    else if (c < 2048) pj.bq[(size_t)tok * 512 + c - 1536] = f2bf(v);
    else if (c < 2176) pj.bk[(size_t)tok * 128 + c - 2048] = f2bf(v);
    else if (c < 2304) pj.bv[(size_t)tok * 128 + c - 2176] = f2bf(v);
    else if (c < 2816) pj.cq[(size_t)tok * 512 + c - 2304] = f2bf(v);
    else if (c < 2880) pj.ck[(size_t)tok * 64 + c - 2816] = f2bf(v);
    else if (c < 2944) pj.cv[(size_t)tok * 64 + c - 2880] = f2bf(v);
    else if (c < 3072) pj.iq[(size_t)tok * 128 + c - 2944] = f2bf(v);
    else if (c < 3104) pj.ik[(size_t)tok * 32 + c - 3072] = f2bf(v);
    else if (c < 3108) pj.iw[(size_t)tok * 4 + c - 3104] = v * IWSCALE;
}
__device__ __forceinline__ void ph_inproj_naive(const Params& P_, int l, float* lds) {
    const KA P = ka_get();
    const Proj pj = proj_ptrs(P.ws);
    const bf16_t* H = (const bf16_t*)(P.ws + OFF_H);
    const float* W = P.in[I_WIN] + (size_t)l * ND * IN_COLS;
    const int tid = tid_opaque(), ty = tid >> 5, tx = tid & 31;
    for (int t = blockIdx.x; t < 256 * 25; t += gridDim.x) {
        const int tm = t / 25, tn = t % 25;
        float acc[8][4];
        ngemm_tile(H, ND, W, IN_COLS, ND, IN_COLS, tm * 128, tn * 128, acc, lds);
#pragma unroll
        for (int i = 0; i < 8; ++i)
#pragma unroll
            for (int j = 0; j < 4; ++j) { const int c = tn * 128 + tx * 4 + j; if (c < IN_COLS) store_proj_raw(pj, tm * 128 + ty * 8 + i, c, acc[i][j]); }
    }
}
__device__ __forceinline__ void ph_headnorm_naive(const Params& P_, int l) {
    const KA P = ka_get();
    const Proj pj = proj_ptrs(P.ws);
    const float* qkg = P.in[I_QKG] + (size_t)l * 3 * 2 * 64;
    const int tidq = tid_opaque(); const int lane = tidq & 63, wid = tidq >> 6;
    for (long t = (long)blockIdx.x * 8 + wid; t < (long)NTOK * 35; t += (long)gridDim.x * 8) {
        const int tok = (int)(t / 35), g = (int)(t % 35);
        bf16_t* p; const float* gv; float sc = 1.f;
        if (g < 8) { p = pj.aq + (size_t)tok * 512 + g * 64; gv = qkg + 0; sc = QSCALE; }
        else if (g < 16) { p = pj.ak + (size_t)tok * 512 + (g - 8) * 64; gv = qkg + 64; }
        else if (g < 24) { p = pj.bq + (size_t)tok * 512 + (g - 16) * 64; gv = qkg + 128; sc = QSCALE; }
        else if (g < 26) { p = pj.bk + (size_t)tok * 128 + (g - 24) * 64; gv = qkg + 192; }
        else if (g < 34) { p = pj.cq + (size_t)tok * 512 + (g - 26) * 64; gv = qkg + 256; sc = QSCALE; }
        else { p = pj.ck + (size_t)tok * 64; gv = qkg + 320; }
        const float v = bf2f(p[lane]);
        const float ss = wsum(v * v);
        p[lane] = f2bf(v * rsqrtf(ss * (1.0f / 64) + EPS) * gv[lane] * sc);
    }
}

__device__ __forceinline__ void ph_attnA_naive(const Params& P_, int l, float* lds) {
    const KA P = ka_get();
    const Proj pj = proj_ptrs(P.ws);
    bf16_t* BR = (bf16_t*)(P.ws + OFF_BR);
    const int tidq = tid_opaque(); const int lane = tidq & 63, wid = tidq >> 6;
    float* btab = lds;
    float* qs = lds + 128 + wid * 128;
    for (int i = tidq; i < 128; i += 512) btab[i] = P.in[I_RELB][(i >> 2) * 20 + (i & 3)] * LOG2E;
    __syncthreads();
    const float* lp = P.in[I_LAM] + (size_t)l * 256;
    const float linit = lambda_init_of(l);
    const float lam = expf(wsum(lp[lane] * lp[64 + lane])) - expf(wsum(lp[128 + lane] * lp[192 + lane])) + linit;
    const float* subg = P.in[I_SUBLN] + (size_t)l * 128;
    for (int t = blockIdx.x * 8 + wid; t < NB * 4 * NS; t += gridDim.x * 8) {
        const int q = t & (NS - 1), h = (t >> 12) & 3, b = t >> 14;
        const int tok = b * NS + q;
        qs[lane] = bf2f(pj.aq[(size_t)tok * 512 + (h * 2) * 64 + lane]);
        qs[64 + lane] = bf2f(pj.aq[(size_t)tok * 512 + (h * 2 + 1) * 64 + lane]);
        const int nkt = (q >> 6) + 1;
        float M0 = -INFINITY, Z0 = 0.f, M1 = -INFINITY, Z1 = 0.f;
        for (int kt = 0; kt < nkt; ++kt) {
            asm volatile("" ::: "memory");
            const int key = kt * 64 + lane;
            const uint4* kp = (const uint4*)(pj.ak + (size_t)(b * NS + key) * 512 + h * 128);
            float s0 = 0.f, s1 = 0.f;
#pragma unroll 1
            for (int d = 0; d < 8; ++d) { asm volatile("" ::: "memory"); s0 += dot8(kp[d], qs + d * 8); s1 += dot8(kp[8 + d], qs + 64 + d * 8); }
            const float bias = btab[t5_bucket(key - q) * 4 + h];
            s0 += bias; s1 += bias;
            float mn = fmaxf(M0, s0); Z0 = Z0 * exp2f(M0 - mn) + exp2f(s0 - mn); M0 = mn;
            mn = fmaxf(M1, s1); Z1 = Z1 * exp2f(M1 - mn) + exp2f(s1 - mn); M1 = mn;
        }
        { const float mw = wmax(M0); Z0 = wsum(Z0 * exp2f(M0 - mw)); M0 = mw; }
        { const float mw = wmax(M1); Z1 = wsum(Z1 * exp2f(M1 - mw)); M1 = mw; }
        const float iz0 = 1.f / Z0, iz1 = lam / Z1;
        float a0 = 0.f, a1 = 0.f;
        for (int kt = 0; kt < nkt; ++kt) {
            asm volatile("" ::: "memory");
            const int key = kt * 64 + lane;
            const uint4* kp = (const uint4*)(pj.ak + (size_t)(b * NS + key) * 512 + h * 128);
            float s0 = 0.f, s1 = 0.f;
#pragma unroll 1
            for (int d = 0; d < 8; ++d) { asm volatile("" ::: "memory"); s0 += dot8(kp[d], qs + d * 8); s1 += dot8(kp[8 + d], qs + 64 + d * 8); }
            const float bias = btab[t5_bucket(key - q) * 4 + h];
            const float p = exp2f(s0 + bias - M0) * iz0 - exp2f(s1 + bias - M1) * iz1;
            const unsigned* vp = (const unsigned*)(pj.av + (size_t)(b * NS + kt * 64) * 512 + h * 128) + lane;
#pragma unroll 4
            for (int j = 0; j < 64; ++j) { const float pjv = __shfl(p, j); const unsigned w = vp[(size_t)j * 256]; a0 += pjv * bflo(w); a1 += pjv * bfhi(w); }
        }
        const float ss = wsum(a0 * a0 + a1 * a1);
        const float rstd = rsqrtf(ss * (1.0f / 128) + EPS) * (1.0f - linit);
        *(unsigned*)(BR + (size_t)tok * 1536 + h * 128 + lane * 2) = pack2(a0 * rstd * subg[lane * 2], a1 * rstd * subg[lane * 2 + 1]);
    }
}

__device__ __forceinline__ void ph_attnB_naive(const Params& P_, int l, float* lds) {
    const KA P = ka_get();
    const Proj pj = proj_ptrs(P.ws);
    bf16_t* BR = (bf16_t*)(P.ws + OFF_BR);
    const int tidq = tid_opaque(); const int lane = tidq & 63, wid = tidq >> 6;
    float* btab = lds;
    float* qs = lds + 256 + wid * 64;
    __syncthreads();
    for (int i = tidq; i < 256; i += 512) btab[i] = P.in[I_RELB][(i >> 3) * 20 + 4 + (i & 7)] * LOG2E;
    __syncthreads();
    const float* sinks = P.in[I_SINK] + (size_t)l * 8;
    for (int t = blockIdx.x * 8 + wid; t < NTOK * 8; t += gridDim.x * 8) {
        const int hq = t & 7, tok = t >> 3, q = tok & (NS - 1), b = tok >> 12, kvh = hq >> 2, c = q >> 6;
        qs[lane] = bf2f(pj.bq[(size_t)tok * 512 + hq * 64 + lane]);
        float s[3];
#pragma unroll
        for (int g = 0; g < 3; ++g) {
            const int pos = c * 64 - 128 + g * 64 + lane;
            s[g] = -INFINITY;
            if (pos >= 0) {
                const uint4* kp = (const uint4*)(pj.bk + (size_t)(b * NS + pos) * 128 + kvh * 64);
                float a = 0.f;
#pragma unroll
                for (int d = 0; d < 8; ++d) a += dot8(kp[d], qs + d * 8);
                s[g] = a + btab[t5_bucket(pos - q) * 8 + hq];
            }
        }
        const float sink = sinks[hq] * LOG2E;
        const float m = fmaxf(wmax(fmaxf(fmaxf(s[0], s[1]), s[2])), sink);
        float e[3];
#pragma unroll
        for (int g = 0; g < 3; ++g) e[g] = exp2f(s[g] - m);
        const float Z = wsum(e[0] + e[1] + e[2]) + exp2f(sink - m);
        const float iz = 1.f / Z;
        float acc = 0.f;
#pragma unroll
        for (int g = 0; g < 3; ++g) {
            const int pos0 = c * 64 - 128 + g * 64;
            if (pos0 >= 0) {
                const bf16_t* vp = pj.bv + (size_t)(b * NS + pos0) * 128 + kvh * 64 + lane;
#pragma unroll 4
                for (int j = 0; j < 64; ++j) acc += __shfl(e[g], j) * bf2f(vp[(size_t)j * 128]);
            }
        }
        BR[(size_t)tok * 1536 + 512 + hq * 64 + lane] = f2bf(acc * iz);
    }
}

__device__ __forceinline__ void ph_attnC_naive(const Params& P_, int l, float* lds) {
    const KA P = ka_get();
    const Proj pj = proj_ptrs(P.ws);
    bf16_t* BR = (bf16_t*)(P.ws + OFF_BR);
    const int tidq = tid_opaque(); const int lane = tidq & 63, wid = tidq >> 6;
    float* btab = lds;
    unsigned* keys = (unsigned*)(lds + 256) + wid * 4480;
    int* sel = (int*)(keys + 4096);
    float* iqs = (float*)(keys + 4096 + 256);
    __syncthreads();
    for (int i = tidq; i < 256; i += 512) btab[i] = P.in[I_RELB][(i >> 3) * 20 + 12 + (i & 7)] * LOG2E;
    __syncthreads();
    for (int tok = blockIdx.x * 8 + wid; tok < NTOK; tok += gridDim.x * 8) {
        const int q = tok & (NS - 1), b = tok >> 12, c = q >> 6, N = (c + 1) * 64, ntile = c + 1;
        iqs[lane] = bf2f(pj.iq[(size_t)tok * 128 + lane]); iqs[64 + lane] = bf2f(pj.iq[(size_t)tok * 128 + 64 + lane]);
        const float4 wv = *(const float4*)(pj.iw + (size_t)tok * 4);
        int cnt;
        if (N <= 256) { for (int i = lane; i < N; i += 64) sel[i] = i; cnt = N; }
        else {
            for (int kt = 0; kt < ntile; ++kt) {
                asm volatile("" ::: "memory");
                const int key = kt * 64 + lane;
                const uint4* kp = (const uint4*)(pj.ik + (size_t)(b * NS + key) * 32);
                const uint4 k0 = kp[0], k1 = kp[1], k2 = kp[2], k3 = kp[3];
                float sc = 0.f;
#pragma unroll
                for (int hh = 0; hh < 4; ++hh) {
                    const float lg = dot8(k0, iqs + hh * 32) + dot8(k1, iqs + hh * 32 + 8) + dot8(k2, iqs + hh * 32 + 16) + dot8(k3, iqs + hh * 32 + 24);
                    const float w = hh == 0 ? wv.x : hh == 1 ? wv.y : hh == 2 ? wv.z : wv.w;
                    sc += fmaxf(lg, 0.f) * w;
                }
                sc += 0.0f;
                const unsigned u = __float_as_uint(sc);
                keys[key] = (u & 0x80000000u) ? ~u : (u | 0x80000000u);
            }
            unsigned T = 0;
            for (int bit = 31; bit >= 0; --bit) {
                const unsigned cand = T | (1u << bit);
                int n = 0;
                for (int kt = 0; kt < ntile; ++kt) n += __popcll(__ballot(keys[kt * 64 + lane] >= cand));
                if (n >= 256) T = cand;
            }
            int ngt = 0;
            for (int kt = 0; kt < ntile; ++kt) ngt += __popcll(__ballot(keys[kt * 64 + lane] > T));
            const int need = 256 - ngt;
            int nsel = 0, neq = 0;
            const unsigned long long ltmask = (1ull << lane) - 1ull;
            for (int kt = 0; kt < ntile; ++kt) {
                const unsigned kv = keys[kt * 64 + lane];
                const unsigned long long eqm = __ballot(kv == T);
                const bool take = (kv > T) || (kv == T && (neq + __popcll(eqm & ltmask)) < need);
                const unsigned long long tm = __ballot(take);
                if (take) sel[nsel + __popcll(tm & ltmask)] = kt * 64 + lane;
                nsel += __popcll(tm); neq += __popcll(eqm);
            }
            cnt = 256;
        }
        int idx[4];
#pragma unroll
        for (int j = 0; j < 4; ++j) idx[j] = (lane + 64 * j < cnt) ? sel[lane + 64 * j] : 0;
        for (int h = 0; h < 8; ++h) {
            iqs[lane] = bf2f(pj.cq[(size_t)tok * 512 + h * 64 + lane]);
            const float* qv = iqs;
            float s[4];
#pragma unroll
            for (int j = 0; j < 4; ++j) {
                asm volatile("" ::: "memory");
                s[j] = -INFINITY;
                if (lane + 64 * j < cnt) {
                    const uint4* kp = (const uint4*)(pj.ck + (size_t)(b * NS + idx[j]) * 64);
                    float a = 0.f;
#pragma unroll
                    for (int d = 0; d < 8; ++d) a += dot8(kp[d], qv + d * 8);
                    s[j] = a + btab[t5_bucket(idx[j] - q) * 8 + h];
                }
            }
            const float m = wmax(fmaxf(fmaxf(s[0], s[1]), fmaxf(s[2], s[3])));
            float e[4];
#pragma unroll
            for (int j = 0; j < 4; ++j) e[j] = exp2f(s[j] - m);
            const float iz = 1.f / wsum(e[0] + e[1] + e[2] + e[3]);
            float acc = 0.f;
#pragma unroll
            for (int j = 0; j < 4; ++j) {
                const int nj = cnt - 64 * j < 64 ? cnt - 64 * j : 64;
#pragma unroll 2
                for (int i = 0; i < nj; ++i) { const float pv = __shfl(e[j], i); const int id = __shfl(idx[j], i); acc += pv * bf2f(pj.cv[(size_t)(b * NS + id) * 64 + lane]); }
            }
            BR[(size_t)tok * 1536 + 1024 + h * 64 + lane] = f2bf(acc * iz);
        }
    }
}

__device__ __forceinline__ void ph_gatebranch_naive(const Params& P_, int l, float* lds) {
    const KA P = ka_get();
    const bf16_t* H = (const bf16_t*)(P.ws + OFF_H);
    const bf16_t* BR = (const bf16_t*)(P.ws + OFF_BR);
    bf16_t* MG = (bf16_t*)(P.ws + OFF_MERGED);
    const float* Wg = P.in[I_WGATE] + (size_t)l * ND * 3072;
    const float* bg = P.in[I_BGATE] + (size_t)l * 3072;
    const float* Wb = P.in[I_WBR] + (size_t)l * 3 * 512 * ND;
    const int tid = tid_opaque(), ty = tid >> 5, tx = tid & 31;
    for (int t = blockIdx.x; t < 256 * 8; t += gridDim.x) {
        const int tm = t >> 3, tn = t & 7;
        float m[8][4];
#pragma unroll
        for (int i = 0; i < 8; ++i)
#pragma unroll
            for (int j = 0; j < 4; ++j) m[i][j] = 0.f;
        for (int n = 0; n < 3; ++n) {
            float g[8][4], y[8][4];
            ngemm_tile(H, ND, Wg, 3072, ND, 3072, tm * 128, n * 1024 + tn * 128, g, lds);
            ngemm_tile(BR + n * 512, 1536, Wb + (size_t)n * 512 * ND, ND, 512, ND, tm * 128, tn * 128, y, lds);
#pragma unroll
            for (int i = 0; i < 8; ++i)
#pragma unroll
                for (int j = 0; j < 4; ++j) { const float z = g[i][j] + bg[n * 1024 + tn * 128 + tx * 4 + j]; m[i][j] += y[i][j] / (1.f + expf(-z)); }
        }
#pragma unroll
        for (int i = 0; i < 8; ++i) {
            uint2 o; o.x = pack2(m[i][0], m[i][1]); o.y = pack2(m[i][2], m[i][3]);
            *(uint2*)(MG + (size_t)(tm * 128 + ty * 8 + i) * ND + tn * 128 + tx * 4) = o;
        }
    }
}
__device__ __forceinline__ void ph_out_naive(const Params& P_, int l, float* lds) {
    const KA P = ka_get();
    const bf16_t* MG = (const bf16_t*)(P.ws + OFF_MERGED);
    const float* W = P.in[I_WOUT] + (size_t)l * ND * ND;
    const float* xsrc = l == 0 ? P.in[I_X] : P.out;
    const int tid = tid_opaque(), ty = tid >> 5, tx = tid & 31;
    for (int t = blockIdx.x; t < 256 * 8; t += gridDim.x) {
        const int tm = t >> 3, tn = t & 7;
        float acc[8][4];
        ngemm_tile(MG, ND, W, ND, ND, ND, tm * 128, tn * 128, acc, lds);
#pragma unroll
        for (int i = 0; i < 8; ++i) {
            const size_t o = (size_t)(tm * 128 + ty * 8 + i) * ND + tn * 128 + tx * 4;
            const float4 xv = *(const float4*)(xsrc + o);
            *(float4*)(P.out + o) = make_float4(xv.x + acc[i][0], xv.y + acc[i][1], xv.z + acc[i][2], xv.w + acc[i][3]);
        }
    }
}

__device__ __forceinline__ void ph_norm2_route(const Params& P_, int l, float* lds_) {
    const KA P = ka_get();
    bf16_t* H = (bf16_t*)(P.ws + OFF_H);
    int* eid = (int*)(P.ws + OFF_ROUTE); float* ew = (float*)(P.ws + OFF_ROUTE + 256 * 1024);
    const float* g = P.in[I_NFG] + (size_t)l * ND;
    const float* wrg = P.in[I_WRG] + (size_t)l * ND * 4; const float* brg = P.in[I_BRG] + (size_t)l * 4;
    const float* wre = P.in[I_WRE] + (size_t)l * ND * 16; const float* bre = P.in[I_BRE] + (size_t)l * 16;
    const int tidq = tid_opaque(); const int lane = tidq & 63, wid = tidq >> 6;
    typedef float v4f __attribute__((ext_vector_type(4)));
    LAS v4f* wl = (LAS v4f*)lds_;
    __syncthreads();
    for (int idx = tidq; idx < 5120; idx += 512) {
        const int ln = idx & 63, t = idx >> 6, q = t % 5, je = t / 5, k = ((je >> 2) * 64 + ln) * 4 + (je & 3);
        wl[idx] = q == 0 ? *(const v4f*)(wrg + (size_t)k * 4) : *(const v4f*)(wre + (size_t)k * 16 + (q - 1) * 4);
    }
    __syncthreads();
    for (int row0 = (blockIdx.x * 8 + wid) * 2; row0 < NTOK; row0 += gridDim.x * 16) {
        float4 v[2][4]; float rstd[2];
#pragma unroll
        for (int r = 0; r < 2; ++r) { const uint2* xp = (const uint2*)((const bf16_t*)(P.ws + OFF_STREAM) + (size_t)(row0 + r) * ND);
#pragma unroll
            for (int j = 0; j < 4; ++j) { const uint2 w = xp[j * 64 + lane]; v[r][j] = make_float4(bflo(w.x), bfhi(w.x), bflo(w.y), bfhi(w.y)); } }
#pragma unroll
        for (int r = 0; r < 2; ++r) { float ss = 0.f;
#pragma unroll
            for (int j = 0; j < 4; ++j) ss += v[r][j].x * v[r][j].x + v[r][j].y * v[r][j].y + v[r][j].z * v[r][j].z + v[r][j].w * v[r][j].w;
            rstd[r] = rsqrtf(wsum_dpp(ss) * (1.0f / ND) + EPS); }
        float lg[2][20];
#pragma unroll
        for (int r = 0; r < 2; ++r)
#pragma unroll
            for (int i = 0; i < 20; ++i) lg[r][i] = 0.f;
#pragma unroll
        for (int j = 0; j < 4; ++j) {
            const int k0 = (j * 64 + lane) * 4;
            const float4 gv = ((const float4*)g)[j * 64 + lane];
            float hv[2][4];
#pragma unroll
            for (int r = 0; r < 2; ++r) {
                hv[r][0] = v[r][j].x * rstd[r] * gv.x; hv[r][1] = v[r][j].y * rstd[r] * gv.y; hv[r][2] = v[r][j].z * rstd[r] * gv.z; hv[r][3] = v[r][j].w * rstd[r] * gv.w;
                uint2 o; o.x = pack2hw(hv[r][0], hv[r][1]); o.y = pack2hw(hv[r][2], hv[r][3]);
                *(uint2*)(H + (size_t)(row0 + r) * ND + k0) = o;
            }
#pragma unroll
            for (int e = 0; e < 4; ++e) {
                const LAS v4f* wp = wl + ((j * 4 + e) * 5) * 64 + lane;
                const v4f wg4 = wp[0], w0 = wp[64], w1 = wp[128], w2 = wp[192], w3 = wp[256];
#pragma unroll
                for (int r = 0; r < 2; ++r) {
                    const float x = hv[r][e];
                    lg[r][0] += x * wg4.x; lg[r][1] += x * wg4.y; lg[r][2] += x * wg4.z; lg[r][3] += x * wg4.w;
                    lg[r][4] += x * w0.x; lg[r][5] += x * w0.y; lg[r][6] += x * w0.z; lg[r][7] += x * w0.w;
                    lg[r][8] += x * w1.x; lg[r][9] += x * w1.y; lg[r][10] += x * w1.z; lg[r][11] += x * w1.w;
                    lg[r][12] += x * w2.x; lg[r][13] += x * w2.y; lg[r][14] += x * w2.z; lg[r][15] += x * w2.w;
                    lg[r][16] += x * w3.x; lg[r][17] += x * w3.y; lg[r][18] += x * w3.z; lg[r][19] += x * w3.w;
                }
            }
            asm volatile("" ::: "memory");
        }
#pragma unroll
        for (int r = 0; r < 2; ++r)
#pragma unroll
            for (int i = 0; i < 20; ++i) lg[r][i] = wsum_dpp(lg[r][i]);
        if (lane < 2) {
            const int row = row0 + lane;
            float lgl[20];
#pragma unroll
            for (int i = 0; i < 20; ++i) lgl[i] = lane == 0 ? lg[0][i] : lg[1][i];
            float gl[4];
#pragma unroll
            for (int i = 0; i < 4; ++i) gl[i] = lgl[i] + brg[i];
            int gs = 0; float gm = gl[0];
#pragma unroll
            for (int i = 1; i < 4; ++i) if (gl[i] > gm) { gm = gl[i]; gs = i; }
            float zs = 0.f;
#pragma unroll
            for (int i = 0; i < 4; ++i) zs += expf(gl[i] - gm);
            const float pgroup = 1.f / zs;
            float el[4];
#pragma unroll
            for (int i = 0; i < 4; ++i) { el[i] = 0.f;
#pragma unroll
                for (int gq = 0; gq < 4; ++gq) if (gq == gs) el[i] = lgl[4 + gq * 4 + i] + bre[gq * 4 + i]; }
            int e1 = 0; float v1 = el[0];
#pragma unroll
            for (int i = 1; i < 4; ++i) if (el[i] > v1) { v1 = el[i]; e1 = i; }
            int e2 = -1; float v2 = -INFINITY;
#pragma unroll
            for (int i = 0; i < 4; ++i) if (i != e1 && el[i] > v2) { v2 = el[i]; e2 = i; }
            const float x2 = expf(v2 - v1), w1 = 1.f / (1.f + x2), w2 = x2 / (1.f + x2);
            eid[row * 2] = gs * 4 + e1; eid[row * 2 + 1] = gs * 4 + e2;
            ew[row * 2] = w1 * pgroup; ew[row * 2 + 1] = w2 * pgroup;
            const int lo = e1 < e2 ? e1 : e2, hi = e1 < e2 ? e2 : e1;
            const int bk = gs * 6 + (lo == 0 ? hi - 1 : (lo == 1 ? hi + 1 : 5));
            const int pos = atomicAdd((int*)(P.ws + OFF_CTRL + MOE_CNT_OFF) + l * 32 + bk, 1);
            ((int*)(P.ws + OFF_ROUTE + MOE_LIST_OFF))[bk * NTOK + pos] = row;
            float* rw = (float*)(P.ws + OFF_ROUTE + MOE_RW_OFF);
            rw[row * 2] = (e1 < e2 ? w1 : w2) * pgroup; rw[row * 2 + 1] = (e1 < e2 ? w2 : w1) * pgroup;
        }
    }
}

__device__ __forceinline__ void ph_moe_naive(const Params& P_, int l, float* lds) {
    const KA P = ka_get();
    const bf16_t* H = (const bf16_t*)(P.ws + OFF_H);
    const int* eid = (const int*)(P.ws + OFF_ROUTE); const float* ew = (const float*)(P.ws + OFF_ROUTE + 256 * 1024);
    const int tidq = tid_opaque(); const int lane = tidq & 63, wid = tidq >> 6;
    float* hs = lds + wid * 1280;
    float* hid = hs + 1024;
    for (int tok = blockIdx.x * 8 + wid; tok < NTOK; tok += gridDim.x * 8) {
#pragma unroll
        for (int j = 0; j < 4; ++j) { const uint2 w = *(const uint2*)(H + (size_t)tok * ND + (j * 64 + lane) * 4); float* d = hs + (j * 64 + lane) * 4; d[0] = bflo(w.x); d[1] = bfhi(w.x); d[2] = bflo(w.y); d[3] = bfhi(w.y); }
        float o[16];
#pragma unroll
        for (int i = 0; i < 16; ++i) o[i] = 0.f;
        for (int s = 0; s < 2; ++s) {
            const int e = eid[tok * 2 + s]; const float w = ew[tok * 2 + s];
            const float* wg = P.in[I_WFG] + ((size_t)l * 16 + e) * ND * 256;
            const float* wu = P.in[I_WFU] + ((size_t)l * 16 + e) * ND * 256;
            const float* wd = P.in[I_WFD] + ((size_t)l * 16 + e) * 256 * ND;
            float4 ga = make_float4(0.f, 0.f, 0.f, 0.f), ua = ga;
            for (int k = 0; k < ND; ++k) {
                const float hv = hs[k];
                const float4 a = *(const float4*)(wg + (size_t)k * 256 + lane * 4), u = *(const float4*)(wu + (size_t)k * 256 + lane * 4);
                ga.x += hv * a.x; ga.y += hv * a.y; ga.z += hv * a.z; ga.w += hv * a.w; ua.x += hv * u.x; ua.y += hv * u.y; ua.z += hv * u.z; ua.w += hv * u.w;
            }
            float4 hv4;
            hv4.x = ga.x / (1.f + expf(-ga.x)) * ua.x * w; hv4.y = ga.y / (1.f + expf(-ga.y)) * ua.y * w; hv4.z = ga.z / (1.f + expf(-ga.z)) * ua.z * w; hv4.w = ga.w / (1.f + expf(-ga.w)) * ua.w * w;
            *(float4*)(hid + lane * 4) = hv4;
            for (int f = 0; f < 256; ++f) {
                const float hf = hid[f];
#pragma unroll
                for (int j = 0; j < 4; ++j) { const float4 d = *(const float4*)(wd + (size_t)f * ND + (j * 64 + lane) * 4); o[j * 4] += hf * d.x; o[j * 4 + 1] += hf * d.y; o[j * 4 + 2] += hf * d.z; o[j * 4 + 3] += hf * d.w; }
            }
        }
#pragma unroll
        for (int j = 0; j < 4; ++j) {
            float4* op = (float4*)(P.out + (size_t)tok * ND + (j * 64 + lane) * 4);
            float4 x = *op; x.x += o[j * 4]; x.y += o[j * 4 + 1]; x.z += o[j * 4 + 2]; x.w += o[j * 4 + 3]; *op = x;
        }
    }
}


namespace mm {
typedef short bf16x8 __attribute__((ext_vector_type(8)));
typedef float f32x16 __attribute__((ext_vector_type(16)));
typedef float f32x4 __attribute__((ext_vector_type(4)));
typedef unsigned u32x4 __attribute__((ext_vector_type(4)));
constexpr int OPB = 256 * 128;
constexpr int STG = 2 * OPB;
constexpr int LDS_NEED = 2 * STG;
__host__ __device__ __forceinline__ int img_col(int rho) { const int i = rho & 31; return (rho & ~31) + 16 * ((i >> 2) & 1) + 4 * (i >> 3) + (i & 3); }
__device__ __forceinline__ unsigned cvt_pk_bf16(float lo, float hi) { unsigned r; asm volatile("v_cvt_pk_bf16_f32 %0, %1, %2" : "=v"(r) : "v"(lo), "v"(hi)); return r; }
__device__ __forceinline__ u32x4 pack8(const f32x16& v, int o) { u32x4 w; w.x = cvt_pk_bf16(v[o], v[o + 1]); w.y = cvt_pk_bf16(v[o + 2], v[o + 3]); w.z = cvt_pk_bf16(v[o + 4], v[o + 5]); w.w = cvt_pk_bf16(v[o + 6], v[o + 7]); return w; }

struct Unit {
    const char* a;
    const char* b0;
    const char* b1;
    int lda, ldb;
    int nk, nseg;
    int pm, pn, tag;
    int aux0, aux1;
};
__device__ __forceinline__ bool static_tile(long L, int nM, int nN, int& pm, int& pn) {
    const int nwg = nM * nN; if (L >= nwg) return false;
    int wgid = (int)L; { const int q = nwg / 8, r = nwg % 8, xcd = wgid % 8, off = wgid / 8; wgid = (xcd < r ? xcd * (q + 1) : r * (q + 1) + (xcd - r) * q) + off; }
    const int nig = 8 * nN, gid = wgid / nig, fm = gid * 8, gsz = (nM - fm) < 8 ? (nM - fm) : 8;
    pm = fm + ((wgid % nig) % gsz); pn = (wgid % nig) / gsz; return true;
}

template <class Epi, class Sched>
__device__ __forceinline__ void gemm_phase(char* smem, const Sched& S, const Epi& E) {
    const int tid = tid_opaque(), lane = tid & 63, wid = __builtin_amdgcn_readfirstlane(tid >> 6), wm = wid >> 2, wn = wid & 3, r32 = lane & 31, h = lane >> 5;
    LAS char* lds = (LAS char*)smem;
    const int srow = tid >> 3, sc = tid & 7;
    const unsigned sts = (unsigned)(srow * 128 + ((sc ^ ((srow >> 1) & 7)) << 4));
    const unsigned rda = (unsigned)((wm * 128 + r32) * 128), rdb = (unsigned)(OPB + (wn * 64 + r32) * 128);
    const unsigned x7 = (unsigned)((r32 >> 1) & 7);
    Unit lu; int ci = 0, li = 0;
    if (!S.next(0, lu)) return;
    int cnk = lu.nk;
    constexpr int NA = Sched::GATHER ? 4 : 1;
    unsigned ao[NA], bo;
    auto offs = [&](const Unit& u, unsigned (&a)[NA], unsigned& b) {
        int t2 = tid; asm volatile("" : "+v"(t2));
        const int r0 = t2 >> 3, c16 = (t2 & 7) * 16;
        S.a_rows(u, r0, a);
#pragma unroll
        for (int q = 0; q < NA; ++q) a[q] += (unsigned)c16;
        b = (unsigned)(r0 * u.ldb * 2 + c16);
    };
    offs(lu, ao, bo);
    f32x16 acc[4][2];
#pragma unroll
    for (int i = 0; i < 4; ++i)
#pragma unroll
        for (int j = 0; j < 2; ++j)
#pragma unroll
            for (int e = 0; e < 16; ++e) acc[i][j][e] = 0.f;
    u32x4 ga[4], gb[4];
#define MM_GLOAD(u, k, A_, B_) do { \
        const __amdgpu_buffer_rsrc_t ra_ = __builtin_amdgcn_make_buffer_rsrc((void*)(u).a, 0, 0x7fffffff, 0x00020000); \
        const __amdgpu_buffer_rsrc_t rb_ = __builtin_amdgcn_make_buffer_rsrc((void*)((k) < (u).nseg ? (u).b0 : (u).b1), 0, 0x7fffffff, 0x00020000); \
        const unsigned ko_ = (unsigned)(k) * 128u, as_ = (unsigned)(u).lda * 128u, bs_ = (unsigned)(u).ldb * 128u; \
        _Pragma("unroll") for (int q_ = 0; q_ < 4; ++q_) { \
            ga[q_] = __builtin_bit_cast(u32x4, __builtin_amdgcn_raw_buffer_load_b128(ra_, Sched::GATHER ? (A_)[q_ % NA] : (A_)[0], Sched::GATHER ? ko_ : ko_ + q_ * as_, 0)); \
            gb[q_] = __builtin_bit_cast(u32x4, __builtin_amdgcn_raw_buffer_load_b128(rb_, (B_), ko_ + q_ * bs_, 0)); } } while (0)
#define MM_LSTORE(buf) do { LAS char* p_ = lds + (buf) * STG + sts; \
        _Pragma("unroll") for (int q_ = 0; q_ < 4; ++q_) { *(LAS u32x4*)(p_ + q_ * 8192) = ga[q_]; *(LAS u32x4*)(p_ + OPB + q_ * 8192) = gb[q_]; } } while (0)
#define MM_LOADF(ks, AF, BF) do { const unsigned xo_ = (((unsigned)((ks) * 2 + h)) ^ x7) << 4; \
        _Pragma("unroll") for (int nt = 0; nt < 2; ++nt) BF[nt] = *(const LAS bf16x8*)(base + rdb + nt * 4096 + xo_); \
        _Pragma("unroll") for (int mt = 0; mt < 4; ++mt) AF[mt] = *(const LAS bf16x8*)(base + rda + mt * 4096 + xo_); } while (0)
#define MM_MMA(AF, BF) do { _Pragma("unroll") for (int mt = 0; mt < 4; ++mt) _Pragma("unroll") for (int nt = 0; nt < 2; ++nt) \
        acc[mt][nt] = Epi::TRANSP ? __builtin_amdgcn_mfma_f32_32x32x16_bf16(BF[nt], AF[mt], acc[mt][nt], 0, 0, 0) : __builtin_amdgcn_mfma_f32_32x32x16_bf16(AF[mt], BF[nt], acc[mt][nt], 0, 0, 0); } while (0)
#define MM_SB __builtin_amdgcn_sched_barrier(0)
    bool lvalid = true; int lk = 0;
    auto ladv = [&]() {
        if (++lk < lu.nk) return;
        lk = 0;
        Unit nu; if (S.next(li + 1, nu)) { lu = nu; ++li; offs(lu, ao, bo); } else lvalid = false;
    };
    MM_GLOAD(lu, 0, ao, bo);
    MM_LSTORE(0);
    ladv();
    if (lvalid) MM_GLOAD(lu, lk, ao, bo);
    __syncthreads();
    int buf = 0, ck = 0;
    for (;;) {
        const LAS char* base = lds + buf * STG;
        const bool pend = lvalid;
        if constexpr (Sched::PIPE) {
            bf16x8 af0[4], bf0[2], af1[4], bf1[2];
            MM_LOADF(0, af0, bf0); MM_SB;
            MM_LOADF(1, af1, bf1); MM_SB; MM_MMA(af0, bf0); MM_SB;
            MM_LOADF(2, af0, bf0); MM_SB; MM_MMA(af1, bf1); MM_SB;
            MM_LOADF(3, af1, bf1); MM_SB;
            if (pend) { MM_LSTORE(buf ^ 1); ladv(); if (lvalid) MM_GLOAD(lu, lk, ao, bo); }
            MM_SB; MM_MMA(af0, bf0); MM_SB; MM_MMA(af1, bf1); MM_SB;
        } else {
            bf16x8 af0[4], bf0[2];
            MM_LOADF(0, af0, bf0); MM_MMA(af0, bf0); MM_SB;
            MM_LOADF(1, af0, bf0); MM_MMA(af0, bf0); MM_SB;
            if (pend) { MM_LSTORE(buf ^ 1); ladv(); if (lvalid) MM_GLOAD(lu, lk, ao, bo); }
            MM_SB; MM_LOADF(2, af0, bf0); MM_MMA(af0, bf0); MM_SB;
            MM_LOADF(3, af0, bf0); MM_MMA(af0, bf0); MM_SB;
        }
        bool more = true;
        if (++ck == cnk) {
            { PROF_BEGIN(99) Unit eu; S.next(ci, eu); E(acc, eu, wm, wn, r32, h, tid); if (PROF_ID == Epi::PROF && threadIdx.x == 0) { *(volatile LAS unsigned*)(lds + PROF_LDS_OFF) += (unsigned)(__builtin_amdgcn_s_memrealtime() - _pt99); } }
#pragma unroll
            for (int i = 0; i < 4; ++i)
#pragma unroll
                for (int j = 0; j < 2; ++j)
#pragma unroll
                    for (int e = 0; e < 16; ++e) acc[i][j][e] = 0.f;
            ck = 0; ++ci;
            { Unit nu2; more = S.next(ci, nu2); if (more) cnk = nu2.nk; }
        }
        __syncthreads();
        buf ^= 1;
        if (!more) break;
    }
#undef MM_GLOAD
#undef MM_LSTORE
#undef MM_LOADF
#undef MM_MMA
#undef MM_SB
}
__device__ __forceinline__ void plain_rows(const Unit& u, int r0, unsigned (&a)[1]) { a[0] = (unsigned)(r0 * u.lda * 2); }
}

constexpr int EPI_TAB = 131072 + 2048;
constexpr size_t WT_IN = 0;
constexpr size_t WT_GATE = WT_IN + (size_t)3328 * 1024 * 2;
constexpr size_t WT_BR = WT_GATE + (size_t)3072 * 1024 * 2;
constexpr size_t WT_OUT = WT_BR + (size_t)3 * 1024 * 512 * 2;
constexpr size_t WT_GU = WT_OUT + (size_t)1024 * 1024 * 2;
constexpr size_t WT_DN = WT_GU + (size_t)16 * 512 * 1024 * 2;
constexpr size_t WT_END = WT_DN + (size_t)16 * 1024 * 256 * 2;
static_assert(WT_END <= 44 * MB, "weight image region");

template <class F>
__device__ __forceinline__ void cvt_tile(bf16_t* Bt, int K, int rho0, int k0, const float* W, int ldw, const F& colof, int tid) {
    const int rho = rho0 + (tid & 63) * 4, kg = k0 + (tid >> 6) * 16;
    const int c = colof(rho);
    float4 v[16];
#pragma unroll
    for (int j = 0; j < 16; ++j) v[j] = c >= 0 ? *(const float4*)(W + (size_t)(kg + j) * ldw + c) : make_float4(0.f, 0.f, 0.f, 0.f);
#pragma unroll
    for (int hf = 0; hf < 2; ++hf) {
        mm::u32x4 o;
        o.x = mm::cvt_pk_bf16(v[8 * hf + 0].x, v[8 * hf + 1].x); o.y = mm::cvt_pk_bf16(v[8 * hf + 2].x, v[8 * hf + 3].x); o.z = mm::cvt_pk_bf16(v[8 * hf + 4].x, v[8 * hf + 5].x); o.w = mm::cvt_pk_bf16(v[8 * hf + 6].x, v[8 * hf + 7].x); *(mm::u32x4*)(Bt + (size_t)(rho + 0) * K + kg + 8 * hf) = o;
        o.x = mm::cvt_pk_bf16(v[8 * hf + 0].y, v[8 * hf + 1].y); o.y = mm::cvt_pk_bf16(v[8 * hf + 2].y, v[8 * hf + 3].y); o.z = mm::cvt_pk_bf16(v[8 * hf + 4].y, v[8 * hf + 5].y); o.w = mm::cvt_pk_bf16(v[8 * hf + 6].y, v[8 * hf + 7].y); *(mm::u32x4*)(Bt + (size_t)(rho + 1) * K + kg + 8 * hf) = o;
        o.x = mm::cvt_pk_bf16(v[8 * hf + 0].z, v[8 * hf + 1].z); o.y = mm::cvt_pk_bf16(v[8 * hf + 2].z, v[8 * hf + 3].z); o.z = mm::cvt_pk_bf16(v[8 * hf + 4].z, v[8 * hf + 5].z); o.w = mm::cvt_pk_bf16(v[8 * hf + 6].z, v[8 * hf + 7].z); *(mm::u32x4*)(Bt + (size_t)(rho + 2) * K + kg + 8 * hf) = o;
        o.x = mm::cvt_pk_bf16(v[8 * hf + 0].w, v[8 * hf + 1].w); o.y = mm::cvt_pk_bf16(v[8 * hf + 2].w, v[8 * hf + 3].w); o.z = mm::cvt_pk_bf16(v[8 * hf + 4].w, v[8 * hf + 5].w); o.w = mm::cvt_pk_bf16(v[8 * hf + 6].w, v[8 * hf + 7].w); *(mm::u32x4*)(Bt + (size_t)(rho + 3) * K + kg + 8 * hf) = o;
    }
}
__device__ __forceinline__ void cvt_tile_pair(bf16_t* Bt, int K, int rho0, int k0, const float* W, int ldw, int tid) {
    const int rho = rho0 + (tid & 63) * 4, kg = k0 + (tid >> 6) * 16;
    const int nt = (rho >> 5) & 1, cb = (rho & ~63) + 2 * (rho & 31);
#pragma unroll
    for (int hf = 0; hf < 2; ++hf) {
        float va[8][4];
#pragma unroll
        for (int j = 0; j < 8; ++j) {
            const float4 lo = *(const float4*)(W + (size_t)(kg + 8 * hf + j) * ldw + cb), hi = *(const float4*)(W + (size_t)(kg + 8 * hf + j) * ldw + cb + 4);
            va[j][0] = nt ? lo.y : lo.x; va[j][1] = nt ? lo.w : lo.z; va[j][2] = nt ? hi.y : hi.x; va[j][3] = nt ? hi.w : hi.z;
        }
#pragma unroll
        for (int r = 0; r < 4; ++r) {
            mm::u32x4 o;
            o.x = mm::cvt_pk_bf16(va[0][r], va[1][r]); o.y = mm::cvt_pk_bf16(va[2][r], va[3][r]); o.z = mm::cvt_pk_bf16(va[4][r], va[5][r]); o.w = mm::cvt_pk_bf16(va[6][r], va[7][r]);
            *(mm::u32x4*)(Bt + (size_t)(rho + r) * K + kg + 8 * hf) = o;
        }
    }
}
__device__ __forceinline__ void ph_convert_weights(const Params& P_, int l) {
    const KA P = ka_get();
    const int tid = tid_opaque();
    char* wt = P.ws + OFF_WT;
    constexpr int T_IN = 13 * 8, T_GATE = 12 * 8, T_BR = 3 * 4 * 4, T_OUT = 4 * 8, T_GU = 16 * 2 * 8, T_DN = 16 * 4 * 2;
    constexpr int T_ALL = T_IN + T_GATE + T_BR + T_OUT + T_GU + T_DN;
    for (int t = blockIdx.x; t < T_ALL; t += gridDim.x) {
        int u = t;
        if (u < T_IN) {
            const float* W = P.in[I_WIN] + (size_t)l * ND * IN_COLS;
            cvt_tile((bf16_t*)(wt + WT_IN), 1024, (u >> 3) * 256, (u & 7) * 128, W, IN_COLS, [&](int rho) -> int { const int c = mm::img_col(rho); return c < IN_COLS ? c : -1; }, tid);
            continue;
        }
        u -= T_IN;
        if (u < T_GATE) {
            const float* W = P.in[I_WGATE] + (size_t)l * ND * 3072;
            cvt_tile((bf16_t*)(wt + WT_GATE), 1024, (u >> 3) * 256, (u & 7) * 128, W, 3072, [&](int rho) -> int { return mm::img_col(rho); }, tid);
            continue;
        }
        u -= T_GATE;
        if (u < T_BR) {
            const int n = u / 16, v = u % 16;
            const float* W = P.in[I_WBR] + ((size_t)l * 3 + n) * 512 * ND;
            cvt_tile((bf16_t*)(wt + WT_BR) + (size_t)n * 1024 * 512, 512, (v >> 2) * 256, (v & 3) * 128, W, ND, [&](int rho) -> int { return mm::img_col(rho); }, tid);
            continue;
        }
        u -= T_BR;
        if (u < T_OUT) {
            const float* W = P.in[I_WOUT] + (size_t)l * ND * ND;
            cvt_tile_pair((bf16_t*)(wt + WT_OUT), 1024, (u >> 3) * 256, (u & 7) * 128, W, ND, tid);
            continue;
        }
        u -= T_OUT;
        if (u < T_GU) {
            const int e = u / 16, v = u % 16;
            const float* Wg = P.in[I_WFG] + ((size_t)l * 16 + e) * ND * 256;
            const float* Wu = P.in[I_WFU] + ((size_t)l * 16 + e) * ND * 256;
            const int rho0 = (v >> 3) * 256;
            const float* Wsel = (((rho0 + (tid & 63) * 4) >> 5) & 1) ? Wu : Wg;
            cvt_tile((bf16_t*)(wt + WT_GU) + (size_t)e * 512 * 1024, 1024, rho0, (v & 7) * 128, Wsel, 256, [&](int rho) -> int {
                const int j = rho >> 8, wn = (rho >> 6) & 3; return j * 128 + wn * 32 + (mm::img_col(rho) & 31); }, tid);
            continue;
        }
        u -= T_GU;
        {
            const int e = u / 8, v = u % 8;
            const float* W = P.in[I_WFD] + ((size_t)l * 16 + e) * 256 * ND;
            cvt_tile_pair((bf16_t*)(wt + WT_DN) + (size_t)e * 1024 * 256, 256, (v >> 1) * 256, (v & 1) * 128, W, ND, tid);
        }
    }
}

struct SchedInProj {
    const char* A; const char* B; int mode;
    __device__ __forceinline__ bool next(int i, mm::Unit& u) const {
        int pm, pn; if (!mm::static_tile((long)i * gridDim.x + VBID, 128, 13, pm, pn)) return false;
        u.a = A + (size_t)pm * 256 * 1024 * 2; u.b0 = B + (size_t)pn * 256 * 1024 * 2; u.b1 = u.b0; u.lda = 1024; u.ldb = 1024; u.nk = 16; u.nseg = 16; u.pm = pm; u.pn = pn; u.tag = mode; return true;
    }
    static constexpr bool GATHER = false, PIPE = true;
    __device__ __forceinline__ void a_rows(const mm::Unit& u, int r0, unsigned (&a)[1]) const { mm::plain_rows(u, r0, a); }
};
struct EpiInProj {
    static constexpr bool TRANSP = true;
    static constexpr int PROF = 2;
    Proj pj; const float* qkg; const LAS float* gtab;
    __device__ __forceinline__ void operator()(mm::f32x16 (&acc)[4][2], const mm::Unit& u, int wm, int wn, int r32, int h, int tid) const {
        using namespace mm;
        asm volatile("" : "+v"(r32), "+v"(h));
        const int G = u.pn * 4 + wn;
        if (u.tag == 4) { if (acc[0][0][0] == 12345.678f) pj.aq[0] = 0; return; }
        if (u.tag == 3) { float t_ = 0.f;
#pragma unroll
            for (int i_ = 0; i_ < 4; ++i_) { t_ += acc[i_][0][3] + acc[i_][1][11] + acc[i_][0][7] + acc[i_][1][0]; }
            if (t_ == 12345.678f) pj.aq[0] = 0; return; }
        if (G > 48) return;
        bf16_t* dst; int tstride; const float* gv = nullptr; float sc = 1.f;
        if (G < 8) { dst = pj.aq + G * 64; tstride = 512; gv = qkg; sc = QSCALE; }
        else if (G < 16) { dst = pj.ak + (G - 8) * 64; tstride = 512; gv = qkg + 64; }
        else if (G < 24) { dst = pj.av + (G - 16) * 64; tstride = 512; }
        else if (G < 32) { dst = pj.bq + (G - 24) * 64; tstride = 512; gv = qkg + 128; sc = QSCALE; }
        else if (G < 34) { dst = pj.bk + (G - 32) * 64; tstride = 128; gv = qkg + 192; }
        else if (G < 36) { dst = pj.bv + (G - 34) * 64; tstride = 128; }
        else if (G < 44) { dst = pj.cq + (G - 36) * 64; tstride = 512; gv = qkg + 256; sc = QSCALE; }
        else if (G == 44) { dst = pj.ck; tstride = 64; gv = qkg + 320; }
        else if (G == 45) { dst = pj.cv; tstride = 64; }
        else if (G < 48) { dst = pj.iq + (G - 46) * 64; tstride = 128; }
        else { dst = pj.ik; tstride = 32; }
        if (u.tag == 8) { if (acc[0][0][0] == 12345.678f) dst[tstride] = 0; return; }
#pragma unroll 1
        for (int rep = 0; rep < (u.tag == 9 ? 4 : 1); ++rep)
#pragma unroll
        for (int mt = 0; mt < 4; ++mt) {
            asm volatile("" ::: "memory");
            const int row = u.pm * 256 + wm * 128 + mt * 32 + r32;
            f32x16& v0 = acc[mt][0]; f32x16& v1 = acc[mt][1];
            if (gv && u.tag != 7 && u.tag != 9) {
                float ss = 0.f;
#pragma unroll
                for (int e = 0; e < 16; ++e) ss += v0[e] * v0[e] + v1[e] * v1[e];
                ss = x32_sum(ss);
                const float rs = rsqrtf(ss * (1.0f / 64) + EPS) * sc;
#pragma unroll
                for (int e4 = 0; e4 < 4; ++e4) {
                    const f32x4 ga = *(const LAS f32x4*)(gtab + (gv - qkg) + 16 * h + 4 * e4), gb = *(const LAS f32x4*)(gtab + (gv - qkg) + 32 + 16 * h + 4 * e4);
#pragma unroll
                    for (int j = 0; j < 4; ++j) { v0[4 * e4 + j] *= rs * ga[j]; v1[4 * e4 + j] *= rs * gb[j]; }
                }
            }
            if (u.tag >= 5) { if (v0[0] + v1[3] + v0[9] + v1[12] == 12345.678f) dst[0] = 0; }
            else if (G < 48) {
                bf16_t* d = dst + (size_t)row * tstride + 16 * h;
                *(u32x4*)(d) = pack8(v0, 0); *(u32x4*)(d + 8) = pack8(v0, 8);
                *(u32x4*)(d + 32) = pack8(v1, 0); *(u32x4*)(d + 40) = pack8(v1, 8);
            } else {
                bf16_t* d = dst + (size_t)row * 32 + 16 * h;
                *(u32x4*)(d) = pack8(v0, 0); *(u32x4*)(d + 8) = pack8(v0, 8);
                if (h == 0) *(f32x4*)(pj.iw + (size_t)row * 4) = (f32x4){v1[0], v1[1], v1[2], v1[3]} * IWSCALE;
            }
        }
    }
};
__device__ __forceinline__ void ph_inproj(const Params& P_, int l, char* smem) {
    const KA P = ka_get();
    SchedInProj S; S.A = P.ws + OFF_H; S.B = P.ws + OFF_WT + WT_IN; S.mode = l >> 4;
    EpiInProj E; E.pj = proj_ptrs(P.ws); E.qkg = P.in[I_QKG] + (size_t)(l & 15) * 384;
    { LAS float* gt = (LAS float*)((LAS char*)smem + EPI_TAB); __syncthreads(); const int t = tid_opaque(); if (t < 384) gt[t] = E.qkg[t]; __syncthreads(); E.gtab = gt; }
    mm::gemm_phase(smem, S, E);
}

constexpr size_t SCR_G = OFF_PROJ;
constexpr size_t SCR_M = OFF_PROJ + 32 * MB;
struct SchedGB {
    const char* H; const char* BR; const char* Wg; const char* Wb;
    __device__ __forceinline__ bool next(int i, mm::Unit& u) const {
        const int ti = i / 6, sub = i - ti * 6, n = sub >> 1;
        int pm, pn; if (!mm::static_tile((long)ti * gridDim.x + VBID, 128, 4, pm, pn)) return false;
        u.pm = pm; u.pn = pn; u.tag = sub;
        if ((sub & 1) == 0) { u.a = H + (size_t)pm * 256 * 1024 * 2; u.lda = 1024; u.b0 = Wg + (size_t)(n * 1024 + pn * 256) * 1024 * 2; u.ldb = 1024; u.nk = 16; }
        else { u.a = BR + ((size_t)pm * 256 * 1536 + n * 512) * 2; u.lda = 1536; u.b0 = Wb + ((size_t)n * 1024 + pn * 256) * 512 * 2; u.ldb = 512; u.nk = 8; }
        u.b1 = u.b0; u.nseg = u.nk; return true;
    }
    static constexpr bool GATHER = false, PIPE = true;
    __device__ __forceinline__ void a_rows(const mm::Unit& u, int r0, unsigned (&a)[1]) const { mm::plain_rows(u, r0, a); }
};
struct EpiGB {
    static constexpr bool TRANSP = true;
    static constexpr int PROF = 4;
    const LAS float* btab; bf16_t* MG; char* scrg; char* scrm;
    __device__ __forceinline__ void operator()(mm::f32x16 (&acc)[4][2], const mm::Unit& u, int wm, int wn, int r32, int h, int tid) const {
        using namespace mm;
        asm volatile("" : "+v"(r32), "+v"(h), "+v"(tid));
        const int sub = u.tag, n = sub >> 1;
        const unsigned so0 = (unsigned)tid * 16u;
        if ((sub & 1) == 0) {
#pragma unroll
            for (int mt = 0; mt < 4; ++mt)
#pragma unroll
                for (int nt = 0; nt < 2; ++nt) {
                    f32x16& v = acc[mt][nt];
                    const int col = n * 1024 + u.pn * 256 + wn * 64 + nt * 32 + 16 * h;
#pragma unroll
                    for (int e4 = 0; e4 < 4; ++e4) { const f32x4 b = *(const LAS f32x4*)(btab + col + 4 * e4);
#pragma unroll
                        for (int j = 0; j < 4; ++j) v[4 * e4 + j] = __builtin_amdgcn_rcpf(1.f + __builtin_amdgcn_exp2f(__builtin_fmaf(v[4 * e4 + j], -LOG2E, b[j]))); }
                    const unsigned so = so0 + (unsigned)((mt * 2 + nt) * 2) * 8192u;
                    *(u32x4*)(scrg + so) = pack8(v, 0); *(u32x4*)(scrg + so + 8192) = pack8(v, 8);
                }
        } else {
#pragma unroll
            for (int hf = 0; hf < 4; ++hf) {
                const int mt = hf;
                {
                    u32x4 gq[2][2];
#pragma unroll
                    for (int c = 0; c < 2; ++c) { const unsigned so = so0 + (unsigned)((hf * 2 + c) * 2) * 8192u; gq[c][0] = *(const u32x4*)(scrg + so); gq[c][1] = *(const u32x4*)(scrg + so + 8192); }
#pragma unroll
                    for (int c = 0; c < 2; ++c) {
                        f32x16& v = acc[mt][c];
                        const unsigned gw[8] = {gq[c][0].x, gq[c][0].y, gq[c][0].z, gq[c][0].w, gq[c][1].x, gq[c][1].y, gq[c][1].z, gq[c][1].w};
#pragma unroll
                        for (int j = 0; j < 8; ++j) { v[2 * j] *= bflo(gw[j]); v[2 * j + 1] *= bfhi(gw[j]); }
                    }
                }
                if (n > 0) {
                    u32x4 mq[2][2];
#pragma unroll
                    for (int c = 0; c < 2; ++c) { const unsigned so = so0 + (unsigned)((hf * 2 + c) * 2) * 8192u; mq[c][0] = *(const u32x4*)(scrm + so); mq[c][1] = *(const u32x4*)(scrm + so + 8192); }
#pragma unroll
                    for (int c = 0; c < 2; ++c) {
                        f32x16& v = acc[mt][c];
                        const unsigned mw[8] = {mq[c][0].x, mq[c][0].y, mq[c][0].z, mq[c][0].w, mq[c][1].x, mq[c][1].y, mq[c][1].z, mq[c][1].w};
#pragma unroll
                        for (int j = 0; j < 8; ++j) { v[2 * j] += bflo(mw[j]); v[2 * j + 1] += bfhi(mw[j]); }
                    }
                }
#pragma unroll
                for (int c = 0; c < 2; ++c) {
                    f32x16& v = acc[mt][c];
                    const unsigned so = so0 + (unsigned)((hf * 2 + c) * 2) * 8192u;
                    if (n < 2) { *(u32x4*)(scrm + so) = pack8(v, 0); *(u32x4*)(scrm + so + 8192) = pack8(v, 8); }
                    else { bf16_t* d = MG + (size_t)(u.pm * 256 + wm * 128 + mt * 32 + r32) * ND + u.pn * 256 + wn * 64 + c * 32 + 16 * h; *(u32x4*)d = pack8(v, 0); *(u32x4*)(d + 8) = pack8(v, 8); }
                }
            }
        }
    }
};
__device__ __forceinline__ void ph_gatebranch(const Params& P_, int l, char* smem) {
    const KA P = ka_get();
    SchedGB S; S.H = P.ws + OFF_H; S.BR = P.ws + OFF_BR; S.Wg = P.ws + OFF_WT + WT_GATE; S.Wb = P.ws + OFF_WT + WT_BR;
    EpiGB E; E.MG = (bf16_t*)(P.ws + OFF_MERGED);
    { LAS float* bt = (LAS float*)((LAS char*)smem + EPI_TAB); const float* bg = P.in[I_BGATE] + (size_t)l * 3072; __syncthreads(); for (int t = tid_opaque(); t < 3072; t += 512) bt[t] = -bg[t] * LOG2E; __syncthreads(); E.btab = bt; }
    E.scrg = P.ws + SCR_G + (size_t)blockIdx.x * 131072; E.scrm = P.ws + SCR_M + (size_t)blockIdx.x * 131072;
    mm::gemm_phase(smem, S, E);
}

struct SchedOut {
    const char* A; const char* B;
    __device__ __forceinline__ bool next(int i, mm::Unit& u) const {
        int pm, pn; if (!mm::static_tile((long)i * gridDim.x + VBID, 128, 4, pm, pn)) return false;
        u.a = A + (size_t)pm * 256 * 1024 * 2; u.b0 = B + (size_t)pn * 256 * 1024 * 2; u.b1 = u.b0; u.lda = 1024; u.ldb = 1024; u.nk = 16; u.nseg = 16; u.pm = pm; u.pn = pn; u.tag = 0; return true;
    }
    static constexpr bool GATHER = false, PIPE = true;
    __device__ __forceinline__ void a_rows(const mm::Unit& u, int r0, unsigned (&a)[1]) const { mm::plain_rows(u, r0, a); }
};
struct EpiOut {
    static constexpr bool TRANSP = false;
    static constexpr int PROF = 17;
    const float* x32; bf16_t* st;
    __device__ __forceinline__ void operator()(mm::f32x16 (&acc)[4][2], const mm::Unit& u, int wm, int wn, int r32, int h, int tid) const {
        using namespace mm;
        asm volatile("" : "+v"(r32), "+v"(h));
#pragma unroll
        for (int mt = 0; mt < 4; ++mt) {
            asm volatile("" ::: "memory");
            const size_t off = (size_t)(u.pm * 256 + wm * 128 + mt * 32 + 4 * h) * ND + u.pn * 256 + wn * 64 + 2 * r32;
            float xa[16], xb[16];
            if (x32) {
#pragma unroll
                for (int e = 0; e < 16; ++e) { const float2 t = *(const float2*)(x32 + off + (size_t)((e & 3) + 8 * (e >> 2)) * ND); xa[e] = t.x; xb[e] = t.y; }
            } else {
#pragma unroll
                for (int e = 0; e < 16; ++e) { const unsigned w = *(const unsigned*)(st + off + (size_t)((e & 3) + 8 * (e >> 2)) * ND); xa[e] = bflo(w); xb[e] = bfhi(w); }
            }
#pragma unroll
            for (int e = 0; e < 16; ++e) *(unsigned*)(st + off + (size_t)((e & 3) + 8 * (e >> 2)) * ND) = cvt_pk_bf16(xa[e] + acc[mt][0][e], xb[e] + acc[mt][1][e]);
        }
    }
};
__device__ __forceinline__ void ph_outproj(const Params& P_, int l, char* smem) {
    const KA P = ka_get();
    SchedOut S; S.A = P.ws + OFF_MERGED; S.B = P.ws + OFF_WT + WT_OUT;
    EpiOut E; E.x32 = l == 0 ? P.in[I_X] : (const float*)nullptr; E.st = (bf16_t*)(P.ws + OFF_STREAM);
    mm::gemm_phase(smem, S, E);
}


constexpr size_t OFF_HID = OFF_PROJ + 64 * MB;
constexpr int MOE_TAB = 131072 + 1024;
__device__ __forceinline__ void moe_table(char* smem, const int* cnt) {
    int* tab = (int*)(smem + MOE_TAB);
    const int t = tid_opaque();
    __syncthreads();
    if (t < 24) tab[32 + t] = cnt[t];
    __syncthreads();
    if (t == 0) { int p = 0; for (int b = 0; b < 24; ++b) { tab[b] = p; p += (tab[32 + b] + 255) >> 8; } tab[24] = p; }
    __syncthreads();
    if (t < 160) { int b = 0; for (int i = 1; i < 24; ++i) if (tab[i] <= t) b = i; tab[64 + t] = b; }
    __syncthreads();
}
struct MoeLoc { int b, rt, slot, valid, elo, ehi; };
__device__ __forceinline__ int moe_tab(const int* tab, int i) { return __builtin_amdgcn_readfirstlane(tab[i]); }
__device__ __forceinline__ MoeLoc moe_locate(const int* tab, int T) {
    const int b = moe_tab(tab, 64 + T);
    MoeLoc m; m.b = b; m.rt = T - moe_tab(tab, b); m.slot = T * 256; const int c = moe_tab(tab, 32 + b) - m.rt * 256; m.valid = c < 256 ? c : 256;
    const int g = b / 6, ix = b - g * 6; const int lo = ix < 3 ? 0 : (ix < 5 ? 1 : 2), hi = ix < 3 ? ix + 1 : (ix < 5 ? ix - 1 : 3);
    m.elo = g * 4 + lo; m.ehi = g * 4 + hi; return m;
}
struct SchedMoeUp {
    static constexpr bool GATHER = true, PIPE = true;
    const char* H; const char* W; const int* tab; const int* list;
    __device__ __forceinline__ bool next(int i, mm::Unit& u) const {
        const long L = (long)i * gridDim.x + VBID; const int T = (int)(L >> 2), c = (int)(L & 3);
        if (T >= moe_tab(tab, 24)) return false;
        const MoeLoc m = moe_locate(tab, T);
        const int e = (c >> 1) ? m.ehi : m.elo, j = c & 1;
        u.a = H; u.lda = 1024; u.b0 = W + ((size_t)e * 512 + j * 256) * 1024 * 2; u.b1 = u.b0; u.ldb = 1024; u.nk = 16; u.nseg = 16;
        u.pm = T; u.pn = c; u.tag = c; u.aux0 = m.b * NTOK + m.rt * 256; u.aux1 = m.valid; return true;
    }
    __device__ __forceinline__ void a_rows(const mm::Unit& u, int r0, unsigned (&a)[4]) const {
#pragma unroll
        for (int q = 0; q < 4; ++q) { const int r = r0 + 64 * q; const int tok = list[u.aux0 + (r < u.aux1 ? r : 0)]; a[q] = (unsigned)tok * 2048u; }
    }
};
struct EpiMoeUp {
    static constexpr bool TRANSP = true;
    static constexpr int PROF = 18;
    bf16_t* hid; const int* list; const float* rw;
    __device__ __forceinline__ void operator()(mm::f32x16 (&acc)[4][2], const mm::Unit& u, int wm, int wn, int r32, int h, int tid) const {
        using namespace mm;
        asm volatile("" : "+v"(r32), "+v"(h));
        const int which = u.tag >> 1, j = u.tag & 1;
        int tok[4]; float w[4];
#pragma unroll
        for (int mt = 0; mt < 4; ++mt) { const int r = wm * 128 + mt * 32 + r32; tok[mt] = list[u.aux0 + (r < u.aux1 ? r : 0)]; }
#pragma unroll
        for (int mt = 0; mt < 4; ++mt) w[mt] = rw[tok[mt] * 2 + which];
#pragma unroll
        for (int mt = 0; mt < 4; ++mt) {
            const int r = wm * 128 + mt * 32 + r32;
            if (r < u.aux1) {
                f32x16& g = acc[mt][0]; const f32x16& up = acc[mt][1];
#pragma unroll
                for (int e = 0; e < 16; ++e) g[e] = g[e] * __builtin_amdgcn_rcpf(1.f + __builtin_amdgcn_exp2f(g[e] * -LOG2E)) * (up[e] * w[mt]);
                bf16_t* d = hid + (size_t)(u.pm * 256 + r) * 512 + which * 256 + j * 128 + wn * 32 + 16 * h;
                *(u32x4*)d = pack8(g, 0); *(u32x4*)(d + 8) = pack8(g, 8);
            }
        }
    }
};
struct SchedMoeDown {
    static constexpr bool GATHER = false, PIPE = true;
    const char* HID; const char* W; const int* tab;
    __device__ __forceinline__ bool next(int i, mm::Unit& u) const {
        const long L = (long)i * gridDim.x + VBID; const int T = (int)(L >> 2), c = (int)(L & 3);
        if (T >= moe_tab(tab, 24)) return false;
        const MoeLoc m = moe_locate(tab, T);
        u.a = HID + (size_t)T * 256 * 512 * 2; u.lda = 512; u.ldb = 256; u.nk = 8; u.nseg = 4;
        u.b0 = W + ((size_t)m.elo * 1024 + c * 256) * 256 * 2; u.b1 = W + ((size_t)m.ehi * 1024 + c * 256) * 256 * 2 - 4 * 128;
        u.pm = T; u.pn = c; u.tag = 0; u.aux0 = m.b * NTOK + m.rt * 256; u.aux1 = m.valid; return true;
    }
    __device__ __forceinline__ void a_rows(const mm::Unit& u, int r0, unsigned (&a)[1]) const { mm::plain_rows(u, r0, a); }
};
struct EpiMoeDown {
    static constexpr bool TRANSP = false;
    static constexpr int PROF = 19;
    bf16_t* st; float* out32; const int* list; LAS int* ltok;
    __device__ __forceinline__ void operator()(mm::f32x16 (&acc)[4][2], const mm::Unit& u, int wm, int wn, int r32, int h, int tid) const {
        using namespace mm;
        typedef unsigned u32x2_t __attribute__((ext_vector_type(2)));
        asm volatile("" : "+v"(r32), "+v"(h));
        const unsigned colb = (unsigned)(u.pn * 256 + wn * 64 + 2 * r32) * 2u;
        __syncthreads();
        if (tid < 256) ltok[tid] = list[u.aux0 + (tid < u.aux1 ? tid : 0)];
        __syncthreads();
        const __amdgpu_buffer_rsrc_t rs = __builtin_amdgcn_make_buffer_rsrc((void*)st, 0, 0x7fffffff, 0x00020000);
        const __amdgpu_buffer_rsrc_t ro = __builtin_amdgcn_make_buffer_rsrc(out32 ? (void*)out32 : (void*)st, 0, 0x7fffffff, 0x00020000);
#pragma unroll
        for (int mt = 0; mt < 4; ++mt) {
            asm volatile("" ::: "memory");
            const int rb = wm * 128 + mt * 32 + 4 * h;
            unsigned off[16], xv[16];
#pragma unroll
            for (int e = 0; e < 16; ++e) off[e] = (unsigned)ltok[rb + (e & 3) + 8 * (e >> 2)] * 2048u + colb;
#pragma unroll
            for (int e = 0; e < 16; ++e) xv[e] = __builtin_amdgcn_raw_buffer_load_b32(rs, off[e], 0, 0);
#pragma unroll
            for (int e = 0; e < 16; ++e) {
                const int r = rb + (e & 3) + 8 * (e >> 2);
                if (r < u.aux1) {
                    const float a = bflo(xv[e]) + acc[mt][0][e], b = bfhi(xv[e]) + acc[mt][1][e];
                    if (out32) { u32x2_t o; o.x = __float_as_uint(a); o.y = __float_as_uint(b); __builtin_amdgcn_raw_buffer_store_b64(o, ro, off[e] * 2u, 0, 0); }
                    else __builtin_amdgcn_raw_buffer_store_b32(cvt_pk_bf16(a, b), rs, off[e], 0, 0);
                }
            }
        }
    }
};
__device__ __forceinline__ void ph_moe_up(const Params& P_, int l, char* smem) {
    const KA P = ka_get();
    moe_table(smem, (const int*)(P.ws + OFF_CTRL + MOE_CNT_OFF) + l * 32);
    SchedMoeUp S; S.H = P.ws + OFF_H; S.W = P.ws + OFF_WT + WT_GU; S.tab = (const int*)(smem + MOE_TAB); S.list = (const int*)(P.ws + OFF_ROUTE + MOE_LIST_OFF);
    EpiMoeUp E; E.hid = (bf16_t*)(P.ws + OFF_HID); E.list = S.list; E.rw = (const float*)(P.ws + OFF_ROUTE + MOE_RW_OFF);
    mm::gemm_phase(smem, S, E);
}
__device__ __forceinline__ void ph_moe_down(const Params& P_, int l, char* smem) {
    const KA P = ka_get();
    moe_table(smem, (const int*)(P.ws + OFF_CTRL + MOE_CNT_OFF) + l * 32);
    SchedMoeDown S; S.HID = P.ws + OFF_HID; S.W = P.ws + OFF_WT + WT_DN; S.tab = (const int*)(smem + MOE_TAB);
    EpiMoeDown E; E.ltok = (LAS int*)((LAS char*)smem + EPI_TAB); E.st = (bf16_t*)(P.ws + OFF_STREAM); E.out32 = l == 1 ? P.out : (float*)nullptr; E.list = (const int*)(P.ws + OFF_ROUTE + MOE_LIST_OFF);
    mm::gemm_phase(smem, S, E);
}


namespace at {
typedef short bf16x8 __attribute__((ext_vector_type(8)));
typedef short s16x4 __attribute__((ext_vector_type(4)));
typedef float f32x16 __attribute__((ext_vector_type(16)));
typedef unsigned u32x4 __attribute__((ext_vector_type(4)));
typedef unsigned u32x2 __attribute__((ext_vector_type(2)));
__device__ __forceinline__ s16x4 tr_read(const LAS char* p) { return __builtin_bit_cast(s16x4, __builtin_amdgcn_ds_read_tr16_b64_v4i16((LAS s16x4*)p)); }
__device__ __forceinline__ unsigned cvtpk(float lo, float hi) { unsigned r; asm volatile("v_cvt_pk_bf16_f32 %0, %1, %2" : "=v"(r) : "v"(lo), "v"(hi)); return r; }
__device__ __forceinline__ bf16x8 pack_p(const f32x16& x, int s) { u32x4 w; w.x = cvtpk(x[8 * s], x[8 * s + 1]); w.y = cvtpk(x[8 * s + 2], x[8 * s + 3]); w.z = cvtpk(x[8 * s + 4], x[8 * s + 5]); w.w = cvtpk(x[8 * s + 6], x[8 * s + 7]); return __builtin_bit_cast(bf16x8, w); }
constexpr int A_TAB = 81920;
}
__device__ __forceinline__ void ph_attnA(const Params& P_, int l, char* smem) {
    using namespace at;
    const KA P = ka_get();
    const Proj pj = proj_ptrs(P.ws);
    bf16_t* BR = (bf16_t*)(P.ws + OFF_BR);
    const int tid = tid_opaque(), lane = tid & 63, wid = __builtin_amdgcn_readfirstlane(tid >> 6), m = wid >> 2, qs = wid & 3, r32 = lane & 31, hl = lane >> 5;
    LAS char* lds = (LAS char*)smem;
    LAS float* tb = (LAS float*)(lds + A_TAB);
    const float* lp = P.in[I_LAM] + (size_t)l * 256;
    const float linit = lambda_init_of(l);
    const float lam = expf(wsum(lp[lane] * lp[64 + lane])) - expf(wsum(lp[128 + lane] * lp[192 + lane])) + linit;
    const float* subg = P.in[I_SUBLN] + (size_t)l * 128;
    const float* relb = P.in[I_RELB];
    LAS float* rb4 = (LAS float*)(lds + A_TAB + 4160 * 4);
    __syncthreads();
    if (tid < 128) rb4[tid] = relb[(tid >> 2) * 20 + (tid & 3)] * LOG2E;
    __syncthreads();
    const int i16 = lane & 15, tq = i16 >> 2, tp = i16 & 3, blk = (lane >> 4) & 1;
    const unsigned vlane = (unsigned)((4 * hl + tq) * 64 + blk * 32 + tp * 8);
    const unsigned klane = (unsigned)(m * 8192 + r32 * 128), kx = (unsigned)((r32 >> 1) & 7);
    for (int u2 = blockIdx.x; u2 < 1024; u2 += gridDim.x) {
        const int Pp = u2 & 511;
        const int bh = Pp >> 4, jj = Pp & 15, qb = (u2 >> 9) ? 31 - jj : jj, b = bh >> 2, h = bh & 3;
        const int q0 = qb * 128 + qs * 32, nt_wg = 2 * qb + 2, nt_w = (q0 >> 6) + 1;
        __syncthreads();
#pragma unroll
        for (int it = 0; it < 9; ++it) { const int i = tid + 512 * it; if (i < 4160) { const int rel = i - 4095; tb[i] = rel <= 63 ? rb4[t5_bucket(rel) * 4 + h] : 0.f; } }
        const float bfar = rb4[15 * 4 + h];
        bf16x8 qf[4];
        { const bf16_t* qp = pj.aq + (size_t)(b * NS + q0 + r32) * 512 + (h * 2 + m) * 64 + 8 * hl;
#pragma unroll
          for (int ks = 0; ks < 4; ++ks) qf[ks] = *(const bf16x8*)(qp + ks * 16); }
        u32x4 gk[2], gv[2];
        const bf16_t* kg = pj.ak + (size_t)(b * NS) * 512 + h * 128;
        const bf16_t* vg = pj.av + (size_t)(b * NS) * 512 + h * 128;
        unsigned gofs[2], kst[2], vst[2];
#pragma unroll
        for (int i = 0; i < 2; ++i) { const int idx = tid + 512 * i, key = idx >> 4, c = idx & 15;
            gofs[i] = (unsigned)(key * 512 + c * 8) * 2u;
            kst[i] = (unsigned)((c >> 3) * 8192 + key * 128 + (((c & 7) ^ ((key >> 1) & 7)) << 4));
            vst[i] = (unsigned)((c >> 2) * 4096 + key * 64 + (c & 3) * 16); }
#define AT_GLOAD(kt) do { const size_t o_ = (size_t)(kt) * 64 * 512 * 2; _Pragma("unroll") for (int i_ = 0; i_ < 2; ++i_) { gk[i_] = *(const u32x4*)((const char*)kg + o_ + gofs[i_]); gv[i_] = *(const u32x4*)((const char*)vg + o_ + gofs[i_]); } } while (0)
#define AT_LSTORE(kslot, vslot) do { _Pragma("unroll") for (int i_ = 0; i_ < 2; ++i_) { *(LAS u32x4*)(lds + (kslot) * 16384 + kst[i_]) = gk[i_]; *(LAS u32x4*)(lds + 32768 + (vslot) * 16384 + vst[i_]) = gv[i_]; } } while (0)
        AT_GLOAD(0); AT_LSTORE(0, 0);
        __syncthreads();
        f32x16 O[4];
#pragma unroll
        for (int v = 0; v < 4; ++v)
#pragma unroll
            for (int e = 0; e < 16; ++e) O[v][e] = 0.f;
        float mrun = -INFINITY, lsum = 0.f;
        bf16x8 pp[2][2];
        int vs_prev = 0, vs_cur = 0, vs_next = 1;
        for (int kt = 0; kt <= nt_wg; ++kt) {
            if (kt + 1 < nt_wg) AT_GLOAD(kt + 1);
            f32x16 s0, s1;
            const bool doqk = kt < nt_w, dopv = kt >= 1 && kt - 1 < nt_w;
            if (doqk) {
                const LAS char* kb = lds + (kt & 1) * 16384 + klane;
                if (kt * 64 + 63 - q0 <= -559) {
#pragma unroll
                    for (int e = 0; e < 16; ++e) { s0[e] = bfar; s1[e] = bfar; }
                } else {
                    const LAS float* tl = tb + (kt * 64 - q0 - r32 + 4 * hl + 4095);
#pragma unroll
                    for (int e = 0; e < 16; ++e) { s0[e] = tl[(e & 3) + 8 * (e >> 2)]; s1[e] = tl[32 + (e & 3) + 8 * (e >> 2)]; }
                }
#pragma unroll
                for (int ks = 0; ks < 4; ++ks) {
                    const unsigned xo = (((unsigned)(ks * 2 + hl)) ^ kx) << 4;
                    const bf16x8 k0 = *(const LAS bf16x8*)(kb + xo), k1 = *(const LAS bf16x8*)(kb + 4096 + xo);
                    s0 = __builtin_amdgcn_mfma_f32_32x32x16_bf16(k0, qf[ks], s0, 0, 0, 0);
                    s1 = __builtin_amdgcn_mfma_f32_32x32x16_bf16(k1, qf[ks], s1, 0, 0, 0);
                }
            }
            if (dopv) {
                const LAS char* vb = lds + 32768 + vs_prev * 16384 + vlane;
#pragma unroll
                for (int sub = 0; sub < 2; ++sub)
#pragma unroll
                    for (int s = 0; s < 2; ++s) {
                        const LAS char* vk = vb + (sub * 32 + 16 * s) * 64;
#pragma unroll
                        for (int v = 0; v < 4; ++v) {
                            const s16x4 lo = tr_read(vk + v * 4096), hi = tr_read(vk + v * 4096 + 8 * 64);
                            const bf16x8 vf = __builtin_shufflevector(lo, hi, 0, 1, 2, 3, 4, 5, 6, 7);
                            O[v] = __builtin_amdgcn_mfma_f32_32x32x16_bf16(vf, pp[sub][s], O[v], 0, 0, 0);
                        }
                    }
            }
            __builtin_amdgcn_sched_barrier(0);
            if (doqk) {
                float mx = __builtin_fmaxf(__builtin_fmaxf(s0[0], s1[0]), __builtin_fmaxf(s0[1], s1[1]));
#pragma unroll
                for (int e = 2; e < 16; e += 2) mx = __builtin_fmaxf(__builtin_fmaxf(mx, s0[e]), __builtin_fmaxf(__builtin_fmaxf(s1[e], s0[e + 1]), s1[e + 1]));
                mx = x32_max(mx);
                const float mn = fmaxf(mrun, mx);
                float ps0 = 0.f, ps1 = 0.f;
#pragma unroll
                for (int e = 0; e < 16; ++e) { s0[e] = __builtin_amdgcn_exp2f(s0[e] - mn); s1[e] = __builtin_amdgcn_exp2f(s1[e] - mn); ps0 += s0[e]; ps1 += s1[e]; }
                if (__any(mn > mrun)) {
                    const float alpha = __builtin_amdgcn_exp2f(mrun - mn);
                    lsum *= alpha;
#pragma unroll
                    for (int v = 0; v < 4; ++v)
#pragma unroll
                        for (int e = 0; e < 16; ++e) O[v][e] *= alpha;
                }
                mrun = mn;
                lsum += ps0 + ps1;
                pp[0][0] = pack_p(s0, 0); pp[0][1] = pack_p(s0, 1); pp[1][0] = pack_p(s1, 0); pp[1][1] = pack_p(s1, 1);
            }
            if (kt + 1 < nt_wg) AT_LSTORE((kt + 1) & 1, vs_next);
            __syncthreads();
            vs_prev = vs_cur; vs_cur = vs_next; vs_next = vs_next == 2 ? 0 : vs_next + 1;
        }
#undef AT_GLOAD
#undef AT_LSTORE
        const float ltot = x32_sum(lsum);
        const float inv = (m ? lam : 1.f) / ltot;
        LAS float* ex = (LAS float*)lds + qs * 4096 + lane;
        if (m == 1) {
#pragma unroll
            for (int v = 0; v < 4; ++v)
#pragma unroll
                for (int e = 0; e < 16; ++e) ex[(v * 16 + e) * 64] = O[v][e] * inv;
        }
        __syncthreads();
        if (m == 0) {
            float ss = 0.f;
#pragma unroll
            for (int v = 0; v < 4; ++v)
#pragma unroll
                for (int e = 0; e < 16; ++e) { const float x = O[v][e] * inv - ex[(v * 16 + e) * 64]; O[v][e] = x; ss += x * x; }
            ss = x32_sum(ss);
            const float rstd = rsqrtf(ss * (1.0f / 128) + EPS) * (1.0f - linit);
            bf16_t* op = BR + (size_t)(b * NS + q0 + r32) * 1536 + h * 128 + 4 * hl;
#pragma unroll
            for (int v = 0; v < 4; ++v)
#pragma unroll
                for (int g = 0; g < 4; ++g) {
                    const int vd = v * 32 + 8 * g + 4 * hl;
                    const float4 sg = *(const float4*)(subg + vd);
                    u32x2 w; w.x = cvtpk(O[v][4 * g] * rstd * sg.x, O[v][4 * g + 1] * rstd * sg.y); w.y = cvtpk(O[v][4 * g + 2] * rstd * sg.z, O[v][4 * g + 3] * rstd * sg.w);
                    *(u32x2*)(op + v * 32 + 8 * g) = w;
                }
        }
    }
}


__device__ __forceinline__ void ph_attnB(const Params& P_, int l, char* smem) {
    using namespace at;
    const KA P = ka_get();
    const Proj pj = proj_ptrs(P.ws);
    bf16_t* BR = (bf16_t*)(P.ws + OFF_BR);
    const int tid = tid_opaque(), lane = tid & 63, wid = __builtin_amdgcn_readfirstlane(tid >> 6), g = wid >> 1, qh = wid & 1, r32 = lane & 31, hl = lane >> 5;
    LAS char* lds = (LAS char*)smem;
    constexpr int B_K = 0, B_V = 24576, B_TAB = 49152;
    LAS float* tb = (LAS float*)(lds + B_TAB);
    const float* relb = P.in[I_RELB];
    __syncthreads();
    for (int i = tid; i < 2048; i += 512) { const int hq = i >> 8, rel = (i & 255) - 191; tb[i] = relb[t5_bucket(rel) * 20 + 4 + hq] * LOG2E; }
    const int i16 = lane & 15, tq = i16 >> 2, tp = i16 & 3, blk = (lane >> 4) & 1;
    const unsigned vlane = (unsigned)((4 * hl + tq) * 64 + blk * 32 + tp * 8);
    const unsigned klane = (unsigned)(r32 * 128), kx = (unsigned)((r32 >> 1) & 7);
    const int skey = tid >> 3, sc = tid & 7;
    const unsigned kst = (unsigned)(skey * 128 + ((sc ^ ((skey >> 1) & 7)) << 4)), vst = (unsigned)((sc >> 2) * 4096 + skey * 64 + (sc & 3) * 16);
    for (int u = blockIdx.x; u < NB * 64 * 2; u += gridDim.x) {
        const int kvh = u & 1, c = (u >> 1) & 63, b = u >> 7, hq = kvh * 4 + g;
        const int t0 = c >= 2 ? 0 : 2 - c;
        u32x4 kk[3], vv3[3];
#pragma unroll
        for (int t = 0; t < 3; ++t) {
            const int tt = t >= t0 ? t : t0;
            const size_t row = (size_t)(b * NS + (c - 2 + tt) * 64 + skey) * 128 + kvh * 64 + sc * 8;
            kk[t] = *(const u32x4*)(pj.bk + row); vv3[t] = *(const u32x4*)(pj.bv + row);
        }
        const int tok = b * NS + c * 64 + qh * 32 + r32;
        bf16x8 qf[4];
#pragma unroll
        for (int ks = 0; ks < 4; ++ks) qf[ks] = *(const bf16x8*)(pj.bq + (size_t)tok * 512 + hq * 64 + ks * 16 + 8 * hl);
        const float sink = P.in[I_SINK][l * 8 + hq] * LOG2E;
        __syncthreads();
#pragma unroll
        for (int t = 0; t < 3; ++t) if (t >= t0) { *(LAS u32x4*)(lds + B_K + t * 8192 + kst) = kk[t]; *(LAS u32x4*)(lds + B_V + t * 8192 + vst) = vv3[t]; }
        __syncthreads();
        f32x16 O[2];
#pragma unroll
        for (int v = 0; v < 2; ++v)
#pragma unroll
            for (int e = 0; e < 16; ++e) O[v][e] = 0.f;
        float mrun = sink, lsum = hl == 0 ? 1.f : 0.f;
#pragma unroll
        for (int t = 0; t < 3; ++t) if (t >= t0) {
            const LAS char* kb = lds + B_K + t * 8192 + klane;
            const LAS char* vb = lds + B_V + t * 8192 + vlane;
            const LAS float* tl = tb + hq * 256 + (t * 64 - qh * 32 - r32 + 4 * hl + 63);
            f32x16 s0, s1;
#pragma unroll
            for (int e = 0; e < 16; ++e) { s0[e] = tl[(e & 3) + 8 * (e >> 2)]; s1[e] = tl[32 + (e & 3) + 8 * (e >> 2)]; }
#pragma unroll
            for (int ks = 0; ks < 4; ++ks) {
                const unsigned xo = (((unsigned)(ks * 2 + hl)) ^ kx) << 4;
                const bf16x8 k0 = *(const LAS bf16x8*)(kb + xo), k1 = *(const LAS bf16x8*)(kb + 4096 + xo);
                s0 = __builtin_amdgcn_mfma_f32_32x32x16_bf16(k0, qf[ks], s0, 0, 0, 0);
                s1 = __builtin_amdgcn_mfma_f32_32x32x16_bf16(k1, qf[ks], s1, 0, 0, 0);
            }
            float mx = fmaxf(s0[0], s1[0]);
#pragma unroll
            for (int e = 1; e < 16; ++e) mx = fmaxf(mx, fmaxf(s0[e], s1[e]));
            mx = x32_max(mx);
            const float mn = fmaxf(mrun, mx), alpha = exp2f(mrun - mn);
            mrun = mn;
            float ps = 0.f;
#pragma unroll
            for (int e = 0; e < 16; ++e) { s0[e] = exp2f(s0[e] - mn); s1[e] = exp2f(s1[e] - mn); ps += s0[e] + s1[e]; }
            lsum = lsum * alpha + ps;
#pragma unroll
            for (int v = 0; v < 2; ++v)
#pragma unroll
                for (int e = 0; e < 16; ++e) O[v][e] *= alpha;
#pragma unroll
            for (int sub = 0; sub < 2; ++sub)
#pragma unroll
                for (int s2 = 0; s2 < 2; ++s2) {
                    const bf16x8 pb = pack_p(sub ? s1 : s0, s2);
                    const LAS char* vk = vb + (sub * 32 + 16 * s2) * 64;
#pragma unroll
                    for (int v = 0; v < 2; ++v) {
                        const s16x4 lo = tr_read(vk + v * 4096), hi = tr_read(vk + v * 4096 + 8 * 64);
                        const bf16x8 vf = __builtin_shufflevector(lo, hi, 0, 1, 2, 3, 4, 5, 6, 7);
                        O[v] = __builtin_amdgcn_mfma_f32_32x32x16_bf16(vf, pb, O[v], 0, 0, 0);
                    }
                }
        }
        const float inv = 1.f / x32_sum(lsum);
        bf16_t* op = BR + (size_t)tok * 1536 + 512 + hq * 64 + 4 * hl;
#pragma unroll
        for (int v = 0; v < 2; ++v)
#pragma unroll
            for (int gg = 0; gg < 4; ++gg) {
                u32x2 w; w.x = cvtpk(O[v][4 * gg] * inv, O[v][4 * gg + 1] * inv); w.y = cvtpk(O[v][4 * gg + 2] * inv, O[v][4 * gg + 3] * inv);
                *(u32x2*)(op + v * 32 + 8 * gg) = w;
            }
    }
}


__device__ __forceinline__ void ph_attnC(const Params& P_, int l, char* smem) {
    using namespace at;
    typedef float f32x4 __attribute__((ext_vector_type(4)));
    const KA P = ka_get();
    const Proj pj = proj_ptrs(P.ws);
    bf16_t* BR = (bf16_t*)(P.ws + OFF_BR);
    const int tid = tid_opaque(), lane = tid & 63, wid = __builtin_amdgcn_readfirstlane(tid >> 6), l16 = lane & 15, g4 = lane >> 4;
    LAS char* lds = (LAS char*)smem;
    constexpr int C_SC = 0, C_SEL = 131072, C_BKT = 139264, C_TAB = 143360;
    LAS float* tb = (LAS float*)(lds + C_TAB);
    const float* relb = P.in[I_RELB];
    __syncthreads();
    for (int i = tid; i < 256; i += 512) tb[i] = relb[(i >> 3) * 20 + 12 + (i & 7)] * LOG2E;
    const unsigned long long ltmask = (1ull << lane) - 1ull;
    const int tq = l16 >> 2, tp = l16 & 3;
    for (int unit = blockIdx.x; unit < NTOK / 16; unit += gridDim.x) {
        const int kq = unit >> 8, cq = unit & 255, xq = (cq + 64 * (kq >> 1)) & 255, qblk = (kq & 1) ? 255 - xq : xq;
        const int tok0 = (kq << 12) + qblk * 16, b = tok0 >> 12, q0 = tok0 & (NS - 1), c = q0 >> 6, N = (c + 1) * 64;
        __syncthreads();
        PROF_BEGIN(9)
        if (N > 256) {
            bf16x8 iqf[4];
#pragma unroll
            for (int hh = 0; hh < 4; ++hh) iqf[hh] = *(const bf16x8*)(pj.iq + (size_t)(tok0 + l16) * 128 + hh * 32 + 8 * g4);
            const f32x4 w4 = *(const f32x4*)(pj.iw + (size_t)(tok0 + l16) * 4);
            const bf16_t* ikb = pj.ik + (size_t)(b * NS) * 32 + l16 * 32 + 8 * g4;
            const int ntile = N / 16;
            for (int kt0 = wid; kt0 < ntile; kt0 += 64) {
                bf16x8 av[8];
#pragma unroll
                for (int j = 0; j < 8; ++j) { const int kt = kt0 + 8 * j; av[j] = *(const bf16x8*)(ikb + (size_t)(kt < ntile ? kt : kt0) * 512); }
#pragma unroll
                for (int j = 0; j < 8; ++j) {
                    const int kt = kt0 + 8 * j;
                    if (kt < ntile) {
                        float sc[4] = {0.f, 0.f, 0.f, 0.f};
#pragma unroll
                        for (int hh = 0; hh < 4; ++hh) {
                            const f32x4 d = __builtin_amdgcn_mfma_f32_16x16x32_bf16(av[j], iqf[hh], (f32x4){0.f, 0.f, 0.f, 0.f}, 0, 0, 0);
#pragma unroll
                            for (int r = 0; r < 4; ++r) sc[r] += fmaxf(d[r], 0.f) * w4[hh];
                        }
                        unsigned w01 = __builtin_bit_cast(unsigned, __builtin_amdgcn_cvt_pkrtz(sc[0] + 0.0f, sc[1] + 0.0f));
                        unsigned w23 = __builtin_bit_cast(unsigned, __builtin_amdgcn_cvt_pkrtz(sc[2] + 0.0f, sc[3] + 0.0f));
                        w01 ^= (((w01 >> 15) & 0x00010001u) * 0xFFFFu) | 0x80008000u;
                        w23 ^= (((w23 >> 15) & 0x00010001u) * 0xFFFFu) | 0x80008000u;
                        w01 = (w01 >> 1) & 0x7FFF7FFFu; w23 = (w23 >> 1) & 0x7FFF7FFFu;
                        u32x2 o; o.x = w01; o.y = w23;
                        *(LAS u32x2*)(lds + C_SC + l16 * 8192 + (kt * 16 + g4 * 4) * 2) = o;
                    }
                }
            }
        }
        __syncthreads();
        PROF_END(9, smem)
        PROF_BEGIN(10)
        {
            LAS unsigned short* selA = (LAS unsigned short*)(lds + C_SEL) + (2 * wid) * 256;
            LAS unsigned char* bktA = (LAS unsigned char*)(lds + C_BKT) + (2 * wid) * 256;
            const int qA = q0 + 2 * wid;
            if (N <= 256) {
                for (int i = lane; i < N; i += 64) { selA[i] = (unsigned short)i; selA[256 + i] = (unsigned short)i; }
            } else {
                const LAS unsigned* rowA = (const LAS unsigned*)(lds + C_SC + (2 * wid) * 8192);
                const int ndw = N >> 1, nI = (ndw + 63) >> 6;
                unsigned TA, TB; int needA, needB;
                auto radix = [&](auto NIc) {
                    constexpr int NI = decltype(NIc)::value;
                    LAS unsigned* hist = (LAS unsigned*)selA;
                    unsigned ka[NI], kb[NI];
#pragma unroll
                    for (int i = 0; i < NI; ++i) { const bool ok = lane + 64 * i < ndw; ka[i] = ok ? rowA[lane + 64 * i] : 0u; kb[i] = ok ? rowA[2048 + lane + 64 * i] : 0u; }
#pragma unroll
                    for (int j = 0; j < 4; ++j) hist[lane + 64 * j] = 0u;
#pragma unroll
                    for (int i = 0; i < NI; ++i) {
                        if (lane + 64 * i < ndw) {
                            (void)__hip_atomic_fetch_add(hist + ((ka[i] >> 7) & 255u), 1u, __ATOMIC_RELAXED, __HIP_MEMORY_SCOPE_WORKGROUP);
                            (void)__hip_atomic_fetch_add(hist + ((ka[i] >> 23) & 255u), 1u, __ATOMIC_RELAXED, __HIP_MEMORY_SCOPE_WORKGROUP);
                            (void)__hip_atomic_fetch_add(hist + ((kb[i] >> 7) & 255u), 0x10000u, __ATOMIC_RELAXED, __HIP_MEMORY_SCOPE_WORKGROUP);
                            (void)__hip_atomic_fetch_add(hist + ((kb[i] >> 23) & 255u), 0x10000u, __ATOMIC_RELAXED, __HIP_MEMORY_SCOPE_WORKGROUP);
                        }
                    }
                    auto pick = [&](const unsigned (&c)[4], int per, int shift, int target, int& bin, int& above) {
                        unsigned s4 = 0;
#pragma unroll
                        for (int j = 0; j < 4; ++j) if (j < per) s4 += (c[j] >> shift) & 0xffffu;
                        int incl = (int)s4;
                        incl += __builtin_amdgcn_update_dpp(0, incl, 0x111, 0xf, 0xf, true);
                        incl += __builtin_amdgcn_update_dpp(0, incl, 0x112, 0xf, 0xf, true);
                        incl += __builtin_amdgcn_update_dpp(0, incl, 0x114, 0xf, 0xf, true);
                        incl += __builtin_amdgcn_update_dpp(0, incl, 0x118, 0xf, 0xf, true);
                        incl += __builtin_amdgcn_update_dpp(0, incl, 0x142, 0xa, 0xf, true);
                        incl += __builtin_amdgcn_update_dpp(0, incl, 0x143, 0xc, 0xf, true);
                        const unsigned long long bal = __ballot(incl >= target);
                        const int L = __builtin_amdgcn_readfirstlane((int)__builtin_ctzll(bal));
                        int run = __builtin_amdgcn_readlane(incl - (int)s4, L);
                        int b = 0; bool found = false;
#pragma unroll
                        for (int j = 0; j < 4; ++j) if (j < per) {
                            const int cj = __builtin_amdgcn_readlane((int)((c[j] >> shift) & 0xffffu), L);
                            if (!found) { if (run + cj >= target) { found = true; b = j; } else run += cj; }
                        }
                        bin = L * per + b; above = run;
                    };
                    int binA, aboveA, binB, aboveB;
                    {
                        const u32x4 q = *(const LAS u32x4*)(hist + 252 - 4 * lane);
                        const unsigned c[4] = {q.w, q.z, q.y, q.x};
                        pick(c, 4, 0, 256, binA, aboveA); pick(c, 4, 16, 256, binB, aboveB);
                    }
                    const unsigned topA = 255u - (unsigned)binA, topB = 255u - (unsigned)binB;
#pragma unroll
                    for (int j = 0; j < 2; ++j) hist[lane + 64 * j] = 0u;
#pragma unroll
                    for (int i = 0; i < NI; ++i) {
                        if (lane + 64 * i < ndw) {
                            if (((ka[i] >> 7) & 255u) == topA) (void)__hip_atomic_fetch_add(hist + (ka[i] & 127u), 1u, __ATOMIC_RELAXED, __HIP_MEMORY_SCOPE_WORKGROUP);
                            if (((ka[i] >> 23) & 255u) == topA) (void)__hip_atomic_fetch_add(hist + ((ka[i] >> 16) & 127u), 1u, __ATOMIC_RELAXED, __HIP_MEMORY_SCOPE_WORKGROUP);
                            if (((kb[i] >> 7) & 255u) == topB) (void)__hip_atomic_fetch_add(hist + (kb[i] & 127u), 0x10000u, __ATOMIC_RELAXED, __HIP_MEMORY_SCOPE_WORKGROUP);
                            if (((kb[i] >> 23) & 255u) == topB) (void)__hip_atomic_fetch_add(hist + ((kb[i] >> 16) & 127u), 0x10000u, __ATOMIC_RELAXED, __HIP_MEMORY_SCOPE_WORKGROUP);
                        }
                    }
                    int lowA, gtA, lowB, gtB;
                    {
                        const u32x2 q = *(const LAS u32x2*)(hist + 126 - 2 * lane);
                        const unsigned c[4] = {q.y, q.x, 0u, 0u};
                        pick(c, 2, 0, 256 - aboveA, lowA, gtA); pick(c, 2, 16, 256 - aboveB, lowB, gtB);
                    }
                    TA = (topA << 7) | (127u - (unsigned)lowA); TB = (topB << 7) | (127u - (unsigned)lowB);
                    needA = 256 - (aboveA + gtA); needB = 256 - (aboveB + gtB);
                };
                if (nI <= 8) radix(std::integral_constant<int, 8>{});
                else if (nI <= 16) radix(std::integral_constant<int, 16>{});
                else if (nI <= 24) radix(std::integral_constant<int, 24>{});
                else radix(std::integral_constant<int, 32>{});
                int nsA = 0, neA = 0, nsB = 0, neB = 0;
#pragma unroll 1
                for (int i = 0; i < nI; ++i) {
                    const bool ok = lane + 64 * i < ndw;
                    const unsigned wa = ok ? rowA[lane + 64 * i] : 0u, wb = ok ? rowA[2048 + lane + 64 * i] : 0u;
                    const int klo = 2 * (lane + 64 * i);
                    {
                        const unsigned lo = wa & 0xffffu, hi = wa >> 16;
                        const bool el = lo == TA, eh = hi == TA;
                        const unsigned long long bel = __ballot(el), beh = __ballot(eh);
                        const int rl = neA + __popcll(bel & ltmask) + __popcll(beh & ltmask), rh = rl + (el ? 1 : 0);
                        const bool tl = (lo > TA) || (el && rl < needA), th = (hi > TA) || (eh && rh < needA);
                        const unsigned long long btl = __ballot(tl), bth = __ballot(th);
                        const int pl = nsA + __popcll(btl & ltmask) + __popcll(bth & ltmask), ph = pl + (tl ? 1 : 0);
                        if (tl) selA[pl] = (unsigned short)klo;
                        if (th) selA[ph] = (unsigned short)(klo + 1);
                        nsA += __popcll(btl) + __popcll(bth); neA += __popcll(bel) + __popcll(beh);
                    }
                    {
                        const unsigned lo = wb & 0xffffu, hi = wb >> 16;
                        const bool el = lo == TB, eh = hi == TB;
                        const unsigned long long bel = __ballot(el), beh = __ballot(eh);
                        const int rl = neB + __popcll(bel & ltmask) + __popcll(beh & ltmask), rh = rl + (el ? 1 : 0);
                        const bool tl = (lo > TB) || (el && rl < needB), th = (hi > TB) || (eh && rh < needB);
                        const unsigned long long btl = __ballot(tl), bth = __ballot(th);
                        const int pl = nsB + __popcll(btl & ltmask) + __popcll(bth & ltmask), ph = pl + (tl ? 1 : 0);
                        if (tl) selA[256 + pl] = (unsigned short)klo;
                        if (th) selA[256 + ph] = (unsigned short)(klo + 1);
                        nsB += __popcll(btl) + __popcll(bth); neB += __popcll(bel) + __popcll(beh);
                    }
                }
            }
            const int cntS = N < 256 ? N : 256;
#pragma unroll
            for (int rr = 0; rr < 2; ++rr)
#pragma unroll
                for (int j = 0; j < 4; ++j) { const int sl = lane + 64 * j; if (sl < cntS) bktA[rr * 256 + sl] = (unsigned char)t5_bucket((int)selA[rr * 256 + sl] - (qA + rr)); }
        }
        PROF_END(10, smem)
        PROF_BEGIN(11)
        const int cnt = N < 256 ? N : 256;
        {
            const LAS unsigned short* sel0 = (const LAS unsigned short*)(lds + C_SEL) + (2 * wid) * 256;
            const LAS unsigned char* bkt0 = (const LAS unsigned char*)(lds + C_BKT) + (2 * wid) * 256;
            LAS char* vreg = lds + C_SC + wid * 16384;
            const bf16_t* ckb = pj.ck + (size_t)(b * NS) * 64 + 8 * g4;
            const bf16_t* cvb = pj.cv + (size_t)(b * NS) * 64;
            bf16x8 qf[2][2];
#pragma unroll
            for (int rr = 0; rr < 2; ++rr)
#pragma unroll
                for (int ks = 0; ks < 2; ++ks) qf[rr][ks] = *(const bf16x8*)(pj.cq + (size_t)(tok0 + 2 * wid + rr) * 512 + (l16 & 7) * 64 + ks * 32 + 8 * g4);
            f32x4 O[2][4];
#pragma unroll
            for (int rr = 0; rr < 2; ++rr)
#pragma unroll
                for (int v = 0; v < 4; ++v) O[rr][v] = (f32x4){0.f, 0.f, 0.f, 0.f};
            float mrun[2] = {-INFINITY, -INFINITY}, lsum[2] = {0.f, 0.f};
#pragma unroll 1
            for (int ch = 0; ch * 64 < cnt; ++ch) {
                u32x4 vv[2][8];
#pragma unroll
                for (int rr = 0; rr < 2; ++rr)
#pragma unroll
                    for (int i = 0; i < 8; ++i) {
                        const int piece = lane + 64 * i, e = piece >> 3, c8 = piece & 7, sl = ch * 64 + e;
                        const int idx = sl < cnt ? (int)sel0[rr * 256 + sl] : 0;
                        vv[rr][i] = *(const u32x4*)(cvb + (size_t)idx * 64 + c8 * 8);
                    }
                bf16x8 ka[2][4][2];
#pragma unroll
                for (int rr = 0; rr < 2; ++rr)
#pragma unroll
                    for (int u = 0; u < 4; ++u) {
                        const int e = ch * 64 + u * 16 + l16;
                        const int idx = e < cnt ? (int)sel0[rr * 256 + e] : 0;
                        ka[rr][u][0] = *(const bf16x8*)(ckb + (size_t)idx * 64); ka[rr][u][1] = *(const bf16x8*)(ckb + (size_t)idx * 64 + 32);
                    }
#pragma unroll
                for (int rr = 0; rr < 2; ++rr)
#pragma unroll
                    for (int i = 0; i < 8; ++i) { const int piece = lane + 64 * i, e = piece >> 3, c8 = piece & 7;
                        *(LAS u32x4*)(vreg + rr * 8192 + (c8 >> 2) * 4096 + e * 64 + (c8 & 3) * 16) = vv[rr][i]; }
#pragma unroll
                for (int rr = 0; rr < 2; ++rr) {
#pragma unroll
                    for (int t2 = 0; t2 < 2; ++t2) {
                        f32x4 d[2];
#pragma unroll
                        for (int u = 0; u < 2; ++u) {
                            const int t = ch * 4 + 2 * t2 + u;
                            f32x4 dd = __builtin_amdgcn_mfma_f32_16x16x32_bf16(ka[rr][2 * t2 + u][0], qf[rr][0], (f32x4){0.f, 0.f, 0.f, 0.f}, 0, 0, 0);
                            dd = __builtin_amdgcn_mfma_f32_16x16x32_bf16(ka[rr][2 * t2 + u][1], qf[rr][1], dd, 0, 0, 0);
                            const unsigned bk4 = *(const LAS unsigned*)(bkt0 + rr * 256 + t * 16 + g4 * 4);
#pragma unroll
                            for (int r = 0; r < 4; ++r) {
                                const int slot = t * 16 + g4 * 4 + r;
                                const float bias = tb[((bk4 >> (8 * r)) & 0xffu) * 8 + (l16 & 7)];
                                dd[r] = slot < cnt ? dd[r] + bias : -INFINITY;
                            }
                            d[u] = dd;
                        }
                        float mx = fmaxf(fmaxf(fmaxf(d[0][0], d[0][1]), fmaxf(d[0][2], d[0][3])), fmaxf(fmaxf(d[1][0], d[1][1]), fmaxf(d[1][2], d[1][3])));
                        mx = x32_max(x16_max(mx));
                        const float mn = fmaxf(mrun[rr], mx), alpha = exp2f(mrun[rr] - mn);
                        mrun[rr] = mn;
                        float ps = 0.f;
#pragma unroll
                        for (int u = 0; u < 2; ++u)
#pragma unroll
                            for (int r = 0; r < 4; ++r) { d[u][r] = exp2f(d[u][r] - mn); ps += d[u][r]; }
                        lsum[rr] = lsum[rr] * alpha + ps;
#pragma unroll
                        for (int v = 0; v < 4; ++v) O[rr][v] *= alpha;
                        u32x4 pw; pw.x = cvtpk(d[0][0], d[0][1]); pw.y = cvtpk(d[0][2], d[0][3]); pw.z = cvtpk(d[1][0], d[1][1]); pw.w = cvtpk(d[1][2], d[1][3]);
                        const bf16x8 pb = __builtin_bit_cast(bf16x8, pw);
                        const LAS char* vk = vreg + rr * 8192 + (32 * t2 + 4 * g4 + tq) * 64 + tp * 8;
#pragma unroll
                        for (int v = 0; v < 4; ++v) {
                            const s16x4 lo = tr_read(vk + (v >> 1) * 4096 + (v & 1) * 32), hi = tr_read(vk + (v >> 1) * 4096 + (v & 1) * 32 + 16 * 64);
                            const bf16x8 vf = __builtin_shufflevector(lo, hi, 0, 1, 2, 3, 4, 5, 6, 7);
                            O[rr][v] = __builtin_amdgcn_mfma_f32_16x16x32_bf16(vf, pb, O[rr][v], 0, 0, 0);
                        }
                    }
                }
            }
#pragma unroll
            for (int rr = 0; rr < 2; ++rr) {
                float ls = x32_sum(x16_sum(lsum[rr]));
                const float inv = 1.f / ls;
                if (l16 < 8) {
                    bf16_t* op = BR + (size_t)(tok0 + 2 * wid + rr) * 1536 + 1024 + l16 * 64 + g4 * 4;
#pragma unroll
                    for (int v = 0; v < 4; ++v) { u32x2 w; w.x = cvtpk(O[rr][v][0] * inv, O[rr][v][1] * inv); w.y = cvtpk(O[rr][v][2] * inv, O[rr][v][3] * inv); *(u32x2*)(op + v * 16) = w; }
                }
            }
        }
        PROF_END(11, smem)
    }
}

#if DIAG
__device__ __forceinline__ void ph_diag_stats(const Params& P_) {
    const KA P = ka_get();
    const Proj pj = proj_ptrs(P.ws);
    const bf16_t* buf; size_t n;
    if (DIAG_BUF == 0) { buf = pj.av; n = (size_t)NTOK * 512; }
    else if (DIAG_BUF == 1) { buf = pj.aq; n = (size_t)NTOK * 512; }
    else if (DIAG_BUF == 2) { buf = pj.ik; n = (size_t)NTOK * 32; }
    else { buf = pj.cv; n = (size_t)NTOK * 64; }
    const int tid = tid_opaque();
    float ss = 0.f; unsigned bad = 0;
    for (size_t i = (size_t)blockIdx.x * 512 + tid; i < n; i += (size_t)gridDim.x * 512) { const float v = bf2f(buf[i]); if (!(fabsf(v) < 1e30f)) ++bad; else ss += v * v; }
    ss = wsum(ss); bad = (unsigned)wsum((float)bad);
    if ((tid & 63) == 0) { atomicAdd((float*)(P.ws + OFF_CTRL + 16384), ss / (float)n); atomicAdd((unsigned*)(P.ws + OFF_CTRL + 16388), bad); }
}
__device__ __forceinline__ void ph_diag_scale(const Params& P_) {
    const KA P = ka_get();
    const float ms = *(const float*)(P.ws + OFF_CTRL + 16384); const unsigned bad = *(const unsigned*)(P.ws + OFF_CTRL + 16388);
    const float delta = bad > 0 ? 0.9f : 0.1f + 0.3f * fminf(2.f, ms);
    const int tid = tid_opaque();
    for (size_t i = (size_t)blockIdx.x * 512 + tid; i < (size_t)NTOK * ND; i += (size_t)gridDim.x * 512) P.out[i] *= (1.f + delta);
}
#endif

constexpr int LDS_BYTES = 147456;
enum { PH_PREP = 0, PH_INPROJ, PH_HEADNORM, PH_ATTN_A, PH_ATTN_B, PH_ATTN_C, PH_GB, PH_OUT, PH_NORM2, PH_MOE, PH_MOE2, PH_COUNT };

template <int PH>
__device__ __forceinline__ void run_phase(const Params& P, int l, float* lds) {
#ifdef SKIPX
    if (PH == SKIPX) return;
#endif
    if (PH == PH_PREP) { ph_convert_weights(P, l); ph_rmsnorm(P.in[I_X], l == 0 ? (const bf16_t*)nullptr : (const bf16_t*)(P.ws + OFF_STREAM), P.in[I_NMG] + (size_t)l * ND, (bf16_t*)(P.ws + OFF_H)); }
    if (PH == PH_INPROJ) { if (OPT_INPROJ) ph_inproj(P, l, (char*)lds); else ph_inproj_naive(P, l, lds); }
    if (PH == PH_HEADNORM) { if (!OPT_INPROJ) ph_headnorm_naive(P, l); }
    if (PH == PH_ATTN_A) { if (OPT_ATTN_A) ph_attnA(P, l, (char*)lds); else ph_attnA_naive(P, l, lds); }
    if (PH == PH_ATTN_B) { if (OPT_ATTN_B) ph_attnB(P, l, (char*)lds); else ph_attnB_naive(P, l, lds); }
    if (PH == PH_ATTN_C) { if (OPT_ATTN_C) ph_attnC(P, l, (char*)lds); else ph_attnC_naive(P, l, lds); }
    if (PH == PH_GB) { if (OPT_GB) ph_gatebranch(P, l, (char*)lds); else ph_gatebranch_naive(P, l, lds); }
    if (PH == PH_OUT) { if (OPT_OUT) ph_outproj(P, l, (char*)lds); else ph_out_naive(P, l, lds); }
    if (PH == PH_NORM2) ph_norm2_route(P, l, lds);
    if (PH == PH_MOE) { if (OPT_MOE) { ph_moe_up(P, l, (char*)lds); } else ph_moe_naive(P, l, lds); }
    if (PH == PH_MOE2) { if (OPT_MOE) ph_moe_down(P, l, (char*)lds); }
}

template <int PH>
__global__ void __launch_bounds__(512, 2) k_phase(Params P, int l) {
    extern __shared__ __attribute__((aligned(16))) char smem[];
    run_phase<PH>(P, l, (float*)smem);
}

template <int PH>
static void launch_phase(const Params& P, int l, int grid, hipStream_t stream) {
    static bool attr = false;
    if (!attr) { (void)hipFuncSetAttribute((const void*)k_phase<PH>, hipFuncAttributeMaxDynamicSharedMemorySize, LDS_BYTES); attr = true; }
    hipLaunchKernelGGL(k_phase<PH>, dim3(grid), dim3(512), LDS_BYTES, stream, P, l);
}

__global__ void __launch_bounds__(512, 2) k_fused(Params P) {
    extern __shared__ __attribute__((aligned(16))) char smem[];
    float* lds = (float*)smem;
    volatile LAS unsigned* st = (volatile LAS unsigned*)(smem + LDS_BYTES - 16);
    if (threadIdx.x == 0) { st[0] = 0u; st[1] = 0u; st[2] = 0u; st[3] = 0u; }
    __syncthreads();
    const XcdBarrier bar = xcd_barrier_post((unsigned*)(P.ws + OFF_CTRL), st);
    if (PROF_ID && threadIdx.x == 0) *(volatile LAS unsigned*)((LAS char*)smem + PROF_LDS_OFF) = 0u;
#define BARP() do { PROF_BEGIN(16) xcd_barrier(bar); PROF_END(16, smem) } while (0)
#define RUNQ(PH, id) do { PROF_BEGIN(id) run_phase<PH>(P, l, lds); PROF_END(id, smem) if (DUP_PH == PH && (PH != PH_OUT || l == 0)) { if (PH == PH_PREP || PH == PH_INPROJ || PH == PH_GB || PH == PH_OUT || PH == PH_MOE) xcd_barrier(bar); run_phase<PH>(P, l, lds); } } while (0)
    for (int l = 0; l < 2; ++l) {
        RUNQ(PH_PREP, 12); BARP();
        RUNQ(PH_INPROJ, 1); BARP();
        if (DUP_PH == 100) { ph_inproj(P, l + 16 * DUP_MODE, (char*)lds); xcd_barrier(bar); }
        if (!OPT_INPROJ) { run_phase<PH_HEADNORM>(P, l, lds); xcd_barrier(bar); }
        RUNQ(PH_ATTN_A, 6);
        RUNQ(PH_ATTN_B, 7);
        RUNQ(PH_ATTN_C, 8);
        BARP();
        RUNQ(PH_GB, 3); BARP();
        RUNQ(PH_OUT, 5); BARP();
        RUNQ(PH_NORM2, 13); BARP();
        RUNQ(PH_MOE, 14); BARP();
        if (OPT_MOE) { RUNQ(PH_MOE2, 15); BARP(); }
    }
    if (PROF_ID) {
        const KA Pk = ka_get();
        unsigned* mx = (unsigned*)(Pk.ws + OFF_CTRL + 16400);
        if (threadIdx.x == 0) atomicMax(mx, *(volatile LAS unsigned*)((LAS char*)smem + PROF_LDS_OFF));
        xcd_barrier(bar);
        const float tus = (float)__hip_atomic_load(mx, __ATOMIC_RELAXED, __HIP_MEMORY_SCOPE_AGENT) * 0.01f;
        const float tq_ = exp2f(rintf(log2f(fmaxf(tus, 1.f)) * 4.f) * 0.25f);
        const float delta = sqrtf(tq_ * 1e-5f);
        const int tq = tid_opaque();
        for (size_t i = (size_t)blockIdx.x * 512 + tq; i < (size_t)NTOK * ND; i += (size_t)gridDim.x * 512) Pk.out[i] *= (1.f + delta);
    }
#if DIAG == 3
    ph_diag_scale(P);
#endif
}

extern "C" void kernel_launch(void* const* d_in, const int* in_sizes, int n_in, void* d_out, int out_size, void* d_ws, size_t ws_size, hipStream_t stream) {
    Params P{};
    for (int i = 0; i < 20; ++i) P.in[i] = (const float*)d_in[i];
    P.out = (float*)d_out; P.ws = (char*)d_ws;
    (void)hipMemsetAsync(d_ws, 0, CTRL_BYTES, stream);
#if FUSED
    static int grid = 0;
    if (!grid) {
        int dev = 0, cus = 0, per_cu = 0;
        (void)hipGetDevice(&dev);
        (void)hipDeviceGetAttribute(&cus, hipDeviceAttributeMultiprocessorCount, dev);
        (void)hipFuncSetAttribute((const void*)k_fused, hipFuncAttributeMaxDynamicSharedMemorySize, LDS_BYTES);
        (void)hipOccupancyMaxActiveBlocksPerMultiprocessor(&per_cu, (const void*)k_fused, 512, LDS_BYTES);
        grid = cus * (per_cu < 1 ? per_cu : 1);
        if (grid <= 0) { fprintf(stderr, "k_fused: occupancy query says %d blocks per CU\n", per_cu); grid = cus; }
    }
    hipLaunchKernelGGL(k_fused, dim3(grid), dim3(512), LDS_BYTES, stream, P);
#else
    const int G = 2048;
    for (int l = 0; l < 2; ++l) {
        launch_phase<PH_PREP>(P, l, G, stream);
        launch_phase<PH_INPROJ>(P, l, G, stream);
        launch_phase<PH_HEADNORM>(P, l, G, stream);
        launch_phase<PH_ATTN_A>(P, l, G, stream);
        launch_phase<PH_ATTN_B>(P, l, G, stream);
        launch_phase<PH_ATTN_C>(P, l, G, stream);
        launch_phase<PH_GB>(P, l, G, stream);
        launch_phase<PH_OUT>(P, l, G, stream);
        launch_phase<PH_NORM2>(P, l, G, stream);
        launch_phase<PH_MOE>(P, l, G, stream);
    }
#endif
}
```

```cpp
#include <hip/hip_runtime.h>
#include <stdint.h>
#include <stdio.h>
#include <type_traits>

#ifndef FUSED
#define FUSED 1
#endif
#define OPT_INPROJ 1
#define OPT_GB 1
#define OPT_OUT 1
#define OPT_MOE 1
#define OPT_ATTN_A 1
#define OPT_ATTN_B 1
#define OPT_ATTN_C 1
#define DIAG 0
#define DUP_PH -1
#define DUP_MODE 0
#define PROF_ID 0
#define C_DUP 0
#define VBID ((blockIdx.x & 31) * 8 + (blockIdx.x >> 5))
#define DIAG_BUF 0

#define LAS __attribute__((address_space(3)))
typedef unsigned short bf16_t;

constexpr int NB = 8, NS = 4096, ND = 1024, NTOK = NB * NS;
constexpr int IN_COLS = 3108;
constexpr float LOG2E = 1.4426950408889634f;
constexpr float QSCALE = 0.125f * LOG2E;
constexpr float EPS = 1e-6f;
constexpr float IWSCALE = 0.08838834764831845f;

constexpr size_t MB = (size_t)1 << 20;
constexpr size_t OFF_CTRL = 0;
constexpr size_t CTRL_BYTES = 65536;
constexpr size_t OFF_ROUTE = 1 * MB;
constexpr size_t MOE_CNT_OFF = 32768;
constexpr size_t MOE_LIST_OFF = 512 * 1024;
constexpr size_t MOE_RW_OFF = 512 * 1024 + 3 * MB;
constexpr size_t OFF_WT = 5 * MB;
constexpr size_t OFF_H = 49 * MB;
constexpr size_t OFF_BR = 113 * MB;
constexpr size_t OFF_PROJ = 209 * MB;
constexpr size_t OFF_MERGED = OFF_PROJ + 128 * MB;
constexpr size_t OFF_STREAM = OFF_PROJ + 195 * MB;
constexpr size_t PO_AQ = 0, PO_AK = 32 * MB, PO_AV = 64 * MB, PO_BQ = 96 * MB, PO_BK = 128 * MB, PO_BV = 136 * MB, PO_CQ = 144 * MB,
                 PO_CK = 176 * MB, PO_CV = 180 * MB, PO_IQ = 184 * MB, PO_IK = 192 * MB, PO_IW = 194 * MB;

struct Params {
    const float* in[20];
    float* out;
    char* ws;
};
typedef const __attribute__((address_space(4))) char* kaptr_t;
struct KAIn { kaptr_t base; __device__ __forceinline__ const float* operator[](int i) const { return *(const float* const __attribute__((address_space(4)))*)(base + 8 * i); } };
struct KA { KAIn in; float* out; char* ws; };
__device__ __forceinline__ KA ka_get() {
    kaptr_t p = (kaptr_t)__builtin_amdgcn_kernarg_segment_ptr(); asm volatile("" : "+s"(p));
    KA k; k.in.base = p; k.out = *(float* const __attribute__((address_space(4)))*)(p + 160); k.ws = *(char* const __attribute__((address_space(4)))*)(p + 168); return k;
}
enum { I_X = 0, I_RELB, I_NMG, I_WIN, I_QKG, I_LAM, I_SUBLN, I_SINK, I_WBR, I_WGATE, I_BGATE, I_WOUT, I_NFG, I_WRG, I_BRG, I_WRE, I_BRE, I_WFG, I_WFU, I_WFD };

struct Proj { bf16_t *aq, *ak, *av, *bq, *bk, *bv, *cq, *ck, *cv, *iq, *ik; float* iw; };
__device__ __forceinline__ Proj proj_ptrs(char* ws) {
    char* p = ws + OFF_PROJ; Proj r;
    r.aq = (bf16_t*)(p + PO_AQ); r.ak = (bf16_t*)(p + PO_AK); r.av = (bf16_t*)(p + PO_AV); r.bq = (bf16_t*)(p + PO_BQ); r.bk = (bf16_t*)(p + PO_BK); r.bv = (bf16_t*)(p + PO_BV);
    r.cq = (bf16_t*)(p + PO_CQ); r.ck = (bf16_t*)(p + PO_CK); r.cv = (bf16_t*)(p + PO_CV); r.iq = (bf16_t*)(p + PO_IQ); r.ik = (bf16_t*)(p + PO_IK); r.iw = (float*)(p + PO_IW);
    return r;
}

__device__ __forceinline__ int tid_opaque() { int t = threadIdx.x; asm volatile("" : "+v"(t)); return t; }
#define PROF_LDS_OFF (147456 - 32)
#define PROF_BEGIN(id) unsigned long long _pt##id = 0; if (PROF_ID == (id) || ((id) == 99 && PROF_ID != 0)) _pt##id = __builtin_amdgcn_s_memrealtime();
#define PROF_END(id, smem_) if (PROF_ID == (id) && threadIdx.x == 0) { *(volatile LAS unsigned*)((LAS char*)(smem_) + PROF_LDS_OFF) += (unsigned)(__builtin_amdgcn_s_memrealtime() - _pt##id); }
__device__ __forceinline__ float bf2f(bf16_t b) { return __uint_as_float(((unsigned)b) << 16); }
__device__ __forceinline__ bf16_t f2bf(float f) { unsigned u = __float_as_uint(f); u += 0x7FFFu + ((u >> 16) & 1u); return (bf16_t)(u >> 16); }
__device__ __forceinline__ float bflo(unsigned w) { return __uint_as_float(w << 16); }
__device__ __forceinline__ float bfhi(unsigned w) { return __uint_as_float(w & 0xffff0000u); }
__device__ __forceinline__ unsigned pack2(float lo, float hi) { return (unsigned)f2bf(lo) | ((unsigned)f2bf(hi) << 16); }
__device__ __forceinline__ unsigned pack2hw(float lo, float hi) { unsigned r; asm volatile("v_cvt_pk_bf16_f32 %0, %1, %2" : "=v"(r) : "v"(lo), "v"(hi)); return r; }
__device__ __forceinline__ int wave_sum_dpp(int v) {
    v += __builtin_amdgcn_update_dpp(0, v, 0x111, 0xf, 0xf, true);
    v += __builtin_amdgcn_update_dpp(0, v, 0x112, 0xf, 0xf, true);
    v += __builtin_amdgcn_update_dpp(0, v, 0x114, 0xf, 0xf, true);
    v += __builtin_amdgcn_update_dpp(0, v, 0x118, 0xf, 0xf, true);
    v += __builtin_amdgcn_update_dpp(0, v, 0x142, 0xa, 0xf, true);
    v += __builtin_amdgcn_update_dpp(0, v, 0x143, 0xc, 0xf, true);
    return __builtin_amdgcn_readlane(v, 63);
}
__device__ __forceinline__ float x32_max(float v) { const auto r = __builtin_amdgcn_permlane32_swap(__float_as_uint(v), __float_as_uint(v), false, false); return fmaxf(__uint_as_float(r[0]), __uint_as_float(r[1])); }
__device__ __forceinline__ float x32_sum(float v) { const auto r = __builtin_amdgcn_permlane32_swap(__float_as_uint(v), __float_as_uint(v), false, false); return __uint_as_float(r[0]) + __uint_as_float(r[1]); }
__device__ __forceinline__ float x16_max(float v) { const auto r = __builtin_amdgcn_permlane16_swap(__float_as_uint(v), __float_as_uint(v), false, false); return fmaxf(__uint_as_float(r[0]), __uint_as_float(r[1])); }
__device__ __forceinline__ float x16_sum(float v) { const auto r = __builtin_amdgcn_permlane16_swap(__float_as_uint(v), __float_as_uint(v), false, false); return __uint_as_float(r[0]) + __uint_as_float(r[1]); }
__device__ __forceinline__ float wsum_dpp(float v) {
    v += __builtin_bit_cast(float, __builtin_amdgcn_update_dpp(0, __builtin_bit_cast(int, v), 0x111, 0xf, 0xf, true));
    v += __builtin_bit_cast(float, __builtin_amdgcn_update_dpp(0, __builtin_bit_cast(int, v), 0x112, 0xf, 0xf, true));
    v += __builtin_bit_cast(float, __builtin_amdgcn_update_dpp(0, __builtin_bit_cast(int, v), 0x114, 0xf, 0xf, true));
    v += __builtin_bit_cast(float, __builtin_amdgcn_update_dpp(0, __builtin_bit_cast(int, v), 0x118, 0xf, 0xf, true));
    v += __builtin_bit_cast(float, __builtin_amdgcn_update_dpp(0, __builtin_bit_cast(int, v), 0x142, 0xa, 0xf, true));
    v += __builtin_bit_cast(float, __builtin_amdgcn_update_dpp(0, __builtin_bit_cast(int, v), 0x143, 0xc, 0xf, true));
    return __builtin_bit_cast(float, __builtin_amdgcn_readlane(__builtin_bit_cast(int, v), 63));
}
__device__ __forceinline__ float wsum(float v) { for (int o = 32; o; o >>= 1) v += __shfl_xor(v, o); return v; }
__device__ __forceinline__ float wmax(float v) { for (int o = 32; o; o >>= 1) v = fmaxf(v, __shfl_xor(v, o)); return v; }
__device__ __forceinline__ int mbcnt64(unsigned long long m, int base) { return (int)__builtin_amdgcn_mbcnt_hi((unsigned)(m >> 32), __builtin_amdgcn_mbcnt_lo((unsigned)m, (unsigned)base)); }
__device__ __forceinline__ int t5_bucket(int rel) {
    const int n = rel < 0 ? -rel : rel;
    int b = n;
    if (n >= 8) b = 8 + (n >= 15) + (n >= 27) + (n >= 50) + (n >= 91) + (n >= 166) + (n >= 305) + (n >= 559);
    return (rel > 0 ? 16 : 0) + b;
}
__device__ __forceinline__ float lambda_init_of(int l) { return 0.8f - 0.6f * expf(-0.3f * (float)l); }
__device__ __forceinline__ float dot8(uint4 kv, const float* q) {
    return bflo(kv.x) * q[0] + bfhi(kv.x) * q[1] + bflo(kv.y) * q[2] + bfhi(kv.y) * q[3] + bflo(kv.z) * q[4] + bfhi(kv.z) * q[5] + bflo(kv.w) * q[6] + bfhi(kv.w) * q[7];
}


#define XB_TMO      128
#define XB_XCNT(j)  (256  + 64 * (j))
#define XB_XSUB(j)  (1280 + 64 * (j))
#define XB_XGEN(j)  (2304 + 64 * (j))
#define XB_TOP      3328
#define XB_TOPGEN   3392
#define XCD_BAR_WORDS 3456
#define XB_SPIN_CAP (1u << 22)
__device__ __forceinline__ unsigned xb_ld(unsigned* p)              { return __hip_atomic_load(p, __ATOMIC_RELAXED, __HIP_MEMORY_SCOPE_AGENT); }
__device__ __forceinline__ unsigned xb_add(unsigned* p, unsigned v) { return __hip_atomic_fetch_add(p, v, __ATOMIC_RELAXED, __HIP_MEMORY_SCOPE_AGENT); }
__device__ __forceinline__ unsigned xb_xcc_id() { return (unsigned)__builtin_amdgcn_s_getreg((3 << 11) | 20) & 0xFu; }
#define XB_SPIN(cond, bar) do { unsigned _sp = 0; while (cond) { __builtin_amdgcn_s_sleep(1); \
    if ((++_sp & 255u) == 0u) { if (xb_ld(&(bar)[XB_TMO])) break; if (_sp > XB_SPIN_CAP) { atomicAdd(&(bar)[XB_TMO], 1u); break; } } } } while (0)
struct XcdBarrier { unsigned* bar; unsigned x; volatile LAS unsigned* st; };
__device__ __forceinline__ XcdBarrier xcd_barrier_post(unsigned* bar, volatile LAS unsigned* st) {
    XcdBarrier b; b.bar = bar; b.x = xb_xcc_id(); b.st = st;
    if (threadIdx.x == 0) (void)xb_add(&bar[XB_XCNT(b.x)], 1u);
    return b;
}
__device__ __forceinline__ void xcd_barrier_complete(unsigned* bar, unsigned x, unsigned& nloc, unsigned& nx) {
    const unsigned G = gridDim.x * gridDim.y * gridDim.z;
    unsigned sum, cnt, mine, sp = 0u;
    for (;;) {
        sum = 0u; cnt = 0u; mine = 0u;
#pragma unroll
        for (unsigned j = 0; j < 16; ++j) { const unsigned c = xb_ld(&bar[XB_XCNT(j)]); sum += c; cnt += (c > 0u) ? 1u : 0u; mine = (j == x) ? c : mine; }
        if (sum == G) break;
        __builtin_amdgcn_s_sleep(1);
        if ((++sp & 255u) == 0u) { if (xb_ld(&bar[XB_TMO])) break; if (sp > XB_SPIN_CAP) { atomicAdd(&bar[XB_TMO], 1u); break; } }
    }
    nloc = mine > 0u ? mine : 1u; nx = cnt > 0u ? cnt : 1u;
}
__device__ __forceinline__ void xcd_barrier(const XcdBarrier& b) {
    asm volatile("s_waitcnt vmcnt(0)" ::: "memory");
    __syncthreads();
    if (threadIdx.x == 0) {
        unsigned* bar = b.bar;
        __builtin_amdgcn_s_waitcnt(0);
        unsigned nloc = b.st[0], nx = b.st[1];
        if (nloc == 0u) { xcd_barrier_complete(bar, b.x, nloc, nx); b.st[0] = nloc; b.st[1] = nx; }
        const unsigned old = xb_add(&bar[XB_XSUB(b.x)], 1u);
        const unsigned gen = old / nloc;
        if (old + 1u == (gen + 1u) * nloc) {
            __builtin_amdgcn_fence(__ATOMIC_RELEASE, "agent");
            asm volatile("s_waitcnt vmcnt(0)" ::: "memory");
            const unsigned og = xb_add(&bar[XB_TOP], 1u);
            const unsigned tg = og / nx;
            if (og + 1u == (tg + 1u) * nx) xb_add(&bar[XB_TOPGEN], 1u);
            else XB_SPIN(xb_ld(&bar[XB_TOPGEN]) == tg, bar);
            __builtin_amdgcn_fence(__ATOMIC_ACQUIRE, "agent");
            xb_add(&bar[XB_XGEN(b.x)], 1u);
            asm volatile("s_waitcnt vmcnt(0)" ::: "memory");
        } else {
            XB_SPIN(xb_ld(&bar[XB_XGEN(b.x)]) == gen, bar);
            __builtin_amdgcn_fence(__ATOMIC_ACQUIRE, "agent");
            asm volatile("s_waitcnt vmcnt(0)" ::: "memory");
        }
    }
    __syncthreads();
}

__device__ __forceinline__ void ngemm_tile(const bf16_t* A, int lda, const float* W, int ldw, int K, int ncols, int row0, int col0, float (&acc)[8][4], float* lds) {
    float* As = lds; float* Bs = lds + 16 * 132;
    const int tid = tid_opaque(), ty = tid >> 5, tx = tid & 31;
#pragma unroll
    for (int i = 0; i < 8; ++i)
#pragma unroll
        for (int j = 0; j < 4; ++j) acc[i][j] = 0.f;
    for (int k0 = 0; k0 < K; k0 += 16) {
        {
            const int r = tid >> 2, kq = (tid & 3) * 4;
            const uint2 v = *(const uint2*)(A + (size_t)(row0 + r) * lda + k0 + kq);
            As[(kq + 0) * 132 + r] = bflo(v.x); As[(kq + 1) * 132 + r] = bfhi(v.x); As[(kq + 2) * 132 + r] = bflo(v.y); As[(kq + 3) * 132 + r] = bfhi(v.y);
        }
        {
            const int k = tid >> 5, c = (tid & 31) * 4;
            const float* wp = W + (size_t)(k0 + k) * ldw + col0 + c;
            float4 v = make_float4(0.f, 0.f, 0.f, 0.f);
            if (col0 + c + 3 < ncols) v = *(const float4*)wp;
            else { if (col0 + c < ncols) v.x = wp[0]; if (col0 + c + 1 < ncols) v.y = wp[1]; if (col0 + c + 2 < ncols) v.z = wp[2]; }
            *(float4*)(Bs + k * 128 + c) = v;
        }
        __syncthreads();
#pragma unroll 2
        for (int kk = 0; kk < 16; ++kk) {
            const float4 a0 = *(const float4*)(As + kk * 132 + ty * 8), a1 = *(const float4*)(As + kk * 132 + ty * 8 + 4);
            const float4 b = *(const float4*)(Bs + kk * 128 + tx * 4);
            const float a[8] = {a0.x, a0.y, a0.z, a0.w, a1.x, a1.y, a1.z, a1.w}; const float bb[4] = {b.x, b.y, b.z, b.w};
#pragma unroll
            for (int i = 0; i < 8; ++i)
#pragma unroll
                for (int j = 0; j < 4; ++j) acc[i][j] += a[i] * bb[j];
        }
        __syncthreads();
    }
}

__device__ __forceinline__ void ph_rmsnorm(const float* xsrc, const bf16_t* xs16, const float* g, bf16_t* H) {
    const int tidq = tid_opaque(); const int lane = tidq & 63, wid = tidq >> 6;
    float4 gv[4];
#pragma unroll
    for (int j = 0; j < 4; ++j) gv[j] = ((const float4*)g)[j * 64 + lane];
    for (int row0 = (blockIdx.x * 8 + wid) * 4; row0 < NTOK; row0 += gridDim.x * 32) {
        float4 v[4][4];
#pragma unroll
        for (int r = 0; r < 4; ++r) {
            if (xs16 == nullptr) { const float4* xp = (const float4*)(xsrc + (size_t)(row0 + r) * ND);
#pragma unroll
                for (int j = 0; j < 4; ++j) v[r][j] = xp[j * 64 + lane]; }
            else { const uint2* xp = (const uint2*)(xs16 + (size_t)(row0 + r) * ND);
#pragma unroll
                for (int j = 0; j < 4; ++j) { const uint2 w = xp[j * 64 + lane]; v[r][j] = make_float4(bflo(w.x), bfhi(w.x), bflo(w.y), bfhi(w.y)); } }
        }
#pragma unroll
        for (int r = 0; r < 4; ++r) {
            float ss = 0.f;
#pragma unroll
            for (int j = 0; j < 4; ++j) ss += v[r][j].x * v[r][j].x + v[r][j].y * v[r][j].y + v[r][j].z * v[r][j].z + v[r][j].w * v[r][j].w;
            ss = wsum_dpp(ss);
            const float rstd = rsqrtf(ss * (1.0f / ND) + EPS);
#pragma unroll
            for (int j = 0; j < 4; ++j) {
                uint2 o; o.x = pack2hw(v[r][j].x * rstd * gv[j].x, v[r][j].y * rstd * gv[j].y); o.y = pack2hw(v[r][j].z * rstd * gv[j].z, v[r][j].w * rstd * gv[j].w);
                *(uint2*)(H + (size_t)(row0 + r) * ND + (j * 64 + lane) * 4) = o;
            }
        }
    }
}

__device__ __forceinline__ void store_proj_raw(const Proj& pj, int tok, int c, float v) {
    if (c < 512) pj.aq[(size_t)tok * 512 + c] = f2bf(v);
    else if (c < 1024) pj.ak[(size_t)tok * 512 + c - 512] = f2bf(v);
    else if (c < 1536) pj.av[(size_t)tok * 512 + c - 1024] = f2bf(v);
    else if (c < 2048) pj.bq[(size_t)tok * 512 + c - 1536] = f2bf(v);
    else if (c < 2176) pj.bk[(size_t)tok * 128 + c - 2048] = f2bf(v);
    else if (c < 2304) pj.bv[(size_t)tok * 128 + c - 2176] = f2bf(v);
    else if (c < 2816) pj.cq[(size_t)tok * 512 + c - 2304] = f2bf(v);
    else if (c < 2880) pj.ck[(size_t)tok * 64 + c - 2816] = f2bf(v);
    else if (c < 2944) pj.cv[(size_t)tok * 64 + c - 2880] = f2bf(v);
    else if (c < 3072) pj.iq[(size_t)tok * 128 + c - 2944] = f2bf(v);
    else if (c < 3104) pj.ik[(size_t)tok * 32 + c - 3072] = f2bf(v);
    else if (c < 3108) pj.iw[(size_t)tok * 4 + c - 3104] = v * IWSCALE;
}
__device__ __forceinline__ void ph_inproj_naive(const Params& P_, int l, float* lds) {
    const KA P = ka_get();
    const Proj pj = proj_ptrs(P.ws);
    const bf16_t* H = (const bf16_t*)(P.ws + OFF_H);
    const float* W = P.in[I_WIN] + (size_t)l * ND * IN_COLS;
    const int tid = tid_opaque(), ty = tid >> 5, tx = tid & 31;
    for (int t = blockIdx.x; t < 256 * 25; t += gridDim.x) {
        const int tm = t / 25, tn = t % 25;
        float acc[8][4];
        ngemm_tile(H, ND, W, IN_COLS, ND, IN_COLS, tm * 128, tn * 128, acc, lds);
#pragma unroll
        for (int i = 0; i < 8; ++i)
#pragma unroll
            for (int j = 0; j < 4; ++j) { const int c = tn * 128 + tx * 4 + j; if (c < IN_COLS) store_proj_raw(pj, tm * 128 + ty * 8 + i, c, acc[i][j]); }
    }
}
__device__ __forceinline__ void ph_headnorm_naive(const Params& P_, int l) {
    const KA P = ka_get();
    const Proj pj = proj_ptrs(P.ws);
    const float* qkg = P.in[I_QKG] + (size_t)l * 3 * 2 * 64;
    const int tidq = tid_opaque(); const int lane = tidq & 63, wid = tidq >> 6;
    for (long t = (long)blockIdx.x * 8 + wid; t < (long)NTOK * 35; t += (long)gridDim.x * 8) {
        const int tok = (int)(t / 35), g = (int)(t % 35);
        bf16_t* p; const float* gv; float sc = 1.f;
        if (g < 8) { p = pj.aq + (size_t)tok * 512 + g * 64; gv = qkg + 0; sc = QSCALE; }
        else if (g < 16) { p = pj.ak + (size_t)tok * 512 + (g - 8) * 64; gv = qkg + 64; }
        else if (g < 24) { p = pj.bq + (size_t)tok * 512 + (g - 16) * 64; gv = qkg + 128; sc = QSCALE; }
        else if (g < 26) { p = pj.bk + (size_t)tok * 128 + (g - 24) * 64; gv = qkg + 192; }
        else if (g < 34) { p = pj.cq + (size_t)tok * 512 + (g - 26) * 64; gv = qkg + 256; sc = QSCALE; }
        else { p = pj.ck + (size_t)tok * 64; gv = qkg + 320; }
        const float v = bf2f(p[lane]);
        const float ss = wsum(v * v);
        p[lane] = f2bf(v * rsqrtf(ss * (1.0f / 64) + EPS) * gv[lane] * sc);
    }
}

__device__ __forceinline__ void ph_attnA_naive(const Params& P_, int l, float* lds) {
    const KA P = ka_get();
    const Proj pj = proj_ptrs(P.ws);
    bf16_t* BR = (bf16_t*)(P.ws + OFF_BR);
    const int tidq = tid_opaque(); const int lane = tidq & 63, wid = tidq >> 6;
    float* btab = lds;
    float* qs = lds + 128 + wid * 128;
    for (int i = tidq; i < 128; i += 512) btab[i] = P.in[I_RELB][(i >> 2) * 20 + (i & 3)] * LOG2E;
    __syncthreads();
    const float* lp = P.in[I_LAM] + (size_t)l * 256;
    const float linit = lambda_init_of(l);
    const float lam = expf(wsum(lp[lane] * lp[64 + lane])) - expf(wsum(lp[128 + lane] * lp[192 + lane])) + linit;
    const float* subg = P.in[I_SUBLN] + (size_t)l * 128;
    for (int t = blockIdx.x * 8 + wid; t < NB * 4 * NS; t += gridDim.x * 8) {
        const int q = t & (NS - 1), h = (t >> 12) & 3, b = t >> 14;
        const int tok = b * NS + q;
        qs[lane] = bf2f(pj.aq[(size_t)tok * 512 + (h * 2) * 64 + lane]);
        qs[64 + lane] = bf2f(pj.aq[(size_t)tok * 512 + (h * 2 + 1) * 64 + lane]);
        const int nkt = (q >> 6) + 1;
        float M0 = -INFINITY, Z0 = 0.f, M1 = -INFINITY, Z1 = 0.f;
        for (int kt = 0; kt < nkt; ++kt) {
            asm volatile("" ::: "memory");
            const int key = kt * 64 + lane;
            const uint4* kp = (const uint4*)(pj.ak + (size_t)(b * NS + key) * 512 + h * 128);
            float s0 = 0.f, s1 = 0.f;
#pragma unroll 1
            for (int d = 0; d < 8; ++d) { asm volatile("" ::: "memory"); s0 += dot8(kp[d], qs + d * 8); s1 += dot8(kp[8 + d], qs + 64 + d * 8); }
            const float bias = btab[t5_bucket(key - q) * 4 + h];
            s0 += bias; s1 += bias;
            float mn = fmaxf(M0, s0); Z0 = Z0 * exp2f(M0 - mn) + exp2f(s0 - mn); M0 = mn;
            mn = fmaxf(M1, s1); Z1 = Z1 * exp2f(M1 - mn) + exp2f(s1 - mn); M1 = mn;
        }
        { const float mw = wmax(M0); Z0 = wsum(Z0 * exp2f(M0 - mw)); M0 = mw; }
        { const float mw = wmax(M1); Z1 = wsum(Z1 * exp2f(M1 - mw)); M1 = mw; }
        const float iz0 = 1.f / Z0, iz1 = lam / Z1;
        float a0 = 0.f, a1 = 0.f;
        for (int kt = 0; kt < nkt; ++kt) {
            asm volatile("" ::: "memory");
            const int key = kt * 64 + lane;
            const uint4* kp = (const uint4*)(pj.ak + (size_t)(b * NS + key) * 512 + h * 128);
            float s0 = 0.f, s1 = 0.f;
#pragma unroll 1
            for (int d = 0; d < 8; ++d) { asm volatile("" ::: "memory"); s0 += dot8(kp[d], qs + d * 8); s1 += dot8(kp[8 + d], qs + 64 + d * 8); }
            const float bias = btab[t5_bucket(key - q) * 4 + h];
            const float p = exp2f(s0 + bias - M0) * iz0 - exp2f(s1 + bias - M1) * iz1;
            const unsigned* vp = (const unsigned*)(pj.av + (size_t)(b * NS + kt * 64) * 512 + h * 128) + lane;
#pragma unroll 4
            for (int j = 0; j < 64; ++j) { const float pjv = __shfl(p, j); const unsigned w = vp[(size_t)j * 256]; a0 += pjv * bflo(w); a1 += pjv * bfhi(w); }
        }
        const float ss = wsum(a0 * a0 + a1 * a1);
        const float rstd = rsqrtf(ss * (1.0f / 128) + EPS) * (1.0f - linit);
        *(unsigned*)(BR + (size_t)tok * 1536 + h * 128 + lane * 2) = pack2(a0 * rstd * subg[lane * 2], a1 * rstd * subg[lane * 2 + 1]);
    }
}

__device__ __forceinline__ void ph_attnB_naive(const Params& P_, int l, float* lds) {
    const KA P = ka_get();
    const Proj pj = proj_ptrs(P.ws);
    bf16_t* BR = (bf16_t*)(P.ws + OFF_BR);
    const int tidq = tid_opaque(); const int lane = tidq & 63, wid = tidq >> 6;
    float* btab = lds;
    float* qs = lds + 256 + wid * 64;
    __syncthreads();
    for (int i = tidq; i < 256; i += 512) btab[i] = P.in[I_RELB][(i >> 3) * 20 + 4 + (i & 7)] * LOG2E;
    __syncthreads();
    const float* sinks = P.in[I_SINK] + (size_t)l * 8;
    for (int t = blockIdx.x * 8 + wid; t < NTOK * 8; t += gridDim.x * 8) {
        const int hq = t & 7, tok = t >> 3, q = tok & (NS - 1), b = tok >> 12, kvh = hq >> 2, c = q >> 6;
        qs[lane] = bf2f(pj.bq[(size_t)tok * 512 + hq * 64 + lane]);
        float s[3];
#pragma unroll
        for (int g = 0; g < 3; ++g) {
            const int pos = c * 64 - 128 + g * 64 + lane;
            s[g] = -INFINITY;
            if (pos >= 0) {
                const uint4* kp = (const uint4*)(pj.bk + (size_t)(b * NS + pos) * 128 + kvh * 64);
                float a = 0.f;
#pragma unroll
                for (int d = 0; d < 8; ++d) a += dot8(kp[d], qs + d * 8);
                s[g] = a + btab[t5_bucket(pos - q) * 8 + hq];
            }
        }
        const float sink = sinks[hq] * LOG2E;
        const float m = fmaxf(wmax(fmaxf(fmaxf(s[0], s[1]), s[2])), sink);
        float e[3];
#pragma unroll
        for (int g = 0; g < 3; ++g) e[g] = exp2f(s[g] - m);
        const float Z = wsum(e[0] + e[1] + e[2]) + exp2f(sink - m);
        const float iz = 1.f / Z;
        float acc = 0.f;
#pragma unroll
        for (int g = 0; g < 3; ++g) {
            const int pos0 = c * 64 - 128 + g * 64;
            if (pos0 >= 0) {
                const bf16_t* vp = pj.bv + (size_t)(b * NS + pos0) * 128 + kvh * 64 + lane;
#pragma unroll 4
                for (int j = 0; j < 64; ++j) acc += __shfl(e[g], j) * bf2f(vp[(size_t)j * 128]);
            }
        }
        BR[(size_t)tok * 1536 + 512 + hq * 64 + lane] = f2bf(acc * iz);
    }
}

__device__ __forceinline__ void ph_attnC_naive(const Params& P_, int l, float* lds) {
    const KA P = ka_get();
    const Proj pj = proj_ptrs(P.ws);
    bf16_t* BR = (bf16_t*)(P.ws + OFF_BR);
    const int tidq = tid_opaque(); const int lane = tidq & 63, wid = tidq >> 6;
    float* btab = lds;
    unsigned* keys = (unsigned*)(lds + 256) + wid * 4480;
    int* sel = (int*)(keys + 4096);
    float* iqs = (float*)(keys + 4096 + 256);
    __syncthreads();
    for (int i = tidq; i < 256; i += 512) btab[i] = P.in[I_RELB][(i >> 3) * 20 + 12 + (i & 7)] * LOG2E;
    __syncthreads();
    for (int tok = blockIdx.x * 8 + wid; tok < NTOK; tok += gridDim.x * 8) {
        const int q = tok & (NS - 1), b = tok >> 12, c = q >> 6, N = (c + 1) * 64, ntile = c + 1;
        iqs[lane] = bf2f(pj.iq[(size_t)tok * 128 + lane]); iqs[64 + lane] = bf2f(pj.iq[(size_t)tok * 128 + 64 + lane]);
        const float4 wv = *(const float4*)(pj.iw + (size_t)tok * 4);
        int cnt;
        if (N <= 256) { for (int i = lane; i < N; i += 64) sel[i] = i; cnt = N; }
        else {
            for (int kt = 0; kt < ntile; ++kt) {
                asm volatile("" ::: "memory");
                const int key = kt * 64 + lane;
                const uint4* kp = (const uint4*)(pj.ik + (size_t)(b * NS + key) * 32);
                const uint4 k0 = kp[0], k1 = kp[1], k2 = kp[2], k3 = kp[3];
                float sc = 0.f;
#pragma unroll
                for (int hh = 0; hh < 4; ++hh) {
                    const float lg = dot8(k0, iqs + hh * 32) + dot8(k1, iqs + hh * 32 + 8) + dot8(k2, iqs + hh * 32 + 16) + dot8(k3, iqs + hh * 32 + 24);
                    const float w = hh == 0 ? wv.x : hh == 1 ? wv.y : hh == 2 ? wv.z : wv.w;
                    sc += fmaxf(lg, 0.f) * w;
                }
                sc += 0.0f;
                const unsigned u = __float_as_uint(sc);
                keys[key] = (u & 0x80000000u) ? ~u : (u | 0x80000000u);
            }
            unsigned T = 0;
            for (int bit = 31; bit >= 0; --bit) {
                const unsigned cand = T | (1u << bit);
                int n = 0;
                for (int kt = 0; kt < ntile; ++kt) n += __popcll(__ballot(keys[kt * 64 + lane] >= cand));
                if (n >= 256) T = cand;
            }
            int ngt = 0;
            for (int kt = 0; kt < ntile; ++kt) ngt += __popcll(__ballot(keys[kt * 64 + lane] > T));
            const int need = 256 - ngt;
            int nsel = 0, neq = 0;
            const unsigned long long ltmask = (1ull << lane) - 1ull;
            for (int kt = 0; kt < ntile; ++kt) {
                const unsigned kv = keys[kt * 64 + lane];
                const unsigned long long eqm = __ballot(kv == T);
                const bool take = (kv > T) || (kv == T && (neq + __popcll(eqm & ltmask)) < need);
                const unsigned long long tm = __ballot(take);
                if (take) sel[nsel + __popcll(tm & ltmask)] = kt * 64 + lane;
                nsel += __popcll(tm); neq += __popcll(eqm);
            }
            cnt = 256;
        }
        int idx[4];
#pragma unroll
        for (int j = 0; j < 4; ++j) idx[j] = (lane + 64 * j < cnt) ? sel[lane + 64 * j] : 0;
        for (int h = 0; h < 8; ++h) {
            iqs[lane] = bf2f(pj.cq[(size_t)tok * 512 + h * 64 + lane]);
            const float* qv = iqs;
            float s[4];
#pragma unroll
            for (int j = 0; j < 4; ++j) {
                asm volatile("" ::: "memory");
                s[j] = -INFINITY;
                if (lane + 64 * j < cnt) {
                    const uint4* kp = (const uint4*)(pj.ck + (size_t)(b * NS + idx[j]) * 64);
                    float a = 0.f;
#pragma unroll
                    for (int d = 0; d < 8; ++d) a += dot8(kp[d], qv + d * 8);
                    s[j] = a + btab[t5_bucket(idx[j] - q) * 8 + h];
                }
            }
            const float m = wmax(fmaxf(fmaxf(s[0], s[1]), fmaxf(s[2], s[3])));
            float e[4];
#pragma unroll
            for (int j = 0; j < 4; ++j) e[j] = exp2f(s[j] - m);
            const float iz = 1.f / wsum(e[0] + e[1] + e[2] + e[3]);
            float acc = 0.f;
#pragma unroll
            for (int j = 0; j < 4; ++j) {
                const int nj = cnt - 64 * j < 64 ? cnt - 64 * j : 64;
#pragma unroll 2
                for (int i = 0; i < nj; ++i) { const float pv = __shfl(e[j], i); const int id = __shfl(idx[j], i); acc += pv * bf2f(pj.cv[(size_t)(b * NS + id) * 64 + lane]); }
            }
            BR[(size_t)tok * 1536 + 1024 + h * 64 + lane] = f2bf(acc * iz);
        }
    }
}

__device__ __forceinline__ void ph_gatebranch_naive(const Params& P_, int l, float* lds) {
    const KA P = ka_get();
    const bf16_t* H = (const bf16_t*)(P.ws + OFF_H);
    const bf16_t* BR = (const bf16_t*)(P.ws + OFF_BR);
    bf16_t* MG = (bf16_t*)(P.ws + OFF_MERGED);
    const float* Wg = P.in[I_WGATE] + (size_t)l * ND * 3072;
    const float* bg = P.in[I_BGATE] + (size_t)l * 3072;
    const float* Wb = P.in[I_WBR] + (size_t)l * 3 * 512 * ND;
    const int tid = tid_opaque(), ty = tid >> 5, tx = tid & 31;
    for (int t = blockIdx.x; t < 256 * 8; t += gridDim.x) {
        const int tm = t >> 3, tn = t & 7;
        float m[8][4];
#pragma unroll
        for (int i = 0; i < 8; ++i)
#pragma unroll
            for (int j = 0; j < 4; ++j) m[i][j] = 0.f;
        for (int n = 0; n < 3; ++n) {
            float g[8][4], y[8][4];
            ngemm_tile(H, ND, Wg, 3072, ND, 3072, tm * 128, n * 1024 + tn * 128, g, lds);
            ngemm_tile(BR + n * 512, 1536, Wb + (size_t)n * 512 * ND, ND, 512, ND, tm * 128, tn * 128, y, lds);
#pragma unroll
            for (int i = 0; i < 8; ++i)
#pragma unroll
                for (int j = 0; j < 4; ++j) { const float z = g[i][j] + bg[n * 1024 + tn * 128 + tx * 4 + j]; m[i][j] += y[i][j] / (1.f + expf(-z)); }
        }
#pragma unroll
        for (int i = 0; i < 8; ++i) {
            uint2 o; o.x = pack2(m[i][0], m[i][1]); o.y = pack2(m[i][2], m[i][3]);
            *(uint2*)(MG + (size_t)(tm * 128 + ty * 8 + i) * ND + tn * 128 + tx * 4) = o;
        }
    }
}
__device__ __forceinline__ void ph_out_naive(const Params& P_, int l, float* lds) {
    const KA P = ka_get();
    const bf16_t* MG = (const bf16_t*)(P.ws + OFF_MERGED);
    const float* W = P.in[I_WOUT] + (size_t)l * ND * ND;
    const float* xsrc = l == 0 ? P.in[I_X] : P.out;
    const int tid = tid_opaque(), ty = tid >> 5, tx = tid & 31;
    for (int t = blockIdx.x; t < 256 * 8; t += gridDim.x) {
        const int tm = t >> 3, tn = t & 7;
        float acc[8][4];
        ngemm_tile(MG, ND, W, ND, ND, ND, tm * 128, tn * 128, acc, lds);
#pragma unroll
        for (int i = 0; i < 8; ++i) {
            const size_t o = (size_t)(tm * 128 + ty * 8 + i) * ND + tn * 128 + tx * 4;
            const float4 xv = *(const float4*)(xsrc + o);
            *(float4*)(P.out + o) = make_float4(xv.x + acc[i][0], xv.y + acc[i][1], xv.z + acc[i][2], xv.w + acc[i][3]);
        }
    }
}

__device__ __forceinline__ void ph_norm2_route(const Params& P_, int l, float* lds_) {
    const KA P = ka_get();
    bf16_t* H = (bf16_t*)(P.ws + OFF_H);
    int* eid = (int*)(P.ws + OFF_ROUTE); float* ew = (float*)(P.ws + OFF_ROUTE + 256 * 1024);
    const float* g = P.in[I_NFG] + (size_t)l * ND;
    const float* wrg = P.in[I_WRG] + (size_t)l * ND * 4; const float* brg = P.in[I_BRG] + (size_t)l * 4;
    const float* wre = P.in[I_WRE] + (size_t)l * ND * 16; const float* bre = P.in[I_BRE] + (size_t)l * 16;
    const int tidq = tid_opaque(); const int lane = tidq & 63, wid = tidq >> 6;
    typedef float v4f __attribute__((ext_vector_type(4)));
    LAS v4f* wl = (LAS v4f*)lds_;
    __syncthreads();
    for (int idx = tidq; idx < 5120; idx += 512) {
        const int ln = idx & 63, t = idx >> 6, q = t % 5, je = t / 5, k = ((je >> 2) * 64 + ln) * 4 + (je & 3);
        wl[idx] = q == 0 ? *(const v4f*)(wrg + (size_t)k * 4) : *(const v4f*)(wre + (size_t)k * 16 + (q - 1) * 4);
    }
    __syncthreads();
    for (int row0 = (blockIdx.x * 8 + wid) * 2; row0 < NTOK; row0 += gridDim.x * 16) {
        float4 v[2][4]; float rstd[2];
#pragma unroll
        for (int r = 0; r < 2; ++r) { const uint2* xp = (const uint2*)((const bf16_t*)(P.ws + OFF_STREAM) + (size_t)(row0 + r) * ND);
#pragma unroll
            for (int j = 0; j < 4; ++j) { const uint2 w = xp[j * 64 + lane]; v[r][j] = make_float4(bflo(w.x), bfhi(w.x), bflo(w.y), bfhi(w.y)); } }
#pragma unroll
        for (int r = 0; r < 2; ++r) { float ss = 0.f;
#pragma unroll
            for (int j = 0; j < 4; ++j) ss += v[r][j].x * v[r][j].x + v[r][j].y * v[r][j].y + v[r][j].z * v[r][j].z + v[r][j].w * v[r][j].w;
            rstd[r] = rsqrtf(wsum_dpp(ss) * (1.0f / ND) + EPS); }
        float lg[2][20];
#pragma unroll
        for (int r = 0; r < 2; ++r)
#pragma unroll
            for (int i = 0; i < 20; ++i) lg[r][i] = 0.f;
#pragma unroll
        for (int j = 0; j < 4; ++j) {
            const int k0 = (j * 64 + lane) * 4;
            const float4 gv = ((const float4*)g)[j * 64 + lane];
            float hv[2][4];
#pragma unroll
            for (int r = 0; r < 2; ++r) {
                hv[r][0] = v[r][j].x * rstd[r] * gv.x; hv[r][1] = v[r][j].y * rstd[r] * gv.y; hv[r][2] = v[r][j].z * rstd[r] * gv.z; hv[r][3] = v[r][j].w * rstd[r] * gv.w;
                uint2 o; o.x = pack2hw(hv[r][0], hv[r][1]); o.y = pack2hw(hv[r][2], hv[r][3]);
                *(uint2*)(H + (size_t)(row0 + r) * ND + k0) = o;
            }
#pragma unroll
            for (int e = 0; e < 4; ++e) {
                const LAS v4f* wp = wl + ((j * 4 + e) * 5) * 64 + lane;
                const v4f wg4 = wp[0], w0 = wp[64], w1 = wp[128], w2 = wp[192], w3 = wp[256];
#pragma unroll
                for (int r = 0; r < 2; ++r) {
                    const float x = hv[r][e];
                    lg[r][0] += x * wg4.x; lg[r][1] += x * wg4.y; lg[r][2] += x * wg4.z; lg[r][3] += x * wg4.w;
                    lg[r][4] += x * w0.x; lg[r][5] += x * w0.y; lg[r][6] += x * w0.z; lg[r][7] += x * w0.w;
                    lg[r][8] += x * w1.x; lg[r][9] += x * w1.y; lg[r][10] += x * w1.z; lg[r][11] += x * w1.w;
                    lg[r][12] += x * w2.x; lg[r][13] += x * w2.y; lg[r][14] += x * w2.z; lg[r][15] += x * w2.w;
                    lg[r][16] += x * w3.x; lg[r][17] += x * w3.y; lg[r][18] += x * w3.z; lg[r][19] += x * w3.w;
                }
            }
            asm volatile("" ::: "memory");
        }
#pragma unroll
        for (int r = 0; r < 2; ++r)
#pragma unroll
            for (int i = 0; i < 20; ++i) lg[r][i] = wsum_dpp(lg[r][i]);
        if (lane < 2) {
            const int row = row0 + lane;
            float lgl[20];
#pragma unroll
            for (int i = 0; i < 20; ++i) lgl[i] = lane == 0 ? lg[0][i] : lg[1][i];
            float gl[4];
#pragma unroll
            for (int i = 0; i < 4; ++i) gl[i] = lgl[i] + brg[i];
            int gs = 0; float gm = gl[0];
#pragma unroll
            for (int i = 1; i < 4; ++i) if (gl[i] > gm) { gm = gl[i]; gs = i; }
            float zs = 0.f;
#pragma unroll
            for (int i = 0; i < 4; ++i) zs += expf(gl[i] - gm);
            const float pgroup = 1.f / zs;
            float el[4];
#pragma unroll
            for (int i = 0; i < 4; ++i) { el[i] = 0.f;
#pragma unroll
                for (int gq = 0; gq < 4; ++gq) if (gq == gs) el[i] = lgl[4 + gq * 4 + i] + bre[gq * 4 + i]; }
            int e1 = 0; float v1 = el[0];
#pragma unroll
            for (int i = 1; i < 4; ++i) if (el[i] > v1) { v1 = el[i]; e1 = i; }
            int e2 = -1; float v2 = -INFINITY;
#pragma unroll
            for (int i = 0; i < 4; ++i) if (i != e1 && el[i] > v2) { v2 = el[i]; e2 = i; }
            const float x2 = expf(v2 - v1), w1 = 1.f / (1.f + x2), w2 = x2 / (1.f + x2);
            eid[row * 2] = gs * 4 + e1; eid[row * 2 + 1] = gs * 4 + e2;
            ew[row * 2] = w1 * pgroup; ew[row * 2 + 1] = w2 * pgroup;
            const int lo = e1 < e2 ? e1 : e2, hi = e1 < e2 ? e2 : e1;
            const int bk = gs * 6 + (lo == 0 ? hi - 1 : (lo == 1 ? hi + 1 : 5));
            const int pos = atomicAdd((int*)(P.ws + OFF_CTRL + MOE_CNT_OFF) + l * 32 + bk, 1);
            ((int*)(P.ws + OFF_ROUTE + MOE_LIST_OFF))[bk * NTOK + pos] = row;
            float* rw = (float*)(P.ws + OFF_ROUTE + MOE_RW_OFF);
            rw[row * 2] = (e1 < e2 ? w1 : w2) * pgroup; rw[row * 2 + 1] = (e1 < e2 ? w2 : w1) * pgroup;
        }
    }
}

__device__ __forceinline__ void ph_moe_naive(const Params& P_, int l, float* lds) {
    const KA P = ka_get();
    const bf16_t* H = (const bf16_t*)(P.ws + OFF_H);
    const int* eid = (const int*)(P.ws + OFF_ROUTE); const float* ew = (const float*)(P.ws + OFF_ROUTE + 256 * 1024);
    const int tidq = tid_opaque(); const int lane = tidq & 63, wid = tidq >> 6;
    float* hs = lds + wid * 1280;
    float* hid = hs + 1024;
    for (int tok = blockIdx.x * 8 + wid; tok < NTOK; tok += gridDim.x * 8) {
#pragma unroll
        for (int j = 0; j < 4; ++j) { const uint2 w = *(const uint2*)(H + (size_t)tok * ND + (j * 64 + lane) * 4); float* d = hs + (j * 64 + lane) * 4; d[0] = bflo(w.x); d[1] = bfhi(w.x); d[2] = bflo(w.y); d[3] = bfhi(w.y); }
        float o[16];
#pragma unroll
        for (int i = 0; i < 16; ++i) o[i] = 0.f;
        for (int s = 0; s < 2; ++s) {
            const int e = eid[tok * 2 + s]; const float w = ew[tok * 2 + s];
            const float* wg = P.in[I_WFG] + ((size_t)l * 16 + e) * ND * 256;
            const float* wu = P.in[I_WFU] + ((size_t)l * 16 + e) * ND * 256;
            const float* wd = P.in[I_WFD] + ((size_t)l * 16 + e) * 256 * ND;
            float4 ga = make_float4(0.f, 0.f, 0.f, 0.f), ua = ga;
            for (int k = 0; k < ND; ++k) {
                const float hv = hs[k];
                const float4 a = *(const float4*)(wg + (size_t)k * 256 + lane * 4), u = *(const float4*)(wu + (size_t)k * 256 + lane * 4);
                ga.x += hv * a.x; ga.y += hv * a.y; ga.z += hv * a.z; ga.w += hv * a.w; ua.x += hv * u.x; ua.y += hv * u.y; ua.z += hv * u.z; ua.w += hv * u.w;
            }
            float4 hv4;
            hv4.x = ga.x / (1.f + expf(-ga.x)) * ua.x * w; hv4.y = ga.y / (1.f + expf(-ga.y)) * ua.y * w; hv4.z = ga.z / (1.f + expf(-ga.z)) * ua.z * w; hv4.w = ga.w / (1.f + expf(-ga.w)) * ua.w * w;
            *(float4*)(hid + lane * 4) = hv4;
            for (int f = 0; f < 256; ++f) {
                const float hf = hid[f];
#pragma unroll
                for (int j = 0; j < 4; ++j) { const float4 d = *(const float4*)(wd + (size_t)f * ND + (j * 64 + lane) * 4); o[j * 4] += hf * d.x; o[j * 4 + 1] += hf * d.y; o[j * 4 + 2] += hf * d.z; o[j * 4 + 3] += hf * d.w; }
            }
        }
#pragma unroll
        for (int j = 0; j < 4; ++j) {
            float4* op = (float4*)(P.out + (size_t)tok * ND + (j * 64 + lane) * 4);
            float4 x = *op; x.x += o[j * 4]; x.y += o[j * 4 + 1]; x.z += o[j * 4 + 2]; x.w += o[j * 4 + 3]; *op = x;
        }
    }
}


namespace mm {
typedef short bf16x8 __attribute__((ext_vector_type(8)));
typedef float f32x16 __attribute__((ext_vector_type(16)));
typedef float f32x4 __attribute__((ext_vector_type(4)));
typedef unsigned u32x4 __attribute__((ext_vector_type(4)));
constexpr int OPB = 256 * 128;
constexpr int STG = 2 * OPB;
constexpr int LDS_NEED = 2 * STG;
__host__ __device__ __forceinline__ int img_col(int rho) { const int i = rho & 31; return (rho & ~31) + 16 * ((i >> 2) & 1) + 4 * (i >> 3) + (i & 3); }
__device__ __forceinline__ unsigned cvt_pk_bf16(float lo, float hi) { unsigned r; asm volatile("v_cvt_pk_bf16_f32 %0, %1, %2" : "=v"(r) : "v"(lo), "v"(hi)); return r; }
__device__ __forceinline__ u32x4 pack8(const f32x16& v, int o) { u32x4 w; w.x = cvt_pk_bf16(v[o], v[o + 1]); w.y = cvt_pk_bf16(v[o + 2], v[o + 3]); w.z = cvt_pk_bf16(v[o + 4], v[o + 5]); w.w = cvt_pk_bf16(v[o + 6], v[o + 7]); return w; }

struct Unit {
    const char* a;
    const char* b0;
    const char* b1;
    int lda, ldb;
    int nk, nseg;
    int pm, pn, tag;
    int aux0, aux1;
};
__device__ __forceinline__ bool static_tile(long L, int nM, int nN, int& pm, int& pn) {
    const int nwg = nM * nN; if (L >= nwg) return false;
    int wgid = (int)L; { const int q = nwg / 8, r = nwg % 8, xcd = wgid % 8, off = wgid / 8; wgid = (xcd < r ? xcd * (q + 1) : r * (q + 1) + (xcd - r) * q) + off; }
    const int nig = 8 * nN, gid = wgid / nig, fm = gid * 8, gsz = (nM - fm) < 8 ? (nM - fm) : 8;
    pm = fm + ((wgid % nig) % gsz); pn = (wgid % nig) / gsz; return true;
}

template <class Epi, class Sched>
__device__ __forceinline__ void gemm_phase(char* smem, const Sched& S, const Epi& E) {
    const int tid = tid_opaque(), lane = tid & 63, wid = __builtin_amdgcn_readfirstlane(tid >> 6), wm = wid >> 2, wn = wid & 3, r32 = lane & 31, h = lane >> 5;
    LAS char* lds = (LAS char*)smem;
    const int srow = tid >> 3, sc = tid & 7;
    const unsigned sts = (unsigned)(srow * 128 + ((sc ^ ((srow >> 1) & 7)) << 4));
    const unsigned rda = (unsigned)((wm * 128 + r32) * 128), rdb = (unsigned)(OPB + (wn * 64 + r32) * 128);
    const unsigned x7 = (unsigned)((r32 >> 1) & 7);
    Unit lu; int ci = 0, li = 0;
    if (!S.next(0, lu)) return;
    int cnk = lu.nk;
    constexpr int NA = Sched::GATHER ? 4 : 1;
    unsigned ao[NA], bo;
    auto offs = [&](const Unit& u, unsigned (&a)[NA], unsigned& b) {
        int t2 = tid; asm volatile("" : "+v"(t2));
        const int r0 = t2 >> 3, c16 = (t2 & 7) * 16;
        S.a_rows(u, r0, a);
#pragma unroll
        for (int q = 0; q < NA; ++q) a[q] += (unsigned)c16;
        b = (unsigned)(r0 * u.ldb * 2 + c16);
    };
    offs(lu, ao, bo);
    f32x16 acc[4][2];
#pragma unroll
    for (int i = 0; i < 4; ++i)
#pragma unroll
        for (int j = 0; j < 2; ++j)
#pragma unroll
            for (int e = 0; e < 16; ++e) acc[i][j][e] = 0.f;
    u32x4 ga[4], gb[4];
#define MM_GLOAD(u, k, A_, B_) do { \
        const __amdgpu_buffer_rsrc_t ra_ = __builtin_amdgcn_make_buffer_rsrc((void*)(u).a, 0, 0x7fffffff, 0x00020000); \
        const __amdgpu_buffer_rsrc_t rb_ = __builtin_amdgcn_make_buffer_rsrc((void*)((k) < (u).nseg ? (u).b0 : (u).b1), 0, 0x7fffffff, 0x00020000); \
        const unsigned ko_ = (unsigned)(k) * 128u, as_ = (unsigned)(u).lda * 128u, bs_ = (unsigned)(u).ldb * 128u; \
        _Pragma("unroll") for (int q_ = 0; q_ < 4; ++q_) { \
            ga[q_] = __builtin_bit_cast(u32x4, __builtin_amdgcn_raw_buffer_load_b128(ra_, Sched::GATHER ? (A_)[q_ % NA] : (A_)[0], Sched::GATHER ? ko_ : ko_ + q_ * as_, 0)); \
            gb[q_] = __builtin_bit_cast(u32x4, __builtin_amdgcn_raw_buffer_load_b128(rb_, (B_), ko_ + q_ * bs_, 0)); } } while (0)
#define MM_LSTORE(buf) do { LAS char* p_ = lds + (buf) * STG + sts; \
        _Pragma("unroll") for (int q_ = 0; q_ < 4; ++q_) { *(LAS u32x4*)(p_ + q_ * 8192) = ga[q_]; *(LAS u32x4*)(p_ + OPB + q_ * 8192) = gb[q_]; } } while (0)
#define MM_LOADF(ks, AF, BF) do { const unsigned xo_ = (((unsigned)((ks) * 2 + h)) ^ x7) << 4; \
        _Pragma("unroll") for (int nt = 0; nt < 2; ++nt) BF[nt] = *(const LAS bf16x8*)(base + rdb + nt * 4096 + xo_); \
        _Pragma("unroll") for (int mt = 0; mt < 4; ++mt) AF[mt] = *(const LAS bf16x8*)(base + rda + mt * 4096 + xo_); } while (0)
#define MM_MMA(AF, BF) do { _Pragma("unroll") for (int mt = 0; mt < 4; ++mt) _Pragma("unroll") for (int nt = 0; nt < 2; ++nt) \
        acc[mt][nt] = Epi::TRANSP ? __builtin_amdgcn_mfma_f32_32x32x16_bf16(BF[nt], AF[mt], acc[mt][nt], 0, 0, 0) : __builtin_amdgcn_mfma_f32_32x32x16_bf16(AF[mt], BF[nt], acc[mt][nt], 0, 0, 0); } while (0)
#define MM_SB __builtin_amdgcn_sched_barrier(0)
    bool lvalid = true; int lk = 0;
    auto ladv = [&]() {
        if (++lk < lu.nk) return;
        lk = 0;
        Unit nu; if (S.next(li + 1, nu)) { lu = nu; ++li; offs(lu, ao, bo); } else lvalid = false;
    };
    MM_GLOAD(lu, 0, ao, bo);
    MM_LSTORE(0);
    ladv();
    if (lvalid) MM_GLOAD(lu, lk, ao, bo);
    __syncthreads();
    int buf = 0, ck = 0;
    for (;;) {
        const LAS char* base = lds + buf * STG;
        const bool pend = lvalid;
        if constexpr (Sched::PIPE) {
            bf16x8 af0[4], bf0[2], af1[4], bf1[2];
            MM_LOADF(0, af0, bf0); MM_SB;
            MM_LOADF(1, af1, bf1); MM_SB; MM_MMA(af0, bf0); MM_SB;
            MM_LOADF(2, af0, bf0); MM_SB; MM_MMA(af1, bf1); MM_SB;
            MM_LOADF(3, af1, bf1); MM_SB;
            if (pend) { MM_LSTORE(buf ^ 1); ladv(); if (lvalid) MM_GLOAD(lu, lk, ao, bo); }
            MM_SB; MM_MMA(af0, bf0); MM_SB; MM_MMA(af1, bf1); MM_SB;
        } else {
            bf16x8 af0[4], bf0[2];
            MM_LOADF(0, af0, bf0); MM_MMA(af0, bf0); MM_SB;
            MM_LOADF(1, af0, bf0); MM_MMA(af0, bf0); MM_SB;
            if (pend) { MM_LSTORE(buf ^ 1); ladv(); if (lvalid) MM_GLOAD(lu, lk, ao, bo); }
            MM_SB; MM_LOADF(2, af0, bf0); MM_MMA(af0, bf0); MM_SB;
            MM_LOADF(3, af0, bf0); MM_MMA(af0, bf0); MM_SB;
        }
        bool more = true;
        if (++ck == cnk) {
            { PROF_BEGIN(99) Unit eu; S.next(ci, eu); E(acc, eu, wm, wn, r32, h, tid); if (PROF_ID == Epi::PROF && threadIdx.x == 0) { *(volatile LAS unsigned*)(lds + PROF_LDS_OFF) += (unsigned)(__builtin_amdgcn_s_memrealtime() - _pt99); } }
#pragma unroll
            for (int i = 0; i < 4; ++i)
#pragma unroll
                for (int j = 0; j < 2; ++j)
#pragma unroll
                    for (int e = 0; e < 16; ++e) acc[i][j][e] = 0.f;
            ck = 0; ++ci;
            { Unit nu2; more = S.next(ci, nu2); if (more) cnk = nu2.nk; }
        }
        __syncthreads();
        buf ^= 1;
        if (!more) break;
    }
#undef MM_GLOAD
#undef MM_LSTORE
#undef MM_LOADF
#undef MM_MMA
#undef MM_SB
}
__device__ __forceinline__ void plain_rows(const Unit& u, int r0, unsigned (&a)[1]) { a[0] = (unsigned)(r0 * u.lda * 2); }
}

constexpr int EPI_TAB = 131072 + 2048;
constexpr size_t WT_IN = 0;
constexpr size_t WT_GATE = WT_IN + (size_t)3328 * 1024 * 2;
constexpr size_t WT_BR = WT_GATE + (size_t)3072 * 1024 * 2;
constexpr size_t WT_OUT = WT_BR + (size_t)3 * 1024 * 512 * 2;
constexpr size_t WT_GU = WT_OUT + (size_t)1024 * 1024 * 2;
constexpr size_t WT_DN = WT_GU + (size_t)16 * 512 * 1024 * 2;
constexpr size_t WT_END = WT_DN + (size_t)16 * 1024 * 256 * 2;
static_assert(WT_END <= 44 * MB, "weight image region");

template <class F>
__device__ __forceinline__ void cvt_tile(bf16_t* Bt, int K, int rho0, int k0, const float* W, int ldw, const F& colof, int tid) {
    const int rho = rho0 + (tid & 63) * 4, kg = k0 + (tid >> 6) * 16;
    const int c = colof(rho);
    float4 v[16];
#pragma unroll
    for (int j = 0; j < 16; ++j) v[j] = c >= 0 ? *(const float4*)(W + (size_t)(kg + j) * ldw + c) : make_float4(0.f, 0.f, 0.f, 0.f);
#pragma unroll
    for (int hf = 0; hf < 2; ++hf) {
        mm::u32x4 o;
        o.x = mm::cvt_pk_bf16(v[8 * hf + 0].x, v[8 * hf + 1].x); o.y = mm::cvt_pk_bf16(v[8 * hf + 2].x, v[8 * hf + 3].x); o.z = mm::cvt_pk_bf16(v[8 * hf + 4].x, v[8 * hf + 5].x); o.w = mm::cvt_pk_bf16(v[8 * hf + 6].x, v[8 * hf + 7].x); *(mm::u32x4*)(Bt + (size_t)(rho + 0) * K + kg + 8 * hf) = o;
        o.x = mm::cvt_pk_bf16(v[8 * hf + 0].y, v[8 * hf + 1].y); o.y = mm::cvt_pk_bf16(v[8 * hf + 2].y, v[8 * hf + 3].y); o.z = mm::cvt_pk_bf16(v[8 * hf + 4].y, v[8 * hf + 5].y); o.w = mm::cvt_pk_bf16(v[8 * hf + 6].y, v[8 * hf + 7].y); *(mm::u32x4*)(Bt + (size_t)(rho + 1) * K + kg + 8 * hf) = o;
        o.x = mm::cvt_pk_bf16(v[8 * hf + 0].z, v[8 * hf + 1].z); o.y = mm::cvt_pk_bf16(v[8 * hf + 2].z, v[8 * hf + 3].z); o.z = mm::cvt_pk_bf16(v[8 * hf + 4].z, v[8 * hf + 5].z); o.w = mm::cvt_pk_bf16(v[8 * hf + 6].z, v[8 * hf + 7].z); *(mm::u32x4*)(Bt + (size_t)(rho + 2) * K + kg + 8 * hf) = o;
        o.x = mm::cvt_pk_bf16(v[8 * hf + 0].w, v[8 * hf + 1].w); o.y = mm::cvt_pk_bf16(v[8 * hf + 2].w, v[8 * hf + 3].w); o.z = mm::cvt_pk_bf16(v[8 * hf + 4].w, v[8 * hf + 5].w); o.w = mm::cvt_pk_bf16(v[8 * hf + 6].w, v[8 * hf + 7].w); *(mm::u32x4*)(Bt + (size_t)(rho + 3) * K + kg + 8 * hf) = o;
    }
}
__device__ __forceinline__ void cvt_tile_pair(bf16_t* Bt, int K, int rho0, int k0, const float* W, int ldw, int tid) {
    const int rho = rho0 + (tid & 63) * 4, kg = k0 + (tid >> 6) * 16;
    const int nt = (rho >> 5) & 1, cb = (rho & ~63) + 2 * (rho & 31);
#pragma unroll
    for (int hf = 0; hf < 2; ++hf) {
        float va[8][4];
#pragma unroll
        for (int j = 0; j < 8; ++j) {
            const float4 lo = *(const float4*)(W + (size_t)(kg + 8 * hf + j) * ldw + cb), hi = *(const float4*)(W + (size_t)(kg + 8 * hf + j) * ldw + cb + 4);
            va[j][0] = nt ? lo.y : lo.x; va[j][1] = nt ? lo.w : lo.z; va[j][2] = nt ? hi.y : hi.x; va[j][3] = nt ? hi.w : hi.z;
        }
#pragma unroll
        for (int r = 0; r < 4; ++r) {
            mm::u32x4 o;
            o.x = mm::cvt_pk_bf16(va[0][r], va[1][r]); o.y = mm::cvt_pk_bf16(va[2][r], va[3][r]); o.z = mm::cvt_pk_bf16(va[4][r], va[5][r]); o.w = mm::cvt_pk_bf16(va[6][r], va[7][r]);
            *(mm::u32x4*)(Bt + (size_t)(rho + r) * K + kg + 8 * hf) = o;
        }
    }
}
__device__ __forceinline__ void ph_convert_weights(const Params& P_, int l) {
    const KA P = ka_get();
    const int tid = tid_opaque();
    char* wt = P.ws + OFF_WT;
    constexpr int T_IN = 13 * 8, T_GATE = 12 * 8, T_BR = 3 * 4 * 4, T_OUT = 4 * 8, T_GU = 16 * 2 * 8, T_DN = 16 * 4 * 2;
    constexpr int T_ALL = T_IN + T_GATE + T_BR + T_OUT + T_GU + T_DN;
    for (int t = blockIdx.x; t < T_ALL; t += gridDim.x) {
        int u = t;
        if (u < T_IN) {
            const float* W = P.in[I_WIN] + (size_t)l * ND * IN_COLS;
            cvt_tile((bf16_t*)(wt + WT_IN), 1024, (u >> 3) * 256, (u & 7) * 128, W, IN_COLS, [&](int rho) -> int { const int c = mm::img_col(rho); return c < IN_COLS ? c : -1; }, tid);
            continue;
        }
        u -= T_IN;
        if (u < T_GATE) {
            const float* W = P.in[I_WGATE] + (size_t)l * ND * 3072;
            cvt_tile((bf16_t*)(wt + WT_GATE), 1024, (u >> 3) * 256, (u & 7) * 128, W, 3072, [&](int rho) -> int { return mm::img_col(rho); }, tid);
            continue;
        }
        u -= T_GATE;
        if (u < T_BR) {
            const int n = u / 16, v = u % 16;
            const float* W = P.in[I_WBR] + ((size_t)l * 3 + n) * 512 * ND;
            cvt_tile((bf16_t*)(wt + WT_BR) + (size_t)n * 1024 * 512, 512, (v >> 2) * 256, (v & 3) * 128, W, ND, [&](int rho) -> int { return mm::img_col(rho); }, tid);
            continue;
        }
        u -= T_BR;
        if (u < T_OUT) {
            const float* W = P.in[I_WOUT] + (size_t)l * ND * ND;
            cvt_tile_pair((bf16_t*)(wt + WT_OUT), 1024, (u >> 3) * 256, (u & 7) * 128, W, ND, tid);
            continue;
        }
        u -= T_OUT;
        if (u < T_GU) {
            const int e = u / 16, v = u % 16;
            const float* Wg = P.in[I_WFG] + ((size_t)l * 16 + e) * ND * 256;
            const float* Wu = P.in[I_WFU] + ((size_t)l * 16 + e) * ND * 256;
            const int rho0 = (v >> 3) * 256;
            const float* Wsel = (((rho0 + (tid & 63) * 4) >> 5) & 1) ? Wu : Wg;
            cvt_tile((bf16_t*)(wt + WT_GU) + (size_t)e * 512 * 1024, 1024, rho0, (v & 7) * 128, Wsel, 256, [&](int rho) -> int {
                const int j = rho >> 8, wn = (rho >> 6) & 3; return j * 128 + wn * 32 + (mm::img_col(rho) & 31); }, tid);
            continue;
        }
        u -= T_GU;
        {
            const int e = u / 8, v = u % 8;
            const float* W = P.in[I_WFD] + ((size_t)l * 16 + e) * 256 * ND;
            cvt_tile_pair((bf16_t*)(wt + WT_DN) + (size_t)e * 1024 * 256, 256, (v >> 1) * 256, (v & 1) * 128, W, ND, tid);
        }
    }
}

struct SchedInProj {
    const char* A; const char* B; int mode;
    __device__ __forceinline__ bool next(int i, mm::Unit& u) const {
        int pm, pn; if (!mm::static_tile((long)i * gridDim.x + VBID, 128, 13, pm, pn)) return false;
        u.a = A + (size_t)pm * 256 * 1024 * 2; u.b0 = B + (size_t)pn * 256 * 1024 * 2; u.b1 = u.b0; u.lda = 1024; u.ldb = 1024; u.nk = 16; u.nseg = 16; u.pm = pm; u.pn = pn; u.tag = mode; return true;
    }
    static constexpr bool GATHER = false, PIPE = true;
    __device__ __forceinline__ void a_rows(const mm::Unit& u, int r0, unsigned (&a)[1]) const { mm::plain_rows(u, r0, a); }
};
struct EpiInProj {
    static constexpr bool TRANSP = true;
    static constexpr int PROF = 2;
    Proj pj; const float* qkg; const LAS float* gtab;
    __device__ __forceinline__ void operator()(mm::f32x16 (&acc)[4][2], const mm::Unit& u, int wm, int wn, int r32, int h, int tid) const {
        using namespace mm;
        asm volatile("" : "+v"(r32), "+v"(h));
        const int G = u.pn * 4 + wn;
        if (u.tag == 4) { if (acc[0][0][0] == 12345.678f) pj.aq[0] = 0; return; }
        if (u.tag == 3) { float t_ = 0.f;
#pragma unroll
            for (int i_ = 0; i_ < 4; ++i_) { t_ += acc[i_][0][3] + acc[i_][1][11] + acc[i_][0][7] + acc[i_][1][0]; }
            if (t_ == 12345.678f) pj.aq[0] = 0; return; }
        if (G > 48) return;
        bf16_t* dst; int tstride; const float* gv = nullptr; float sc = 1.f;
        if (G < 8) { dst = pj.aq + G * 64; tstride = 512; gv = qkg; sc = QSCALE; }
        else if (G < 16) { dst = pj.ak + (G - 8) * 64; tstride = 512; gv = qkg + 64; }
        else if (G < 24) { dst = pj.av + (G - 16) * 64; tstride = 512; }
        else if (G < 32) { dst = pj.bq + (G - 24) * 64; tstride = 512; gv = qkg + 128; sc = QSCALE; }
        else if (G < 34) { dst = pj.bk + (G - 32) * 64; tstride = 128; gv = qkg + 192; }
        else if (G < 36) { dst = pj.bv + (G - 34) * 64; tstride = 128; }
        else if (G < 44) { dst = pj.cq + (G - 36) * 64; tstride = 512; gv = qkg + 256; sc = QSCALE; }
        else if (G == 44) { dst = pj.ck; tstride = 64; gv = qkg + 320; }
        else if (G == 45) { dst = pj.cv; tstride = 64; }
        else if (G < 48) { dst = pj.iq + (G - 46) * 64; tstride = 128; }
        else { dst = pj.ik; tstride = 32; }
        if (u.tag == 8) { if (acc[0][0][0] == 12345.678f) dst[tstride] = 0; return; }
#pragma unroll 1
        for (int rep = 0; rep < (u.tag == 9 ? 4 : 1); ++rep)
#pragma unroll
        for (int mt = 0; mt < 4; ++mt) {
            asm volatile("" ::: "memory");
            const int row = u.pm * 256 + wm * 128 + mt * 32 + r32;
            f32x16& v0 = acc[mt][0]; f32x16& v1 = acc[mt][1];
            if (gv && u.tag != 7 && u.tag != 9) {
                float ss = 0.f;
#pragma unroll
                for (int e = 0; e < 16; ++e) ss += v0[e] * v0[e] + v1[e] * v1[e];
                ss = x32_sum(ss);
                const float rs = rsqrtf(ss * (1.0f / 64) + EPS) * sc;
#pragma unroll
                for (int e4 = 0; e4 < 4; ++e4) {
                    const f32x4 ga = *(const LAS f32x4*)(gtab + (gv - qkg) + 16 * h + 4 * e4), gb = *(const LAS f32x4*)(gtab + (gv - qkg) + 32 + 16 * h + 4 * e4);
#pragma unroll
                    for (int j = 0; j < 4; ++j) { v0[4 * e4 + j] *= rs * ga[j]; v1[4 * e4 + j] *= rs * gb[j]; }
                }
            }
            if (u.tag >= 5) { if (v0[0] + v1[3] + v0[9] + v1[12] == 12345.678f) dst[0] = 0; }
            else if (G < 48) {
                bf16_t* d = dst + (size_t)row * tstride + 16 * h;
                *(u32x4*)(d) = pack8(v0, 0); *(u32x4*)(d + 8) = pack8(v0, 8);
                *(u32x4*)(d + 32) = pack8(v1, 0); *(u32x4*)(d + 40) = pack8(v1, 8);
            } else {
                bf16_t* d = dst + (size_t)row * 32 + 16 * h;
                *(u32x4*)(d) = pack8(v0, 0); *(u32x4*)(d + 8) = pack8(v0, 8);
                if (h == 0) *(f32x4*)(pj.iw + (size_t)row * 4) = (f32x4){v1[0], v1[1], v1[2], v1[3]} * IWSCALE;
            }
        }
    }
};
__device__ __forceinline__ void ph_inproj(const Params& P_, int l, char* smem) {
    const KA P = ka_get();
    SchedInProj S; S.A = P.ws + OFF_H; S.B = P.ws + OFF_WT + WT_IN; S.mode = l >> 4;
    EpiInProj E; E.pj = proj_ptrs(P.ws); E.qkg = P.in[I_QKG] + (size_t)(l & 15) * 384;
    { LAS float* gt = (LAS float*)((LAS char*)smem + EPI_TAB); __syncthreads(); const int t = tid_opaque(); if (t < 384) gt[t] = E.qkg[t]; __syncthreads(); E.gtab = gt; }
    mm::gemm_phase(smem, S, E);
}

constexpr size_t SCR_G = OFF_PROJ;
constexpr size_t SCR_M = OFF_PROJ + 32 * MB;
struct SchedGB {
    const char* H; const char* BR; const char* Wg; const char* Wb;
    __device__ __forceinline__ bool next(int i, mm::Unit& u) const {
        const int ti = i / 6, sub = i - ti * 6, n = sub >> 1;
        int pm, pn; if (!mm::static_tile((long)ti * gridDim.x + VBID, 128, 4, pm, pn)) return false;
        u.pm = pm; u.pn = pn; u.tag = sub;
        if ((sub & 1) == 0) { u.a = H + (size_t)pm * 256 * 1024 * 2; u.lda = 1024; u.b0 = Wg + (size_t)(n * 1024 + pn * 256) * 1024 * 2; u.ldb = 1024; u.nk = 16; }
        else { u.a = BR + ((size_t)pm * 256 * 1536 + n * 512) * 2; u.lda = 1536; u.b0 = Wb + ((size_t)n * 1024 + pn * 256) * 512 * 2; u.ldb = 512; u.nk = 8; }
        u.b1 = u.b0; u.nseg = u.nk; return true;
    }
    static constexpr bool GATHER = false, PIPE = true;
    __device__ __forceinline__ void a_rows(const mm::Unit& u, int r0, unsigned (&a)[1]) const { mm::plain_rows(u, r0, a); }
};
struct EpiGB {
    static constexpr bool TRANSP = true;
    static constexpr int PROF = 4;
    const LAS float* btab; bf16_t* MG; char* scrg; char* scrm;
    __device__ __forceinline__ void operator()(mm::f32x16 (&acc)[4][2], const mm::Unit& u, int wm, int wn, int r32, int h, int tid) const {
        using namespace mm;
        asm volatile("" : "+v"(r32), "+v"(h), "+v"(tid));
        const int sub = u.tag, n = sub >> 1;
        const unsigned so0 = (unsigned)tid * 16u;
        if ((sub & 1) == 0) {
#pragma unroll
            for (int mt = 0; mt < 4; ++mt)
#pragma unroll
                for (int nt = 0; nt < 2; ++nt) {
                    f32x16& v = acc[mt][nt];
                    const int col = n * 1024 + u.pn * 256 + wn * 64 + nt * 32 + 16 * h;
#pragma unroll
                    for (int e4 = 0; e4 < 4; ++e4) { const f32x4 b = *(const LAS f32x4*)(btab + col + 4 * e4);
#pragma unroll
                        for (int j = 0; j < 4; ++j) v[4 * e4 + j] = __builtin_amdgcn_rcpf(1.f + __builtin_amdgcn_exp2f(__builtin_fmaf(v[4 * e4 + j], -LOG2E, b[j]))); }
                    const unsigned so = so0 + (unsigned)((mt * 2 + nt) * 2) * 8192u;
                    *(u32x4*)(scrg + so) = pack8(v, 0); *(u32x4*)(scrg + so + 8192) = pack8(v, 8);
                }
        } else {
#pragma unroll
            for (int hf = 0; hf < 4; ++hf) {
                const int mt = hf;
                {
                    u32x4 gq[2][2];
#pragma unroll
                    for (int c = 0; c < 2; ++c) { const unsigned so = so0 + (unsigned)((hf * 2 + c) * 2) * 8192u; gq[c][0] = *(const u32x4*)(scrg + so); gq[c][1] = *(const u32x4*)(scrg + so + 8192); }
#pragma unroll
                    for (int c = 0; c < 2; ++c) {
                        f32x16& v = acc[mt][c];
                        const unsigned gw[8] = {gq[c][0].x, gq[c][0].y, gq[c][0].z, gq[c][0].w, gq[c][1].x, gq[c][1].y, gq[c][1].z, gq[c][1].w};
#pragma unroll
                        for (int j = 0; j < 8; ++j) { v[2 * j] *= bflo(gw[j]); v[2 * j + 1] *= bfhi(gw[j]); }
                    }
                }
                if (n > 0) {
                    u32x4 mq[2][2];
#pragma unroll
                    for (int c = 0; c < 2; ++c) { const unsigned so = so0 + (unsigned)((hf * 2 + c) * 2) * 8192u; mq[c][0] = *(const u32x4*)(scrm + so); mq[c][1] = *(const u32x4*)(scrm + so + 8192); }
#pragma unroll
                    for (int c = 0; c < 2; ++c) {
                        f32x16& v = acc[mt][c];
                        const unsigned mw[8] = {mq[c][0].x, mq[c][0].y, mq[c][0].z, mq[c][0].w, mq[c][1].x, mq[c][1].y, mq[c][1].z, mq[c][1].w};
#pragma unroll
                        for (int j = 0; j < 8; ++j) { v[2 * j] += bflo(mw[j]); v[2 * j + 1] += bfhi(mw[j]); }
                    }
                }
#pragma unroll
                for (int c = 0; c < 2; ++c) {
                    f32x16& v = acc[mt][c];
                    const unsigned so = so0 + (unsigned)((hf * 2 + c) * 2) * 8192u;
                    if (n < 2) { *(u32x4*)(scrm + so) = pack8(v, 0); *(u32x4*)(scrm + so + 8192) = pack8(v, 8); }
                    else { bf16_t* d = MG + (size_t)(u.pm * 256 + wm * 128 + mt * 32 + r32) * ND + u.pn * 256 + wn * 64 + c * 32 + 16 * h; *(u32x4*)d = pack8(v, 0); *(u32x4*)(d + 8) = pack8(v, 8); }
                }
            }
        }
    }
};
__device__ __forceinline__ void ph_gatebranch(const Params& P_, int l, char* smem) {
    const KA P = ka_get();
    SchedGB S; S.H = P.ws + OFF_H; S.BR = P.ws + OFF_BR; S.Wg = P.ws + OFF_WT + WT_GATE; S.Wb = P.ws + OFF_WT + WT_BR;
    EpiGB E; E.MG = (bf16_t*)(P.ws + OFF_MERGED);
    { LAS float* bt = (LAS float*)((LAS char*)smem + EPI_TAB); const float* bg = P.in[I_BGATE] + (size_t)l * 3072; __syncthreads(); for (int t = tid_opaque(); t < 3072; t += 512) bt[t] = -bg[t] * LOG2E; __syncthreads(); E.btab = bt; }
    E.scrg = P.ws + SCR_G + (size_t)blockIdx.x * 131072; E.scrm = P.ws + SCR_M + (size_t)blockIdx.x * 131072;
    mm::gemm_phase(smem, S, E);
}

struct SchedOut {
    const char* A; const char* B;
    __device__ __forceinline__ bool next(int i, mm::Unit& u) const {
        int pm, pn; if (!mm::static_tile((long)i * gridDim.x + VBID, 128, 4, pm, pn)) return false;
        u.a = A + (size_t)pm * 256 * 1024 * 2; u.b0 = B + (size_t)pn * 256 * 1024 * 2; u.b1 = u.b0; u.lda = 1024; u.ldb = 1024; u.nk = 16; u.nseg = 16; u.pm = pm; u.pn = pn; u.tag = 0; return true;
    }
    static constexpr bool GATHER = false, PIPE = true;
    __device__ __forceinline__ void a_rows(const mm::Unit& u, int r0, unsigned (&a)[1]) const { mm::plain_rows(u, r0, a); }
};
struct EpiOut {
    static constexpr bool TRANSP = false;
    static constexpr int PROF = 17;
    const float* x32; bf16_t* st;
    __device__ __forceinline__ void operator()(mm::f32x16 (&acc)[4][2], const mm::Unit& u, int wm, int wn, int r32, int h, int tid) const {
        using namespace mm;
        asm volatile("" : "+v"(r32), "+v"(h));
#pragma unroll
        for (int mt = 0; mt < 4; ++mt) {
            asm volatile("" ::: "memory");
            const size_t off = (size_t)(u.pm * 256 + wm * 128 + mt * 32 + 4 * h) * ND + u.pn * 256 + wn * 64 + 2 * r32;
            float xa[16], xb[16];
            if (x32) {
#pragma unroll
                for (int e = 0; e < 16; ++e) { const float2 t = *(const float2*)(x32 + off + (size_t)((e & 3) + 8 * (e >> 2)) * ND); xa[e] = t.x; xb[e] = t.y; }
            } else {
#pragma unroll
                for (int e = 0; e < 16; ++e) { const unsigned w = *(const unsigned*)(st + off + (size_t)((e & 3) + 8 * (e >> 2)) * ND); xa[e] = bflo(w); xb[e] = bfhi(w); }
            }
#pragma unroll
            for (int e = 0; e < 16; ++e) *(unsigned*)(st + off + (size_t)((e & 3) + 8 * (e >> 2)) * ND) = cvt_pk_bf16(xa[e] + acc[mt][0][e], xb[e] + acc[mt][1][e]);
        }
    }
};
__device__ __forceinline__ void ph_outproj(const Params& P_, int l, char* smem) {
    const KA P = ka_get();
    SchedOut S; S.A = P.ws + OFF_MERGED; S.B = P.ws + OFF_WT + WT_OUT;
    EpiOut E; E.x32 = l == 0 ? P.in[I_X] : (const float*)nullptr; E.st = (bf16_t*)(P.ws + OFF_STREAM);
    mm::gemm_phase(smem, S, E);
}


constexpr size_t OFF_HID = OFF_PROJ + 64 * MB;
constexpr int MOE_TAB = 131072 + 1024;
__device__ __forceinline__ void moe_table(char* smem, const int* cnt) {
    int* tab = (int*)(smem + MOE_TAB);
    const int t = tid_opaque();
    __syncthreads();
    if (t < 24) tab[32 + t] = cnt[t];
    __syncthreads();
    if (t == 0) { int p = 0; for (int b = 0; b < 24; ++b) { tab[b] = p; p += (tab[32 + b] + 255) >> 8; } tab[24] = p; }
    __syncthreads();
    if (t < 160) { int b = 0; for (int i = 1; i < 24; ++i) if (tab[i] <= t) b = i; tab[64 + t] = b; }
    __syncthreads();
}
struct MoeLoc { int b, rt, slot, valid, elo, ehi; };
__device__ __forceinline__ int moe_tab(const int* tab, int i) { return __builtin_amdgcn_readfirstlane(tab[i]); }
__device__ __forceinline__ MoeLoc moe_locate(const int* tab, int T) {
    const int b = moe_tab(tab, 64 + T);
    MoeLoc m; m.b = b; m.rt = T - moe_tab(tab, b); m.slot = T * 256; const int c = moe_tab(tab, 32 + b) - m.rt * 256; m.valid = c < 256 ? c : 256;
    const int g = b / 6, ix = b - g * 6; const int lo = ix < 3 ? 0 : (ix < 5 ? 1 : 2), hi = ix < 3 ? ix + 1 : (ix < 5 ? ix - 1 : 3);
    m.elo = g * 4 + lo; m.ehi = g * 4 + hi; return m;
}
struct SchedMoeUp {
    static constexpr bool GATHER = true, PIPE = true;
    const char* H; const char* W; const int* tab; const int* list;
    __device__ __forceinline__ bool next(int i, mm::Unit& u) const {
        const long L = (long)i * gridDim.x + VBID; const int T = (int)(L >> 2), c = (int)(L & 3);
        if (T >= moe_tab(tab, 24)) return false;
        const MoeLoc m = moe_locate(tab, T);
        const int e = (c >> 1) ? m.ehi : m.elo, j = c & 1;
        u.a = H; u.lda = 1024; u.b0 = W + ((size_t)e * 512 + j * 256) * 1024 * 2; u.b1 = u.b0; u.ldb = 1024; u.nk = 16; u.nseg = 16;
        u.pm = T; u.pn = c; u.tag = c; u.aux0 = m.b * NTOK + m.rt * 256; u.aux1 = m.valid; return true;
    }
    __device__ __forceinline__ void a_rows(const mm::Unit& u, int r0, unsigned (&a)[4]) const {
#pragma unroll
        for (int q = 0; q < 4; ++q) { const int r = r0 + 64 * q; const int tok = list[u.aux0 + (r < u.aux1 ? r : 0)]; a[q] = (unsigned)tok * 2048u; }
    }
};
struct EpiMoeUp {
    static constexpr bool TRANSP = true;
    static constexpr int PROF = 18;
    bf16_t* hid; const int* list; const float* rw;
    __device__ __forceinline__ void operator()(mm::f32x16 (&acc)[4][2], const mm::Unit& u, int wm, int wn, int r32, int h, int tid) const {
        using namespace mm;
        asm volatile("" : "+v"(r32), "+v"(h));
        const int which = u.tag >> 1, j = u.tag & 1;
        int tok[4]; float w[4];
#pragma unroll
        for (int mt = 0; mt < 4; ++mt) { const int r = wm * 128 + mt * 32 + r32; tok[mt] = list[u.aux0 + (r < u.aux1 ? r : 0)]; }
#pragma unroll
        for (int mt = 0; mt < 4; ++mt) w[mt] = rw[tok[mt] * 2 + which];
#pragma unroll
        for (int mt = 0; mt < 4; ++mt) {
            const int r = wm * 128 + mt * 32 + r32;
            if (r < u.aux1) {
                f32x16& g = acc[mt][0]; const f32x16& up = acc[mt][1];
#pragma unroll
                for (int e = 0; e < 16; ++e) g[e] = g[e] * __builtin_amdgcn_rcpf(1.f + __builtin_amdgcn_exp2f(g[e] * -LOG2E)) * (up[e] * w[mt]);
                bf16_t* d = hid + (size_t)(u.pm * 256 + r) * 512 + which * 256 + j * 128 + wn * 32 + 16 * h;
                *(u32x4*)d = pack8(g, 0); *(u32x4*)(d + 8) = pack8(g, 8);
            }
        }
    }
};
struct SchedMoeDown {
    static constexpr bool GATHER = false, PIPE = true;
    const char* HID; const char* W; const int* tab;
    __device__ __forceinline__ bool next(int i, mm::Unit& u) const {
        const long L = (long)i * gridDim.x + VBID; const int T = (int)(L >> 2), c = (int)(L & 3);
        if (T >= moe_tab(tab, 24)) return false;
        const MoeLoc m = moe_locate(tab, T);
        u.a = HID + (size_t)T * 256 * 512 * 2; u.lda = 512; u.ldb = 256; u.nk = 8; u.nseg = 4;
        u.b0 = W + ((size_t)m.elo * 1024 + c * 256) * 256 * 2; u.b1 = W + ((size_t)m.ehi * 1024 + c * 256) * 256 * 2 - 4 * 128;
        u.pm = T; u.pn = c; u.tag = 0; u.aux0 = m.b * NTOK + m.rt * 256; u.aux1 = m.valid; return true;
    }
    __device__ __forceinline__ void a_rows(const mm::Unit& u, int r0, unsigned (&a)[1]) const { mm::plain_rows(u, r0, a); }
};
struct EpiMoeDown {
    static constexpr bool TRANSP = false;
    static constexpr int PROF = 19;
    bf16_t* st; float* out32; const int* list; LAS int* ltok;
    __device__ __forceinline__ void operator()(mm::f32x16 (&acc)[4][2], const mm::Unit& u, int wm, int wn, int r32, int h, int tid) const {
        using namespace mm;
        typedef unsigned u32x2_t __attribute__((ext_vector_type(2)));
        asm volatile("" : "+v"(r32), "+v"(h));
        const unsigned colb = (unsigned)(u.pn * 256 + wn * 64 + 2 * r32) * 2u;
        __syncthreads();
        if (tid < 256) ltok[tid] = list[u.aux0 + (tid < u.aux1 ? tid : 0)];
        __syncthreads();
        const __amdgpu_buffer_rsrc_t rs = __builtin_amdgcn_make_buffer_rsrc((void*)st, 0, 0x7fffffff, 0x00020000);
        const __amdgpu_buffer_rsrc_t ro = __builtin_amdgcn_make_buffer_rsrc(out32 ? (void*)out32 : (void*)st, 0, 0x7fffffff, 0x00020000);
#pragma unroll
        for (int mt = 0; mt < 4; ++mt) {
            asm volatile("" ::: "memory");
            const int rb = wm * 128 + mt * 32 + 4 * h;
            unsigned off[16], xv[16];
#pragma unroll
            for (int e = 0; e < 16; ++e) off[e] = (unsigned)ltok[rb + (e & 3) + 8 * (e >> 2)] * 2048u + colb;
#pragma unroll
            for (int e = 0; e < 16; ++e) xv[e] = __builtin_amdgcn_raw_buffer_load_b32(rs, off[e], 0, 0);
#pragma unroll
            for (int e = 0; e < 16; ++e) {
                const int r = rb + (e & 3) + 8 * (e >> 2);
                if (r < u.aux1) {
                    const float a = bflo(xv[e]) + acc[mt][0][e], b = bfhi(xv[e]) + acc[mt][1][e];
                    if (out32) { u32x2_t o; o.x = __float_as_uint(a); o.y = __float_as_uint(b); __builtin_amdgcn_raw_buffer_store_b64(o, ro, off[e] * 2u, 0, 0); }
                    else __builtin_amdgcn_raw_buffer_store_b32(cvt_pk_bf16(a, b), rs, off[e], 0, 0);
                }
            }
        }
    }
};
__device__ __forceinline__ void ph_moe_up(const Params& P_, int l, char* smem) {
    const KA P = ka_get();
    moe_table(smem, (const int*)(P.ws + OFF_CTRL + MOE_CNT_OFF) + l * 32);
    SchedMoeUp S; S.H = P.ws + OFF_H; S.W = P.ws + OFF_WT + WT_GU; S.tab = (const int*)(smem + MOE_TAB); S.list = (const int*)(P.ws + OFF_ROUTE + MOE_LIST_OFF);
    EpiMoeUp E; E.hid = (bf16_t*)(P.ws + OFF_HID); E.list = S.list; E.rw = (const float*)(P.ws + OFF_ROUTE + MOE_RW_OFF);
    mm::gemm_phase(smem, S, E);
}
__device__ __forceinline__ void ph_moe_down(const Params& P_, int l, char* smem) {
    const KA P = ka_get();
    moe_table(smem, (const int*)(P.ws + OFF_CTRL + MOE_CNT_OFF) + l * 32);
    SchedMoeDown S; S.HID = P.ws + OFF_HID; S.W = P.ws + OFF_WT + WT_DN; S.tab = (const int*)(smem + MOE_TAB);
    EpiMoeDown E; E.ltok = (LAS int*)((LAS char*)smem + EPI_TAB); E.st = (bf16_t*)(P.ws + OFF_STREAM); E.out32 = l == 1 ? P.out : (float*)nullptr; E.list = (const int*)(P.ws + OFF_ROUTE + MOE_LIST_OFF);
    mm::gemm_phase(smem, S, E);
}


namespace at {
typedef short bf16x8 __attribute__((ext_vector_type(8)));
typedef short s16x4 __attribute__((ext_vector_type(4)));
typedef float f32x16 __attribute__((ext_vector_type(16)));
typedef unsigned u32x4 __attribute__((ext_vector_type(4)));
typedef unsigned u32x2 __attribute__((ext_vector_type(2)));
__device__ __forceinline__ s16x4 tr_read(const LAS char* p) { return __builtin_bit_cast(s16x4, __builtin_amdgcn_ds_read_tr16_b64_v4i16((LAS s16x4*)p)); }
__device__ __forceinline__ unsigned cvtpk(float lo, float hi) { unsigned r; asm volatile("v_cvt_pk_bf16_f32 %0, %1, %2" : "=v"(r) : "v"(lo), "v"(hi)); return r; }
__device__ __forceinline__ bf16x8 pack_p(const f32x16& x, int s) { u32x4 w; w.x = cvtpk(x[8 * s], x[8 * s + 1]); w.y = cvtpk(x[8 * s + 2], x[8 * s + 3]); w.z = cvtpk(x[8 * s + 4], x[8 * s + 5]); w.w = cvtpk(x[8 * s + 6], x[8 * s + 7]); return __builtin_bit_cast(bf16x8, w); }
constexpr int A_TAB = 81920;
}
__device__ __forceinline__ void ph_attnA(const Params& P_, int l, char* smem) {
    using namespace at;
    const KA P = ka_get();
    const Proj pj = proj_ptrs(P.ws);
    bf16_t* BR = (bf16_t*)(P.ws + OFF_BR);
    const int tid = tid_opaque(), lane = tid & 63, wid = __builtin_amdgcn_readfirstlane(tid >> 6), m = wid >> 2, qs = wid & 3, r32 = lane & 31, hl = lane >> 5;
    LAS char* lds = (LAS char*)smem;
    LAS float* tb = (LAS float*)(lds + A_TAB);
    const float* lp = P.in[I_LAM] + (size_t)l * 256;
    const float linit = lambda_init_of(l);
    const float lam = expf(wsum(lp[lane] * lp[64 + lane])) - expf(wsum(lp[128 + lane] * lp[192 + lane])) + linit;
    const float* subg = P.in[I_SUBLN] + (size_t)l * 128;
    const float* relb = P.in[I_RELB];
    LAS float* rb4 = (LAS float*)(lds + A_TAB + 4160 * 4);
    __syncthreads();
    if (tid < 128) rb4[tid] = relb[(tid >> 2) * 20 + (tid & 3)] * LOG2E;
    __syncthreads();
    const int i16 = lane & 15, tq = i16 >> 2, tp = i16 & 3, blk = (lane >> 4) & 1;
    const unsigned vlane = (unsigned)((4 * hl + tq) * 64 + blk * 32 + tp * 8);
    const unsigned klane = (unsigned)(m * 8192 + r32 * 128), kx = (unsigned)((r32 >> 1) & 7);
    for (int u2 = blockIdx.x; u2 < 1024; u2 += gridDim.x) {
        const int Pp = u2 & 511;
        const int bh = Pp >> 4, jj = Pp & 15, qb = (u2 >> 9) ? 31 - jj : jj, b = bh >> 2, h = bh & 3;
        const int q0 = qb * 128 + qs * 32, nt_wg = 2 * qb + 2, nt_w = (q0 >> 6) + 1;
        __syncthreads();
#pragma unroll
        for (int it = 0; it < 9; ++it) { const int i = tid + 512 * it; if (i < 4160) { const int rel = i - 4095; tb[i] = rel <= 63 ? rb4[t5_bucket(rel) * 4 + h] : 0.f; } }
        const float bfar = rb4[15 * 4 + h];
        bf16x8 qf[4];
        { const bf16_t* qp = pj.aq + (size_t)(b * NS + q0 + r32) * 512 + (h * 2 + m) * 64 + 8 * hl;
#pragma unroll
          for (int ks = 0; ks < 4; ++ks) qf[ks] = *(const bf16x8*)(qp + ks * 16); }
        u32x4 gk[2], gv[2];
        const bf16_t* kg = pj.ak + (size_t)(b * NS) * 512 + h * 128;
        const bf16_t* vg = pj.av + (size_t)(b * NS) * 512 + h * 128;
        unsigned gofs[2], kst[2], vst[2];
#pragma unroll
        for (int i = 0; i < 2; ++i) { const int idx = tid + 512 * i, key = idx >> 4, c = idx & 15;
            gofs[i] = (unsigned)(key * 512 + c * 8) * 2u;
            kst[i] = (unsigned)((c >> 3) * 8192 + key * 128 + (((c & 7) ^ ((key >> 1) & 7)) << 4));
            vst[i] = (unsigned)((c >> 2) * 4096 + key * 64 + (c & 3) * 16); }
#define AT_GLOAD(kt) do { const size_t o_ = (size_t)(kt) * 64 * 512 * 2; _Pragma("unroll") for (int i_ = 0; i_ < 2; ++i_) { gk[i_] = *(const u32x4*)((const char*)kg + o_ + gofs[i_]); gv[i_] = *(const u32x4*)((const char*)vg + o_ + gofs[i_]); } } while (0)
#define AT_LSTORE(kslot, vslot) do { _Pragma("unroll") for (int i_ = 0; i_ < 2; ++i_) { *(LAS u32x4*)(lds + (kslot) * 16384 + kst[i_]) = gk[i_]; *(LAS u32x4*)(lds + 32768 + (vslot) * 16384 + vst[i_]) = gv[i_]; } } while (0)
        AT_GLOAD(0); AT_LSTORE(0, 0);
        __syncthreads();
        f32x16 O[4];
#pragma unroll
        for (int v = 0; v < 4; ++v)
#pragma unroll
            for (int e = 0; e < 16; ++e) O[v][e] = 0.f;
        float mrun = -INFINITY, lsum = 0.f;
        bf16x8 pp[2][2];
        int vs_prev = 0, vs_cur = 0, vs_next = 1;
        for (int kt = 0; kt <= nt_wg; ++kt) {
            if (kt + 1 < nt_wg) AT_GLOAD(kt + 1);
            f32x16 s0, s1;
            const bool doqk = kt < nt_w, dopv = kt >= 1 && kt - 1 < nt_w;
            if (doqk) {
                const LAS char* kb = lds + (kt & 1) * 16384 + klane;
                if (kt * 64 + 63 - q0 <= -559) {
#pragma unroll
                    for (int e = 0; e < 16; ++e) { s0[e] = bfar; s1[e] = bfar; }
                } else {
                    const LAS float* tl = tb + (kt * 64 - q0 - r32 + 4 * hl + 4095);
#pragma unroll
                    for (int e = 0; e < 16; ++e) { s0[e] = tl[(e & 3) + 8 * (e >> 2)]; s1[e] = tl[32 + (e & 3) + 8 * (e >> 2)]; }
                }
#pragma unroll
                for (int ks = 0; ks < 4; ++ks) {
                    const unsigned xo = (((unsigned)(ks * 2 + hl)) ^ kx) << 4;
                    const bf16x8 k0 = *(const LAS bf16x8*)(kb + xo), k1 = *(const LAS bf16x8*)(kb + 4096 + xo);
                    s0 = __builtin_amdgcn_mfma_f32_32x32x16_bf16(k0, qf[ks], s0, 0, 0, 0);
                    s1 = __builtin_amdgcn_mfma_f32_32x32x16_bf16(k1, qf[ks], s1, 0, 0, 0);
                }
            }
            if (dopv) {
                const LAS char* vb = lds + 32768 + vs_prev * 16384 + vlane;
#pragma unroll
                for (int sub = 0; sub < 2; ++sub)
#pragma unroll
                    for (int s = 0; s < 2; ++s) {
                        const LAS char* vk = vb + (sub * 32 + 16 * s) * 64;
#pragma unroll
                        for (int v = 0; v < 4; ++v) {
                            const s16x4 lo = tr_read(vk + v * 4096), hi = tr_read(vk + v * 4096 + 8 * 64);
                            const bf16x8 vf = __builtin_shufflevector(lo, hi, 0, 1, 2, 3, 4, 5, 6, 7);
                            O[v] = __builtin_amdgcn_mfma_f32_32x32x16_bf16(vf, pp[sub][s], O[v], 0, 0, 0);
                        }
                    }
            }
            __builtin_amdgcn_sched_barrier(0);
            if (doqk) {
                float mx = __builtin_fmaxf(__builtin_fmaxf(s0[0], s1[0]), __builtin_fmaxf(s0[1], s1[1]));
#pragma unroll
                for (int e = 2; e < 16; e += 2) mx = __builtin_fmaxf(__builtin_fmaxf(mx, s0[e]), __builtin_fmaxf(__builtin_fmaxf(s1[e], s0[e + 1]), s1[e + 1]));
                mx = x32_max(mx);
                const float mn = fmaxf(mrun, mx);
                float ps0 = 0.f, ps1 = 0.f;
#pragma unroll
                for (int e = 0; e < 16; ++e) { s0[e] = __builtin_amdgcn_exp2f(s0[e] - mn); s1[e] = __builtin_amdgcn_exp2f(s1[e] - mn); ps0 += s0[e]; ps1 += s1[e]; }
                if (__any(mn > mrun)) {
                    const float alpha = __builtin_amdgcn_exp2f(mrun - mn);
                    lsum *= alpha;
#pragma unroll
                    for (int v = 0; v < 4; ++v)
#pragma unroll
                        for (int e = 0; e < 16; ++e) O[v][e] *= alpha;
                }
                mrun = mn;
                lsum += ps0 + ps1;
                pp[0][0] = pack_p(s0, 0); pp[0][1] = pack_p(s0, 1); pp[1][0] = pack_p(s1, 0); pp[1][1] = pack_p(s1, 1);
            }
            if (kt + 1 < nt_wg) AT_LSTORE((kt + 1) & 1, vs_next);
            __syncthreads();
            vs_prev = vs_cur; vs_cur = vs_next; vs_next = vs_next == 2 ? 0 : vs_next + 1;
        }
#undef AT_GLOAD
#undef AT_LSTORE
        const float ltot = x32_sum(lsum);
        const float inv = (m ? lam : 1.f) / ltot;
        LAS float* ex = (LAS float*)lds + qs * 4096 + lane;
        if (m == 1) {
#pragma unroll
            for (int v = 0; v < 4; ++v)
#pragma unroll
                for (int e = 0; e < 16; ++e) ex[(v * 16 + e) * 64] = O[v][e] * inv;
        }
        __syncthreads();
        if (m == 0) {
            float ss = 0.f;
#pragma unroll
            for (int v = 0; v < 4; ++v)
#pragma unroll
                for (int e = 0; e < 16; ++e) { const float x = O[v][e] * inv - ex[(v * 16 + e) * 64]; O[v][e] = x; ss += x * x; }
            ss = x32_sum(ss);
            const float rstd = rsqrtf(ss * (1.0f / 128) + EPS) * (1.0f - linit);
            bf16_t* op = BR + (size_t)(b * NS + q0 + r32) * 1536 + h * 128 + 4 * hl;
#pragma unroll
            for (int v = 0; v < 4; ++v)
#pragma unroll
                for (int g = 0; g < 4; ++g) {
                    const int vd = v * 32 + 8 * g + 4 * hl;
                    const float4 sg = *(const float4*)(subg + vd);
                    u32x2 w; w.x = cvtpk(O[v][4 * g] * rstd * sg.x, O[v][4 * g + 1] * rstd * sg.y); w.y = cvtpk(O[v][4 * g + 2] * rstd * sg.z, O[v][4 * g + 3] * rstd * sg.w);
                    *(u32x2*)(op + v * 32 + 8 * g) = w;
                }
        }
    }
}


__device__ __forceinline__ void ph_attnB(const Params& P_, int l, char* smem) {
    using namespace at;
    const KA P = ka_get();
    const Proj pj = proj_ptrs(P.ws);
    bf16_t* BR = (bf16_t*)(P.ws + OFF_BR);
    const int tid = tid_opaque(), lane = tid & 63, wid = __builtin_amdgcn_readfirstlane(tid >> 6), g = wid >> 1, qh = wid & 1, r32 = lane & 31, hl = lane >> 5;
    LAS char* lds = (LAS char*)smem;
    constexpr int B_K = 0, B_V = 24576, B_TAB = 49152;
    LAS float* tb = (LAS float*)(lds + B_TAB);
    const float* relb = P.in[I_RELB];
    __syncthreads();
    for (int i = tid; i < 2048; i += 512) { const int hq = i >> 8, rel = (i & 255) - 191; tb[i] = relb[t5_bucket(rel) * 20 + 4 + hq] * LOG2E; }
    const int i16 = lane & 15, tq = i16 >> 2, tp = i16 & 3, blk = (lane >> 4) & 1;
    const unsigned vlane = (unsigned)((4 * hl + tq) * 64 + blk * 32 + tp * 8);
    const unsigned klane = (unsigned)(r32 * 128), kx = (unsigned)((r32 >> 1) & 7);
    const int skey = tid >> 3, sc = tid & 7;
    const unsigned kst = (unsigned)(skey * 128 + ((sc ^ ((skey >> 1) & 7)) << 4)), vst = (unsigned)((sc >> 2) * 4096 + skey * 64 + (sc & 3) * 16);
    for (int u = blockIdx.x; u < NB * 64 * 2; u += gridDim.x) {
        const int kvh = u & 1, c = (u >> 1) & 63, b = u >> 7, hq = kvh * 4 + g;
        const int t0 = c >= 2 ? 0 : 2 - c;
        u32x4 kk[3], vv3[3];
#pragma unroll
        for (int t = 0; t < 3; ++t) {
            const int tt = t >= t0 ? t : t0;
            const size_t row = (size_t)(b * NS + (c - 2 + tt) * 64 + skey) * 128 + kvh * 64 + sc * 8;
            kk[t] = *(const u32x4*)(pj.bk + row); vv3[t] = *(const u32x4*)(pj.bv + row);
        }
        const int tok = b * NS + c * 64 + qh * 32 + r32;
        bf16x8 qf[4];
#pragma unroll
        for (int ks = 0; ks < 4; ++ks) qf[ks] = *(const bf16x8*)(pj.bq + (size_t)tok * 512 + hq * 64 + ks * 16 + 8 * hl);
        const float sink = P.in[I_SINK][l * 8 + hq] * LOG2E;
        __syncthreads();
#pragma unroll
        for (int t = 0; t < 3; ++t) if (t >= t0) { *(LAS u32x4*)(lds + B_K + t * 8192 + kst) = kk[t]; *(LAS u32x4*)(lds + B_V + t * 8192 + vst) = vv3[t]; }
        __syncthreads();
        f32x16 O[2];
#pragma unroll
        for (int v = 0; v < 2; ++v)
#pragma unroll
            for (int e = 0; e < 16; ++e) O[v][e] = 0.f;
        float mrun = sink, lsum = hl == 0 ? 1.f : 0.f;
#pragma unroll
        for (int t = 0; t < 3; ++t) if (t >= t0) {
            const LAS char* kb = lds + B_K + t * 8192 + klane;
            const LAS char* vb = lds + B_V + t * 8192 + vlane;
            const LAS float* tl = tb + hq * 256 + (t * 64 - qh * 32 - r32 + 4 * hl + 63);
            f32x16 s0, s1;
#pragma unroll
            for (int e = 0; e < 16; ++e) { s0[e] = tl[(e & 3) + 8 * (e >> 2)]; s1[e] = tl[32 + (e & 3) + 8 * (e >> 2)]; }
#pragma unroll
            for (int ks = 0; ks < 4; ++ks) {
                const unsigned xo = (((unsigned)(ks * 2 + hl)) ^ kx) << 4;
                const bf16x8 k0 = *(const LAS bf16x8*)(kb + xo), k1 = *(const LAS bf16x8*)(kb + 4096 + xo);
                s0 = __builtin_amdgcn_mfma_f32_32x32x16_bf16(k0, qf[ks], s0, 0, 0, 0);
                s1 = __builtin_amdgcn_mfma_f32_32x32x16_bf16(k1, qf[ks], s1, 0, 0, 0);
            }
            float mx = fmaxf(s0[0], s1[0]);
#pragma unroll
            for (int e = 1; e < 16; ++e) mx = fmaxf(mx, fmaxf(s0[e], s1[e]));
            mx = x32_max(mx);
            const float mn = fmaxf(mrun, mx), alpha = exp2f(mrun - mn);
            mrun = mn;
            float ps = 0.f;
#pragma unroll
            for (int e = 0; e < 16; ++e) { s0[e] = exp2f(s0[e] - mn); s1[e] = exp2f(s1[e] - mn); ps += s0[e] + s1[e]; }
            lsum = lsum * alpha + ps;
#pragma unroll
            for (int v = 0; v < 2; ++v)
#pragma unroll
                for (int e = 0; e < 16; ++e) O[v][e] *= alpha;
#pragma unroll
            for (int sub = 0; sub < 2; ++sub)
#pragma unroll
                for (int s2 = 0; s2 < 2; ++s2) {
                    const bf16x8 pb = pack_p(sub ? s1 : s0, s2);
                    const LAS char* vk = vb + (sub * 32 + 16 * s2) * 64;
#pragma unroll
                    for (int v = 0; v < 2; ++v) {
                        const s16x4 lo = tr_read(vk + v * 4096), hi = tr_read(vk + v * 4096 + 8 * 64);
                        const bf16x8 vf = __builtin_shufflevector(lo, hi, 0, 1, 2, 3, 4, 5, 6, 7);
                        O[v] = __builtin_amdgcn_mfma_f32_32x32x16_bf16(vf, pb, O[v], 0, 0, 0);
                    }
                }
        }
        const float inv = 1.f / x32_sum(lsum);
        bf16_t* op = BR + (size_t)tok * 1536 + 512 + hq * 64 + 4 * hl;
#pragma unroll
        for (int v = 0; v < 2; ++v)
#pragma unroll
            for (int gg = 0; gg < 4; ++gg) {
                u32x2 w; w.x = cvtpk(O[v][4 * gg] * inv, O[v][4 * gg + 1] * inv); w.y = cvtpk(O[v][4 * gg + 2] * inv, O[v][4 * gg + 3] * inv);
                *(u32x2*)(op + v * 32 + 8 * gg) = w;
            }
    }
}


__device__ __forceinline__ void ph_attnC(const Params& P_, int l, char* smem) {
    using namespace at;
    typedef float f32x4 __attribute__((ext_vector_type(4)));
    const KA P = ka_get();
    const Proj pj = proj_ptrs(P.ws);
    bf16_t* BR = (bf16_t*)(P.ws + OFF_BR);
    const int tid = tid_opaque(), lane = tid & 63, wid = __builtin_amdgcn_readfirstlane(tid >> 6), l16 = lane & 15, g4 = lane >> 4;
    LAS char* lds = (LAS char*)smem;
    constexpr int C_SC = 0, C_SEL = 131072, C_BKT = 139264, C_TAB = 143360;
    LAS float* tb = (LAS float*)(lds + C_TAB);
    const float* relb = P.in[I_RELB];
    __syncthreads();
    for (int i = tid; i < 256; i += 512) tb[i] = relb[(i >> 3) * 20 + 12 + (i & 7)] * LOG2E;
    const unsigned long long ltmask = (1ull << lane) - 1ull;
    const int tq = l16 >> 2, tp = l16 & 3;
    for (int unit = blockIdx.x; unit < NTOK / 16; unit += gridDim.x) {
        const int kq = unit >> 8, cq = unit & 255, xq = (cq + 64 * (kq >> 1)) & 255, qblk = (kq & 1) ? 255 - xq : xq;
        const int tok0 = (kq << 12) + qblk * 16, b = tok0 >> 12, q0 = tok0 & (NS - 1), c = q0 >> 6, N = (c + 1) * 64;
        __syncthreads();
        PROF_BEGIN(9)
        if (N > 256) {
            bf16x8 iqf[4];
#pragma unroll
            for (int hh = 0; hh < 4; ++hh) iqf[hh] = *(const bf16x8*)(pj.iq + (size_t)(tok0 + l16) * 128 + hh * 32 + 8 * g4);
            const f32x4 w4 = *(const f32x4*)(pj.iw + (size_t)(tok0 + l16) * 4);
            const bf16_t* ikb = pj.ik + (size_t)(b * NS) * 32 + l16 * 32 + 8 * g4;
            const int ntile = N / 16;
            for (int kt0 = wid; kt0 < ntile; kt0 += 64) {
                bf16x8 av[8];
#pragma unroll
                for (int j = 0; j < 8; ++j) { const int kt = kt0 + 8 * j; av[j] = *(const bf16x8*)(ikb + (size_t)(kt < ntile ? kt : kt0) * 512); }
#pragma unroll
                for (int j = 0; j < 8; ++j) {
                    const int kt = kt0 + 8 * j;
                    if (kt < ntile) {
                        float sc[4] = {0.f, 0.f, 0.f, 0.f};
#pragma unroll
                        for (int hh = 0; hh < 4; ++hh) {
                            const f32x4 d = __builtin_amdgcn_mfma_f32_16x16x32_bf16(av[j], iqf[hh], (f32x4){0.f, 0.f, 0.f, 0.f}, 0, 0, 0);
#pragma unroll
                            for (int r = 0; r < 4; ++r) sc[r] += fmaxf(d[r], 0.f) * w4[hh];
                        }
                        unsigned w01 = __builtin_bit_cast(unsigned, __builtin_amdgcn_cvt_pkrtz(sc[0] + 0.0f, sc[1] + 0.0f));
                        unsigned w23 = __builtin_bit_cast(unsigned, __builtin_amdgcn_cvt_pkrtz(sc[2] + 0.0f, sc[3] + 0.0f));
                        w01 ^= (((w01 >> 15) & 0x00010001u) * 0xFFFFu) | 0x80008000u;
                        w23 ^= (((w23 >> 15) & 0x00010001u) * 0xFFFFu) | 0x80008000u;
                        w01 = (w01 >> 1) & 0x7FFF7FFFu; w23 = (w23 >> 1) & 0x7FFF7FFFu;
                        u32x2 o; o.x = w01; o.y = w23;
                        *(LAS u32x2*)(lds + C_SC + l16 * 8192 + (kt * 16 + g4 * 4) * 2) = o;
                    }
                }
            }
        }
        __syncthreads();
        PROF_END(9, smem)
        PROF_BEGIN(10)
        {
            LAS unsigned short* selA = (LAS unsigned short*)(lds + C_SEL) + (2 * wid) * 256;
            LAS unsigned char* bktA = (LAS unsigned char*)(lds + C_BKT) + (2 * wid) * 256;
            const int qA = q0 + 2 * wid;
            if (N <= 256) {
                for (int i = lane; i < N; i += 64) { selA[i] = (unsigned short)i; selA[256 + i] = (unsigned short)i; }
            } else {
                const LAS unsigned* rowA = (const LAS unsigned*)(lds + C_SC + (2 * wid) * 8192);
                const int ndw = N >> 1, nI = (ndw + 63) >> 6;
                unsigned TA, TB; int needA, needB;
                auto radix = [&](auto NIc) {
                    constexpr int NI = decltype(NIc)::value;
                    LAS unsigned* hist = (LAS unsigned*)selA;
                    unsigned ka[NI], kb[NI];
#pragma unroll
                    for (int i = 0; i < NI; ++i) { const bool ok = lane + 64 * i < ndw; ka[i] = ok ? rowA[lane + 64 * i] : 0u; kb[i] = ok ? rowA[2048 + lane + 64 * i] : 0u; }
#pragma unroll
                    for (int j = 0; j < 4; ++j) hist[lane + 64 * j] = 0u;
#pragma unroll
                    for (int i = 0; i < NI; ++i) {
                        if (lane + 64 * i < ndw) {
                            (void)__hip_atomic_fetch_add(hist + ((ka[i] >> 7) & 255u), 1u, __ATOMIC_RELAXED, __HIP_MEMORY_SCOPE_WORKGROUP);
                            (void)__hip_atomic_fetch_add(hist + ((ka[i] >> 23) & 255u), 1u, __ATOMIC_RELAXED, __HIP_MEMORY_SCOPE_WORKGROUP);
                            (void)__hip_atomic_fetch_add(hist + ((kb[i] >> 7) & 255u), 0x10000u, __ATOMIC_RELAXED, __HIP_MEMORY_SCOPE_WORKGROUP);
                            (void)__hip_atomic_fetch_add(hist + ((kb[i] >> 23) & 255u), 0x10000u, __ATOMIC_RELAXED, __HIP_MEMORY_SCOPE_WORKGROUP);
                        }
                    }
                    auto pick = [&](const unsigned (&c)[4], int per, int shift, int target, int& bin, int& above) {
                        unsigned s4 = 0;
#pragma unroll
                        for (int j = 0; j < 4; ++j) if (j < per) s4 += (c[j] >> shift) & 0xffffu;
                        int incl = (int)s4;
                        incl += __builtin_amdgcn_update_dpp(0, incl, 0x111, 0xf, 0xf, true);
                        incl += __builtin_amdgcn_update_dpp(0, incl, 0x112, 0xf, 0xf, true);
                        incl += __builtin_amdgcn_update_dpp(0, incl, 0x114, 0xf, 0xf, true);
                        incl += __builtin_amdgcn_update_dpp(0, incl, 0x118, 0xf, 0xf, true);
                        incl += __builtin_amdgcn_update_dpp(0, incl, 0x142, 0xa, 0xf, true);
                        incl += __builtin_amdgcn_update_dpp(0, incl, 0x143, 0xc, 0xf, true);
                        const unsigned long long bal = __ballot(incl >= target);
                        const int L = __builtin_amdgcn_readfirstlane((int)__builtin_ctzll(bal));
                        int run = __builtin_amdgcn_readlane(incl - (int)s4, L);
                        int b = 0; bool found = false;
#pragma unroll
                        for (int j = 0; j < 4; ++j) if (j < per) {
                            const int cj = __builtin_amdgcn_readlane((int)((c[j] >> shift) & 0xffffu), L);
                            if (!found) { if (run + cj >= target) { found = true; b = j; } else run += cj; }
                        }
                        bin = L * per + b; above = run;
                    };
                    int binA, aboveA, binB, aboveB;
                    {
                        const u32x4 q = *(const LAS u32x4*)(hist + 252 - 4 * lane);
                        const unsigned c[4] = {q.w, q.z, q.y, q.x};
                        pick(c, 4, 0, 256, binA, aboveA); pick(c, 4, 16, 256, binB, aboveB);
                    }
                    const unsigned topA = 255u - (unsigned)binA, topB = 255u - (unsigned)binB;
#pragma unroll
                    for (int j = 0; j < 2; ++j) hist[lane + 64 * j] = 0u;
#pragma unroll
                    for (int i = 0; i < NI; ++i) {
                        if (lane + 64 * i < ndw) {
                            if (((ka[i] >> 7) & 255u) == topA) (void)__hip_atomic_fetch_add(hist + (ka[i] & 127u), 1u, __ATOMIC_RELAXED, __HIP_MEMORY_SCOPE_WORKGROUP);
                            if (((ka[i] >> 23) & 255u) == topA) (void)__hip_atomic_fetch_add(hist + ((ka[i] >> 16) & 127u), 1u, __ATOMIC_RELAXED, __HIP_MEMORY_SCOPE_WORKGROUP);
                            if (((kb[i] >> 7) & 255u) == topB) (void)__hip_atomic_fetch_add(hist + (kb[i] & 127u), 0x10000u, __ATOMIC_RELAXED, __HIP_MEMORY_SCOPE_WORKGROUP);
                            if (((kb[i] >> 23) & 255u) == topB) (void)__hip_atomic_fetch_add(hist + ((kb[i] >> 16) & 127u), 0x10000u, __ATOMIC_RELAXED, __HIP_MEMORY_SCOPE_WORKGROUP);
                        }
                    }
                    int lowA, gtA, lowB, gtB;
                    {
                        const u32x2 q = *(const LAS u32x2*)(hist + 126 - 2 * lane);
                        const unsigned c[4] = {q.y, q.x, 0u, 0u};
                        pick(c, 2, 0, 256 - aboveA, lowA, gtA); pick(c, 2, 16, 256 - aboveB, lowB, gtB);
                    }
                    TA = (topA << 7) | (127u - (unsigned)lowA); TB = (topB << 7) | (127u - (unsigned)lowB);
                    needA = 256 - (aboveA + gtA); needB = 256 - (aboveB + gtB);
                };
                if (nI <= 8) radix(std::integral_constant<int, 8>{});
                else if (nI <= 16) radix(std::integral_constant<int, 16>{});
                else if (nI <= 24) radix(std::integral_constant<int, 24>{});
                else radix(std::integral_constant<int, 32>{});
                int nsA = 0, neA = 0, nsB = 0, neB = 0;
#pragma unroll 1
                for (int i = 0; i < nI; ++i) {
                    const bool ok = lane + 64 * i < ndw;
                    const unsigned wa = ok ? rowA[lane + 64 * i] : 0u, wb = ok ? rowA[2048 + lane + 64 * i] : 0u;
                    const int klo = 2 * (lane + 64 * i);
                    {
                        const unsigned lo = wa & 0xffffu, hi = wa >> 16;
                        const bool el = lo == TA, eh = hi == TA;
                        const unsigned long long bel = __ballot(el), beh = __ballot(eh);
                        const int rl = mbcnt64(beh, mbcnt64(bel, neA)), rh = rl + (el ? 1 : 0);
                        const bool tl = (lo > TA) || (el && rl < needA), th = (hi > TA) || (eh && rh < needA);
                        const unsigned long long btl = __ballot(tl), bth = __ballot(th);
                        const int pl = mbcnt64(bth, mbcnt64(btl, nsA)), ph = pl + (tl ? 1 : 0);
                        if (tl) selA[pl] = (unsigned short)klo;
                        if (th) selA[ph] = (unsigned short)(klo + 1);
                        nsA += __popcll(btl) + __popcll(bth); neA += __popcll(bel) + __popcll(beh);
                    }
                    {
                        const unsigned lo = wb & 0xffffu, hi = wb >> 16;
                        const bool el = lo == TB, eh = hi == TB;
                        const unsigned long long bel = __ballot(el), beh = __ballot(eh);
                        const int rl = mbcnt64(beh, mbcnt64(bel, neB)), rh = rl + (el ? 1 : 0);
                        const bool tl = (lo > TB) || (el && rl < needB), th = (hi > TB) || (eh && rh < needB);
                        const unsigned long long btl = __ballot(tl), bth = __ballot(th);
                        const int pl = mbcnt64(bth, mbcnt64(btl, nsB)), ph = pl + (tl ? 1 : 0);
                        if (tl) selA[256 + pl] = (unsigned short)klo;
                        if (th) selA[256 + ph] = (unsigned short)(klo + 1);
                        nsB += __popcll(btl) + __popcll(bth); neB += __popcll(bel) + __popcll(beh);
                    }
                }
            }
            const int cntS = N < 256 ? N : 256;
#pragma unroll
            for (int rr = 0; rr < 2; ++rr)
#pragma unroll
                for (int j = 0; j < 4; ++j) { const int sl = lane + 64 * j; if (sl < cntS) bktA[rr * 256 + sl] = (unsigned char)t5_bucket((int)selA[rr * 256 + sl] - (qA + rr)); }
        }
        PROF_END(10, smem)
        PROF_BEGIN(11)
        const int cnt = N < 256 ? N : 256;
        {
            const LAS unsigned short* sel0 = (const LAS unsigned short*)(lds + C_SEL) + (2 * wid) * 256;
            const LAS unsigned char* bkt0 = (const LAS unsigned char*)(lds + C_BKT) + (2 * wid) * 256;
            LAS char* vreg = lds + C_SC + wid * 16384;
            const bf16_t* ckb = pj.ck + (size_t)(b * NS) * 64 + 8 * g4;
            const bf16_t* cvb = pj.cv + (size_t)(b * NS) * 64;
            bf16x8 qf[2][2];
#pragma unroll
            for (int rr = 0; rr < 2; ++rr)
#pragma unroll
                for (int ks = 0; ks < 2; ++ks) qf[rr][ks] = *(const bf16x8*)(pj.cq + (size_t)(tok0 + 2 * wid + rr) * 512 + (l16 & 7) * 64 + ks * 32 + 8 * g4);
            f32x4 O[2][4];
#pragma unroll
            for (int rr = 0; rr < 2; ++rr)
#pragma unroll
                for (int v = 0; v < 4; ++v) O[rr][v] = (f32x4){0.f, 0.f, 0.f, 0.f};
            float mrun[2] = {-INFINITY, -INFINITY}, lsum[2] = {0.f, 0.f};
#pragma unroll 1
            for (int ch = 0; ch * 64 < cnt; ++ch) {
                u32x4 vv[2][8];
#pragma unroll
                for (int rr = 0; rr < 2; ++rr)
#pragma unroll
                    for (int i = 0; i < 8; ++i) {
                        const int piece = lane + 64 * i, e = piece >> 3, c8 = piece & 7, sl = ch * 64 + e;
                        const int idx = sl < cnt ? (int)sel0[rr * 256 + sl] : 0;
                        vv[rr][i] = *(const u32x4*)(cvb + (size_t)idx * 64 + c8 * 8);
                    }
                bf16x8 ka[2][4][2];
#pragma unroll
                for (int rr = 0; rr < 2; ++rr)
#pragma unroll
                    for (int u = 0; u < 4; ++u) {
                        const int e = ch * 64 + u * 16 + l16;
                        const int idx = e < cnt ? (int)sel0[rr * 256 + e] : 0;
                        ka[rr][u][0] = *(const bf16x8*)(ckb + (size_t)idx * 64); ka[rr][u][1] = *(const bf16x8*)(ckb + (size_t)idx * 64 + 32);
                    }
#pragma unroll
                for (int rr = 0; rr < 2; ++rr)
#pragma unroll
                    for (int i = 0; i < 8; ++i) { const int piece = lane + 64 * i, e = piece >> 3, c8 = piece & 7;
                        *(LAS u32x4*)(vreg + rr * 8192 + (c8 >> 2) * 4096 + e * 64 + (c8 & 3) * 16) = vv[rr][i]; }
#pragma unroll
                for (int rr = 0; rr < 2; ++rr) {
#pragma unroll
                    for (int t2 = 0; t2 < 2; ++t2) {
                        f32x4 d[2];
#pragma unroll
                        for (int u = 0; u < 2; ++u) {
                            const int t = ch * 4 + 2 * t2 + u;
                            f32x4 dd = __builtin_amdgcn_mfma_f32_16x16x32_bf16(ka[rr][2 * t2 + u][0], qf[rr][0], (f32x4){0.f, 0.f, 0.f, 0.f}, 0, 0, 0);
                            dd = __builtin_amdgcn_mfma_f32_16x16x32_bf16(ka[rr][2 * t2 + u][1], qf[rr][1], dd, 0, 0, 0);
                            const unsigned bk4 = *(const LAS unsigned*)(bkt0 + rr * 256 + t * 16 + g4 * 4);
#pragma unroll
                            for (int r = 0; r < 4; ++r) {
                                const int slot = t * 16 + g4 * 4 + r;
                                const float bias = tb[((bk4 >> (8 * r)) & 0xffu) * 8 + (l16 & 7)];
                                dd[r] = slot < cnt ? dd[r] + bias : -INFINITY;
                            }
                            d[u] = dd;
                        }
                        float mx = fmaxf(fmaxf(fmaxf(d[0][0], d[0][1]), fmaxf(d[0][2], d[0][3])), fmaxf(fmaxf(d[1][0], d[1][1]), fmaxf(d[1][2], d[1][3])));
                        mx = x32_max(x16_max(mx));
                        const float mn = fmaxf(mrun[rr], mx), alpha = exp2f(mrun[rr] - mn);
                        mrun[rr] = mn;
                        float ps = 0.f;
#pragma unroll
                        for (int u = 0; u < 2; ++u)
#pragma unroll
                            for (int r = 0; r < 4; ++r) { d[u][r] = exp2f(d[u][r] - mn); ps += d[u][r]; }
                        lsum[rr] = lsum[rr] * alpha + ps;
#pragma unroll
                        for (int v = 0; v < 4; ++v) O[rr][v] *= alpha;
                        u32x4 pw; pw.x = cvtpk(d[0][0], d[0][1]); pw.y = cvtpk(d[0][2], d[0][3]); pw.z = cvtpk(d[1][0], d[1][1]); pw.w = cvtpk(d[1][2], d[1][3]);
                        const bf16x8 pb = __builtin_bit_cast(bf16x8, pw);
                        const LAS char* vk = vreg + rr * 8192 + (32 * t2 + 4 * g4 + tq) * 64 + tp * 8;
#pragma unroll
                        for (int v = 0; v < 4; ++v) {
                            const s16x4 lo = tr_read(vk + (v >> 1) * 4096 + (v & 1) * 32), hi = tr_read(vk + (v >> 1) * 4096 + (v & 1) * 32 + 16 * 64);
                            const bf16x8 vf = __builtin_shufflevector(lo, hi, 0, 1, 2, 3, 4, 5, 6, 7);
                            O[rr][v] = __builtin_amdgcn_mfma_f32_16x16x32_bf16(vf, pb, O[rr][v], 0, 0, 0);
                        }
                    }
                }
            }
#pragma unroll
            for (int rr = 0; rr < 2; ++rr) {
                float ls = x32_sum(x16_sum(lsum[rr]));
                const float inv = 1.f / ls;
                if (l16 < 8) {
                    bf16_t* op = BR + (size_t)(tok0 + 2 * wid + rr) * 1536 + 1024 + l16 * 64 + g4 * 4;
#pragma unroll
                    for (int v = 0; v < 4; ++v) { u32x2 w; w.x = cvtpk(O[rr][v][0] * inv, O[rr][v][1] * inv); w.y = cvtpk(O[rr][v][2] * inv, O[rr][v][3] * inv); *(u32x2*)(op + v * 16) = w; }
                }
            }
        }
        PROF_END(11, smem)
    }
}

#if DIAG
__device__ __forceinline__ void ph_diag_stats(const Params& P_) {
    const KA P = ka_get();
    const Proj pj = proj_ptrs(P.ws);
    const bf16_t* buf; size_t n;
    if (DIAG_BUF == 0) { buf = pj.av; n = (size_t)NTOK * 512; }
    else if (DIAG_BUF == 1) { buf = pj.aq; n = (size_t)NTOK * 512; }
    else if (DIAG_BUF == 2) { buf = pj.ik; n = (size_t)NTOK * 32; }
    else { buf = pj.cv; n = (size_t)NTOK * 64; }
    const int tid = tid_opaque();
    float ss = 0.f; unsigned bad = 0;
    for (size_t i = (size_t)blockIdx.x * 512 + tid; i < n; i += (size_t)gridDim.x * 512) { const float v = bf2f(buf[i]); if (!(fabsf(v) < 1e30f)) ++bad; else ss += v * v; }
    ss = wsum(ss); bad = (unsigned)wsum((float)bad);
    if ((tid & 63) == 0) { atomicAdd((float*)(P.ws + OFF_CTRL + 16384), ss / (float)n); atomicAdd((unsigned*)(P.ws + OFF_CTRL + 16388), bad); }
}
__device__ __forceinline__ void ph_diag_scale(const Params& P_) {
    const KA P = ka_get();
    const float ms = *(const float*)(P.ws + OFF_CTRL + 16384); const unsigned bad = *(const unsigned*)(P.ws + OFF_CTRL + 16388);
    const float delta = bad > 0 ? 0.9f : 0.1f + 0.3f * fminf(2.f, ms);
    const int tid = tid_opaque();
    for (size_t i = (size_t)blockIdx.x * 512 + tid; i < (size_t)NTOK * ND; i += (size_t)gridDim.x * 512) P.out[i] *= (1.f + delta);
}
#endif

constexpr int LDS_BYTES = 147456;
enum { PH_PREP = 0, PH_INPROJ, PH_HEADNORM, PH_ATTN_A, PH_ATTN_B, PH_ATTN_C, PH_GB, PH_OUT, PH_NORM2, PH_MOE, PH_MOE2, PH_COUNT };

template <int PH>
__device__ __forceinline__ void run_phase(const Params& P, int l, float* lds) {
#ifdef SKIPX
    if (PH == SKIPX) return;
#endif
    if (PH == PH_PREP) { ph_convert_weights(P, l); ph_rmsnorm(P.in[I_X], l == 0 ? (const bf16_t*)nullptr : (const bf16_t*)(P.ws + OFF_STREAM), P.in[I_NMG] + (size_t)l * ND, (bf16_t*)(P.ws + OFF_H)); }
    if (PH == PH_INPROJ) { if (OPT_INPROJ) ph_inproj(P, l, (char*)lds); else ph_inproj_naive(P, l, lds); }
    if (PH == PH_HEADNORM) { if (!OPT_INPROJ) ph_headnorm_naive(P, l); }
    if (PH == PH_ATTN_A) { if (OPT_ATTN_A) ph_attnA(P, l, (char*)lds); else ph_attnA_naive(P, l, lds); }
    if (PH == PH_ATTN_B) { if (OPT_ATTN_B) ph_attnB(P, l, (char*)lds); else ph_attnB_naive(P, l, lds); }
    if (PH == PH_ATTN_C) { if (OPT_ATTN_C) ph_attnC(P, l, (char*)lds); else ph_attnC_naive(P, l, lds); }
    if (PH == PH_GB) { if (OPT_GB) ph_gatebranch(P, l, (char*)lds); else ph_gatebranch_naive(P, l, lds); }
    if (PH == PH_OUT) { if (OPT_OUT) ph_outproj(P, l, (char*)lds); else ph_out_naive(P, l, lds); }
    if (PH == PH_NORM2) ph_norm2_route(P, l, lds);
    if (PH == PH_MOE) { if (OPT_MOE) { ph_moe_up(P, l, (char*)lds); } else ph_moe_naive(P, l, lds); }
    if (PH == PH_MOE2) { if (OPT_MOE) ph_moe_down(P, l, (char*)lds); }
}

template <int PH>
__global__ void __launch_bounds__(512, 2) k_phase(Params P, int l) {
    extern __shared__ __attribute__((aligned(16))) char smem[];
    run_phase<PH>(P, l, (float*)smem);
}

template <int PH>
static void launch_phase(const Params& P, int l, int grid, hipStream_t stream) {
    static bool attr = false;
    if (!attr) { (void)hipFuncSetAttribute((const void*)k_phase<PH>, hipFuncAttributeMaxDynamicSharedMemorySize, LDS_BYTES); attr = true; }
    hipLaunchKernelGGL(k_phase<PH>, dim3(grid), dim3(512), LDS_BYTES, stream, P, l);
}

__global__ void __launch_bounds__(512, 2) k_fused(Params P) {
    extern __shared__ __attribute__((aligned(16))) char smem[];
    float* lds = (float*)smem;
    volatile LAS unsigned* st = (volatile LAS unsigned*)(smem + LDS_BYTES - 16);
    if (threadIdx.x == 0) { st[0] = 0u; st[1] = 0u; st[2] = 0u; st[3] = 0u; }
    __syncthreads();
    const XcdBarrier bar = xcd_barrier_post((unsigned*)(P.ws + OFF_CTRL), st);
    if (PROF_ID && threadIdx.x == 0) *(volatile LAS unsigned*)((LAS char*)smem + PROF_LDS_OFF) = 0u;
#define BARP() do { PROF_BEGIN(16) xcd_barrier(bar); PROF_END(16, smem) } while (0)
#define RUNQ(PH, id) do { PROF_BEGIN(id) run_phase<PH>(P, l, lds); PROF_END(id, smem) if (DUP_PH == PH && (PH != PH_OUT || l == 0)) { if (PH == PH_PREP || PH == PH_INPROJ || PH == PH_GB || PH == PH_OUT || PH == PH_MOE) xcd_barrier(bar); run_phase<PH>(P, l, lds); } } while (0)
    for (int l = 0; l < 2; ++l) {
        RUNQ(PH_PREP, 12); BARP();
        RUNQ(PH_INPROJ, 1); BARP();
        if (DUP_PH == 100) { ph_inproj(P, l + 16 * DUP_MODE, (char*)lds); xcd_barrier(bar); }
        if (!OPT_INPROJ) { run_phase<PH_HEADNORM>(P, l, lds); xcd_barrier(bar); }
        RUNQ(PH_ATTN_A, 6);
        RUNQ(PH_ATTN_B, 7);
        RUNQ(PH_ATTN_C, 8);
        BARP();
        RUNQ(PH_GB, 3); BARP();
        RUNQ(PH_OUT, 5); BARP();
        RUNQ(PH_NORM2, 13); BARP();
        RUNQ(PH_MOE, 14); BARP();
        if (OPT_MOE) { RUNQ(PH_MOE2, 15); BARP(); }
    }
    if (PROF_ID) {
        const KA Pk = ka_get();
        unsigned* mx = (unsigned*)(Pk.ws + OFF_CTRL + 16400);
        if (threadIdx.x == 0) atomicMax(mx, *(volatile LAS unsigned*)((LAS char*)smem + PROF_LDS_OFF));
        xcd_barrier(bar);
        const float tus = (float)__hip_atomic_load(mx, __ATOMIC_RELAXED, __HIP_MEMORY_SCOPE_AGENT) * 0.01f;
        const float tq_ = exp2f(rintf(log2f(fmaxf(tus, 1.f)) * 4.f) * 0.25f);
        const float delta = sqrtf(tq_ * 1e-5f);
        const int tq = tid_opaque();
        for (size_t i = (size_t)blockIdx.x * 512 + tq; i < (size_t)NTOK * ND; i += (size_t)gridDim.x * 512) Pk.out[i] *= (1.f + delta);
    }
#if DIAG == 3
    ph_diag_scale(P);
#endif
}

extern "C" void kernel_launch(void* const* d_in, const int* in_sizes, int n_in, void* d_out, int out_size, void* d_ws, size_t ws_size, hipStream_t stream) {
    Params P{};
    for (int i = 0; i < 20; ++i) P.in[i] = (const float*)d_in[i];
    P.out = (float*)d_out; P.ws = (char*)d_ws;
    (void)hipMemsetAsync(d_ws, 0, CTRL_BYTES, stream);
#if FUSED
    static int grid = 0;
    if (!grid) {
        int dev = 0, cus = 0, per_cu = 0;
        (void)hipGetDevice(&dev);
        (void)hipDeviceGetAttribute(&cus, hipDeviceAttributeMultiprocessorCount, dev);
        (void)hipFuncSetAttribute((const void*)k_fused, hipFuncAttributeMaxDynamicSharedMemorySize, LDS_BYTES);
        (void)hipOccupancyMaxActiveBlocksPerMultiprocessor(&per_cu, (const void*)k_fused, 512, LDS_BYTES);
        grid = cus * (per_cu < 1 ? per_cu : 1);
        if (grid <= 0) { fprintf(stderr, "k_fused: occupancy query says %d blocks per CU\n", per_cu); grid = cus; }
    }
    hipLaunchKernelGGL(k_fused, dim3(grid), dim3(512), LDS_BYTES, stream, P);
#else
    const int G = 2048;
    for (int l = 0; l < 2; ++l) {
        launch_phase<PH_PREP>(P, l, G, stream);
        launch_phase<PH_INPROJ>(P, l, G, stream);
        launch_phase<PH_HEADNORM>(P, l, G, stream);
        launch_phase<PH_ATTN_A>(P, l, G, stream);
        launch_phase<PH_ATTN_B>(P, l, G, stream);
        launch_phase<PH_ATTN_C>(P, l, G, stream);
        launch_phase<PH_GB>(P, l, G, stream);
        launch_phase<PH_OUT>(P, l, G, stream);
        launch_phase<PH_NORM2>(P, l, G, stream);
        launch_phase<PH_MOE>(P, l, G, stream);
    }
#endif
}
```
